# Optimizing an MI355X kernel written in HIP

```python
import math
import jax, jax.numpy as jnp
from jax import lax
import numpy as np

D_MODEL = 1024
BATCH = 8
SEQ = 2048
DEPTH = 1

CHUNK = 64
Q_BLOCK = 128
EPS = 1e-6
N_HEADS_A = 8
HEAD_DIM_A = 64
KV_DIM_A = 64
ATTN_OUT = N_HEADS_A * KV_DIM_A
N_IDX_HEADS = 4
IDX_DIM = 64
TOPK_MAX = 256
LRU_WIDTH = 512
LRU_BLOCKS = 8
LRU_BLOCK_DIM = LRU_WIDTH // LRU_BLOCKS
CONV_WIDTH = 4
LRU_C = 8.0
N_GROUPS = 4
EXPERTS_PER_GROUP = 8
N_EXPERTS = N_GROUPS * EXPERTS_PER_GROUP
TOPK_IN_GROUP = 2
D_FF_EXPERT = 256
SPLITS = (N_HEADS_A * HEAD_DIM_A, KV_DIM_A, KV_DIM_A, N_IDX_HEADS * IDX_DIM, IDX_DIM, N_IDX_HEADS,
          LRU_WIDTH, LRU_WIDTH, D_MODEL, D_MODEL)
D_IN = sum(SPLITS)

kernel_name = "hybrid_dsa_rglru_hmoe_block"


def _split_offsets():
    return [int(o) for o in np.cumsum(SPLITS)[:-1]]


def rmsnorm(x, g):
    xf = x.astype(jnp.float32)
    y = xf * lax.rsqrt(jnp.mean(xf * xf, axis=-1, keepdims=True) + EPS)
    return (y * g.astype(jnp.float32)).astype(x.dtype)


def modulate(h, shift, scale):
    return h * (1.0 + scale[:, None, :]) + shift[:, None, :]


def alibi_slopes(n):
    return jnp.exp2(-8.0 * jnp.arange(1, n + 1, dtype=jnp.float32) / n)


def dsa_attention(q, k, v, q_idx, k_idx, w_idx, q_norm_w, k_norm_w):
    B, S = q.shape[0], q.shape[1]
    topk = min(TOPK_MAX, S // 4)
    n_blocks = S // Q_BLOCK
    q = rmsnorm(q, q_norm_w) * (HEAD_DIM_A ** -0.5)
    k = rmsnorm(k, k_norm_w)
    w_idx = w_idx * (N_IDX_HEADS ** -0.5 * IDX_DIM ** -0.5)
    slopes = alibi_slopes(N_HEADS_A)
    key_chunk = jnp.arange(S) // CHUNK
    gather = jax.vmap(lambda table, idx: table[idx])

    def block(i):
        start = i * Q_BLOCK
        qb = lax.dynamic_slice_in_dim(q, start, Q_BLOCK, axis=1)
        qib = lax.dynamic_slice_in_dim(q_idx, start, Q_BLOCK, axis=1)
        wb = lax.dynamic_slice_in_dim(w_idx, start, Q_BLOCK, axis=1)
        q_pos = start + jnp.arange(Q_BLOCK)
        q_chunk = q_pos // CHUNK
        admissible = key_chunk[None, :] <= q_chunk[:, None]
        rel = jax.nn.relu(jnp.einsum('bqhd,bsd->bqhs', qib, k_idx).astype(jnp.float32))
        score = jnp.einsum('bqhs,bqh->bqs', rel, wb.astype(jnp.float32))
        score = jnp.where(admissible[None], score, -jnp.inf)
        _, sel = lax.top_k(score, topk)
        k_sel = gather(k, sel)
        v_sel = gather(v, sel)
        logits = jnp.einsum('bqhd,bqkd->bqhk', qb, k_sel).astype(jnp.float32)
        dist = jnp.abs(q_pos[None, :, None] - sel).astype(jnp.float32)
        logits = logits - slopes[None, None, :, None] * dist[:, :, None, :]
        valid = (sel // CHUNK) <= q_chunk[None, :, None]
        logits = jnp.where(valid[:, :, None, :], logits, -jnp.inf)
        p = jax.nn.softmax(logits, axis=-1).astype(v.dtype)
        return jnp.einsum('bqhk,bqkd->bqhd', p, v_sel)

    out = lax.map(block, jnp.arange(n_blocks))
    return jnp.moveaxis(out, 0, 1).reshape(B, S, ATTN_OUT)


def rg_lru_branch(xb, gb, conv_w, conv_b, w_rec_gate, b_rec_gate, w_in_gate, b_in_gate, lam):
    B, S, W = xb.shape
    xpad = jnp.pad(xb, ((0, 0), (CONV_WIDTH - 1, 0), (0, 0)))
    xc = conv_b + xpad[:, 0:S] * conv_w[0]
    for j in range(1, CONV_WIDTH):
        xc = xc + xpad[:, j:j + S] * conv_w[j]
    xblk = xc.reshape(B, S, LRU_BLOCKS, LRU_BLOCK_DIM)
    r = jax.nn.sigmoid(jnp.einsum('bsnd,nde->bsne', xblk, w_rec_gate).reshape(B, S, W) + b_rec_gate)
    i = jax.nn.sigmoid(jnp.einsum('bsnd,nde->bsne', xblk, w_in_gate).reshape(B, S, W) + b_in_gate)
    log_a = -LRU_C * r.astype(jnp.float32) * jax.nn.softplus(-lam.astype(jnp.float32))
    a = jnp.exp(log_a)
    b = jnp.sqrt(-jnp.expm1(2.0 * log_a)) * (i * xc).astype(jnp.float32)

    def combine(left, right):
        a1, b1 = left
        a2, b2 = right
        return a1 * a2, a2 * b1 + b2

    _, h = lax.associative_scan(combine, (a, b), axis=1)
    return h.astype(xb.dtype) * jax.nn.gelu(gb)


def hierarchical_moe(h, w_group, b_group, w_expert_router, b_expert_router, w1, w3, w2):
    B, S, D = h.shape
    hf = h.reshape(B * S, D)
    g_logits = (hf @ w_group + b_group).astype(jnp.float32)
    g_prob = jax.nn.softmax(g_logits, axis=-1)
    g_sel = jnp.argmax(g_logits, axis=-1)
    g_weight = jnp.take_along_axis(g_prob, g_sel[:, None], axis=1)
    e_logits = (hf @ w_expert_router + b_expert_router).astype(jnp.float32)
    e_logits = e_logits.reshape(-1, N_GROUPS, EXPERTS_PER_GROUP)
    e_logits = jnp.take_along_axis(e_logits, g_sel[:, None, None], axis=1)[:, 0]
    top_val, top_idx = lax.top_k(e_logits, TOPK_IN_GROUP)
    top_w = jax.nn.softmax(top_val, axis=-1) * g_weight
    expert_id = g_sel[:, None] * EXPERTS_PER_GROUP + top_idx
    comb = jnp.sum(jax.nn.one_hot(expert_id, N_EXPERTS, dtype=jnp.float32) * top_w[..., None], axis=1)
    comb = comb.astype(hf.dtype)
    y = jnp.zeros_like(hf)
    for e in range(N_EXPERTS):
        act = jax.nn.silu(hf @ w1[e]) * (hf @ w3[e])
        y = y + comb[:, e:e + 1] * (act @ w2[e])
    return y.reshape(B, S, D)


def setup_inputs(seed: int = 0) -> dict:
    key = jax.random.key(seed)
    ks = jax.random.split(key, 32)
    f32 = jnp.float32
    nrm = lambda k, shape, scale: jax.random.normal(k, shape, f32) * scale
    L, D = DEPTH, D_MODEL
    u = jax.random.uniform(ks[15], (L, LRU_WIDTH), f32, minval=0.9, maxval=0.999)
    sp = -jnp.log(u) / LRU_C
    lru_lambda = -jnp.log(jnp.expm1(sp))
    return {
        "x": nrm(ks[0], (BATCH, SEQ, D), 1.0),
        "c": nrm(ks[1], (BATCH, D), 1.0),
        "ada_w": nrm(ks[2], (L, D, 6 * D), 0.5 * D ** -0.5),
        "ada_b": nrm(ks[3], (L, 6 * D), 0.01),
        "norm_mix_w": 1.0 + nrm(ks[4], (L, D), 0.02),
        "w_in": nrm(ks[5], (L, D, D_IN), D ** -0.5),
        "q_norm_w": 1.0 + nrm(ks[6], (L, HEAD_DIM_A), 0.02),
        "k_norm_w": 1.0 + nrm(ks[7], (L, KV_DIM_A), 0.02),
        "conv_w": nrm(ks[8], (L, CONV_WIDTH, LRU_WIDTH), CONV_WIDTH ** -0.5),
        "conv_b": nrm(ks[9], (L, LRU_WIDTH), 0.01),
        "w_rec_gate": nrm(ks[10], (L, LRU_BLOCKS, LRU_BLOCK_DIM, LRU_BLOCK_DIM), LRU_BLOCK_DIM ** -0.5),
        "b_rec_gate": nrm(ks[11], (L, LRU_WIDTH), 0.01),
        "w_in_gate": nrm(ks[12], (L, LRU_BLOCKS, LRU_BLOCK_DIM, LRU_BLOCK_DIM), LRU_BLOCK_DIM ** -0.5),
        "b_in_gate": nrm(ks[13], (L, LRU_WIDTH), 0.01),
        "lru_lambda": lru_lambda,
        "w_proj_a": nrm(ks[16], (L, ATTN_OUT, D), ATTN_OUT ** -0.5),
        "w_proj_b": nrm(ks[17], (L, LRU_WIDTH, D), LRU_WIDTH ** -0.5),
        "w_out": nrm(ks[18], (L, D, D), D ** -0.5),
        "norm_ffn_w": 1.0 + nrm(ks[19], (L, D), 0.02),
        "w_group": nrm(ks[20], (L, D, N_GROUPS), D ** -0.5),
        "b_group": nrm(ks[21], (L, N_GROUPS), 0.01),
        "w_expert_router": nrm(ks[22], (L, D, N_EXPERTS), D ** -0.5),
        "b_expert_router": nrm(ks[23], (L, N_EXPERTS), 0.01),
        "w1": nrm(ks[24], (L, N_EXPERTS, D, D_FF_EXPERT), D ** -0.5),
        "w3": nrm(ks[25], (L, N_EXPERTS, D, D_FF_EXPERT), D ** -0.5),
        "w2": nrm(ks[26], (L, N_EXPERTS, D_FF_EXPERT, D), D_FF_EXPERT ** -0.5),
    }


def reference(x, c, ada_w, ada_b, norm_mix_w, w_in, q_norm_w, k_norm_w, conv_w, conv_b,
              w_rec_gate, b_rec_gate, w_in_gate, b_in_gate, lru_lambda, w_proj_a, w_proj_b,
              w_out, norm_ffn_w, w_group, b_group, w_expert_router, b_expert_router, w1, w3, w2):
    B, S, _ = x.shape
    cond = jax.nn.silu(c)
    offsets = _split_offsets()
    for l in range(DEPTH):
        mod = cond @ ada_w[l] + ada_b[l]
        shift_m, scale_m, gate_m, shift_f, scale_f, gate_f = jnp.split(mod, 6, axis=-1)
        h = modulate(rmsnorm(x, norm_mix_w[l]), shift_m, scale_m)
        proj = h @ w_in[l]
        q, k, v, q_idx, k_idx, w_idx, lru_x, lru_g, gate_a, gate_b = jnp.split(proj, offsets, axis=-1)
        q = q.reshape(B, S, N_HEADS_A, HEAD_DIM_A)
        q_idx = q_idx.reshape(B, S, N_IDX_HEADS, IDX_DIM)
        y_a = dsa_attention(q, k, v, q_idx, k_idx, w_idx, q_norm_w[l], k_norm_w[l]) @ w_proj_a[l]
        y_b = rg_lru_branch(lru_x, lru_g, conv_w[l], conv_b[l], w_rec_gate[l], b_rec_gate[l],
                            w_in_gate[l], b_in_gate[l], lru_lambda[l]) @ w_proj_b[l]
        merged = jax.nn.sigmoid(gate_a) * y_a + jax.nn.sigmoid(gate_b) * y_b
        x = x + gate_m[:, None, :] * (merged @ w_out[l])
        h2 = modulate(rmsnorm(x, norm_ffn_w[l]), shift_f, scale_f)
        x = x + gate_f[:, None, :] * hierarchical_moe(h2, w_group[l], b_group[l], w_expert_router[l],
                                                      b_expert_router[l], w1[l], w3[l], w2[l])
    return x
```

```cpp
#include <hip/hip_runtime.h>
#include <cstdint>
#include <cstdio>

#ifndef MK_N_LAUNCHES
#define MK_N_LAUNCHES 10
#endif

#define LAS __attribute__((address_space(3)))
#define GAS __attribute__((address_space(1)))
typedef unsigned short bf16_t;
typedef short bf16x8 __attribute__((ext_vector_type(8)));
typedef float f32x4 __attribute__((ext_vector_type(4)));
typedef float f32x2 __attribute__((ext_vector_type(2)));
typedef unsigned u32x4 __attribute__((ext_vector_type(4)));
typedef unsigned u32x2 __attribute__((ext_vector_type(2)));
typedef GAS unsigned gu32;

constexpr int BATCH = 8, SEQ = 2048, DM = 1024, NTOK = BATCH * SEQ;
constexpr int NH = 8, HD = 64, NIH = 4, TOPK = 256, CHUNK = 64;
constexpr int LRUW = 512;
constexpr int NEXP = 32, NGRP = 4, EPG = 8, DFF = 256, NCLS = NGRP * 28;
constexpr int DIN_PAD = 4096;
constexpr float EPS = 1e-6f;
constexpr int C_Q = 0, C_K = 512, C_V = 576, C_QI = 640, C_KI = 896, C_LX = 960, C_LG = 1472, C_GA = 1984, C_GB = 3008, C_WI = 4032, C_END = 4036;

constexpr size_t MiB = 1u << 20;
constexpr size_t WS_CTL = 0, CTL_ZERO_BYTES = 1 * MiB;
constexpr size_t WS_MOD = 1 * MiB;
constexpr size_t WS_META = 1 * MiB + 512 * 1024;
constexpr size_t WS_WIN = 2 * MiB, WS_WPA = 10 * MiB, WS_WPB = 11 * MiB, WS_WOUT = 12 * MiB, WS_W13 = 14 * MiB, WS_W2 = 46 * MiB;
constexpr size_t WS_H = 64 * MiB;
constexpr size_t WS_AO = 64 * MiB, WS_LO = 80 * MiB;
constexpr size_t WS_Q = 96 * MiB, WS_QI = 112 * MiB, WS_K = 120 * MiB, WS_KI = 122 * MiB, WS_VT = 124 * MiB, WS_WI = 126 * MiB, WS_VR = 224 * MiB;
constexpr size_t WS_LX = 128 * MiB, WS_LG = 144 * MiB, WS_MG = 128 * MiB;
constexpr size_t WS_GA = 160 * MiB, WS_GB = 192 * MiB;
constexpr size_t WS_A1 = 64 * MiB;
constexpr size_t WS_H2T = 160 * MiB;
constexpr size_t WS_ACT2 = 192 * MiB;
constexpr size_t WS_DEST2 = 240 * MiB, WS_CW = 241 * MiB, WS_TOK2 = 242 * MiB;
constexpr size_t WS_END = 256 * MiB;
constexpr int CW_BAR = 4096, CW_CNTE = 8192, CW_CNTC = 8192 + 64;

constexpr int NWAVES = 8, NTHREADS = 512;
constexpr int LDS_BYTES = 147456, RING_BYTES = 131072, MISC_OFF = RING_BYTES + 320;

__device__ __forceinline__ unsigned f2bf(float f) { unsigned u = __builtin_bit_cast(unsigned, f); return (u + 0x7fffu + ((u >> 16) & 1u)) >> 16; }
__device__ __forceinline__ unsigned pk2(float lo, float hi) { return f2bf(lo) | (f2bf(hi) << 16); }
__device__ __forceinline__ float bf2f(unsigned short b) { return __builtin_bit_cast(float, (unsigned)b << 16); }
__device__ __forceinline__ float bflo(unsigned w) { return __builtin_bit_cast(float, w << 16); }
__device__ __forceinline__ float bfhi(unsigned w) { return __builtin_bit_cast(float, w & 0xffff0000u); }
__device__ __forceinline__ float wave_sum(float v) {
#pragma unroll
    for (int o = 1; o < 64; o <<= 1) v += __shfl_xor(v, o);
    return v;
}
__device__ __forceinline__ float wave_max(float v) {
#pragma unroll
    for (int o = 1; o < 64; o <<= 1) v = fmaxf(v, __shfl_xor(v, o));
    return v;
}
__device__ __forceinline__ int wave_isum(int v) {
#pragma unroll
    for (int o = 1; o < 64; o <<= 1) v += __shfl_xor(v, o);
    return v;
}
__device__ __forceinline__ float sigmoidf_(float x) { return 1.f / (1.f + __expf(-x)); }
__host__ __device__ __forceinline__ int perm32(int rho) { const int n = rho >> 4, i = rho & 15; return 8 * (i >> 2) + 4 * n + (i & 3); }
__device__ __forceinline__ int vt_pos(int o) { return 8 * ((o >> 2) & 1) + 4 * (o >> 3) + (o & 3); }

#define XB_TMO      128
#define XB_XCNT(j)  (256  + 64 * (j))
#define XB_XSUB(j)  (1280 + 64 * (j))
#define XB_XGEN(j)  (2304 + 64 * (j))
#define XB_TOP      3328
#define XB_TOPGEN   3392
#define XCD_BAR_WORDS 3456
#define XB_SPIN_CAP (1u << 18)
__device__ __forceinline__ unsigned xb_ld(unsigned* p)              { return __hip_atomic_load(p, __ATOMIC_RELAXED, __HIP_MEMORY_SCOPE_AGENT); }
__device__ __forceinline__ unsigned xb_add(unsigned* p, unsigned v) { return __hip_atomic_fetch_add(p, v, __ATOMIC_RELAXED, __HIP_MEMORY_SCOPE_AGENT); }
__device__ __forceinline__ unsigned xb_xcc_id() { return (unsigned)__builtin_amdgcn_s_getreg((3 << 11) | 20) & 0xFu; }
#define XB_SPIN(cond, bar) do { unsigned _sp = 0; while (cond) { __builtin_amdgcn_s_sleep(1); \
    if ((++_sp & 255u) == 0u) { if (xb_ld(&(bar)[XB_TMO])) break; if (_sp > XB_SPIN_CAP) { atomicAdd(&(bar)[XB_TMO], 1u); break; } } } } while (0)
struct XcdBarrier { unsigned* bar; unsigned x; volatile LAS unsigned* st; };
__device__ __forceinline__ XcdBarrier xcd_barrier_post(unsigned* bar, volatile LAS unsigned* st) {
    XcdBarrier b; b.bar = bar; b.x = xb_xcc_id(); b.st = st;
    if (threadIdx.x == 0) (void)xb_add(&bar[XB_XCNT(b.x)], 1u);
    return b;
}
__device__ __forceinline__ void xcd_barrier_complete(unsigned* bar, unsigned x, unsigned& nloc, unsigned& nx) {
    const unsigned G = gridDim.x * gridDim.y * gridDim.z;
    unsigned sum, cnt, mine, sp = 0u;
    for (;;) {
        sum = 0u; cnt = 0u; mine = 0u;
#pragma unroll
        for (unsigned j = 0; j < 16; ++j) { const unsigned c = xb_ld(&bar[XB_XCNT(j)]); sum += c; cnt += (c > 0u) ? 1u : 0u; mine = (j == x) ? c : mine; }
        if (sum == G) break;
        __builtin_amdgcn_s_sleep(1);
        if ((++sp & 255u) == 0u) { if (xb_ld(&bar[XB_TMO])) break; if (sp > XB_SPIN_CAP) { atomicAdd(&bar[XB_TMO], 1u); break; } }
    }
    nloc = mine > 0u ? mine : 1u; nx = cnt > 0u ? cnt : 1u;
}
__device__ __forceinline__ void xcd_barrier(const XcdBarrier& b) {
    asm volatile("s_waitcnt vmcnt(0)" ::: "memory");
    __syncthreads();
    if (threadIdx.x == 0) {
        unsigned* bar = b.bar;
        __builtin_amdgcn_s_waitcnt(0);
        unsigned nloc = b.st[0], nx = b.st[1];
        if (nloc == 0u) { xcd_barrier_complete(bar, b.x, nloc, nx); b.st[0] = nloc; b.st[1] = nx; }
        const unsigned old = xb_add(&bar[XB_XSUB(b.x)], 1u);
        const unsigned gen = old / nloc;
        if (old + 1u == (gen + 1u) * nloc) {
            __builtin_amdgcn_fence(__ATOMIC_RELEASE, "agent");
            asm volatile("s_waitcnt vmcnt(0)" ::: "memory");
            const unsigned og = xb_add(&bar[XB_TOP], 1u);
            const unsigned tg = og / nx;
            if (og + 1u == (tg + 1u) * nx) xb_add(&bar[XB_TOPGEN], 1u);
            else XB_SPIN(xb_ld(&bar[XB_TOPGEN]) == tg, bar);
            __builtin_amdgcn_fence(__ATOMIC_ACQUIRE, "agent");
            xb_add(&bar[XB_XGEN(b.x)], 1u);
            asm volatile("s_waitcnt vmcnt(0)" ::: "memory");
        } else {
            XB_SPIN(xb_ld(&bar[XB_XGEN(b.x)]) == gen, bar);
            __builtin_amdgcn_fence(__ATOMIC_ACQUIRE, "agent");
            asm volatile("s_waitcnt vmcnt(0)" ::: "memory");
        }
    }
    __syncthreads();
}

struct Args { const void* in[26]; float* out; unsigned char* ws; int ph_lo, ph_hi; };
struct Frame {
    LAS unsigned char* lds;
    int tid, lane, wave, G, bid;
    const float *x, *c, *ada_w, *ada_b, *norm_mix_w, *w_in, *q_norm_w, *k_norm_w, *conv_w, *conv_b, *w_rec, *b_rec, *w_ing, *b_ing, *lam,
                *w_pa, *w_pb, *w_out, *norm_ffn_w, *w_group, *b_group, *w_er, *b_er, *w1, *w3, *w2;
    float* out; unsigned char* ws;
};
#define WSP(T, off) ((T*)(F.ws + (off)))

__device__ __forceinline__ void tr_item(const float* __restrict__ src, int ld, int k0, int c0, int nvalid, bf16_t* dst, int ldd, LAS float* scr, int lane) {
#pragma unroll 8
    for (int i = 0; i < 32; ++i) { const int kk = 2 * i + (lane >> 5), cc = lane & 31;
        scr[kk * 33 + cc] = (cc < nvalid) ? src[(size_t)(k0 + kk) * ld + c0 + cc] : 0.f; }
    asm volatile("s_waitcnt lgkmcnt(0)" ::: "memory");
    const int c = lane & 7;
#pragma unroll
    for (int j = 0; j < 4; ++j) { const int n = (lane >> 3) + 8 * j; const LAS float* s = scr + (8 * c) * 33 + n;
        u32x4 o; o.x = pk2(s[0 * 33], s[1 * 33]); o.y = pk2(s[2 * 33], s[3 * 33]); o.z = pk2(s[4 * 33], s[5 * 33]); o.w = pk2(s[6 * 33], s[7 * 33]);
        *(u32x4*)(dst + (size_t)n * ldd + k0 + 8 * c) = o; }
    asm volatile("s_waitcnt lgkmcnt(0)" ::: "memory");
}
__device__ __forceinline__ void p0_phase(Frame& F) {
    LAS float* cond = (LAS float*)(F.lds);
    for (int i = F.tid; i < BATCH * DM; i += NTHREADS) { const float v = F.c[i]; cond[i] = v / (1.f + __expf(-v)); }
    __syncthreads();
    {
        const int item = F.wave * F.G + F.bid;
        if (item < 384) {
            const int col = item * 16 + (F.lane & 15), kq = F.lane >> 4;
            float acc[8];
#pragma unroll
            for (int b = 0; b < 8; ++b) acc[b] = 0.f;
#pragma unroll 4
            for (int k = kq; k < DM; k += 4) { const float w = F.ada_w[(size_t)k * 6144 + col];
#pragma unroll
                for (int b = 0; b < 8; ++b) acc[b] += cond[b * DM + k] * w; }
#pragma unroll
            for (int b = 0; b < 8; ++b) { float v = acc[b]; v += __shfl_xor(v, 16); v += __shfl_xor(v, 32); acc[b] = v; }
            if (kq == 0) { float* mod = WSP(float, WS_MOD); const float bb = F.ada_b[col];
#pragma unroll
                for (int b = 0; b < 8; ++b) mod[b * 6144 + col] = acc[b] + bb; }
        }
    }
    __syncthreads();
    LAS float* scr = (LAS float*)(F.lds + F.wave * 16384);
    const int gw = F.bid * NWAVES + F.wave, NGW = F.G * NWAVES;
    constexpr int I_WIN = 16 * 128, I_WP = 8 * 32, I_WO = 16 * 32, I_W13 = 32 * 256, I_W2 = 32 * 128;
    constexpr int NITEMS = I_WIN + 2 * I_WP + I_WO + I_W13 + I_W2;
    for (int it = gw; it < NITEMS; it += NGW) {
        int r = it;
        if (r < I_WIN) { const int kb = r / 128, nb = r % 128, n0 = 32 * nb; int c0, nv;
            if (n0 < C_LX) { c0 = n0; nv = 32; } else if (n0 < C_WI) { c0 = n0 + 4; nv = 32; } else if (n0 == C_WI) { c0 = 960; nv = 4; } else { c0 = 0; nv = 0; }
            tr_item(F.w_in, 4036, 64 * kb, c0, nv, WSP(bf16_t, WS_WIN) + (size_t)n0 * 1024, 1024, scr, F.lane); continue; } r -= I_WIN;
        if (r < I_WP) { const int kb = r / 32, nb = r % 32; tr_item(F.w_pa, 1024, 64 * kb, 32 * nb, 32, WSP(bf16_t, WS_WPA) + (size_t)(32 * nb) * 512, 512, scr, F.lane); continue; } r -= I_WP;
        if (r < I_WP) { const int kb = r / 32, nb = r % 32; tr_item(F.w_pb, 1024, 64 * kb, 32 * nb, 32, WSP(bf16_t, WS_WPB) + (size_t)(32 * nb) * 512, 512, scr, F.lane); continue; } r -= I_WP;
        if (r < I_WO) { const int kb = r / 32, nb = r % 32; tr_item(F.w_out, 1024, 64 * kb, 32 * nb, 32, WSP(bf16_t, WS_WOUT) + (size_t)(32 * nb) * 1024, 1024, scr, F.lane); continue; } r -= I_WO;
        if (r < I_W13) { const int e = r / 256, r2 = r % 256, kb = r2 / 16, nb = r2 % 16, n0 = 32 * nb, j = n0 >> 8, half = (n0 >> 7) & 1, cc0 = n0 & 127;
            const float* src = (half ? F.w3 : F.w1) + (size_t)e * 1024 * 256;
            tr_item(src, 256, 64 * kb, 128 * j + cc0, 32, WSP(bf16_t, WS_W13) + ((size_t)e * 512 + n0) * 1024, 1024, scr, F.lane); continue; } r -= I_W13;
        { const int e = r / 128, r2 = r % 128, kb = r2 / 32, nb = r2 % 32;
            tr_item(F.w2 + (size_t)e * 256 * 1024, 1024, 64 * kb, 32 * nb, 32, WSP(bf16_t, WS_W2) + ((size_t)e * 1024 + 32 * nb) * 256, 256, scr, F.lane); }
    }
}

__device__ __forceinline__ void p1a_phase(Frame& F) {
    const int gw = F.bid * NWAVES + F.wave, NGW = F.G * NWAVES;
    const float* mod = WSP(float, WS_MOD);
    bf16_t* H = WSP(bf16_t, WS_H);
    for (int row = gw; row < NTOK; row += NGW) {
        const int b = row / SEQ;
        const f32x4* xr = (const f32x4*)(F.x + (size_t)row * DM) + F.lane;
        f32x4 v[4]; float s = 0.f;
#pragma unroll
        for (int j = 0; j < 4; ++j) { v[j] = xr[64 * j]; s += (v[j].x * v[j].x + v[j].y * v[j].y) + (v[j].z * v[j].z + v[j].w * v[j].w); }
        const float rinv = rsqrtf(wave_sum(s) * (1.f / DM) + EPS);
        unsigned long long* o8 = (unsigned long long*)(H + (size_t)row * DM) + F.lane;
#pragma unroll
        for (int j = 0; j < 4; ++j) { const int col = 4 * F.lane + 256 * j;
            const f32x4 g = *(const f32x4*)(F.norm_mix_w + col), sh = *(const f32x4*)(mod + b * 6144 + col), sc = *(const f32x4*)(mod + b * 6144 + 1024 + col);
            const f32x4 hv = v[j] * rinv * g * (sc + 1.f) + sh;
            o8[64 * j] = (unsigned long long)pk2(hv.x, hv.y) | ((unsigned long long)pk2(hv.z, hv.w) << 32); }
    }
}

struct Unit { const bf16_t* A; const bf16_t* B; int pm, pn, aux, flags; };
template <bool PERM, class Sched, class Epi>
__device__ __forceinline__ void gemm_naive(int lda, int ldb, int K, const Sched& S, const Epi& E) {
    const int tid = threadIdx.x, wid = __builtin_amdgcn_readfirstlane(tid >> 6), lane = tid & 63, wr = wid >> 2, wc = wid & 3, fr = lane & 15, fq = lane >> 4;
    f32x4 acc[2][2][4][2];
    Unit u;
    for (int i = 0; S.next(i, u); ++i) {
        if (!(u.flags & 1)) {
#pragma unroll
            for (int a = 0; a < 2; ++a)
#pragma unroll
                for (int b = 0; b < 2; ++b)
#pragma unroll
                    for (int m = 0; m < 4; ++m)
#pragma unroll
                        for (int n = 0; n < 2; ++n) acc[a][b][m][n] = (f32x4){0.f, 0.f, 0.f, 0.f};
        }
#pragma unroll 1
        for (int k0 = 0; k0 < K; k0 += 32) {
            bf16x8 bfr[2][2];
#pragma unroll
            for (int bj = 0; bj < 2; ++bj)
#pragma unroll
                for (int n = 0; n < 2; ++n) { const int rho = 16 * n + fr, rr = PERM ? perm32(rho) : rho;
                    bfr[bj][n] = *(const bf16x8*)(u.B + (size_t)(128 * bj + 32 * wc + rr) * ldb + k0 + 8 * fq); }
#pragma unroll
            for (int ai = 0; ai < 2; ++ai) {
                bf16x8 af[4];
#pragma unroll
                for (int m = 0; m < 4; ++m) af[m] = *(const bf16x8*)(u.A + (size_t)(128 * ai + 64 * wr + 16 * m + fr) * lda + k0 + 8 * fq);
#pragma unroll
                for (int bj = 0; bj < 2; ++bj)
#pragma unroll
                    for (int m = 0; m < 4; ++m)
#pragma unroll
                        for (int n = 0; n < 2; ++n) acc[ai][bj][m][n] = __builtin_amdgcn_mfma_f32_16x16x32_bf16(bfr[bj][n], af[m], acc[ai][bj][m][n], 0, 0, 0);
            }
        }
        if (!(u.flags & 2)) E(acc, u, wr, wc, fr, fq);
    }
}

struct SchedProj { const bf16_t* A; const bf16_t* B; int G, c;
    __device__ __forceinline__ bool next(int i, Unit& u) const { const int L = i * G + c; if (L >= 64 * 16) return false;
        const int gid = L / 128, w = L % 128; u.pm = gid * 8 + (w % 8); u.pn = w / 8;
        u.A = A + (size_t)u.pm * 256 * 1024; u.B = B + (size_t)u.pn * 256 * 1024; u.aux = 0; u.flags = 0; return true; } };
struct EpiProj {
    bf16_t *Q, *Kb, *Vt, *Vr, *QI, *KI, *LX, *LG, *GA, *GB; float* WI;
    __device__ __forceinline__ void operator()(const f32x4 (&acc)[2][2][4][2], const Unit& u, int wr, int wc, int fr, int fq) const {
#pragma unroll
        for (int bj = 0; bj < 2; ++bj) {
            const int cg = u.pn * 256 + bj * 128 + wc * 32;
            if (cg >= C_END) continue;
            const int col = cg + 8 * fq;
            bf16_t* dst; int ld, cb; int mode = 0;
            if (cg < C_K) { dst = Q; ld = 512; cb = C_Q; }
            else if (cg < C_V) { dst = Kb; ld = 64; cb = C_K; }
            else if (cg < C_QI) { dst = Vr; ld = 64; cb = C_V; mode = 2; }
            else if (cg < C_KI) { dst = QI; ld = 256; cb = C_QI; }
            else if (cg < C_LX) { dst = KI; ld = 64; cb = C_KI; }
            else if (cg < C_LG) { dst = LX; ld = 512; cb = C_LX; }
            else if (cg < C_GA) { dst = LG; ld = 512; cb = C_LG; }
            else if (cg < C_GB) { dst = GA; ld = 1024; cb = C_GA; mode = 1; }
            else if (cg < C_WI) { dst = GB; ld = 1024; cb = C_GB; mode = 1; }
            else { dst = nullptr; ld = 0; cb = C_WI; mode = 3; }
#pragma unroll
            for (int ai = 0; ai < 2; ++ai)
#pragma unroll
                for (int m = 0; m < 4; ++m) {
                    const int row = u.pm * 256 + ai * 128 + wr * 64 + m * 16 + fr;
                    f32x4 v0 = acc[ai][bj][m][0], v1 = acc[ai][bj][m][1];
                    if (mode == 3) { if (fq == 0) *(f32x4*)(WI + (size_t)row * 4) = v0; continue; }
                    if (mode == 1) {
#pragma unroll
                        for (int e = 0; e < 4; ++e) { v0[e] = sigmoidf_(v0[e]); v1[e] = sigmoidf_(v1[e]); } }
                    u32x4 w; w.x = pk2(v0[0], v0[1]); w.y = pk2(v0[2], v0[3]); w.z = pk2(v1[0], v1[1]); w.w = pk2(v1[2], v1[3]);
                    *(u32x4*)(dst + (size_t)row * ld + (col - cb)) = w;
                    if (mode == 2) {
                        const int b = row / SEQ, t = row % SEQ, d0 = col - cb; bf16_t* vp = Vt + ((size_t)b * 64 + d0) * SEQ + (t & ~15) + vt_pos(t & 15);
                        vp[0 * SEQ] = (bf16_t)(w.x & 0xffff); vp[1 * SEQ] = (bf16_t)(w.x >> 16); vp[2 * SEQ] = (bf16_t)(w.y & 0xffff); vp[3 * SEQ] = (bf16_t)(w.y >> 16);
                        vp[4 * SEQ] = (bf16_t)(w.z & 0xffff); vp[5 * SEQ] = (bf16_t)(w.z >> 16); vp[6 * SEQ] = (bf16_t)(w.w & 0xffff); vp[7 * SEQ] = (bf16_t)(w.w >> 16); }
                }
        }
    }
};

__device__ __forceinline__ unsigned sortkey(float f) { const unsigned u = __builtin_bit_cast(unsigned, f); return (u & 0x80000000u) ? ~u : (u | 0x80000000u); }
__device__ __forceinline__ void attn_query(Frame& F, int tok, LAS float* sc, LAS int* list, LAS float* qs) {
    const int lane = F.lane, b = tok / SEQ, t = tok % SEQ, nk = CHUNK * (t / CHUNK + 1);
    const bf16_t* KI = WSP(bf16_t, WS_KI) + (size_t)b * SEQ * 64;
    const bf16_t* Kb = WSP(bf16_t, WS_K) + (size_t)b * SEQ * 64;
    const bf16_t* Vr = WSP(bf16_t, WS_VR) + (size_t)b * SEQ * 64;
    int nsel;
    if (nk <= TOPK) { for (int i = lane; i < nk; i += 64) list[i] = i; nsel = nk; }
    else {
        { const bf16_t* qi = WSP(bf16_t, WS_QI) + (size_t)tok * 256;
#pragma unroll
          for (int j = 0; j < 4; ++j) qs[lane + 64 * j] = bf2f(qi[lane + 64 * j]); }
        const f32x4 wv = *(const f32x4*)(WSP(float, WS_WI) + (size_t)tok * 4);
        const float wsc = 0.0625f;
        asm volatile("s_waitcnt lgkmcnt(0)" ::: "memory");
        for (int s = lane; s < nk; s += 64) {
            u32x4 kr[8];
#pragma unroll
            for (int j = 0; j < 8; ++j) kr[j] = *(const u32x4*)(KI + (size_t)s * 64 + 8 * j);
            float tot = 0.f;
#pragma unroll
            for (int h = 0; h < 4; ++h) { float a = 0.f;
#pragma unroll
                for (int j = 0; j < 8; ++j) { const LAS float* q = qs + h * 64 + 8 * j;
                    a += q[0] * bflo(kr[j].x) + q[1] * bfhi(kr[j].x) + q[2] * bflo(kr[j].y) + q[3] * bfhi(kr[j].y) + q[4] * bflo(kr[j].z) + q[5] * bfhi(kr[j].z) + q[6] * bflo(kr[j].w) + q[7] * bfhi(kr[j].w); }
                tot += fmaxf(a, 0.f) * (wv[h] * wsc); }
            sc[s] = tot;
        }
        asm volatile("s_waitcnt lgkmcnt(0)" ::: "memory");
        unsigned T = 0u;
        for (int bit = 31; bit >= 0; --bit) { const unsigned cand = T | (1u << bit); int c = 0;
            for (int s = lane; s < nk; s += 64) c += (sortkey(sc[s]) >= cand) ? 1 : 0;
            if (wave_isum(c) >= TOPK) T = cand; }
        int cgt = 0;
        for (int s = lane; s < nk; s += 64) cgt += (sortkey(sc[s]) > T) ? 1 : 0;
        cgt = wave_isum(cgt);
        int need = TOPK - cgt, pos = 0, ties = 0;
        for (int s0 = 0; s0 < nk; s0 += 64) { const unsigned kx = sortkey(sc[s0 + lane]);
            const unsigned long long mg = __ballot(kx > T), me = __ballot(kx == T);
            const unsigned long long lower = (1ull << lane) - 1ull;
            const int te = __popcll(me & lower);
            const bool sel = (kx > T) || (kx == T && (ties + te) < need);
            const unsigned long long ms = __ballot(sel);
            if (sel) list[pos + __popcll(ms & lower)] = s0 + lane;
            pos += __popcll(ms); ties += __popcll(me); }
        nsel = pos;
    }
    { const bf16_t* q = WSP(bf16_t, WS_Q) + (size_t)tok * 512; const float cw = F.q_norm_w[lane] * F.k_norm_w[lane] * 0.125f;
      asm volatile("s_waitcnt lgkmcnt(0)" ::: "memory");
#pragma unroll
      for (int h = 0; h < 8; ++h) { const float v = bf2f(q[h * 64 + lane]); const float r = rsqrtf(wave_sum(v * v) * (1.f / 64.f) + EPS); qs[h * 64 + lane] = v * r * cw; } }
    asm volatile("s_waitcnt lgkmcnt(0)" ::: "memory");
    LAS float* lg = sc;
    for (int e = lane; e < nsel; e += 64) { const int s = list[e];
        u32x4 kr[8]; float ss = 0.f;
#pragma unroll
        for (int j = 0; j < 8; ++j) { kr[j] = *(const u32x4*)(Kb + (size_t)s * 64 + 8 * j);
            const float a0 = bflo(kr[j].x), a1 = bfhi(kr[j].x), a2 = bflo(kr[j].y), a3 = bfhi(kr[j].y), a4 = bflo(kr[j].z), a5 = bfhi(kr[j].z), a6 = bflo(kr[j].w), a7 = bfhi(kr[j].w);
            ss += a0 * a0 + a1 * a1 + a2 * a2 + a3 * a3 + a4 * a4 + a5 * a5 + a6 * a6 + a7 * a7; }
        const float rk = rsqrtf(ss * (1.f / 64.f) + EPS); const float dist = fabsf((float)(t - s));
#pragma unroll
        for (int h = 0; h < 8; ++h) { float a = 0.f;
#pragma unroll
            for (int j = 0; j < 8; ++j) { const LAS float* q = qs + h * 64 + 8 * j;
                a += q[0] * bflo(kr[j].x) + q[1] * bfhi(kr[j].x) + q[2] * bflo(kr[j].y) + q[3] * bfhi(kr[j].y) + q[4] * bflo(kr[j].z) + q[5] * bfhi(kr[j].z) + q[6] * bflo(kr[j].w) + q[7] * bfhi(kr[j].w); }
            lg[h * 256 + e] = a * rk - exp2f(-(float)(h + 1)) * dist; }
    }
    asm volatile("s_waitcnt lgkmcnt(0)" ::: "memory");
    bf16_t* AO = WSP(bf16_t, WS_AO) + (size_t)tok * 512;
    for (int h = 0; h < 8; ++h) {
        float mx = -INFINITY;
        for (int e = lane; e < nsel; e += 64) mx = fmaxf(mx, lg[h * 256 + e]);
        mx = wave_max(mx);
        float sm = 0.f;
        for (int e = lane; e < nsel; e += 64) { const float p = __expf(lg[h * 256 + e] - mx); lg[h * 256 + e] = p; sm += p; }
        sm = wave_sum(sm);
        asm volatile("s_waitcnt lgkmcnt(0)" ::: "memory");
        float o = 0.f;
        for (int e = 0; e < nsel; ++e) o += lg[h * 256 + e] * bf2f(Vr[(size_t)list[e] * 64 + lane]);
        AO[h * 64 + lane] = (bf16_t)f2bf(o / sm);
    }
    asm volatile("s_waitcnt lgkmcnt(0)" ::: "memory");
}
__device__ __forceinline__ void attn_phase_naive(Frame& F) {
    LAS float* sc = (LAS float*)(F.lds + F.wave * 12288); LAS int* list = (LAS int*)(F.lds + F.wave * 12288 + 8192); LAS float* qs = (LAS float*)(F.lds + F.wave * 12288 + 9216);
    const int gw = F.wave * F.G + F.bid, NGW = F.G * NWAVES;
    for (int q = gw; q < NTOK; q += NGW) { const int b = q / SEQ, r = q % SEQ; const int t = (r & 1) ? (SEQ - 1 - (r >> 1)) : (r >> 1); attn_query(F, b * SEQ + t, sc, list, qs); }
}

__device__ __forceinline__ float gelu_tanh(float x) { const float u = 0.7978845608028654f * (x + 0.044715f * x * x * x); return 0.5f * x * (1.f + tanhf(u)); }
__device__ __forceinline__ void lru_item(Frame& F, int item, LAS float* wb) {
    const int lane = F.lane, cgq = item & 15, n = (item >> 4) & 7, b = item >> 7;
    const bf16_t* LX = WSP(bf16_t, WS_LX) + (size_t)b * SEQ * 512 + 64 * n;
    const bf16_t* LG = WSP(bf16_t, WS_LG) + (size_t)b * SEQ * 512 + 64 * n;
    bf16_t* LO = WSP(bf16_t, WS_LO) + (size_t)b * SEQ * 512 + 64 * n;
    float carry[4] = {0.f, 0.f, 0.f, 0.f};
    float spl[4], brc[4], bin[4];
#pragma unroll
    for (int e = 0; e < 4; ++e) { const int ch = 64 * n + 4 * cgq + e; spl[e] = log1pf(__expf(-F.lam[ch])); brc[e] = F.b_rec[ch]; bin[e] = F.b_ing[ch]; }
    { const float* wr = F.w_rec + (size_t)n * 64 * 64; const float* wi = F.w_ing + (size_t)n * 64 * 64;
#pragma unroll
      for (int e = 0; e < 4; ++e) { wb[lane * 4 + e] = wr[lane * 64 + 4 * cgq + e]; wb[256 + lane * 4 + e] = wi[lane * 64 + 4 * cgq + e]; }
      asm volatile("s_waitcnt lgkmcnt(0)" ::: "memory"); }
    for (int ck = 0; ck < SEQ / 64; ++ck) {
        const int t = 64 * ck + lane;
        float xc[64];
#pragma unroll
        for (int d = 0; d < 64; ++d) xc[d] = F.conv_b[64 * n + d];
#pragma unroll
        for (int j = 0; j < 4; ++j) { const int ts = t - 3 + j;
            if (ts >= 0) {
#pragma unroll
                for (int d8 = 0; d8 < 8; ++d8) { const u32x4 v = *(const u32x4*)(LX + (size_t)ts * 512 + 8 * d8); const float* cw = F.conv_w + j * 512 + 64 * n + 8 * d8;
                    xc[8 * d8 + 0] += bflo(v.x) * cw[0]; xc[8 * d8 + 1] += bfhi(v.x) * cw[1]; xc[8 * d8 + 2] += bflo(v.y) * cw[2]; xc[8 * d8 + 3] += bfhi(v.y) * cw[3];
                    xc[8 * d8 + 4] += bflo(v.z) * cw[4]; xc[8 * d8 + 5] += bfhi(v.z) * cw[5]; xc[8 * d8 + 6] += bflo(v.w) * cw[6]; xc[8 * d8 + 7] += bfhi(v.w) * cw[7]; } } }
        float av[4], bv[4];
#pragma unroll
        for (int e = 0; e < 4; ++e) { const int ce = 4 * cgq + e; float r = brc[e], ig = bin[e];
#pragma unroll
            for (int d = 0; d < 64; ++d) { r += xc[d] * wb[d * 4 + e]; ig += xc[d] * wb[256 + d * 4 + e]; }
            r = sigmoidf_(r); ig = sigmoidf_(ig);
            const float la = -8.f * r * spl[e]; av[e] = __expf(la);
            float xce = 0.f;
#pragma unroll
            for (int d = 0; d < 64; ++d) xce = (d == ce) ? xc[d] : xce;
            bv[e] = sqrtf(-expm1f(2.f * la)) * (ig * xce); }
#pragma unroll
        for (int off = 1; off < 64; off <<= 1) {
#pragma unroll
            for (int e = 0; e < 4; ++e) { const float ap = __shfl_up(av[e], off), bp = __shfl_up(bv[e], off);
                if (lane >= off) { bv[e] = av[e] * bp + bv[e]; av[e] = av[e] * ap; } } }
        unsigned hw[2];
        float hv[4];
#pragma unroll
        for (int e = 0; e < 4; ++e) { const float h = bv[e] + av[e] * carry[e]; carry[e] = __shfl(h, 63); hv[e] = h; }
        const u32x2 g = *(const u32x2*)(LG + (size_t)t * 512 + 4 * cgq);
        hv[0] *= gelu_tanh(bflo(g.x)); hv[1] *= gelu_tanh(bfhi(g.x)); hv[2] *= gelu_tanh(bflo(g.y)); hv[3] *= gelu_tanh(bfhi(g.y));
        hw[0] = pk2(hv[0], hv[1]); hw[1] = pk2(hv[2], hv[3]);
        *(u32x2*)(LO + (size_t)t * 512 + 4 * cgq) = (u32x2){hw[0], hw[1]};
    }
}
__device__ __forceinline__ void lru_phase_naive(Frame& F) {
    const int gw = F.wave * F.G + F.bid, NGW = F.G * NWAVES;
    LAS float* wb = (LAS float*)(F.lds + F.wave * 2048);
    for (int it = gw; it < BATCH * 8 * 16; it += NGW) lru_item(F, it, wb);
}

struct SchedMerge { const bf16_t *AO, *LO, *WPA, *WPB; int G, c;
    __device__ __forceinline__ bool next(int i, Unit& u) const { const int L = (i >> 1) * G + c; if (L >= 64 * 4) return false; const int sub = i & 1;
        u.pm = L % 64; u.pn = L / 64; u.aux = sub; u.flags = 0;
        u.A = (sub ? LO : AO) + (size_t)u.pm * 256 * 512; u.B = (sub ? WPB : WPA) + (size_t)u.pn * 256 * 512; return true; } };
struct EpiMerge {
    bf16_t* MG; const bf16_t *GA, *GB;
    __device__ __forceinline__ void operator()(const f32x4 (&acc)[2][2][4][2], const Unit& u, int wr, int wc, int fr, int fq) const {
        const bf16_t* G = u.aux ? GB : GA;
#pragma unroll
        for (int ai = 0; ai < 2; ++ai)
#pragma unroll
            for (int m = 0; m < 4; ++m)
#pragma unroll
                for (int bj = 0; bj < 2; ++bj) {
                    const size_t off = (size_t)(u.pm * 256 + ai * 128 + wr * 64 + m * 16 + fr) * 1024 + u.pn * 256 + bj * 128 + wc * 32 + 8 * fq;
                    const u32x4 g = *(const u32x4*)(G + off);
                    f32x4 v0 = acc[ai][bj][m][0], v1 = acc[ai][bj][m][1];
                    v0[0] *= bflo(g.x); v0[1] *= bfhi(g.x); v0[2] *= bflo(g.y); v0[3] *= bfhi(g.y); v1[0] *= bflo(g.z); v1[1] *= bfhi(g.z); v1[2] *= bflo(g.w); v1[3] *= bfhi(g.w);
                    if (u.aux) { const u32x4 p = *(const u32x4*)(MG + off);
                        v0[0] += bflo(p.x); v0[1] += bfhi(p.x); v0[2] += bflo(p.y); v0[3] += bfhi(p.y); v1[0] += bflo(p.z); v1[1] += bfhi(p.z); v1[2] += bflo(p.w); v1[3] += bfhi(p.w); }
                    u32x4 w; w.x = pk2(v0[0], v0[1]); w.y = pk2(v0[2], v0[3]); w.z = pk2(v1[0], v1[1]); w.w = pk2(v1[2], v1[3]);
                    *(u32x4*)(MG + off) = w; }
    }
};
struct SchedOut { const bf16_t *A, *B; int G, c;
    __device__ __forceinline__ bool next(int i, Unit& u) const { const int L = i * G + c; if (L >= 64 * 4) return false;
        u.pm = L % 64; u.pn = L / 64; u.aux = 0; u.flags = 0; u.A = A + (size_t)u.pm * 256 * 1024; u.B = B + (size_t)u.pn * 256 * 1024; return true; } };
struct EpiOut {
    const float* x; const float* mod; float* out;
    __device__ __forceinline__ void operator()(const f32x4 (&acc)[2][2][4][2], const Unit& u, int wr, int wc, int fr, int fq) const {
        const int b = (u.pm * 256) / SEQ;
#pragma unroll
        for (int bj = 0; bj < 2; ++bj)
#pragma unroll
            for (int n = 0; n < 2; ++n) { const int col = u.pn * 256 + bj * 128 + wc * 32 + 16 * n + 4 * fq; const f32x4 gm = *(const f32x4*)(mod + b * 6144 + 2048 + col);
#pragma unroll
                for (int ai = 0; ai < 2; ++ai)
#pragma unroll
                    for (int m = 0; m < 4; ++m) { const size_t off = (size_t)(u.pm * 256 + ai * 128 + wr * 64 + m * 16 + fr) * 1024 + col;
                        *(f32x4*)(out + off) = *(const f32x4*)(x + off) + gm * acc[ai][bj][m][n]; } }
    }
};

struct TokMeta { int ea, eb; float ca, cb; int re_a, re_b, cls, rc; };
__device__ __forceinline__ int pair_index(int lo, int hi) { return lo * (15 - lo) / 2 + (hi - lo - 1); }
__device__ __forceinline__ void route_token(Frame& F, int tok) {
    const int lane = F.lane, b = tok / SEQ;
    const float* mod = WSP(float, WS_MOD) + b * 6144;
    const f32x4* xr = (const f32x4*)(F.out + (size_t)tok * DM) + lane;
    f32x4 v[4]; float s = 0.f;
#pragma unroll
    for (int j = 0; j < 4; ++j) { v[j] = xr[64 * j]; s += (v[j].x * v[j].x + v[j].y * v[j].y) + (v[j].z * v[j].z + v[j].w * v[j].w); }
    const float rinv = rsqrtf(wave_sum(s) * (1.f / DM) + EPS);
    unsigned long long* o8 = (unsigned long long*)(WSP(bf16_t, WS_H2T) + (size_t)tok * DM) + lane;
    float lgt[36];
#pragma unroll
    for (int r = 0; r < 36; ++r) lgt[r] = 0.f;
#pragma unroll
    for (int j = 0; j < 4; ++j) { const int col = 4 * lane + 256 * j;
        const f32x4 g = *(const f32x4*)(F.norm_ffn_w + col), sh = *(const f32x4*)(mod + 3072 + col), sc = *(const f32x4*)(mod + 4096 + col);
        const f32x4 hv = v[j] * rinv * g * (sc + 1.f) + sh;
        o8[64 * j] = (unsigned long long)pk2(hv.x, hv.y) | ((unsigned long long)pk2(hv.z, hv.w) << 32);
#pragma unroll
        for (int e = 0; e < 4; ++e) { const int k = col + e; const float hh = hv[e];
            const f32x4 wg = *(const f32x4*)(F.w_group + (size_t)k * 4);
            lgt[0] += hh * wg.x; lgt[1] += hh * wg.y; lgt[2] += hh * wg.z; lgt[3] += hh * wg.w;
#pragma unroll
            for (int q = 0; q < 8; ++q) { const f32x4 we = *(const f32x4*)(F.w_er + (size_t)k * 32 + 4 * q);
                lgt[4 + 4 * q] += hh * we.x; lgt[5 + 4 * q] += hh * we.y; lgt[6 + 4 * q] += hh * we.z; lgt[7 + 4 * q] += hh * we.w; } } }
#pragma unroll
    for (int r = 0; r < 36; ++r) lgt[r] = wave_sum(lgt[r]);
    if (lane == 0) {
        float gl[4];
#pragma unroll
        for (int i = 0; i < 4; ++i) { gl[i] = lgt[i] + F.b_group[i]; }
        int g = 0; float gmx = gl[0];
#pragma unroll
        for (int i = 1; i < 4; ++i) if (gl[i] > gmx) { gmx = gl[i]; g = i; }
        float gs = 0.f;
#pragma unroll
        for (int i = 0; i < 4; ++i) gs += __expf(gl[i] - gmx);
        const float gw = 1.f / gs;
        float el[8];
#pragma unroll
        for (int i = 0; i < 8; ++i) { float vsel = 0.f;
#pragma unroll
            for (int gg = 0; gg < 4; ++gg) vsel = (gg == g) ? (lgt[4 + gg * 8 + i] + F.b_er[gg * 8 + i]) : vsel;
            el[i] = vsel; }
        int i1 = 0; float v1 = el[0];
#pragma unroll
        for (int i = 1; i < 8; ++i) if (el[i] > v1) { v1 = el[i]; i1 = i; }
        int i2 = -1; float v2 = -INFINITY;
#pragma unroll
        for (int i = 0; i < 8; ++i) if (i != i1 && (i2 < 0 || el[i] > v2)) { v2 = el[i]; i2 = i; }
        const float e2 = __expf(v2 - v1); const float w1v = gw / (1.f + e2), w2v = gw * e2 / (1.f + e2);
        TokMeta mt; const int lo = i1 < i2 ? i1 : i2, hi = i1 < i2 ? i2 : i1;
        mt.ea = g * 8 + lo; mt.eb = g * 8 + hi; mt.ca = (i1 < i2) ? w1v : w2v; mt.cb = (i1 < i2) ? w2v : w1v;
        mt.cls = g * 28 + pair_index(lo, hi);
        unsigned* ctl = (unsigned*)(F.ws + WS_CTL);
        mt.re_a = (int)atomicAdd(ctl + CW_CNTE + mt.ea, 1u); mt.re_b = (int)atomicAdd(ctl + CW_CNTE + mt.eb, 1u); mt.rc = (int)atomicAdd(ctl + CW_CNTC + mt.cls, 1u);
        WSP(TokMeta, WS_META)[tok] = mt;
    }
}
__device__ __forceinline__ void route_phase_naive(Frame& F) {
    const int gw = F.bid * NWAVES + F.wave, NGW = F.G * NWAVES;
    for (int tok = gw; tok < NTOK; tok += NGW) route_token(F, tok);
}
struct MoeTables { LAS int* ebase; LAS int* cbase; };
__device__ __forceinline__ MoeTables build_tables(Frame& F, int lds_off) {
    MoeTables T; T.ebase = (LAS int*)(F.lds + lds_off); T.cbase = T.ebase + 40;
    const unsigned* ctl = (const unsigned*)(F.ws + WS_CTL);
    __syncthreads();
    if (F.tid == 0) { int a = 0; for (int e = 0; e < NEXP; ++e) { T.ebase[e] = a; a += ((int)__hip_atomic_load(ctl + CW_CNTE + e, __ATOMIC_RELAXED, __HIP_MEMORY_SCOPE_AGENT) + 255) >> 8; } T.ebase[NEXP] = a; }
    if (F.tid == 64) { int a = 0; for (int c = 0; c < NCLS; ++c) { T.cbase[c] = a; a += ((int)__hip_atomic_load(ctl + CW_CNTC + c, __ATOMIC_RELAXED, __HIP_MEMORY_SCOPE_AGENT) + 255) >> 8; } T.cbase[NCLS] = a; }
    __syncthreads();
    return T;
}
__device__ __forceinline__ void sort_phase_naive(Frame& F) {
    const MoeTables T = build_tables(F, RING_BYTES + 4096);
    const int gw = F.bid * NWAVES + F.wave, NGW = F.G * NWAVES;
    bf16_t* A1 = WSP(bf16_t, WS_A1); const bf16_t* H2 = WSP(bf16_t, WS_H2T);
    int* dest2 = WSP(int, WS_DEST2); float* cw = WSP(float, WS_CW); int* tok2 = WSP(int, WS_TOK2);
    for (int tok = gw; tok < NTOK; tok += NGW) {
        const TokMeta mt = WSP(TokMeta, WS_META)[tok];
        const int sa = T.ebase[mt.ea] * 256 + mt.re_a, sb = T.ebase[mt.eb] * 256 + mt.re_b, rc = T.cbase[mt.cls] * 256 + mt.rc;
        const u32x4* src = (const u32x4*)(H2 + (size_t)tok * DM) + F.lane;
        u32x4* da = (u32x4*)(A1 + (size_t)sa * DM) + F.lane; u32x4* db = (u32x4*)(A1 + (size_t)sb * DM) + F.lane;
        const u32x4 v0 = src[0], v1 = src[64];
        da[0] = v0; da[64] = v1; db[0] = v0; db[64] = v1;
        if (F.lane == 0) { dest2[sa] = rc * 512; dest2[sb] = rc * 512 + 256; cw[sa] = mt.ca; cw[sb] = mt.cb; tok2[rc] = tok; }
    }
}

struct SchedMoe1 { const bf16_t *A1, *W13; const LAS int* ebase; const unsigned* cnte; int G, c;
    __device__ __forceinline__ bool next(int i, Unit& u) const { const int L = i * G + c, ntile = ebase[NEXP]; if (L >= ntile * 2) return false;
        const int rt = L >> 1, j = L & 1; int e = 0;
        for (int q = 1; q < NEXP; ++q) e = (ebase[q] <= rt) ? q : e;
        u.pm = rt; u.pn = j; u.flags = 0; u.aux = (int)cnte[e] - 256 * (rt - ebase[e]);
        u.A = A1 + (size_t)rt * 256 * 1024; u.B = W13 + ((size_t)e * 512 + 256 * j) * 1024; return true; } };
struct EpiMoe1 {
    bf16_t* act2; const int* dest2; const float* cw;
    __device__ __forceinline__ void operator()(const f32x4 (&acc)[2][2][4][2], const Unit& u, int wr, int wc, int fr, int fq) const {
#pragma unroll
        for (int ai = 0; ai < 2; ++ai)
#pragma unroll
            for (int m = 0; m < 4; ++m) { const int r = ai * 128 + wr * 64 + m * 16 + fr; if (r >= u.aux) continue;
                const int slot = u.pm * 256 + r; const float cs = cw[slot]; const int d = dest2[slot];
                float o[8];
#pragma unroll
                for (int n = 0; n < 2; ++n)
#pragma unroll
                    for (int e = 0; e < 4; ++e) { const float a = acc[ai][0][m][n][e], g = acc[ai][1][m][n][e]; o[4 * n + e] = a * sigmoidf_(a) * g * cs; }
                u32x4 w; w.x = pk2(o[0], o[1]); w.y = pk2(o[2], o[3]); w.z = pk2(o[4], o[5]); w.w = pk2(o[6], o[7]);
                *(u32x4*)(act2 + (size_t)d + 128 * u.pn + 32 * wc + 8 * fq) = w; }
    }
};
struct SchedMoe2 { const bf16_t *act2, *W2; const LAS int* cbase; const unsigned* cntc; int G, c;
    __device__ __forceinline__ bool next(int i, Unit& u) const { const int L = (i >> 1) * G + c, ntile = cbase[NCLS]; if (L >= ntile * 4) return false;
        const int sub = i & 1, rt = L >> 2, pn = L & 3; int cl = 0;
        for (int q = 1; q < NCLS; ++q) cl = (cbase[q] <= rt) ? q : cl;
        const int g = cl / 28; int p = cl % 28, lo = 0; while (p >= 7 - lo) { p -= 7 - lo; ++lo; } const int hi = lo + 1 + p;
        const int e = g * 8 + (sub ? hi : lo);
        u.pm = rt; u.pn = pn; u.flags = sub ? 1 : 2; u.aux = (int)cntc[cl] - 256 * (rt - cbase[cl]);
        u.A = act2 + (size_t)rt * 256 * 512 + 256 * sub; u.B = W2 + ((size_t)e * 1024 + 256 * pn) * 256; return true; } };
struct EpiMoe2 {
    float* out; const float* mod; const int* tok2;
    __device__ __forceinline__ void operator()(const f32x4 (&acc)[2][2][4][2], const Unit& u, int wr, int wc, int fr, int fq) const {
#pragma unroll
        for (int ai = 0; ai < 2; ++ai)
#pragma unroll
            for (int m = 0; m < 4; ++m) { const int r = ai * 128 + wr * 64 + m * 16 + fr; if (r >= u.aux) continue;
                const int tok = tok2[u.pm * 256 + r]; const int b = tok / SEQ;
#pragma unroll
                for (int bj = 0; bj < 2; ++bj)
#pragma unroll
                    for (int n = 0; n < 2; ++n) { const int col = u.pn * 256 + bj * 128 + wc * 32 + 16 * n + 4 * fq; const f32x4 gf = *(const f32x4*)(mod + b * 6144 + 5120 + col);
                        float* p = out + (size_t)tok * 1024 + col; *(f32x4*)p = *(const f32x4*)p + gf * acc[ai][bj][m][n]; }
                asm volatile("" ::: "memory"); }
    }
};

constexpr int NPHASE = 10;
template <int LO, int HI> __global__ void __launch_bounds__(NTHREADS, 2) mk_fwd(Args args) {
    extern __shared__ __attribute__((aligned(16))) unsigned char lds[];
    Frame F;
    F.lds = (LAS unsigned char*)lds; F.tid = threadIdx.x; F.lane = F.tid & 63; F.wave = __builtin_amdgcn_readfirstlane(F.tid >> 6); F.G = gridDim.x; F.bid = blockIdx.x;
    F.x = (const float*)args.in[0]; F.c = (const float*)args.in[1]; F.ada_w = (const float*)args.in[2]; F.ada_b = (const float*)args.in[3]; F.norm_mix_w = (const float*)args.in[4];
    F.w_in = (const float*)args.in[5]; F.q_norm_w = (const float*)args.in[6]; F.k_norm_w = (const float*)args.in[7]; F.conv_w = (const float*)args.in[8]; F.conv_b = (const float*)args.in[9];
    F.w_rec = (const float*)args.in[10]; F.b_rec = (const float*)args.in[11]; F.w_ing = (const float*)args.in[12]; F.b_ing = (const float*)args.in[13]; F.lam = (const float*)args.in[14];
    F.w_pa = (const float*)args.in[15]; F.w_pb = (const float*)args.in[16]; F.w_out = (const float*)args.in[17]; F.norm_ffn_w = (const float*)args.in[18]; F.w_group = (const float*)args.in[19];
    F.b_group = (const float*)args.in[20]; F.w_er = (const float*)args.in[21]; F.b_er = (const float*)args.in[22]; F.w1 = (const float*)args.in[23]; F.w3 = (const float*)args.in[24]; F.w2 = (const float*)args.in[25];
    F.out = args.out; F.ws = args.ws;
    volatile LAS unsigned* MISC = (volatile LAS unsigned*)((LAS unsigned char*)lds + MISC_OFF);
    if (F.tid < 32) MISC[F.tid] = 0u;
    __syncthreads();
    unsigned* ctl = (unsigned*)(F.ws + WS_CTL);
    XcdBarrier bar; bar.bar = ctl + CW_BAR; bar.x = 0; bar.st = nullptr;
    if (MK_N_LAUNCHES == 1) bar = xcd_barrier_post(ctl + CW_BAR, MISC + 8);
#define IN(k) (LO <= (k) && (k) < HI)
#define SEAM(k) do { if constexpr (IN(k) && IN((k) + 1)) xcd_barrier(bar); } while (0)
    if constexpr (IN(0)) { p0_phase(F); } SEAM(0);
    if constexpr (IN(1)) { p1a_phase(F); } SEAM(1);
    if constexpr (IN(2)) { SchedProj S{WSP(bf16_t, WS_H), WSP(bf16_t, WS_WIN), F.G, F.bid};
        EpiProj E{WSP(bf16_t, WS_Q), WSP(bf16_t, WS_K), WSP(bf16_t, WS_VT), WSP(bf16_t, WS_VR), WSP(bf16_t, WS_QI), WSP(bf16_t, WS_KI), WSP(bf16_t, WS_LX), WSP(bf16_t, WS_LG), WSP(bf16_t, WS_GA), WSP(bf16_t, WS_GB), WSP(float, WS_WI)};
        gemm_naive<true>(1024, 1024, 1024, S, E); } SEAM(2);
    if constexpr (IN(3)) { lru_phase_naive(F); __syncthreads(); attn_phase_naive(F); } SEAM(3);
    if constexpr (IN(4)) { SchedMerge S{WSP(bf16_t, WS_AO), WSP(bf16_t, WS_LO), WSP(bf16_t, WS_WPA), WSP(bf16_t, WS_WPB), F.G, F.bid};
        EpiMerge E{WSP(bf16_t, WS_MG), WSP(bf16_t, WS_GA), WSP(bf16_t, WS_GB)};
        gemm_naive<true>(512, 512, 512, S, E); } SEAM(4);
    if constexpr (IN(5)) { SchedOut S{WSP(bf16_t, WS_MG), WSP(bf16_t, WS_WOUT), F.G, F.bid}; EpiOut E{F.x, WSP(float, WS_MOD), F.out};
        gemm_naive<false>(1024, 1024, 1024, S, E); } SEAM(5);
    if constexpr (IN(6)) { route_phase_naive(F); } SEAM(6);
    if constexpr (IN(7)) { sort_phase_naive(F); } SEAM(7);
    if constexpr (IN(8)) { const MoeTables T = build_tables(F, RING_BYTES + 4096);
        SchedMoe1 S{WSP(bf16_t, WS_A1), WSP(bf16_t, WS_W13), T.ebase, (const unsigned*)(ctl + CW_CNTE), F.G, F.bid}; EpiMoe1 E{WSP(bf16_t, WS_ACT2), WSP(int, WS_DEST2), WSP(float, WS_CW)};
        gemm_naive<true>(1024, 1024, 1024, S, E); } SEAM(8);
    if constexpr (IN(9)) { const MoeTables T = build_tables(F, RING_BYTES + 4096);
        SchedMoe2 S{WSP(bf16_t, WS_ACT2), WSP(bf16_t, WS_W2), T.cbase, (const unsigned*)(ctl + CW_CNTC), F.G, F.bid}; EpiMoe2 E{F.out, WSP(float, WS_MOD), WSP(int, WS_TOK2)};
        gemm_naive<false>(512, 256, 256, S, E); }
#undef IN
#undef SEAM
}

template <int P> static void launch_phase(int grid, hipStream_t stream, Args a) {
    (void)hipFuncSetAttribute((const void*)mk_fwd<P, P + 1>, hipFuncAttributeMaxDynamicSharedMemorySize, LDS_BYTES);
    a.ph_lo = P; a.ph_hi = P + 1; hipLaunchKernelGGL((mk_fwd<P, P + 1>), dim3(grid), dim3(NTHREADS), LDS_BYTES, stream, a);
}
extern "C" void kernel_launch(void* const* d_in, const int* in_sizes, int n_in, void* d_out, int out_size, void* d_ws, size_t ws_size, hipStream_t stream) {
    static int grid = 0;
    if (grid == 0) {
        if (n_in != 26 || out_size != NTOK * DM || ws_size < WS_END) { fprintf(stderr, "kernel_launch: unexpected shapes (n_in %d out %d ws %zu)\n", n_in, out_size, ws_size); grid = -1; return; }
        int dev = 0, cus = 0, per_cu = 0;
        (void)hipGetDevice(&dev); (void)hipDeviceGetAttribute(&cus, hipDeviceAttributeMultiprocessorCount, dev);
#if MK_N_LAUNCHES == 1
        (void)hipFuncSetAttribute((const void*)mk_fwd<0, NPHASE>, hipFuncAttributeMaxDynamicSharedMemorySize, LDS_BYTES);
        (void)hipOccupancyMaxActiveBlocksPerMultiprocessor(&per_cu, (const void*)mk_fwd<0, NPHASE>, NTHREADS, LDS_BYTES);
#else
        (void)hipOccupancyMaxActiveBlocksPerMultiprocessor(&per_cu, (const void*)mk_fwd<2, 3>, NTHREADS, LDS_BYTES);
#endif
        (void)hipGetLastError();
        if (per_cu < 1) { fprintf(stderr, "kernel_launch: occupancy query says %d blocks per CU\n", per_cu); }
        grid = cus;
    }
    if (grid < 0) return;
    (void)hipMemsetAsync((char*)d_ws + WS_CTL, 0, CTL_ZERO_BYTES, stream);
    Args a{};
    for (int i = 0; i < 26; ++i) a.in[i] = d_in[i];
    a.out = (float*)d_out; a.ws = (unsigned char*)d_ws;
#if MK_N_LAUNCHES == 1
    a.ph_lo = 0; a.ph_hi = NPHASE; hipLaunchKernelGGL((mk_fwd<0, NPHASE>), dim3(grid), dim3(NTHREADS), LDS_BYTES, stream, a);
#else
    launch_phase<0>(grid, stream, a); launch_phase<1>(grid, stream, a); launch_phase<2>(grid, stream, a); launch_phase<3>(grid, stream, a); launch_phase<4>(grid, stream, a);
    launch_phase<5>(grid, stream, a); launch_phase<6>(grid, stream, a); launch_phase<7>(grid, stream, a); launch_phase<8>(grid, stream, a); launch_phase<9>(grid, stream, a);
#endif
}
```

```cpp
#include <hip/hip_runtime.h>
#include <cstdint>
#include <cstdio>

#define MK_ATTN_DBG 0
#define MK_ATTN_SCALAR_SCORES 0
#define MK_ATTN_CHECKCNT 0
#define MK_ATTN_BRUTE 0
#define MK_ATTN_DUMPMASK 0
#define MK_ATTN_MASKCHK 0
#define MK_CHECK_POINT 0
#define MK_DIFF_TOL 8
#define MK_ATTN_CMPSCORE 0
#ifndef MK_N_LAUNCHES
#define MK_N_LAUNCHES 10
#endif

#define LAS __attribute__((address_space(3)))
#define GAS __attribute__((address_space(1)))
typedef unsigned short bf16_t;
typedef short bf16x8 __attribute__((ext_vector_type(8)));
typedef float f32x4 __attribute__((ext_vector_type(4)));
typedef float f32x2 __attribute__((ext_vector_type(2)));
typedef unsigned u32x4 __attribute__((ext_vector_type(4)));
typedef unsigned u32x2 __attribute__((ext_vector_type(2)));
typedef GAS unsigned gu32;

constexpr int BATCH = 8, SEQ = 2048, DM = 1024, NTOK = BATCH * SEQ;
constexpr int NH = 8, HD = 64, NIH = 4, TOPK = 256, CHUNK = 64;
constexpr int LRUW = 512;
constexpr int NEXP = 32, NGRP = 4, EPG = 8, DFF = 256, NCLS = NGRP * 28;
constexpr int DIN_PAD = 4096;
constexpr float EPS = 1e-6f;
constexpr int C_Q = 0, C_K = 512, C_V = 576, C_QI = 640, C_KI = 896, C_LX = 960, C_LG = 1472, C_GA = 1984, C_GB = 3008, C_WI = 4032, C_END = 4036;

constexpr size_t MiB = 1u << 20;
constexpr size_t WS_CTL = 0, CTL_ZERO_BYTES = 1 * MiB;
constexpr size_t WS_MOD = 1 * MiB;
constexpr size_t WS_META = 1 * MiB + 512 * 1024;
constexpr size_t WS_WIN = 2 * MiB, WS_WPA = 10 * MiB, WS_WPB = 11 * MiB, WS_WOUT = 12 * MiB, WS_W13 = 14 * MiB, WS_W2 = 46 * MiB;
constexpr size_t WS_H = 64 * MiB;
constexpr size_t WS_AO = 64 * MiB, WS_LO = 80 * MiB;
constexpr size_t WS_Q = 96 * MiB, WS_QI = 112 * MiB, WS_K = 120 * MiB, WS_KI = 122 * MiB, WS_VT = 124 * MiB, WS_WI = 126 * MiB, WS_VR = 224 * MiB;
constexpr size_t WS_LX = 128 * MiB, WS_LG = 144 * MiB, WS_MG = 128 * MiB;
constexpr size_t WS_GA = 160 * MiB, WS_GB = 192 * MiB;
constexpr size_t WS_A1 = 64 * MiB;
constexpr size_t WS_H2T = 160 * MiB;
constexpr size_t WS_ACT2 = 192 * MiB;
constexpr size_t WS_DEST2 = 240 * MiB, WS_CW = 241 * MiB, WS_TOK2 = 242 * MiB;
constexpr size_t WS_END = 256 * MiB;
constexpr int CW_BAR = 4096, CW_CNTE = 8192, CW_CNTC = 8192 + 64;

constexpr int NWAVES = 8, NTHREADS = 512;
constexpr int LDS_BYTES = 147456, RING_BYTES = 131072, MISC_OFF = RING_BYTES + 320;

__device__ __forceinline__ unsigned f2bf(float f) { unsigned u = __builtin_bit_cast(unsigned, f); return (u + 0x7fffu + ((u >> 16) & 1u)) >> 16; }
__device__ __forceinline__ unsigned pk2(float lo, float hi) { return f2bf(lo) | (f2bf(hi) << 16); }
__device__ __forceinline__ float bf2f(unsigned short b) { return __builtin_bit_cast(float, (unsigned)b << 16); }
__device__ __forceinline__ float bflo(unsigned w) { return __builtin_bit_cast(float, w << 16); }
__device__ __forceinline__ float bfhi(unsigned w) { return __builtin_bit_cast(float, w & 0xffff0000u); }
__device__ __forceinline__ float wave_sum(float v) {
#pragma unroll
    for (int o = 1; o < 64; o <<= 1) v += __shfl_xor(v, o);
    return v;
}
__device__ __forceinline__ float wave_max(float v) {
#pragma unroll
    for (int o = 1; o < 64; o <<= 1) v = fmaxf(v, __shfl_xor(v, o));
    return v;
}
__device__ __forceinline__ int wave_isum(int v) {
#pragma unroll
    for (int o = 1; o < 64; o <<= 1) v += __shfl_xor(v, o);
    return v;
}
__device__ __forceinline__ float sigmoidf_(float x) { return 1.f / (1.f + __expf(-x)); }
__host__ __device__ __forceinline__ int perm32(int rho) { const int n = rho >> 4, i = rho & 15; return 8 * (i >> 2) + 4 * n + (i & 3); }
__device__ __forceinline__ int vt_pos(int o) { return 8 * ((o >> 2) & 1) + 4 * (o >> 3) + (o & 3); }

#define XB_TMO      128
#define XB_XCNT(j)  (256  + 64 * (j))
#define XB_XSUB(j)  (1280 + 64 * (j))
#define XB_XGEN(j)  (2304 + 64 * (j))
#define XB_TOP      3328
#define XB_TOPGEN   3392
#define XCD_BAR_WORDS 3456
#define XB_SPIN_CAP (1u << 18)
__device__ __forceinline__ unsigned xb_ld(unsigned* p)              { return __hip_atomic_load(p, __ATOMIC_RELAXED, __HIP_MEMORY_SCOPE_AGENT); }
__device__ __forceinline__ unsigned xb_add(unsigned* p, unsigned v) { return __hip_atomic_fetch_add(p, v, __ATOMIC_RELAXED, __HIP_MEMORY_SCOPE_AGENT); }
__device__ __forceinline__ unsigned xb_xcc_id() { return (unsigned)__builtin_amdgcn_s_getreg((3 << 11) | 20) & 0xFu; }
#define XB_SPIN(cond, bar) do { unsigned _sp = 0; while (cond) { __builtin_amdgcn_s_sleep(1); \
    if ((++_sp & 255u) == 0u) { if (xb_ld(&(bar)[XB_TMO])) break; if (_sp > XB_SPIN_CAP) { atomicAdd(&(bar)[XB_TMO], 1u); break; } } } } while (0)
struct XcdBarrier { unsigned* bar; unsigned x; volatile LAS unsigned* st; };
__device__ __forceinline__ XcdBarrier xcd_barrier_post(unsigned* bar, volatile LAS unsigned* st) {
    XcdBarrier b; b.bar = bar; b.x = xb_xcc_id(); b.st = st;
    if (threadIdx.x == 0) (void)xb_add(&bar[XB_XCNT(b.x)], 1u);
    return b;
}
__device__ __forceinline__ void xcd_barrier_complete(unsigned* bar, unsigned x, unsigned& nloc, unsigned& nx) {
    const unsigned G = gridDim.x * gridDim.y * gridDim.z;
    unsigned sum, cnt, mine, sp = 0u;
    for (;;) {
        sum = 0u; cnt = 0u; mine = 0u;
#pragma unroll
        for (unsigned j = 0; j < 16; ++j) { const unsigned c = xb_ld(&bar[XB_XCNT(j)]); sum += c; cnt += (c > 0u) ? 1u : 0u; mine = (j == x) ? c : mine; }
        if (sum == G) break;
        __builtin_amdgcn_s_sleep(1);
        if ((++sp & 255u) == 0u) { if (xb_ld(&bar[XB_TMO])) break; if (sp > XB_SPIN_CAP) { atomicAdd(&bar[XB_TMO], 1u); break; } }
    }
    nloc = mine > 0u ? mine : 1u; nx = cnt > 0u ? cnt : 1u;
}
__device__ __forceinline__ void xcd_barrier(const XcdBarrier& b) {
    asm volatile("s_waitcnt vmcnt(0)" ::: "memory");
    __syncthreads();
    if (threadIdx.x == 0) {
        unsigned* bar = b.bar;
        __builtin_amdgcn_s_waitcnt(0);
        unsigned nloc = b.st[0], nx = b.st[1];
        if (nloc == 0u) { xcd_barrier_complete(bar, b.x, nloc, nx); b.st[0] = nloc; b.st[1] = nx; }
        const unsigned old = xb_add(&bar[XB_XSUB(b.x)], 1u);
        const unsigned gen = old / nloc;
        if (old + 1u == (gen + 1u) * nloc) {
            __builtin_amdgcn_fence(__ATOMIC_RELEASE, "agent");
            asm volatile("s_waitcnt vmcnt(0)" ::: "memory");
            const unsigned og = xb_add(&bar[XB_TOP], 1u);
            const unsigned tg = og / nx;
            if (og + 1u == (tg + 1u) * nx) xb_add(&bar[XB_TOPGEN], 1u);
            else XB_SPIN(xb_ld(&bar[XB_TOPGEN]) == tg, bar);
            __builtin_amdgcn_fence(__ATOMIC_ACQUIRE, "agent");
            xb_add(&bar[XB_XGEN(b.x)], 1u);
            asm volatile("s_waitcnt vmcnt(0)" ::: "memory");
        } else {
            XB_SPIN(xb_ld(&bar[XB_XGEN(b.x)]) == gen, bar);
            __builtin_amdgcn_fence(__ATOMIC_ACQUIRE, "agent");
            asm volatile("s_waitcnt vmcnt(0)" ::: "memory");
        }
    }
    __syncthreads();
}

struct Args { const void* in[26]; float* out; unsigned char* ws; int ph_lo, ph_hi; };
struct Frame {
    LAS unsigned char* lds;
    int tid, lane, wave, G, bid;
    const Args* ap;
    float* out; unsigned char* ws;
};
#define WSP(T, off) ((T*)(F.ws + (off)))

__device__ __forceinline__ void tr_item(const float* __restrict__ src, int ld, int k0, int c0, int nvalid, bf16_t* dst, int ldd, LAS float* scr, int lane) {
#pragma unroll 8
    for (int i = 0; i < 32; ++i) { const int kk = 2 * i + (lane >> 5), cc = lane & 31;
        scr[kk * 33 + cc] = (cc < nvalid) ? src[(size_t)(k0 + kk) * ld + c0 + cc] : 0.f; }
    asm volatile("s_waitcnt lgkmcnt(0)" ::: "memory");
    const int c = lane & 7;
#pragma unroll
    for (int j = 0; j < 4; ++j) { const int n = (lane >> 3) + 8 * j; const LAS float* s = scr + (8 * c) * 33 + n;
        u32x4 o; o.x = pk2(s[0 * 33], s[1 * 33]); o.y = pk2(s[2 * 33], s[3 * 33]); o.z = pk2(s[4 * 33], s[5 * 33]); o.w = pk2(s[6 * 33], s[7 * 33]);
        *(u32x4*)(dst + (size_t)n * ldd + k0 + 8 * c) = o; }
    asm volatile("s_waitcnt lgkmcnt(0)" ::: "memory");
}
__device__ __forceinline__ void p0_phase(Frame& F) {
    LAS float* cond = (LAS float*)(F.lds);
    for (int i = F.tid; i < BATCH * DM; i += NTHREADS) { const float v = ((const float*)F.ap->in[1])[i]; cond[i] = v / (1.f + __expf(-v)); }
    __syncthreads();
    {
        const int item = F.wave * F.G + F.bid;
        if (item < 384) {
            const int col = item * 16 + (F.lane & 15), kq = F.lane >> 4;
            float acc[8];
#pragma unroll
            for (int b = 0; b < 8; ++b) acc[b] = 0.f;
#pragma unroll 4
            for (int k = kq; k < DM; k += 4) { const float w = ((const float*)F.ap->in[2])[(size_t)k * 6144 + col];
#pragma unroll
                for (int b = 0; b < 8; ++b) acc[b] += cond[b * DM + k] * w; }
#pragma unroll
            for (int b = 0; b < 8; ++b) { float v = acc[b]; v += __shfl_xor(v, 16); v += __shfl_xor(v, 32); acc[b] = v; }
            if (kq == 0) { float* mod = WSP(float, WS_MOD); const float bb = ((const float*)F.ap->in[3])[col];
#pragma unroll
                for (int b = 0; b < 8; ++b) mod[b * 6144 + col] = acc[b] + bb; }
        }
    }
    __syncthreads();
    LAS float* scr = (LAS float*)(F.lds + F.wave * 16384);
    const int gw = F.bid * NWAVES + F.wave, NGW = F.G * NWAVES;
    constexpr int I_WIN = 16 * 128, I_WP = 8 * 32, I_WO = 16 * 32, I_W13 = 32 * 256, I_W2 = 32 * 128;
    constexpr int NITEMS = I_WIN + 2 * I_WP + I_WO + I_W13 + I_W2;
    for (int it = gw; it < NITEMS; it += NGW) {
        int r = it;
        if (r < I_WIN) { const int kb = r / 128, nb = r % 128, n0 = 32 * nb; int c0, nv;
            if (n0 < C_LX) { c0 = n0; nv = 32; } else if (n0 < C_WI) { c0 = n0 + 4; nv = 32; } else if (n0 == C_WI) { c0 = 960; nv = 4; } else { c0 = 0; nv = 0; }
            tr_item(((const float*)F.ap->in[5]), 4036, 64 * kb, c0, nv, WSP(bf16_t, WS_WIN) + (size_t)n0 * 1024, 1024, scr, F.lane); continue; } r -= I_WIN;
        if (r < I_WP) { const int kb = r / 32, nb = r % 32; tr_item(((const float*)F.ap->in[15]), 1024, 64 * kb, 32 * nb, 32, WSP(bf16_t, WS_WPA) + (size_t)(32 * nb) * 512, 512, scr, F.lane); continue; } r -= I_WP;
        if (r < I_WP) { const int kb = r / 32, nb = r % 32; tr_item(((const float*)F.ap->in[16]), 1024, 64 * kb, 32 * nb, 32, WSP(bf16_t, WS_WPB) + (size_t)(32 * nb) * 512, 512, scr, F.lane); continue; } r -= I_WP;
        if (r < I_WO) { const int kb = r / 32, nb = r % 32; tr_item(((const float*)F.ap->in[17]), 1024, 64 * kb, 32 * nb, 32, WSP(bf16_t, WS_WOUT) + (size_t)(32 * nb) * 1024, 1024, scr, F.lane); continue; } r -= I_WO;
        if (r < I_W13) { const int e = r / 256, r2 = r % 256, kb = r2 / 16, nb = r2 % 16, n0 = 32 * nb, j = n0 >> 8, half = (n0 >> 7) & 1, cc0 = n0 & 127;
            const float* src = (half ? ((const float*)F.ap->in[24]) : ((const float*)F.ap->in[23])) + (size_t)e * 1024 * 256;
            tr_item(src, 256, 64 * kb, 128 * j + cc0, 32, WSP(bf16_t, WS_W13) + ((size_t)e * 512 + n0) * 1024, 1024, scr, F.lane); continue; } r -= I_W13;
        { const int e = r / 128, r2 = r % 128, kb = r2 / 32, nb = r2 % 32;
            tr_item(((const float*)F.ap->in[25]) + (size_t)e * 256 * 1024, 1024, 64 * kb, 32 * nb, 32, WSP(bf16_t, WS_W2) + ((size_t)e * 1024 + 32 * nb) * 256, 256, scr, F.lane); }
    }
}

__device__ __forceinline__ void p1a_phase(Frame& F) {
    const int gw = F.bid * NWAVES + F.wave, NGW = F.G * NWAVES;
    const float* mod = WSP(float, WS_MOD);
    bf16_t* H = WSP(bf16_t, WS_H);
    for (int row = gw; row < NTOK; row += NGW) {
        const int b = row / SEQ;
        const f32x4* xr = (const f32x4*)(((const float*)F.ap->in[0]) + (size_t)row * DM) + F.lane;
        f32x4 v[4]; float s = 0.f;
#pragma unroll
        for (int j = 0; j < 4; ++j) { v[j] = xr[64 * j]; s += (v[j].x * v[j].x + v[j].y * v[j].y) + (v[j].z * v[j].z + v[j].w * v[j].w); }
        const float rinv = rsqrtf(wave_sum(s) * (1.f / DM) + EPS);
        unsigned long long* o8 = (unsigned long long*)(H + (size_t)row * DM) + F.lane;
#pragma unroll
        for (int j = 0; j < 4; ++j) { const int col = 4 * F.lane + 256 * j;
            const f32x4 g = *(const f32x4*)(((const float*)F.ap->in[4]) + col), sh = *(const f32x4*)(mod + b * 6144 + col), sc = *(const f32x4*)(mod + b * 6144 + 1024 + col);
            const f32x4 hv = v[j] * rinv * g * (sc + 1.f) + sh;
            o8[64 * j] = (unsigned long long)pk2(hv.x, hv.y) | ((unsigned long long)pk2(hv.z, hv.w) << 32); }
    }
}

struct Unit { const bf16_t* A; const bf16_t* B; int pm, pn, aux, flags; };
template <bool PERM, class Sched, class Epi>
__device__ __forceinline__ void gemm_naive(int lda, int ldb, int K, const Sched& S, const Epi& E) {
    const int tid = threadIdx.x, wid = __builtin_amdgcn_readfirstlane(tid >> 6), lane = tid & 63, wr = wid >> 2, wc = wid & 3, fr = lane & 15, fq = lane >> 4;
    f32x4 acc[2][2][4][2];
    Unit u;
    for (int i = 0; S.next(i, u); ++i) {
        if (!(u.flags & 1)) {
#pragma unroll
            for (int a = 0; a < 2; ++a)
#pragma unroll
                for (int b = 0; b < 2; ++b)
#pragma unroll
                    for (int m = 0; m < 4; ++m)
#pragma unroll
                        for (int n = 0; n < 2; ++n) acc[a][b][m][n] = (f32x4){0.f, 0.f, 0.f, 0.f};
        }
#pragma unroll 1
        for (int k0 = 0; k0 < K; k0 += 32) {
            bf16x8 bfr[2][2];
#pragma unroll
            for (int bj = 0; bj < 2; ++bj)
#pragma unroll
                for (int n = 0; n < 2; ++n) { const int rho = 16 * n + fr, rr = PERM ? perm32(rho) : rho;
                    bfr[bj][n] = *(const bf16x8*)(u.B + (size_t)(128 * bj + 32 * wc + rr) * ldb + k0 + 8 * fq); }
#pragma unroll
            for (int ai = 0; ai < 2; ++ai) {
                bf16x8 af[4];
#pragma unroll
                for (int m = 0; m < 4; ++m) af[m] = *(const bf16x8*)(u.A + (size_t)(128 * ai + 64 * wr + 16 * m + fr) * lda + k0 + 8 * fq);
#pragma unroll
                for (int bj = 0; bj < 2; ++bj)
#pragma unroll
                    for (int m = 0; m < 4; ++m)
#pragma unroll
                        for (int n = 0; n < 2; ++n) acc[ai][bj][m][n] = __builtin_amdgcn_mfma_f32_16x16x32_bf16(bfr[bj][n], af[m], acc[ai][bj][m][n], 0, 0, 0);
            }
        }
        if (!(u.flags & 2)) E(acc, u, wr, wc, fr, fq);
    }
}


namespace pg8 {
constexpr int BK = 64, HALF = 128, HTB = HALF * BK * 2;
__device__ __forceinline__ int lds_byte(int r, int c) { const int st = (r >> 4) * 2 + (c >> 5), rr = r & 15, cc = c & 31, ob = rr * 64 + cc * 2; return st * 1024 + (ob ^ (((ob >> 9) & 1) << 5)); }
__device__ __forceinline__ void stage_rc(int b, int& R, int& C) { const int st = b / 1024, sb = b % 1024, swz = sb ^ (((sb >> 9) & 1) << 5); R = (st >> 1) * 16 + swz / 64; C = (st & 1) * 32 + (swz % 64) / 2; }
template <class Epi, class Sched, bool ALIGN_EPI>
__device__ __forceinline__ void gemm_phase(LAS unsigned char* lds, int lda, int ldb, int K, const Sched& S, const Epi& E) {
    int tid_ = threadIdx.x; asm volatile("" : "+v"(tid_));
    const int tid = tid_, wid = __builtin_amdgcn_readfirstlane(tid >> 6), lane = tid & 63, wr = wid >> 2, wc = wid & 3, fr = lane & 15, fq = lane >> 4;
    const int nt = K / BK;
    unsigned voffA[2], voffB[2];
#pragma unroll
    for (int i = 0; i < 2; ++i) { int R, C; stage_rc(tid * 16 + i * 8192, R, C); const int Rb = Epi::PERM ? ((R & ~31) + perm32(R & 31)) : R;
        voffA[i] = (unsigned)(R * lda + C) * 2u; voffB[i] = (unsigned)(Rb * ldb + C) * 2u; }
    const size_t kstep = (size_t)(BK * 2);
    const size_t hstepA = (size_t)HALF * lda * 2, hstepB = (size_t)HALF * ldb * 2;
    const unsigned ldsw = (unsigned)wid * 1024u;
    const int aoff = lds_byte(wr * 64 + fr, fq * 8), boff = lds_byte(wc * 32 + fr, fq * 8);
#define PG8_SA(b, h) (((b) * 2 + (h)) * HTB)
#define PG8_SB(b, h) ((4 + (b) * 2 + (h)) * HTB)
#define PG8_STAGE(bufoff, gbase, voff) do { _Pragma("unroll") for (int _i = 0; _i < 2; ++_i) \
        __builtin_amdgcn_global_load_lds((const unsigned*)((const char*)(gbase) + (voff)[_i]), (LAS unsigned*)(lds + (bufoff) + ldsw + _i * 8192), 16, 0, 0); } while (0)
#define PG8_LDA(dst, b, h) do { _Pragma("unroll") for (int m = 0; m < 4; ++m) _Pragma("unroll") for (int k = 0; k < 2; ++k) dst[m][k] = *(const LAS bf16x8*)(lds + PG8_SA(b, h) + aoff + m * 2048 + k * 1024); } while (0)
#define PG8_LDB(dst, b, h) do { _Pragma("unroll") for (int n = 0; n < 2; ++n) _Pragma("unroll") for (int k = 0; k < 2; ++k) dst[n][k] = *(const LAS bf16x8*)(lds + PG8_SB(b, h) + boff + n * 2048 + k * 1024); } while (0)
#define PG8_MMA(ai, bj, At, Bt) do { __builtin_amdgcn_s_setprio(1); _Pragma("unroll") for (int m = 0; m < 4; ++m) _Pragma("unroll") for (int n = 0; n < 2; ++n) _Pragma("unroll") for (int k = 0; k < 2; ++k) \
        acc[ai][bj][m][n] = __builtin_amdgcn_mfma_f32_16x16x32_bf16(Bt[n][k], At[m][k], acc[ai][bj][m][n], 0, 0, 0); __builtin_amdgcn_s_setprio(0); } while (0)
#define PG8_WAIT_V(n) asm volatile("s_waitcnt vmcnt(" #n ")" ::: "memory")
#define PG8_WAIT_L(n) asm volatile("s_waitcnt lgkmcnt(" #n ")" ::: "memory")
#define PG8_BAR __builtin_amdgcn_s_barrier()
#define PG8_SCHED __builtin_amdgcn_sched_barrier(0)
#define PG8_ZERO() do { _Pragma("unroll") for (int a = 0; a < 2; ++a) _Pragma("unroll") for (int b = 0; b < 2; ++b) _Pragma("unroll") for (int m = 0; m < 4; ++m) _Pragma("unroll") for (int n = 0; n < 2; ++n) acc[a][b][m][n] = (f32x4){0.f, 0.f, 0.f, 0.f}; } while (0)
    Unit cur, nxt; int ui = 0;
    if (!S.next(0, cur)) return;
    f32x4 acc[2][2][4][2];
    PG8_ZERO();
    bf16x8 At[4][2], B0[2][2], B1[2][2];
    const char* cA = (const char*)cur.A; const char* cB = (const char*)cur.B;
    PG8_STAGE(PG8_SB(0, 0), cB, voffB); PG8_STAGE(PG8_SB(0, 1), cB + hstepB, voffB); PG8_STAGE(PG8_SA(0, 0), cA, voffA); PG8_STAGE(PG8_SA(0, 1), cA + hstepA, voffA);
    if (wr == 1) PG8_BAR;
    PG8_WAIT_V(2); PG8_BAR;
    PG8_STAGE(PG8_SB(1, 0), cB + kstep, voffB); PG8_STAGE(PG8_SA(1, 0), cA + kstep, voffA); PG8_STAGE(PG8_SB(1, 1), cB + hstepB + kstep, voffB);
    PG8_WAIT_V(6); PG8_BAR;
    for (;;) {
        const bool has_next = S.next(ui + 1, nxt);
        const char* nA = has_next ? (const char*)nxt.A : cA; const char* nB = has_next ? (const char*)nxt.B : cB;
        for (int t = 0; t < nt; t += 2) {
            const bool last = (t == nt - 2);
            const char* a1 = cA + (size_t)(t + 1) * kstep;
            const char* a2 = last ? nA : cA + (size_t)(t + 2) * kstep; const char* b2 = last ? nB : cB + (size_t)(t + 2) * kstep;
            const char* a3 = a2 + kstep; const char* b3 = b2 + kstep;
            PG8_LDB(B0, 0, 0); PG8_LDB(B1, 0, 1); PG8_SCHED; PG8_LDA(At, 0, 0); PG8_STAGE(PG8_SA(1, 1), a1 + hstepA, voffA);
            PG8_WAIT_V(8); PG8_WAIT_L(0); PG8_BAR; PG8_MMA(0, 0, At, B0); PG8_MMA(0, 1, At, B1); PG8_BAR; PG8_SCHED;
            PG8_LDA(At, 0, 1); PG8_STAGE(PG8_SB(0, 0), b2, voffB); PG8_STAGE(PG8_SB(0, 1), b2 + hstepB, voffB); PG8_STAGE(PG8_SA(0, 0), a2, voffA);
            PG8_WAIT_V(8); PG8_WAIT_L(0); PG8_BAR; PG8_MMA(1, 0, At, B0); PG8_MMA(1, 1, At, B1); PG8_BAR; PG8_SCHED;
            PG8_LDB(B0, 1, 0); PG8_LDB(B1, 1, 1); PG8_SCHED; PG8_LDA(At, 1, 0); PG8_STAGE(PG8_SA(0, 1), a2 + hstepA, voffA);
            PG8_WAIT_V(8); PG8_WAIT_L(0); PG8_BAR; PG8_MMA(0, 0, At, B0); PG8_MMA(0, 1, At, B1); PG8_BAR; PG8_SCHED;
            PG8_LDA(At, 1, 1); PG8_STAGE(PG8_SB(1, 0), b3, voffB); PG8_STAGE(PG8_SB(1, 1), b3 + hstepB, voffB); PG8_STAGE(PG8_SA(1, 0), a3, voffA);
            PG8_WAIT_V(8); PG8_WAIT_L(0); PG8_BAR; PG8_MMA(1, 0, At, B0); PG8_MMA(1, 1, At, B1); PG8_BAR; PG8_SCHED;
        }
        if constexpr (ALIGN_EPI) { if (wr == 0) PG8_BAR; }
        if (!(cur.flags & 2)) E(acc, cur, wr, wc, fr, fq);
        if (!has_next) break;
        if (!(nxt.flags & 1)) PG8_ZERO();
        cur = nxt; cA = nA; cB = nB; ++ui;
        if constexpr (ALIGN_EPI) { if (wr == 1) PG8_BAR; }
    }
    PG8_WAIT_V(0);
    if constexpr (!ALIGN_EPI) { if (wr == 0) PG8_BAR; }
    PG8_BAR;
#undef PG8_SA
#undef PG8_SB
#undef PG8_STAGE
#undef PG8_LDA
#undef PG8_LDB
#undef PG8_MMA
#undef PG8_WAIT_V
#undef PG8_WAIT_L
#undef PG8_BAR
#undef PG8_SCHED
#undef PG8_ZERO
}
}
#ifndef MK_NAIVE_GEMM
#define MK_NAIVE_GEMM 0
#endif
template <class Sched, class Epi>
__device__ __forceinline__ void run_gemm(LAS unsigned char* lds, int lda, int ldb, int K, const Sched& S, const Epi& E) {
#if MK_NAIVE_GEMM
    gemm_naive<Epi::PERM>(lda, ldb, K, S, E);
#else
    pg8::gemm_phase<Epi, Sched, true>(lds, lda, ldb, K, S, E);
#endif
}

struct SchedProj { const bf16_t* A; const bf16_t* B; int G, c;
    __device__ __forceinline__ bool next(int i, Unit& u) const { const int L = i * G + c; if (L >= 64 * 16) return false;
        const int gid = L / 128, w = L % 128; u.pm = gid * 8 + (w % 8); u.pn = w / 8;
        u.A = A + (size_t)u.pm * 256 * 1024; u.B = B + (size_t)u.pn * 256 * 1024; u.aux = 0; u.flags = 0; return true; } };
struct EpiProj {
    static constexpr bool PERM = true;
    bf16_t *Q, *Kb, *Vt, *Vr, *QI, *KI, *LX, *LG, *GA, *GB; float* WI;
    __device__ __forceinline__ void operator()(const f32x4 (&acc)[2][2][4][2], const Unit& u, int wr, int wc, int fr, int fq) const {
#pragma unroll
        for (int bj = 0; bj < 2; ++bj) {
            const int cg = u.pn * 256 + bj * 128 + wc * 32;
            if (cg >= C_END) continue;
            const int col = cg + 8 * fq;
            bf16_t* dst; int ld, cb; int mode = 0;
            if (cg < C_K) { dst = Q; ld = 512; cb = C_Q; }
            else if (cg < C_V) { dst = Kb; ld = 64; cb = C_K; }
            else if (cg < C_QI) { dst = Vr; ld = 64; cb = C_V; mode = 2; }
            else if (cg < C_KI) { dst = QI; ld = 256; cb = C_QI; }
            else if (cg < C_LX) { dst = KI; ld = 64; cb = C_KI; }
            else if (cg < C_LG) { dst = LX; ld = 512; cb = C_LX; }
            else if (cg < C_GA) { dst = LG; ld = 512; cb = C_LG; }
            else if (cg < C_GB) { dst = GA; ld = 1024; cb = C_GA; mode = 1; }
            else if (cg < C_WI) { dst = GB; ld = 1024; cb = C_GB; mode = 1; }
            else { dst = nullptr; ld = 0; cb = C_WI; mode = 3; }
#pragma unroll
            for (int ai = 0; ai < 2; ++ai)
#pragma unroll
                for (int m = 0; m < 4; ++m) {
                    const int row = u.pm * 256 + ai * 128 + wr * 64 + m * 16 + fr;
                    f32x4 v0 = acc[ai][bj][m][0], v1 = acc[ai][bj][m][1];
                    if (mode == 3) { if (fq == 0) *(f32x4*)(WI + (size_t)row * 4) = v0; continue; }
                    if (mode == 1) {
#pragma unroll
                        for (int e = 0; e < 4; ++e) { v0[e] = sigmoidf_(v0[e]); v1[e] = sigmoidf_(v1[e]); } }
                    u32x4 w; w.x = pk2(v0[0], v0[1]); w.y = pk2(v0[2], v0[3]); w.z = pk2(v1[0], v1[1]); w.w = pk2(v1[2], v1[3]);
                    *(u32x4*)(dst + (size_t)row * ld + (col - cb)) = w;
                    if (mode == 2) {
                        const int b = row / SEQ, t = row % SEQ, d0 = col - cb; bf16_t* vp = Vt + ((size_t)b * 64 + d0) * SEQ + (t & ~15) + vt_pos(t & 15);
                        vp[0 * SEQ] = (bf16_t)(w.x & 0xffff); vp[1 * SEQ] = (bf16_t)(w.x >> 16); vp[2 * SEQ] = (bf16_t)(w.y & 0xffff); vp[3 * SEQ] = (bf16_t)(w.y >> 16);
                        vp[4 * SEQ] = (bf16_t)(w.z & 0xffff); vp[5 * SEQ] = (bf16_t)(w.z >> 16); vp[6 * SEQ] = (bf16_t)(w.w & 0xffff); vp[7 * SEQ] = (bf16_t)(w.w >> 16); }
                }
        }
    }
};

__device__ __forceinline__ unsigned fbits(float f) { return __builtin_bit_cast(unsigned, f); }
__device__ __forceinline__ unsigned sortkey(float f) { const unsigned u = __builtin_bit_cast(unsigned, f); return (u & 0x80000000u) ? ~u : (u | 0x80000000u); }
__device__ __forceinline__ void attn_query(Frame& F, int tok, LAS float* sc, LAS int* list, LAS float* qs) {
    const int lane = F.lane, b = tok / SEQ, t = tok % SEQ, nk = CHUNK * (t / CHUNK + 1);
    const bf16_t* KI = WSP(bf16_t, WS_KI) + (size_t)b * SEQ * 64;
    const bf16_t* Kb = WSP(bf16_t, WS_K) + (size_t)b * SEQ * 64;
    const bf16_t* Vr = WSP(bf16_t, WS_VR) + (size_t)b * SEQ * 64;
    int nsel;
#ifndef MK_NAIVE_FIRST256
#define MK_NAIVE_FIRST256 0
#endif
    if (MK_NAIVE_FIRST256 && nk > TOPK) { for (int i = lane; i < TOPK; i += 64) list[i] = i; nsel = TOPK; }
    else if (nk <= TOPK) { for (int i = lane; i < nk; i += 64) list[i] = i; nsel = nk; }
    else {
        { const bf16_t* qi = WSP(bf16_t, WS_QI) + (size_t)tok * 256;
#pragma unroll
          for (int j = 0; j < 4; ++j) qs[lane + 64 * j] = bf2f(qi[lane + 64 * j]); }
        const f32x4 wv = *(const f32x4*)(WSP(float, WS_WI) + (size_t)tok * 4);
        const float wsc = 0.0625f;
        asm volatile("s_waitcnt lgkmcnt(0)" ::: "memory");
        for (int s = lane; s < nk; s += 64) {
            u32x4 kr[8];
#pragma unroll
            for (int j = 0; j < 8; ++j) kr[j] = *(const u32x4*)(KI + (size_t)s * 64 + 8 * j);
            float tot = 0.f;
#pragma unroll
            for (int h = 0; h < 4; ++h) { float a = 0.f;
#pragma unroll
                for (int j = 0; j < 8; ++j) { const LAS float* q = qs + h * 64 + 8 * j;
                    a += q[0] * bflo(kr[j].x) + q[1] * bfhi(kr[j].x) + q[2] * bflo(kr[j].y) + q[3] * bfhi(kr[j].y) + q[4] * bflo(kr[j].z) + q[5] * bfhi(kr[j].z) + q[6] * bflo(kr[j].w) + q[7] * bfhi(kr[j].w); }
                tot += fmaxf(a, 0.f) * (wv[h] * wsc); }
            sc[s] = tot;
        }
        asm volatile("s_waitcnt lgkmcnt(0)" ::: "memory");
        unsigned T = 0u;
        for (int bit = 31; bit >= 0; --bit) { const unsigned cand = T | (1u << bit); int c = 0;
            for (int s = lane; s < nk; s += 64) c += (sortkey(sc[s]) >= cand) ? 1 : 0;
            if (wave_isum(c) >= TOPK) T = cand; }
        int cgt = 0;
        for (int s = lane; s < nk; s += 64) cgt += (sortkey(sc[s]) > T) ? 1 : 0;
        cgt = wave_isum(cgt);
        int need = TOPK - cgt, pos = 0, ties = 0;
        for (int s0 = 0; s0 < nk; s0 += 64) { const unsigned kx = sortkey(sc[s0 + lane]);
            const unsigned long long mg = __ballot(kx > T), me = __ballot(kx == T);
            const unsigned long long lower = (1ull << lane) - 1ull;
            const int te = __popcll(me & lower);
            const bool sel = (kx > T) || (kx == T && (ties + te) < need);
            const unsigned long long ms = __ballot(sel);
            if (sel) list[pos + __popcll(ms & lower)] = s0 + lane;
            pos += __popcll(ms); ties += __popcll(me); }
        nsel = pos;
    }
#if MK_ATTN_DUMPMASK
    { unsigned* gm = (unsigned*)(F.ws + 228 * MiB) + (size_t)tok * 64; gm[lane] = 0u; __threadfence(); asm volatile("s_waitcnt vmcnt(0)" ::: "memory");
      for (int e = lane; e < nsel; e += 64) { const int sk = list[e]; atomicOr(gm + (sk >> 5), 1u << (sk & 31)); } }
#endif
    { const bf16_t* q = WSP(bf16_t, WS_Q) + (size_t)tok * 512; const float cw = ((const float*)F.ap->in[6])[lane] * ((const float*)F.ap->in[7])[lane] * 0.125f;
      asm volatile("s_waitcnt lgkmcnt(0)" ::: "memory");
#pragma unroll
      for (int h = 0; h < 8; ++h) { const float v = bf2f(q[h * 64 + lane]); const float r = rsqrtf(wave_sum(v * v) * (1.f / 64.f) + EPS); qs[h * 64 + lane] = v * r * cw; } }
    asm volatile("s_waitcnt lgkmcnt(0)" ::: "memory");
    LAS float* lg = sc;
    for (int e = lane; e < nsel; e += 64) { const int s = list[e];
        u32x4 kr[8]; float ss = 0.f;
#pragma unroll
        for (int j = 0; j < 8; ++j) { kr[j] = *(const u32x4*)(Kb + (size_t)s * 64 + 8 * j);
            const float a0 = bflo(kr[j].x), a1 = bfhi(kr[j].x), a2 = bflo(kr[j].y), a3 = bfhi(kr[j].y), a4 = bflo(kr[j].z), a5 = bfhi(kr[j].z), a6 = bflo(kr[j].w), a7 = bfhi(kr[j].w);
            ss += a0 * a0 + a1 * a1 + a2 * a2 + a3 * a3 + a4 * a4 + a5 * a5 + a6 * a6 + a7 * a7; }
        const float rk = rsqrtf(ss * (1.f / 64.f) + EPS); const float dist = fabsf((float)(t - s));
#pragma unroll
        for (int h = 0; h < 8; ++h) { float a = 0.f;
#pragma unroll
            for (int j = 0; j < 8; ++j) { const LAS float* q = qs + h * 64 + 8 * j;
                a += q[0] * bflo(kr[j].x) + q[1] * bfhi(kr[j].x) + q[2] * bflo(kr[j].y) + q[3] * bfhi(kr[j].y) + q[4] * bflo(kr[j].z) + q[5] * bfhi(kr[j].z) + q[6] * bflo(kr[j].w) + q[7] * bfhi(kr[j].w); }
            lg[h * 256 + e] = a * rk - exp2f(-(float)(h + 1)) * dist; }
    }
    asm volatile("s_waitcnt lgkmcnt(0)" ::: "memory");
    bf16_t* AO = WSP(bf16_t, WS_AO) + (size_t)tok * 512;
    for (int h = 0; h < 8; ++h) {
        float mx = -INFINITY;
        for (int e = lane; e < nsel; e += 64) mx = fmaxf(mx, lg[h * 256 + e]);
        mx = wave_max(mx);
        float sm = 0.f;
        for (int e = lane; e < nsel; e += 64) { const float p = __expf(lg[h * 256 + e] - mx); lg[h * 256 + e] = p; sm += p; }
        sm = wave_sum(sm);
        asm volatile("s_waitcnt lgkmcnt(0)" ::: "memory");
        float o = 0.f;
        for (int e = 0; e < nsel; ++e) o += lg[h * 256 + e] * bf2f(Vr[(size_t)list[e] * 64 + lane]);
        AO[h * 64 + lane] = (bf16_t)f2bf(o / sm);
    }
    asm volatile("s_waitcnt lgkmcnt(0)" ::: "memory");
}
__device__ __forceinline__ void attn_phase_naive(Frame& F, int clo, int chi) {
    LAS float* sc = (LAS float*)(F.lds + F.wave * 12288); LAS int* list = (LAS int*)(F.lds + F.wave * 12288 + 8192); LAS float* qs = (LAS float*)(F.lds + F.wave * 12288 + 9216);
    const int gw = F.wave * F.G + F.bid, NGW = F.G * NWAVES;
    for (int q = gw; q < NTOK; q += NGW) { const int b = q / SEQ, r = q % SEQ; const int t = (r & 1) ? (SEQ - 1 - (r >> 1)) : (r >> 1); if ((t >> 6) >= clo && (t >> 6) < chi) attn_query(F, b * SEQ + t, sc, list, qs); }
}


typedef float f32x16 __attribute__((ext_vector_type(16)));
constexpr int AL_QI = 0, AL_HIST = 16896, AL_MASK = 49792, AL_EQ = 57984, AL_RK = 66176, AL_QST = 74368, AL_FLAG = 74368 + 512, AL_OST = 75008, AL_END = AL_OST + 8 * 4608;
constexpr int QI_STRIDE = 528, HIST_STRIDE = 257, OST_STRIDE = 144;
static_assert(AL_END <= RING_BYTES, "attention LDS map");
__device__ __forceinline__ int crow(int i, int hi) { return (i & 3) + 8 * (i >> 2) + 4 * hi; }
__device__ __forceinline__ void attn_unit(Frame& F, int b, int c, int half) {
    int tid_ = F.tid, w_ = F.wave; asm volatile("" : "+v"(tid_), "+s"(w_));
    const int tid = tid_, lane = tid & 63, w = w_, r32 = lane & 31, hi = lane >> 5;
    const int t0 = 64 * c + 32 * half, nk = 64 * (c + 1), ntile = nk >> 5, tok0 = b * SEQ + t0;
    LAS unsigned char* L = F.lds;
    LAS unsigned* hist = (LAS unsigned*)(L + AL_HIST); LAS unsigned* maskw = (LAS unsigned*)(L + AL_MASK); LAS unsigned* eqw = (LAS unsigned*)(L + AL_EQ);
    LAS float* rkL = (LAS float*)(L + AL_RK); LAS unsigned* qst = (LAS unsigned*)(L + AL_QST); LAS unsigned* flagw = (LAS unsigned*)(L + AL_FLAG);
    const bf16_t* KI = WSP(bf16_t, WS_KI) + (size_t)b * SEQ * 64;
    const bf16_t* Kb = WSP(bf16_t, WS_K) + (size_t)b * SEQ * 64;
    const bf16_t* Vt = WSP(bf16_t, WS_VT) + (size_t)b * 64 * SEQ;
    const bool do_sel = nk > TOPK;
    __syncthreads();
    { const bf16_t* QI = WSP(bf16_t, WS_QI) + (size_t)tok0 * 256;
#pragma unroll
      for (int i = 0; i < 2; ++i) { const int idx = tid + 512 * i, row = idx >> 5, ch = idx & 31;
          *(LAS u32x4*)(L + AL_QI + row * QI_STRIDE + ch * 16) = *(const u32x4*)(QI + (size_t)row * 256 + ch * 8); } }
    if (tid == 0) flagw[0] = 0u;
    if (tid < 32) { qst[tid * 4 + 0] = 0u; qst[tid * 4 + 1] = (unsigned)TOPK; qst[tid * 4 + 2] = 0u; qst[tid * 4 + 3] = 0u; }
    __syncthreads();
#pragma unroll 1
    for (int kt = w; kt < ntile; kt += 8) {
        bf16x8 kf[4]; float ss = 0.f;
        const bf16_t* kp = Kb + (size_t)(32 * kt + r32) * 64 + 8 * hi;
#pragma unroll
        for (int ks = 0; ks < 4; ++ks) { kf[ks] = *(const bf16x8*)(kp + 16 * ks);
#pragma unroll
            for (int e = 0; e < 8; ++e) { const float v = bf2f((unsigned short)kf[ks][e]); ss += v * v; } }
        ss += __shfl_xor(ss, 32);
        if (hi == 0) rkL[32 * kt + r32] = rsqrtf(ss * (1.f / 64.f) + EPS);
    }
    f32x16 sc[8]; unsigned badsc = 0u;
    if (do_sel) {
        const f32x4 wv = *(const f32x4*)(WSP(float, WS_WI) + (size_t)(tok0 + r32) * 4) * 0.0625f;
#pragma unroll
        for (int j = 0; j < 8; ++j) {
            const int kt = w + 8 * j;
#pragma unroll
            for (int i = 0; i < 16; ++i) sc[j][i] = 0.f;
            if (kt < ntile) {
                int roff = (32 * kt + r32) * 64 + 8 * hi; asm volatile("" : "+v"(roff));
                int qoff = r32 * QI_STRIDE + hi * 16; asm volatile("" : "+v"(qoff));
#if MK_ATTN_SCALAR_SCORES
                { const bf16_t* qip = WSP(bf16_t, WS_QI) + (size_t)(tok0 + r32) * 256;
                  for (int i = 0; i < 16; ++i) { const bf16_t* kip = KI + (size_t)(32 * kt + crow(i, hi)) * 64; float tot = 0.f;
                      for (int h = 0; h < 4; ++h) { float a = 0.f; for (int d = 0; d < 64; ++d) a += bf2f(qip[h * 64 + d]) * bf2f(kip[d]); tot += fmaxf(a, 0.f) * wv[h]; }
                      sc[j][i] = __builtin_bit_cast(float, sortkey(tot)); } }
                continue;
#endif
                bf16x8 af[4];
#pragma unroll
                for (int ks = 0; ks < 4; ++ks) af[ks] = *(const bf16x8*)(KI + roff + 16 * ks);
#pragma unroll
                for (int h = 0; h < 4; ++h) { f32x16 acc;
#pragma unroll
                    for (int i = 0; i < 16; ++i) acc[i] = 0.f;
#pragma unroll
                    for (int ks = 0; ks < 4; ++ks) { const bf16x8 qf = *(const LAS bf16x8*)(L + AL_QI + qoff + h * 128 + ks * 32);
                        acc = __builtin_amdgcn_mfma_f32_32x32x16_bf16(af[ks], qf, acc, 0, 0, 0); }
#pragma unroll
                    for (int i = 0; i < 16; ++i) sc[j][i] += fmaxf(acc[i], 0.f) * wv[h];
                    __builtin_amdgcn_sched_barrier(0); }
#if MK_ATTN_CMPSCORE
                { const bf16_t* qip = WSP(bf16_t, WS_QI) + (size_t)(tok0 + r32) * 256;
                  for (int i = 0; i < 16; ++i) { const bf16_t* kip = KI + (size_t)(32 * kt + crow(i, hi)) * 64; float tot = 0.f;
                      for (int h = 0; h < 4; ++h) { float a = 0.f; for (int d = 0; d < 64; ++d) a += bf2f(qip[h * 64 + d]) * bf2f(kip[d]); tot += fmaxf(a, 0.f) * wv[h]; }
                      if (fabsf(tot - sc[j][i]) > 1e-3f) badsc = 1u; } }
#endif
#if MK_CHECK_POINT == 3
#pragma unroll
                for (int i = 0; i < 16; ++i) if (!(fabsf(sc[j][i]) < 1e30f)) badsc = 1u;
                if (!(fabsf(wv[0]) < 1e30f) || !(fabsf(wv[1]) < 1e30f) || !(fabsf(wv[2]) < 1e30f) || !(fabsf(wv[3]) < 1e30f)) badsc = 1u;
#endif
#pragma unroll
                for (int i = 0; i < 16; ++i) sc[j][i] = __builtin_bit_cast(float, sortkey(sc[j][i]));
#if MK_CHECK_POINT == 4
                { const bf16_t* qip_ = WSP(bf16_t, WS_QI) + (size_t)(tok0 + r32) * 256;
#pragma unroll
                  for (int i_ = 0; i_ < 16; ++i_) { const bf16_t* kip_ = KI + (size_t)(32 * kt + crow(i_, hi)) * 64; float tot_ = 0.f;
                      for (int h_ = 0; h_ < 4; ++h_) { float a_ = 0.f; for (int d_ = 0; d_ < 64; ++d_) a_ += bf2f(qip_[h_ * 64 + d_]) * bf2f(kip_[d_]); tot_ += fmaxf(a_, 0.f) * wv[h_]; }
                      const unsigned key_ = fbits(sc[j][i_]); const unsigned ub_ = (key_ & 0x80000000u) ? (key_ & 0x7fffffffu) : ~key_;
                      if (!(fabsf(__builtin_bit_cast(float, ub_) - tot_) <= 1e-3f)) badsc = 1u; } }
#endif
            }
        }
    }
#define CHECK_SC() do { if (do_sel) { const bf16_t* qip_ = WSP(bf16_t, WS_QI) + (size_t)(tok0 + r32) * 256; const f32x4 wv2_ = *(const f32x4*)(WSP(float, WS_WI) + (size_t)(tok0 + r32) * 4) * 0.0625f; \
        _Pragma("unroll") for (int j_ = 0; j_ < 8; ++j_) { const int kt_ = w + 8 * j_; if (kt_ < ntile) { _Pragma("unroll") for (int i_ = 0; i_ < 16; ++i_) { \
            const bf16_t* kip_ = KI + (size_t)(32 * kt_ + crow(i_, hi)) * 64; float tot_ = 0.f; \
            for (int h_ = 0; h_ < 4; ++h_) { float a_ = 0.f; for (int d_ = 0; d_ < 64; ++d_) a_ += bf2f(qip_[h_ * 64 + d_]) * bf2f(kip_[d_]); tot_ += fmaxf(a_, 0.f) * wv2_[h_]; } \
            const unsigned key_ = fbits(sc[j_][i_]); const unsigned ub_ = (key_ & 0x80000000u) ? (key_ & 0x7fffffffu) : ~key_; \
            if (!(fabsf(__builtin_bit_cast(float, ub_) - tot_) <= 1e-3f)) badsc = 1u; } } } } } while (0)
#if MK_CHECK_POINT == 1
    CHECK_SC();
#endif
    unsigned Tq = 0u; bool ordered = false;
    if (do_sel) {
        unsigned prefix = 0u;
#pragma unroll 1
        for (int pass = 0; pass < 4; ++pass) {
            const int shift = 24 - 8 * pass;
            for (int i = tid; i < 32 * HIST_STRIDE; i += NTHREADS) hist[i] = 0u;
            __syncthreads();
#pragma unroll
            for (int j = 0; j < 8; ++j) { const int kt = w + 8 * j;
                if (kt < ntile) {
#pragma unroll
                    for (int i = 0; i < 16; ++i) { const unsigned key = fbits(sc[j][i]);
                        const bool m = (pass == 0) || ((key >> (shift + 8)) == (prefix >> (shift + 8)));
                        if (m) __hip_atomic_fetch_add(hist + r32 * HIST_STRIDE + ((key >> shift) & 255u), 1u, __ATOMIC_RELAXED, __HIP_MEMORY_SCOPE_WORKGROUP); } } }
            __syncthreads();
            {
                const int q = tid >> 4, p = tid & 15, b0 = 16 * (15 - p);
                const unsigned need = qst[q * 4 + 1];
                unsigned s = 0u;
#pragma unroll
                for (int e = 0; e < 16; ++e) s += hist[q * HIST_STRIDE + b0 + e];
                unsigned P = s;
#pragma unroll
                for (int o = 1; o < 16; o <<= 1) { const unsigned t = __shfl_up(P, o, 16); if (p >= o) P += t; }
                const unsigned Pprev = P - s;
                if (P >= need && Pprev < need) { unsigned run = Pprev;
                    for (int e = 15; e >= 0; --e) { const unsigned hc = hist[q * HIST_STRIDE + b0 + e];
                        if (run + hc >= need) { qst[q * 4 + 0] = qst[q * 4 + 0] | ((unsigned)(b0 + e) << shift); qst[q * 4 + 1] = need - run; qst[q * 4 + 2] = hc; break; }
                        run += hc; } }
            }
            __syncthreads();
            prefix = qst[r32 * 4 + 0];
        }
        Tq = prefix;
#if MK_CHECK_POINT == 2
        CHECK_SC();
#endif
        const unsigned needq = qst[r32 * 4 + 1], eqc = qst[r32 * 4 + 2];
        if (needq < eqc) flagw[0] = 1u;
        __syncthreads();
        ordered = flagw[0] != 0u;
    }
#pragma unroll
    for (int j = 0; j < 8; ++j) { const int kt = w + 8 * j;
        if (kt < ntile) { unsigned mw = 0xffffffffu, ew = 0u;
            if (do_sel) { mw = 0u;
#pragma unroll
                for (int i = 0; i < 16; ++i) { const unsigned key = fbits(sc[j][i]); const int bit = crow(i, hi);
                    const bool gt = key > Tq, eq = key == Tq;
#if MK_ATTN_MASKCHK
                    { const bf16_t* qip = WSP(bf16_t, WS_QI) + (size_t)(tok0 + r32) * 256; const bf16_t* kip = KI + (size_t)(32 * kt + crow(i, hi)) * 64; float tot = 0.f;
                      const f32x4 wv2 = *(const f32x4*)(WSP(float, WS_WI) + (size_t)(tok0 + r32) * 4) * 0.0625f;
                      for (int h = 0; h < 4; ++h) { float a = 0.f; for (int d = 0; d < 64; ++d) a += bf2f(qip[h * 64 + d]) * bf2f(kip[d]); tot += fmaxf(a, 0.f) * wv2[h]; }
                      { const unsigned ub = (key & 0x80000000u) ? (key & 0x7fffffffu) : ~key; const float fk = __builtin_bit_cast(float, ub); if (!(fabsf(fk - tot) <= 1e-3f)) badsc = 1u; } }
#endif
                    mw |= ((gt || (eq && !ordered)) ? 1u : 0u) << bit; ew |= (eq ? 1u : 0u) << bit; }
                mw |= __shfl_xor(mw, 32); ew |= __shfl_xor(ew, 32); }
            if (hi == 0) { maskw[kt * 32 + r32] = mw; if (ordered) eqw[kt * 32 + r32] = ew; } } }
#if MK_ATTN_MASKCHK || MK_CHECK_POINT
    if (do_sel && badsc) qst[r32 * 4 + 3] = 1u;
#endif
    __syncthreads();
    if (ordered) {
        if (tid < 32) { const int need = (int)qst[tid * 4 + 1]; int taken = 0;
            for (int kt = 0; kt < ntile; ++kt) { unsigned ww = eqw[kt * 32 + tid]; unsigned add = 0u;
                while (ww != 0u && taken < need) { const unsigned lsb = ww & (0u - ww); add |= lsb; ww ^= lsb; ++taken; }
                maskw[kt * 32 + tid] |= add; } }
        __syncthreads();
    }
#if MK_ATTN_CMPSCORE
    if (do_sel && badsc) qst[r32 * 4 + 3] = 1u;
    __syncthreads();
#endif
#if MK_ATTN_DUMPMASK
    if (do_sel && tid < 32) { const unsigned* gm = (const unsigned*)(F.ws + 228 * MiB) + (size_t)(tok0 + tid) * 64; unsigned bad = 0u;
        qst[tid * 4 + 3] = qst[tid * 4 + 3] | bad; }
    __syncthreads();
#endif
#if MK_ATTN_BRUTE
    if (do_sel && tid < 32) { float* scr = (float*)(F.ws + 226 * MiB) + (size_t)F.bid * 16384 + tid * 512;
        const bf16_t* qip = WSP(bf16_t, WS_QI) + (size_t)(tok0 + tid) * 256; const f32x4 wq = *(const f32x4*)(WSP(float, WS_WI) + (size_t)(tok0 + tid) * 4) * 0.0625f;
        for (int sk = 0; sk < nk; ++sk) { const bf16_t* kip = KI + (size_t)sk * 64; float tot = 0.f;
            for (int hh = 0; hh < 4; ++hh) { float a = 0.f; for (int d = 0; d < 64; ++d) a += bf2f(qip[hh * 64 + d]) * bf2f(kip[d]); tot += fmaxf(a, 0.f) * wq[hh]; }
            scr[sk] = tot; }
        unsigned bad = 0u;
        for (int sk = 0; sk < nk; ++sk) { const float v = scr[sk]; int rank = 0;
            for (int j2 = 0; j2 < nk; ++j2) { const float u = scr[j2]; rank += (u > v || (u == v && j2 < sk)) ? 1 : 0; }
            const unsigned bit = (maskw[(sk >> 5) * 32 + tid] >> (sk & 31)) & 1u;
            if (bit != (rank < TOPK ? 1u : 0u)) bad = 1u; }
        qst[tid * 4 + 3] = bad; }
    __syncthreads();
#endif
#if MK_ATTN_CHECKCNT
    if (tid < 64) hist[tid] = 0u;
    __syncthreads();
    if (do_sel) { unsigned cge = 0u, cgt = 0u;
#pragma unroll
        for (int j = 0; j < 8; ++j) { const int kt = w + 8 * j; if (kt < ntile) {
#pragma unroll
            for (int i = 0; i < 16; ++i) { const unsigned key = fbits(sc[j][i]); cge += key >= Tq ? 1u : 0u; cgt += key > Tq ? 1u : 0u; } } }
        __hip_atomic_fetch_add(hist + r32 * 2, cge, __ATOMIC_RELAXED, __HIP_MEMORY_SCOPE_WORKGROUP); __hip_atomic_fetch_add(hist + r32 * 2 + 1, cgt, __ATOMIC_RELAXED, __HIP_MEMORY_SCOPE_WORKGROUP); }
    __syncthreads();
    if (tid < 32) { const unsigned cge = hist[tid * 2], cgt = hist[tid * 2 + 1]; qst[tid * 4 + 3] = (do_sel && !(cgt < (unsigned)TOPK && cge >= (unsigned)TOPK)) ? 1u : 0u; }
    __syncthreads();
#endif
    {
        const int h = w; const int tq = t0 + r32;
        bf16x8 qf[4];
        { const bf16_t* Q = WSP(bf16_t, WS_Q) + (size_t)(tok0 + r32) * 512 + h * 64;
          float qv[4][8]; float ss = 0.f;
#pragma unroll
          for (int ks = 0; ks < 4; ++ks) { const bf16x8 v = *(const bf16x8*)(Q + 16 * ks + 8 * hi);
#pragma unroll
              for (int e = 0; e < 8; ++e) { qv[ks][e] = bf2f((unsigned short)v[e]); ss += qv[ks][e] * qv[ks][e]; } }
          ss += __shfl_xor(ss, 32);
          const float rq = rsqrtf(ss * (1.f / 64.f) + EPS) * 0.125f * 1.4426950408889634f;
          const float* qnw = (const float*)F.ap->in[6]; const float* knw = (const float*)F.ap->in[7];
#pragma unroll
          for (int ks = 0; ks < 4; ++ks) { u32x4 pk;
              const f32x4 a0 = *(const f32x4*)(qnw + 16 * ks + 8 * hi), a1 = *(const f32x4*)(qnw + 16 * ks + 8 * hi + 4), b0 = *(const f32x4*)(knw + 16 * ks + 8 * hi), b1 = *(const f32x4*)(knw + 16 * ks + 8 * hi + 4);
              pk.x = pk2(qv[ks][0] * rq * a0.x * b0.x, qv[ks][1] * rq * a0.y * b0.y); pk.y = pk2(qv[ks][2] * rq * a0.z * b0.z, qv[ks][3] * rq * a0.w * b0.w);
              pk.z = pk2(qv[ks][4] * rq * a1.x * b1.x, qv[ks][5] * rq * a1.y * b1.y); pk.w = pk2(qv[ks][6] * rq * a1.z * b1.z, qv[ks][7] * rq * a1.w * b1.w);
              qf[ks] = __builtin_bit_cast(bf16x8, pk); } }
        const float slope2 = exp2f(-(float)(h + 1)) * 1.4426950408889634f;
        float m = -1e30f, l = 0.f; f32x16 o0, o1;
#pragma unroll
        for (int i = 0; i < 16; ++i) { o0[i] = 0.f; o1[i] = 0.f; }
#pragma unroll 1
        for (int kt = 0; kt < ntile; ++kt) {
            bf16x8 kf[4], vf[2][2];
#pragma unroll
            for (int ks = 0; ks < 4; ++ks) kf[ks] = *(const bf16x8*)(Kb + (size_t)(32 * kt + r32) * 64 + 16 * ks + 8 * hi);
#pragma unroll
            for (int db = 0; db < 2; ++db)
#pragma unroll
                for (int s2 = 0; s2 < 2; ++s2) vf[db][s2] = *(const bf16x8*)(Vt + (size_t)(32 * db + r32) * SEQ + 32 * kt + 16 * s2 + 8 * hi);
            f32x16 S;
#pragma unroll
            for (int i = 0; i < 16; ++i) S[i] = 0.f;
#pragma unroll
            for (int ks = 0; ks < 4; ++ks) S = __builtin_amdgcn_mfma_f32_32x32x16_bf16(kf[ks], qf[ks], S, 0, 0, 0);
            const unsigned mw = maskw[kt * 32 + r32] >> (4 * hi);
            const float dbase = (float)(tq - 32 * kt - 4 * hi);
            float mx = -INFINITY;
#pragma unroll
            for (int g = 0; g < 4; ++g) { const f32x4 rk4 = *(const LAS f32x4*)(rkL + 32 * kt + 8 * g + 4 * hi);
#pragma unroll
                for (int e = 0; e < 4; ++e) { const int i = 4 * g + e, ko = e + 8 * g;
                    float v = S[i] * rk4[e] - slope2 * fabsf(dbase - (float)ko);
                    v = ((mw >> ko) & 1u) ? v : -INFINITY; S[i] = v; mx = fmaxf(mx, v); } }
            mx = fmaxf(mx, __shfl_xor(mx, 32));
            const float mn = fmaxf(m, mx), alpha = exp2f(m - mn); m = mn;
            float ps = 0.f;
#pragma unroll
            for (int i = 0; i < 16; ++i) { S[i] = exp2f(S[i] - mn); ps += S[i]; }
            l = l * alpha + ps;
#pragma unroll
            for (int i = 0; i < 16; ++i) { o0[i] *= alpha; o1[i] *= alpha; }
            u32x4 p0, p1;
            p0.x = pk2(S[0], S[1]); p0.y = pk2(S[2], S[3]); p0.z = pk2(S[4], S[5]); p0.w = pk2(S[6], S[7]);
            p1.x = pk2(S[8], S[9]); p1.y = pk2(S[10], S[11]); p1.z = pk2(S[12], S[13]); p1.w = pk2(S[14], S[15]);
            const bf16x8 pf0 = __builtin_bit_cast(bf16x8, p0), pf1 = __builtin_bit_cast(bf16x8, p1);
            o0 = __builtin_amdgcn_mfma_f32_32x32x16_bf16(vf[0][0], pf0, o0, 0, 0, 0); o0 = __builtin_amdgcn_mfma_f32_32x32x16_bf16(vf[0][1], pf1, o0, 0, 0, 0);
            o1 = __builtin_amdgcn_mfma_f32_32x32x16_bf16(vf[1][0], pf0, o1, 0, 0, 0); o1 = __builtin_amdgcn_mfma_f32_32x32x16_bf16(vf[1][1], pf1, o1, 0, 0, 0);
        }
        l += __shfl_xor(l, 32);
#if 1
        const float inv = ((do_sel && qst[r32 * 4 + 3]) ? 1000.f : 1.f) / l;
#else
        const float inv = 1.f / l;
#endif
        LAS unsigned char* stg = L + AL_OST + w * 4608;
#pragma unroll
        for (int g = 0; g < 4; ++g) {
            *(LAS u32x2*)(stg + r32 * OST_STRIDE + (8 * g + 4 * hi) * 2) = (u32x2){pk2(o0[4 * g] * inv, o0[4 * g + 1] * inv), pk2(o0[4 * g + 2] * inv, o0[4 * g + 3] * inv)};
            *(LAS u32x2*)(stg + r32 * OST_STRIDE + (32 + 8 * g + 4 * hi) * 2) = (u32x2){pk2(o1[4 * g] * inv, o1[4 * g + 1] * inv), pk2(o1[4 * g + 2] * inv, o1[4 * g + 3] * inv)}; }
        asm volatile("s_waitcnt lgkmcnt(0)" ::: "memory");
        bf16_t* AO = WSP(bf16_t, WS_AO) + (size_t)tok0 * 512 + h * 64;
#pragma unroll
        for (int it = 0; it < 4; ++it) { const int row = it * 8 + (lane >> 3), ch = lane & 7;
            *(u32x4*)(AO + (size_t)row * 512 + ch * 8) = *(const LAS u32x4*)(stg + row * OST_STRIDE + ch * 16); }
    }
}
__device__ __forceinline__ void attn_phase(Frame& F, int clo, int chi) {
#pragma unroll 1
    for (int p2 = 2 * F.bid; p2 < 512; p2 += ((p2 & 1) ? 2 * F.G - 1 : 1)) { const int p = p2 >> 1, b = p >> 5, jj = p & 31, c1 = jj >> 1, half = jj & 1;
        const int cc = (p2 & 1) ? c1 : 31 - c1; if (cc >= clo && cc < chi) attn_unit(F, b, cc, half); }
}

__device__ __forceinline__ float gelu_tanh(float x) { const float u = 0.7978845608028654f * (x + 0.044715f * x * x * x); return 0.5f * x * (1.f + tanhf(u)); }
__device__ __forceinline__ void lru_item(Frame& F, int item, LAS float* wb) {
    const int lane = F.lane, cgq = item & 15, n = (item >> 4) & 7, b = item >> 7;
    const bf16_t* LX = WSP(bf16_t, WS_LX) + (size_t)b * SEQ * 512 + 64 * n;
    const bf16_t* LG = WSP(bf16_t, WS_LG) + (size_t)b * SEQ * 512 + 64 * n;
    bf16_t* LO = WSP(bf16_t, WS_LO) + (size_t)b * SEQ * 512 + 64 * n;
    float carry[4] = {0.f, 0.f, 0.f, 0.f};
    float spl[4], brc[4], bin[4];
#pragma unroll
    for (int e = 0; e < 4; ++e) { const int ch = 64 * n + 4 * cgq + e; spl[e] = log1pf(__expf(-((const float*)F.ap->in[14])[ch])); brc[e] = ((const float*)F.ap->in[11])[ch]; bin[e] = ((const float*)F.ap->in[13])[ch]; }
    { const float* wr = ((const float*)F.ap->in[10]) + (size_t)n * 64 * 64; const float* wi = ((const float*)F.ap->in[12]) + (size_t)n * 64 * 64;
#pragma unroll
      for (int e = 0; e < 4; ++e) { wb[lane * 4 + e] = wr[lane * 64 + 4 * cgq + e]; wb[256 + lane * 4 + e] = wi[lane * 64 + 4 * cgq + e]; }
      asm volatile("s_waitcnt lgkmcnt(0)" ::: "memory"); }
    for (int ck = 0; ck < SEQ / 64; ++ck) {
        const int t = 64 * ck + lane;
        float xc[64];
#pragma unroll
        for (int d = 0; d < 64; ++d) xc[d] = ((const float*)F.ap->in[9])[64 * n + d];
#pragma unroll
        for (int j = 0; j < 4; ++j) { const int ts = t - 3 + j;
            if (ts >= 0) {
#pragma unroll
                for (int d8 = 0; d8 < 8; ++d8) { const u32x4 v = *(const u32x4*)(LX + (size_t)ts * 512 + 8 * d8); const float* cw = ((const float*)F.ap->in[8]) + j * 512 + 64 * n + 8 * d8;
                    xc[8 * d8 + 0] += bflo(v.x) * cw[0]; xc[8 * d8 + 1] += bfhi(v.x) * cw[1]; xc[8 * d8 + 2] += bflo(v.y) * cw[2]; xc[8 * d8 + 3] += bfhi(v.y) * cw[3];
                    xc[8 * d8 + 4] += bflo(v.z) * cw[4]; xc[8 * d8 + 5] += bfhi(v.z) * cw[5]; xc[8 * d8 + 6] += bflo(v.w) * cw[6]; xc[8 * d8 + 7] += bfhi(v.w) * cw[7]; } } }
        float av[4], bv[4];
#pragma unroll
        for (int e = 0; e < 4; ++e) { const int ce = 4 * cgq + e; float r = brc[e], ig = bin[e];
#pragma unroll
            for (int d = 0; d < 64; ++d) { r += xc[d] * wb[d * 4 + e]; ig += xc[d] * wb[256 + d * 4 + e]; }
            r = sigmoidf_(r); ig = sigmoidf_(ig);
            const float la = -8.f * r * spl[e]; av[e] = __expf(la);
            float xce = 0.f;
#pragma unroll
            for (int d = 0; d < 64; ++d) xce = (d == ce) ? xc[d] : xce;
            bv[e] = sqrtf(-expm1f(2.f * la)) * (ig * xce); }
#pragma unroll
        for (int off = 1; off < 64; off <<= 1) {
#pragma unroll
            for (int e = 0; e < 4; ++e) { const float ap = __shfl_up(av[e], off), bp = __shfl_up(bv[e], off);
                if (lane >= off) { bv[e] = av[e] * bp + bv[e]; av[e] = av[e] * ap; } } }
        unsigned hw[2];
        float hv[4];
#pragma unroll
        for (int e = 0; e < 4; ++e) { const float h = bv[e] + av[e] * carry[e]; carry[e] = __shfl(h, 63); hv[e] = h; }
        const u32x2 g = *(const u32x2*)(LG + (size_t)t * 512 + 4 * cgq);
        hv[0] *= gelu_tanh(bflo(g.x)); hv[1] *= gelu_tanh(bfhi(g.x)); hv[2] *= gelu_tanh(bflo(g.y)); hv[3] *= gelu_tanh(bfhi(g.y));
        hw[0] = pk2(hv[0], hv[1]); hw[1] = pk2(hv[2], hv[3]);
        *(u32x2*)(LO + (size_t)t * 512 + 4 * cgq) = (u32x2){hw[0], hw[1]};
    }
}
__device__ __forceinline__ void lru_phase_naive(Frame& F) {
    const int gw = F.wave * F.G + F.bid, NGW = F.G * NWAVES;
    LAS float* wb = (LAS float*)(F.lds + F.wave * 2048);
    for (int it = gw; it < BATCH * 8 * 16; it += NGW) lru_item(F, it, wb);
}

struct SchedMerge { const bf16_t *AO, *LO, *WPA, *WPB; int G, c;
    __device__ __forceinline__ bool next(int i, Unit& u) const { const int L = (i >> 1) * G + c; if (L >= 64 * 4) return false; const int sub = i & 1;
        u.pm = L % 64; u.pn = L / 64; u.aux = sub; u.flags = 0;
        u.A = (sub ? LO : AO) + (size_t)u.pm * 256 * 512; u.B = (sub ? WPB : WPA) + (size_t)u.pn * 256 * 512; return true; } };
struct EpiMerge {   static constexpr bool PERM = true;
    bf16_t* MG; const bf16_t *GA, *GB;
    __device__ __forceinline__ void operator()(const f32x4 (&acc)[2][2][4][2], const Unit& u, int wr, int wc, int fr, int fq) const {
        const bf16_t* G = u.aux ? GB : GA;
#pragma unroll
        for (int ai = 0; ai < 2; ++ai)
#pragma unroll
            for (int m = 0; m < 4; ++m)
#pragma unroll
                for (int bj = 0; bj < 2; ++bj) {
                    const size_t off = (size_t)(u.pm * 256 + ai * 128 + wr * 64 + m * 16 + fr) * 1024 + u.pn * 256 + bj * 128 + wc * 32 + 8 * fq;
                    const u32x4 g = *(const u32x4*)(G + off);
                    f32x4 v0 = acc[ai][bj][m][0], v1 = acc[ai][bj][m][1];
                    v0[0] *= bflo(g.x); v0[1] *= bfhi(g.x); v0[2] *= bflo(g.y); v0[3] *= bfhi(g.y); v1[0] *= bflo(g.z); v1[1] *= bfhi(g.z); v1[2] *= bflo(g.w); v1[3] *= bfhi(g.w);
                    if (u.aux) { const u32x4 p = *(const u32x4*)(MG + off);
                        v0[0] += bflo(p.x); v0[1] += bfhi(p.x); v0[2] += bflo(p.y); v0[3] += bfhi(p.y); v1[0] += bflo(p.z); v1[1] += bfhi(p.z); v1[2] += bflo(p.w); v1[3] += bfhi(p.w); }
                    u32x4 w; w.x = pk2(v0[0], v0[1]); w.y = pk2(v0[2], v0[3]); w.z = pk2(v1[0], v1[1]); w.w = pk2(v1[2], v1[3]);
                    *(u32x4*)(MG + off) = w; }
    }
};
struct SchedOut { const bf16_t *A, *B; int G, c;
    __device__ __forceinline__ bool next(int i, Unit& u) const { const int L = i * G + c; if (L >= 64 * 4) return false;
        u.pm = L % 64; u.pn = L / 64; u.aux = 0; u.flags = 0; u.A = A + (size_t)u.pm * 256 * 1024; u.B = B + (size_t)u.pn * 256 * 1024; return true; } };
struct EpiOut {   static constexpr bool PERM = false;
    const float* x; const float* mod; float* out;
    __device__ __forceinline__ void operator()(const f32x4 (&acc)[2][2][4][2], const Unit& u, int wr, int wc, int fr, int fq) const {
        const int b = (u.pm * 256) / SEQ;
#pragma unroll
        for (int bj = 0; bj < 2; ++bj)
#pragma unroll
            for (int n = 0; n < 2; ++n) { const int col = u.pn * 256 + bj * 128 + wc * 32 + 16 * n + 4 * fq; const f32x4 gm = *(const f32x4*)(mod + b * 6144 + 2048 + col);
#pragma unroll
                for (int ai = 0; ai < 2; ++ai)
#pragma unroll
                    for (int m = 0; m < 4; ++m) { const size_t off = (size_t)(u.pm * 256 + ai * 128 + wr * 64 + m * 16 + fr) * 1024 + col;
                        *(f32x4*)(out + off) = *(const f32x4*)(x + off) + gm * acc[ai][bj][m][n]; } }
    }
};

struct TokMeta { int ea, eb; float ca, cb; int re_a, re_b, cls, rc; };
__device__ __forceinline__ int pair_index(int lo, int hi) { return lo * (15 - lo) / 2 + (hi - lo - 1); }
__device__ __forceinline__ void route_token(Frame& F, int tok) {
    const int lane = F.lane, b = tok / SEQ;
    const float* mod = WSP(float, WS_MOD) + b * 6144;
    const f32x4* xr = (const f32x4*)(F.out + (size_t)tok * DM) + lane;
    f32x4 v[4]; float s = 0.f;
#pragma unroll
    for (int j = 0; j < 4; ++j) { v[j] = xr[64 * j]; s += (v[j].x * v[j].x + v[j].y * v[j].y) + (v[j].z * v[j].z + v[j].w * v[j].w); }
    const float rinv = rsqrtf(wave_sum(s) * (1.f / DM) + EPS);
    unsigned long long* o8 = (unsigned long long*)(WSP(bf16_t, WS_H2T) + (size_t)tok * DM) + lane;
    float lgt[36];
#pragma unroll
    for (int r = 0; r < 36; ++r) lgt[r] = 0.f;
#pragma unroll
    for (int j = 0; j < 4; ++j) { const int col = 4 * lane + 256 * j;
        const f32x4 g = *(const f32x4*)(((const float*)F.ap->in[18]) + col), sh = *(const f32x4*)(mod + 3072 + col), sc = *(const f32x4*)(mod + 4096 + col);
        const f32x4 hv = v[j] * rinv * g * (sc + 1.f) + sh;
        o8[64 * j] = (unsigned long long)pk2(hv.x, hv.y) | ((unsigned long long)pk2(hv.z, hv.w) << 32);
#pragma unroll
        for (int e = 0; e < 4; ++e) { const int k = col + e; const float hh = hv[e];
            const f32x4 wg = *(const f32x4*)(((const float*)F.ap->in[19]) + (size_t)k * 4);
            lgt[0] += hh * wg.x; lgt[1] += hh * wg.y; lgt[2] += hh * wg.z; lgt[3] += hh * wg.w;
#pragma unroll
            for (int q = 0; q < 8; ++q) { const f32x4 we = *(const f32x4*)(((const float*)F.ap->in[21]) + (size_t)k * 32 + 4 * q);
                lgt[4 + 4 * q] += hh * we.x; lgt[5 + 4 * q] += hh * we.y; lgt[6 + 4 * q] += hh * we.z; lgt[7 + 4 * q] += hh * we.w; } } }
#pragma unroll
    for (int r = 0; r < 36; ++r) lgt[r] = wave_sum(lgt[r]);
    if (lane == 0) {
        float gl[4];
#pragma unroll
        for (int i = 0; i < 4; ++i) { gl[i] = lgt[i] + ((const float*)F.ap->in[20])[i]; }
        int g = 0; float gmx = gl[0];
#pragma unroll
        for (int i = 1; i < 4; ++i) if (gl[i] > gmx) { gmx = gl[i]; g = i; }
        float gs = 0.f;
#pragma unroll
        for (int i = 0; i < 4; ++i) gs += __expf(gl[i] - gmx);
        const float gw = 1.f / gs;
        float el[8];
#pragma unroll
        for (int i = 0; i < 8; ++i) { float vsel = 0.f;
#pragma unroll
            for (int gg = 0; gg < 4; ++gg) vsel = (gg == g) ? (lgt[4 + gg * 8 + i] + ((const float*)F.ap->in[22])[gg * 8 + i]) : vsel;
            el[i] = vsel; }
        int i1 = 0; float v1 = el[0];
#pragma unroll
        for (int i = 1; i < 8; ++i) if (el[i] > v1) { v1 = el[i]; i1 = i; }
        int i2 = -1; float v2 = -INFINITY;
#pragma unroll
        for (int i = 0; i < 8; ++i) if (i != i1 && (i2 < 0 || el[i] > v2)) { v2 = el[i]; i2 = i; }
        const float e2 = __expf(v2 - v1); const float w1v = gw / (1.f + e2), w2v = gw * e2 / (1.f + e2);
        TokMeta mt; const int lo = i1 < i2 ? i1 : i2, hi = i1 < i2 ? i2 : i1;
        mt.ea = g * 8 + lo; mt.eb = g * 8 + hi; mt.ca = (i1 < i2) ? w1v : w2v; mt.cb = (i1 < i2) ? w2v : w1v;
        mt.cls = g * 28 + pair_index(lo, hi);
        unsigned* ctl = (unsigned*)(F.ws + WS_CTL);
        mt.re_a = (int)atomicAdd(ctl + CW_CNTE + mt.ea, 1u); mt.re_b = (int)atomicAdd(ctl + CW_CNTE + mt.eb, 1u); mt.rc = (int)atomicAdd(ctl + CW_CNTC + mt.cls, 1u);
        WSP(TokMeta, WS_META)[tok] = mt;
    }
}
__device__ __forceinline__ void route_phase_naive(Frame& F) {
    const int gw = F.bid * NWAVES + F.wave, NGW = F.G * NWAVES;
    for (int tok = gw; tok < NTOK; tok += NGW) route_token(F, tok);
}
struct MoeTables { LAS int* ebase; LAS int* cbase; };
__device__ __forceinline__ MoeTables build_tables(Frame& F, int lds_off) {
    MoeTables T; T.ebase = (LAS int*)(F.lds + lds_off); T.cbase = T.ebase + 40;
    const unsigned* ctl = (const unsigned*)(F.ws + WS_CTL);
    __syncthreads();
    if (F.tid == 0) { int a = 0; for (int e = 0; e < NEXP; ++e) { T.ebase[e] = a; a += ((int)__hip_atomic_load(ctl + CW_CNTE + e, __ATOMIC_RELAXED, __HIP_MEMORY_SCOPE_AGENT) + 255) >> 8; } T.ebase[NEXP] = a; }
    if (F.tid == 64) { int a = 0; for (int c = 0; c < NCLS; ++c) { T.cbase[c] = a; a += ((int)__hip_atomic_load(ctl + CW_CNTC + c, __ATOMIC_RELAXED, __HIP_MEMORY_SCOPE_AGENT) + 255) >> 8; } T.cbase[NCLS] = a; }
    __syncthreads();
    return T;
}
__device__ __forceinline__ void sort_phase_naive(Frame& F) {
    const MoeTables T = build_tables(F, RING_BYTES + 4096);
    const int gw = F.bid * NWAVES + F.wave, NGW = F.G * NWAVES;
    bf16_t* A1 = WSP(bf16_t, WS_A1); const bf16_t* H2 = WSP(bf16_t, WS_H2T);
    int* dest2 = WSP(int, WS_DEST2); float* cw = WSP(float, WS_CW); int* tok2 = WSP(int, WS_TOK2);
    for (int tok = gw; tok < NTOK; tok += NGW) {
        const TokMeta mt = WSP(TokMeta, WS_META)[tok];
        const int sa = T.ebase[mt.ea] * 256 + mt.re_a, sb = T.ebase[mt.eb] * 256 + mt.re_b, rc = T.cbase[mt.cls] * 256 + mt.rc;
        const u32x4* src = (const u32x4*)(H2 + (size_t)tok * DM) + F.lane;
        u32x4* da = (u32x4*)(A1 + (size_t)sa * DM) + F.lane; u32x4* db = (u32x4*)(A1 + (size_t)sb * DM) + F.lane;
        const u32x4 v0 = src[0], v1 = src[64];
        da[0] = v0; da[64] = v1; db[0] = v0; db[64] = v1;
        if (F.lane == 0) { dest2[sa] = rc * 512; dest2[sb] = rc * 512 + 256; cw[sa] = mt.ca; cw[sb] = mt.cb; tok2[rc] = tok; }
    }
}

struct SchedMoe1 { const bf16_t *A1, *W13; const LAS int* ebase; const unsigned* cnte; int G, c;
    __device__ __forceinline__ bool next(int i, Unit& u) const { const int L = i * G + c, ntile = ebase[NEXP]; if (L >= ntile * 2) return false;
        const int rt = L >> 1, j = L & 1; int e = 0;
        for (int q = 1; q < NEXP; ++q) e = (ebase[q] <= rt) ? q : e;
        u.pm = rt; u.pn = j; u.flags = 0; u.aux = (int)cnte[e] - 256 * (rt - ebase[e]);
        u.A = A1 + (size_t)rt * 256 * 1024; u.B = W13 + ((size_t)e * 512 + 256 * j) * 1024; return true; } };
struct EpiMoe1 {   static constexpr bool PERM = true;
    bf16_t* act2; const int* dest2; const float* cw;
    __device__ __forceinline__ void operator()(const f32x4 (&acc)[2][2][4][2], const Unit& u, int wr, int wc, int fr, int fq) const {
#pragma unroll
        for (int ai = 0; ai < 2; ++ai)
#pragma unroll
            for (int m = 0; m < 4; ++m) { const int r = ai * 128 + wr * 64 + m * 16 + fr; if (r >= u.aux) continue;
                const int slot = u.pm * 256 + r; const float cs = cw[slot]; const int d = dest2[slot];
                float o[8];
#pragma unroll
                for (int n = 0; n < 2; ++n)
#pragma unroll
                    for (int e = 0; e < 4; ++e) { const float a = acc[ai][0][m][n][e], g = acc[ai][1][m][n][e]; o[4 * n + e] = a * sigmoidf_(a) * g * cs; }
                u32x4 w; w.x = pk2(o[0], o[1]); w.y = pk2(o[2], o[3]); w.z = pk2(o[4], o[5]); w.w = pk2(o[6], o[7]);
                *(u32x4*)(act2 + (size_t)d + 128 * u.pn + 32 * wc + 8 * fq) = w; }
    }
};
struct SchedMoe2 { const bf16_t *act2, *W2; const LAS int* cbase; const unsigned* cntc; int G, c;
    __device__ __forceinline__ bool next(int i, Unit& u) const { const int L = (i >> 1) * G + c, ntile = cbase[NCLS]; if (L >= ntile * 4) return false;
        const int sub = i & 1, rt = L >> 2, pn = L & 3; int cl = 0;
        for (int q = 1; q < NCLS; ++q) cl = (cbase[q] <= rt) ? q : cl;
        const int g = cl / 28; int p = cl % 28, lo = 0; while (p >= 7 - lo) { p -= 7 - lo; ++lo; } const int hi = lo + 1 + p;
        const int e = g * 8 + (sub ? hi : lo);
        u.pm = rt; u.pn = pn; u.flags = sub ? 1 : 2; u.aux = (int)cntc[cl] - 256 * (rt - cbase[cl]);
        u.A = act2 + (size_t)rt * 256 * 512 + 256 * sub; u.B = W2 + ((size_t)e * 1024 + 256 * pn) * 256; return true; } };
struct EpiMoe2 {   static constexpr bool PERM = false;
    float* out; const float* mod; const int* tok2;
    __device__ __forceinline__ void operator()(const f32x4 (&acc)[2][2][4][2], const Unit& u, int wr, int wc, int fr, int fq) const {
#pragma unroll
        for (int ai = 0; ai < 2; ++ai)
#pragma unroll
            for (int m = 0; m < 4; ++m) { const int r = ai * 128 + wr * 64 + m * 16 + fr; if (r >= u.aux) continue;
                const int tok = tok2[u.pm * 256 + r]; const int b = tok / SEQ;
#pragma unroll
                for (int bj = 0; bj < 2; ++bj)
#pragma unroll
                    for (int n = 0; n < 2; ++n) { const int col = u.pn * 256 + bj * 128 + wc * 32 + 16 * n + 4 * fq; const f32x4 gf = *(const f32x4*)(mod + b * 6144 + 5120 + col);
                        float* p = out + (size_t)tok * 1024 + col; *(f32x4*)p = *(const f32x4*)p + gf * acc[ai][bj][m][n]; }
                asm volatile("" ::: "memory"); }
    }
};

constexpr int NPHASE = 10;
template <int LO, int HI> __global__ void __launch_bounds__(NTHREADS, 2) mk_fwd(Args args) {
    extern __shared__ __attribute__((aligned(16))) unsigned char lds[];
    Frame F;
    F.lds = (LAS unsigned char*)lds; F.tid = threadIdx.x; F.lane = F.tid & 63; F.wave = __builtin_amdgcn_readfirstlane(F.tid >> 6); F.G = gridDim.x; F.bid = blockIdx.x;
    F.ap = &args;
    F.out = args.out; F.ws = args.ws;
    volatile LAS unsigned* MISC = (volatile LAS unsigned*)((LAS unsigned char*)lds + MISC_OFF);
    if (F.tid < 32) MISC[F.tid] = 0u;
    __syncthreads();
    unsigned* ctl = (unsigned*)(F.ws + WS_CTL);
    XcdBarrier bar; bar.bar = ctl + CW_BAR; bar.x = 0; bar.st = nullptr;
    if (MK_N_LAUNCHES == 1) bar = xcd_barrier_post(ctl + CW_BAR, MISC + 8);
#define IN(k) (LO <= (k) && (k) < HI)
#define SEAM(k) do { if constexpr (IN(k) && IN((k) + 1)) xcd_barrier(bar); } while (0)
    if constexpr (IN(0)) { p0_phase(F); } SEAM(0);
    if constexpr (IN(1)) { p1a_phase(F); } SEAM(1);
    if constexpr (IN(2)) { SchedProj S{WSP(bf16_t, WS_H), WSP(bf16_t, WS_WIN), F.G, F.bid};
        EpiProj E{WSP(bf16_t, WS_Q), WSP(bf16_t, WS_K), WSP(bf16_t, WS_VT), WSP(bf16_t, WS_VR), WSP(bf16_t, WS_QI), WSP(bf16_t, WS_KI), WSP(bf16_t, WS_LX), WSP(bf16_t, WS_LG), WSP(bf16_t, WS_GA), WSP(bf16_t, WS_GB), WSP(float, WS_WI)};
        run_gemm(F.lds, 1024, 1024, 1024, S, E); } SEAM(2);
#ifndef MK_NAIVE_ATTN
#define MK_NAIVE_ATTN 0
#endif
    if constexpr (IN(3)) { lru_phase_naive(F); __syncthreads();
#ifndef MK_ATTN_DBG
#define MK_ATTN_DBG 0
#endif
        if (MK_NAIVE_ATTN) attn_phase_naive(F, 0, 32); else if (MK_ATTN_DBG == 1) { attn_phase(F, 0, 4); __syncthreads(); attn_phase_naive(F, 4, 32); }
        else if (MK_ATTN_DBG == 3) { if (args.ph_hi == 4) attn_phase_naive(F, 0, 32); else attn_phase(F, 4, 5); }
        else if (MK_ATTN_DBG == 2) { attn_phase(F, 4, 32); __syncthreads(); attn_phase_naive(F, 0, 4); } else attn_phase(F, 0, 32); } SEAM(3);
    if constexpr (IN(4)) { SchedMerge S{WSP(bf16_t, WS_AO), WSP(bf16_t, WS_LO), WSP(bf16_t, WS_WPA), WSP(bf16_t, WS_WPB), F.G, F.bid};
        EpiMerge E{WSP(bf16_t, WS_MG), WSP(bf16_t, WS_GA), WSP(bf16_t, WS_GB)};
        run_gemm(F.lds, 512, 512, 512, S, E); } SEAM(4);
    if constexpr (IN(5)) { SchedOut S{WSP(bf16_t, WS_MG), WSP(bf16_t, WS_WOUT), F.G, F.bid}; EpiOut E{((const float*)F.ap->in[0]), WSP(float, WS_MOD), F.out};
        run_gemm(F.lds, 1024, 1024, 1024, S, E); } SEAM(5);
    if constexpr (IN(6)) { route_phase_naive(F); } SEAM(6);
    if constexpr (IN(7)) { sort_phase_naive(F); } SEAM(7);
    if constexpr (IN(8)) { const MoeTables T = build_tables(F, RING_BYTES + 4096);
        SchedMoe1 S{WSP(bf16_t, WS_A1), WSP(bf16_t, WS_W13), T.ebase, (const unsigned*)(ctl + CW_CNTE), F.G, F.bid}; EpiMoe1 E{WSP(bf16_t, WS_ACT2), WSP(int, WS_DEST2), WSP(float, WS_CW)};
        run_gemm(F.lds, 1024, 1024, 1024, S, E); } SEAM(8);
    if constexpr (IN(9)) { const MoeTables T = build_tables(F, RING_BYTES + 4096);
        SchedMoe2 S{WSP(bf16_t, WS_ACT2), WSP(bf16_t, WS_W2), T.cbase, (const unsigned*)(ctl + CW_CNTC), F.G, F.bid}; EpiMoe2 E{F.out, WSP(float, WS_MOD), WSP(int, WS_TOK2)};
        run_gemm(F.lds, 512, 256, 256, S, E); }
#undef IN
#undef SEAM
}

template <int P> static void launch_phase(int grid, hipStream_t stream, Args a) {
    (void)hipFuncSetAttribute((const void*)mk_fwd<P, P + 1>, hipFuncAttributeMaxDynamicSharedMemorySize, LDS_BYTES);
    a.ph_lo = P; a.ph_hi = P + 1; hipLaunchKernelGGL((mk_fwd<P, P + 1>), dim3(grid), dim3(NTHREADS), LDS_BYTES, stream, a);
}
extern "C" void kernel_launch(void* const* d_in, const int* in_sizes, int n_in, void* d_out, int out_size, void* d_ws, size_t ws_size, hipStream_t stream) {
    static int grid = 0;
    if (grid == 0) {
        if (n_in != 26 || out_size != NTOK * DM || ws_size < WS_END) { fprintf(stderr, "kernel_launch: unexpected shapes (n_in %d out %d ws %zu)\n", n_in, out_size, ws_size); grid = -1; return; }
        int dev = 0, cus = 0, per_cu = 0;
        (void)hipGetDevice(&dev); (void)hipDeviceGetAttribute(&cus, hipDeviceAttributeMultiprocessorCount, dev);
#if MK_N_LAUNCHES == 1
        (void)hipFuncSetAttribute((const void*)mk_fwd<0, NPHASE>, hipFuncAttributeMaxDynamicSharedMemorySize, LDS_BYTES);
        (void)hipOccupancyMaxActiveBlocksPerMultiprocessor(&per_cu, (const void*)mk_fwd<0, NPHASE>, NTHREADS, LDS_BYTES);
#else
        (void)hipOccupancyMaxActiveBlocksPerMultiprocessor(&per_cu, (const void*)mk_fwd<2, 3>, NTHREADS, LDS_BYTES);
#endif
        (void)hipGetLastError();
        if (per_cu < 1) { fprintf(stderr, "kernel_launch: occupancy query says %d blocks per CU\n", per_cu); }
        grid = cus;
    }
    if (grid < 0) return;
    (void)hipMemsetAsync((char*)d_ws + WS_CTL, 0, CTL_ZERO_BYTES, stream);
    Args a{};
    for (int i = 0; i < 26; ++i) a.in[i] = d_in[i];
    a.out = (float*)d_out; a.ws = (unsigned char*)d_ws;
#if MK_N_LAUNCHES == 1
    a.ph_lo = 0; a.ph_hi = NPHASE; hipLaunchKernelGGL((mk_fwd<0, NPHASE>), dim3(grid), dim3(NTHREADS), LDS_BYTES, stream, a);
#else
    launch_phase<0>(grid, stream, a); launch_phase<1>(grid, stream, a); launch_phase<2>(grid, stream, a); launch_phase<3>(grid, stream, a);
#if MK_ATTN_DBG == 3
    { Args a2 = a; a2.ph_lo = 3; a2.ph_hi = 99; hipLaunchKernelGGL((mk_fwd<3, 4>), dim3(grid), dim3(NTHREADS), LDS_BYTES, stream, a2); }
#endif
    launch_phase<4>(grid, stream, a);
    launch_phase<5>(grid, stream, a); launch_phase<6>(grid, stream, a); launch_phase<7>(grid, stream, a); launch_phase<8>(grid, stream, a); launch_phase<9>(grid, stream, a);
#endif
}
```

```cpp
#include <hip/hip_runtime.h>
#include <cstdint>
#include <cstdio>

#ifndef MK_N_LAUNCHES
#define MK_N_LAUNCHES 1
#endif

#define LAS __attribute__((address_space(3)))
#define GAS __attribute__((address_space(1)))
typedef unsigned short bf16_t;
typedef short bf16x8 __attribute__((ext_vector_type(8)));
typedef float f32x4 __attribute__((ext_vector_type(4)));
typedef float f32x2 __attribute__((ext_vector_type(2)));
typedef unsigned u32x4 __attribute__((ext_vector_type(4)));
typedef unsigned u32x2 __attribute__((ext_vector_type(2)));
typedef GAS unsigned gu32;

constexpr int BATCH = 8, SEQ = 2048, DM = 1024, NTOK = BATCH * SEQ;
constexpr int NH = 8, HD = 64, NIH = 4, TOPK = 256, CHUNK = 64;
constexpr int LRUW = 512;
constexpr int NEXP = 32, NGRP = 4, EPG = 8, DFF = 256, NCLS = NGRP * 28;
constexpr int DIN_PAD = 4096;
constexpr float EPS = 1e-6f;
constexpr int C_Q = 0, C_K = 512, C_V = 576, C_QI = 640, C_KI = 896, C_LX = 960, C_LG = 1472, C_GA = 1984, C_GB = 3008, C_WI = 4032, C_END = 4036;

constexpr size_t MiB = 1u << 20;
constexpr size_t WS_CTL = 0, CTL_ZERO_BYTES = 1 * MiB;
constexpr size_t WS_MOD = 1 * MiB;
constexpr size_t WS_META = 1 * MiB + 512 * 1024;
constexpr size_t WS_WIN = 2 * MiB, WS_WPA = 10 * MiB, WS_WPB = 11 * MiB, WS_WOUT = 12 * MiB, WS_W13 = 14 * MiB, WS_W2 = 46 * MiB;
constexpr size_t WS_WRH = 62 * MiB, WS_WRL = 62 * MiB + 256 * 1024;
constexpr size_t WS_H = 64 * MiB;
constexpr size_t WS_AO = 64 * MiB, WS_LO = 80 * MiB;
constexpr size_t WS_Q = 96 * MiB, WS_QI = 112 * MiB, WS_K = 120 * MiB, WS_KI = 122 * MiB, WS_VT = 124 * MiB, WS_WI = 126 * MiB, WS_VR = 224 * MiB;
constexpr size_t WS_LX = 128 * MiB, WS_LG = 144 * MiB, WS_MG = 128 * MiB;
constexpr size_t WS_GA = 160 * MiB, WS_GB = 192 * MiB;
constexpr size_t WS_A1 = 64 * MiB;
constexpr size_t WS_H2T = 160 * MiB;
constexpr size_t WS_ACT2 = 192 * MiB;
constexpr size_t WS_DEST2 = 240 * MiB, WS_CW = 241 * MiB, WS_TOK2 = 242 * MiB;
constexpr size_t WS_END = 256 * MiB;
constexpr int CW_BAR = 4096, CW_CNTE = 8192, CW_CNTC = 8192 + 64;

constexpr int NWAVES = 8, NTHREADS = 512;
constexpr int LDS_BYTES = 147456, RING_BYTES = 131072, MISC_OFF = RING_BYTES + 320;

__device__ __forceinline__ unsigned f2bf(float f) { unsigned u = __builtin_bit_cast(unsigned, f); return (u + 0x7fffu + ((u >> 16) & 1u)) >> 16; }
__device__ __forceinline__ unsigned pk2(float lo, float hi) { return f2bf(lo) | (f2bf(hi) << 16); }
__device__ __forceinline__ float bf2f(unsigned short b) { return __builtin_bit_cast(float, (unsigned)b << 16); }
__device__ __forceinline__ float bflo(unsigned w) { return __builtin_bit_cast(float, w << 16); }
__device__ __forceinline__ float bfhi(unsigned w) { return __builtin_bit_cast(float, w & 0xffff0000u); }
__device__ __forceinline__ float wave_sum(float v) {
#pragma unroll
    for (int o = 1; o < 64; o <<= 1) v += __shfl_xor(v, o);
    return v;
}
__device__ __forceinline__ float wave_max(float v) {
#pragma unroll
    for (int o = 1; o < 64; o <<= 1) v = fmaxf(v, __shfl_xor(v, o));
    return v;
}
__device__ __forceinline__ int wave_isum(int v) {
#pragma unroll
    for (int o = 1; o < 64; o <<= 1) v += __shfl_xor(v, o);
    return v;
}
__device__ __forceinline__ float sigmoidf_(float x) { return 1.f / (1.f + __expf(-x)); }
__host__ __device__ __forceinline__ int perm32(int rho) { const int n = rho >> 4, i = rho & 15; return 8 * (i >> 2) + 4 * n + (i & 3); }
__device__ __forceinline__ int vt_pos(int o) { return 8 * ((o >> 2) & 1) + 4 * (o >> 3) + (o & 3); }

#define XB_TMO      128
#define XB_XCNT(j)  (256  + 64 * (j))
#define XB_XSUB(j)  (1280 + 64 * (j))
#define XB_XGEN(j)  (2304 + 64 * (j))
#define XB_TOP      3328
#define XB_TOPGEN   3392
#define XCD_BAR_WORDS 3456
#define XB_SPIN_CAP (1u << 18)
__device__ __forceinline__ unsigned xb_ld(unsigned* p)              { return __hip_atomic_load(p, __ATOMIC_RELAXED, __HIP_MEMORY_SCOPE_AGENT); }
__device__ __forceinline__ unsigned xb_add(unsigned* p, unsigned v) { return __hip_atomic_fetch_add(p, v, __ATOMIC_RELAXED, __HIP_MEMORY_SCOPE_AGENT); }
__device__ __forceinline__ unsigned xb_xcc_id() { return (unsigned)__builtin_amdgcn_s_getreg((3 << 11) | 20) & 0xFu; }
#define XB_SPIN(cond, bar) do { unsigned _sp = 0; while (cond) { __builtin_amdgcn_s_sleep(1); \
    if ((++_sp & 255u) == 0u) { if (xb_ld(&(bar)[XB_TMO])) break; if (_sp > XB_SPIN_CAP) { atomicAdd(&(bar)[XB_TMO], 1u); break; } } } } while (0)
struct XcdBarrier { unsigned* bar; unsigned x; volatile LAS unsigned* st; };
__device__ __forceinline__ XcdBarrier xcd_barrier_post(unsigned* bar, volatile LAS unsigned* st) {
    XcdBarrier b; b.bar = bar; b.x = xb_xcc_id(); b.st = st;
    if (threadIdx.x == 0) (void)xb_add(&bar[XB_XCNT(b.x)], 1u);
    return b;
}
__device__ __forceinline__ void xcd_barrier_complete(unsigned* bar, unsigned x, unsigned& nloc, unsigned& nx) {
    const unsigned G = gridDim.x * gridDim.y * gridDim.z;
    unsigned sum, cnt, mine, sp = 0u;
    for (;;) {
        sum = 0u; cnt = 0u; mine = 0u;
#pragma unroll
        for (unsigned j = 0; j < 16; ++j) { const unsigned c = xb_ld(&bar[XB_XCNT(j)]); sum += c; cnt += (c > 0u) ? 1u : 0u; mine = (j == x) ? c : mine; }
        if (sum == G) break;
        __builtin_amdgcn_s_sleep(1);
        if ((++sp & 255u) == 0u) { if (xb_ld(&bar[XB_TMO])) break; if (sp > XB_SPIN_CAP) { atomicAdd(&bar[XB_TMO], 1u); break; } }
    }
    nloc = mine > 0u ? mine : 1u; nx = cnt > 0u ? cnt : 1u;
}
__device__ __forceinline__ void xcd_barrier(const XcdBarrier& b) {
    asm volatile("s_waitcnt vmcnt(0)" ::: "memory");
    __syncthreads();
    if (threadIdx.x == 0) {
        unsigned* bar = b.bar;
        __builtin_amdgcn_s_waitcnt(0);
        unsigned nloc = b.st[0], nx = b.st[1];
        if (nloc == 0u) { xcd_barrier_complete(bar, b.x, nloc, nx); b.st[0] = nloc; b.st[1] = nx; }
        const unsigned old = xb_add(&bar[XB_XSUB(b.x)], 1u);
        const unsigned gen = old / nloc;
        if (old + 1u == (gen + 1u) * nloc) {
            __builtin_amdgcn_fence(__ATOMIC_RELEASE, "agent");
            asm volatile("s_waitcnt vmcnt(0)" ::: "memory");
            const unsigned og = xb_add(&bar[XB_TOP], 1u);
            const unsigned tg = og / nx;
            if (og + 1u == (tg + 1u) * nx) xb_add(&bar[XB_TOPGEN], 1u);
            else XB_SPIN(xb_ld(&bar[XB_TOPGEN]) == tg, bar);
            __builtin_amdgcn_fence(__ATOMIC_ACQUIRE, "agent");
            xb_add(&bar[XB_XGEN(b.x)], 1u);
            asm volatile("s_waitcnt vmcnt(0)" ::: "memory");
        } else {
            XB_SPIN(xb_ld(&bar[XB_XGEN(b.x)]) == gen, bar);
            __builtin_amdgcn_fence(__ATOMIC_ACQUIRE, "agent");
            asm volatile("s_waitcnt vmcnt(0)" ::: "memory");
        }
    }
    __syncthreads();
}

struct Args { const void* in[26]; float* out; unsigned char* ws; int ph_lo, ph_hi; };
struct Frame {
    LAS unsigned char* lds;
    int tid, lane, wave, G, bid;
    const Args* ap;
    float* out; unsigned char* ws;
};
#define WSP(T, off) ((T*)(F.ws + (off)))

__device__ __forceinline__ void tr_item(const float* __restrict__ src, int ld, int k0, int c0, int nvalid, bf16_t* dst, int ldd, LAS float* scr, int lane) {
#pragma unroll 8
    for (int i = 0; i < 32; ++i) { const int kk = 2 * i + (lane >> 5), cc = lane & 31;
        scr[kk * 33 + cc] = (cc < nvalid) ? src[(size_t)(k0 + kk) * ld + c0 + cc] : 0.f; }
    asm volatile("s_waitcnt lgkmcnt(0)" ::: "memory");
    const int c = lane & 7;
#pragma unroll
    for (int j = 0; j < 4; ++j) { const int n = (lane >> 3) + 8 * j; const LAS float* s = scr + (8 * c) * 33 + n;
        u32x4 o; o.x = pk2(s[0 * 33], s[1 * 33]); o.y = pk2(s[2 * 33], s[3 * 33]); o.z = pk2(s[4 * 33], s[5 * 33]); o.w = pk2(s[6 * 33], s[7 * 33]);
        *(u32x4*)(dst + (size_t)n * ldd + k0 + 8 * c) = o; }
    asm volatile("s_waitcnt lgkmcnt(0)" ::: "memory");
}
__device__ __forceinline__ void p0_phase(Frame& F) {
    LAS float* cond = (LAS float*)(F.lds);
    for (int i = F.tid; i < BATCH * DM; i += NTHREADS) { const float v = ((const float*)F.ap->in[1])[i]; cond[i] = v / (1.f + __expf(-v)); }
    __syncthreads();
    {
        const int item = F.wave * F.G + F.bid;
        if (item < 384) {
            const int col = item * 16 + (F.lane & 15), kq = F.lane >> 4;
            float acc[8];
#pragma unroll
            for (int b = 0; b < 8; ++b) acc[b] = 0.f;
#pragma unroll 4
            for (int k = kq; k < DM; k += 4) { const float w = ((const float*)F.ap->in[2])[(size_t)k * 6144 + col];
#pragma unroll
                for (int b = 0; b < 8; ++b) acc[b] += cond[b * DM + k] * w; }
#pragma unroll
            for (int b = 0; b < 8; ++b) { float v = acc[b]; v += __shfl_xor(v, 16); v += __shfl_xor(v, 32); acc[b] = v; }
            if (kq == 0) { float* mod = WSP(float, WS_MOD); const float bb = ((const float*)F.ap->in[3])[col];
#pragma unroll
                for (int b = 0; b < 8; ++b) mod[b * 6144 + col] = acc[b] + bb; }
        }
    }
    __syncthreads();
    LAS float* scr = (LAS float*)(F.lds + F.wave * 16384);
    const int gw = F.bid * NWAVES + F.wave, NGW = F.G * NWAVES;
    constexpr int I_WIN = 16 * 128, I_WP = 8 * 32, I_WO = 16 * 32, I_W13 = 32 * 256, I_W2 = 32 * 128;
    constexpr int NITEMS = I_WIN + 2 * I_WP + I_WO + I_W13 + I_W2;
    for (int it = gw; it < NITEMS; it += NGW) {
        int r = it;
        if (r < I_WIN) { const int kb = r / 128, nb = r % 128, n0 = 32 * nb; int c0, nv;
            if (n0 < C_LX) { c0 = n0; nv = 32; } else if (n0 < C_WI) { c0 = n0 + 4; nv = 32; } else if (n0 == C_WI) { c0 = 960; nv = 4; } else { c0 = 0; nv = 0; }
            tr_item(((const float*)F.ap->in[5]), 4036, 64 * kb, c0, nv, WSP(bf16_t, WS_WIN) + (size_t)n0 * 1024, 1024, scr, F.lane); continue; } r -= I_WIN;
        if (r < I_WP) { const int kb = r / 32, nb = r % 32; tr_item(((const float*)F.ap->in[15]), 1024, 64 * kb, 32 * nb, 32, WSP(bf16_t, WS_WPA) + (size_t)(32 * nb) * 512, 512, scr, F.lane); continue; } r -= I_WP;
        if (r < I_WP) { const int kb = r / 32, nb = r % 32; tr_item(((const float*)F.ap->in[16]), 1024, 64 * kb, 32 * nb, 32, WSP(bf16_t, WS_WPB) + (size_t)(32 * nb) * 512, 512, scr, F.lane); continue; } r -= I_WP;
        if (r < I_WO) { const int kb = r / 32, nb = r % 32; tr_item(((const float*)F.ap->in[17]), 1024, 64 * kb, 32 * nb, 32, WSP(bf16_t, WS_WOUT) + (size_t)(32 * nb) * 1024, 1024, scr, F.lane); continue; } r -= I_WO;
        if (r < I_W13) { const int e = r / 256, r2 = r % 256, kb = r2 / 16, nb = r2 % 16, n0 = 32 * nb, j = n0 >> 8, half = (n0 >> 7) & 1, cc0 = n0 & 127;
            const float* src = (half ? ((const float*)F.ap->in[24]) : ((const float*)F.ap->in[23])) + (size_t)e * 1024 * 256;
            tr_item(src, 256, 64 * kb, 128 * j + cc0, 32, WSP(bf16_t, WS_W13) + ((size_t)e * 512 + n0) * 1024, 1024, scr, F.lane); continue; } r -= I_W13;
        { const int e = r / 128, r2 = r % 128, kb = r2 / 32, nb = r2 % 32;
            tr_item(((const float*)F.ap->in[25]) + (size_t)e * 256 * 1024, 1024, 64 * kb, 32 * nb, 32, WSP(bf16_t, WS_W2) + ((size_t)e * 1024 + 32 * nb) * 256, 256, scr, F.lane); }
    }
    for (int i = F.bid * NTHREADS + F.tid; i < 48 * 1024; i += F.G * NTHREADS) { const int r = i >> 10, k = i & 1023;
        const float v = r < 4 ? ((const float*)F.ap->in[19])[k * 4 + r] : r < 36 ? ((const float*)F.ap->in[21])[k * 32 + (r - 4)] : 0.f;
        const unsigned hi = f2bf(v); const float rem = v - bf2f((unsigned short)hi);
        WSP(bf16_t, WS_WRH)[i] = (bf16_t)hi; WSP(bf16_t, WS_WRL)[i] = (bf16_t)f2bf(rem); }
}

__device__ __forceinline__ void p1a_phase(Frame& F) {
    const int gw = F.bid * NWAVES + F.wave, NGW = F.G * NWAVES;
    const float* mod = WSP(float, WS_MOD);
    bf16_t* H = WSP(bf16_t, WS_H);
    for (int row = gw; row < NTOK; row += NGW) {
        const int b = row / SEQ;
        const f32x4* xr = (const f32x4*)(((const float*)F.ap->in[0]) + (size_t)row * DM) + F.lane;
        f32x4 v[4]; float s = 0.f;
#pragma unroll
        for (int j = 0; j < 4; ++j) { v[j] = xr[64 * j]; s += (v[j].x * v[j].x + v[j].y * v[j].y) + (v[j].z * v[j].z + v[j].w * v[j].w); }
        const float rinv = rsqrtf(wave_sum(s) * (1.f / DM) + EPS);
        unsigned long long* o8 = (unsigned long long*)(H + (size_t)row * DM) + F.lane;
#pragma unroll
        for (int j = 0; j < 4; ++j) { const int col = 4 * F.lane + 256 * j;
            const f32x4 g = *(const f32x4*)(((const float*)F.ap->in[4]) + col), sh = *(const f32x4*)(mod + b * 6144 + col), sc = *(const f32x4*)(mod + b * 6144 + 1024 + col);
            const f32x4 hv = v[j] * rinv * g * (sc + 1.f) + sh;
            o8[64 * j] = (unsigned long long)pk2(hv.x, hv.y) | ((unsigned long long)pk2(hv.z, hv.w) << 32); }
    }
}

struct Unit { const bf16_t* A; const bf16_t* B; int pm, pn, aux, flags; };
template <bool PERM, class Sched, class Epi>
__device__ __forceinline__ void gemm_naive(int lda, int ldb, int K, const Sched& S, const Epi& E) {
    const int tid = threadIdx.x, wid = __builtin_amdgcn_readfirstlane(tid >> 6), lane = tid & 63, wr = wid >> 2, wc = wid & 3, fr = lane & 15, fq = lane >> 4;
    f32x4 acc[2][2][4][2];
    Unit u;
    for (int i = 0; S.next(i, u); ++i) {
        if (!(u.flags & 1)) {
#pragma unroll
            for (int a = 0; a < 2; ++a)
#pragma unroll
                for (int b = 0; b < 2; ++b)
#pragma unroll
                    for (int m = 0; m < 4; ++m)
#pragma unroll
                        for (int n = 0; n < 2; ++n) acc[a][b][m][n] = (f32x4){0.f, 0.f, 0.f, 0.f};
        }
#pragma unroll 1
        for (int k0 = 0; k0 < K; k0 += 32) {
            bf16x8 bfr[2][2];
#pragma unroll
            for (int bj = 0; bj < 2; ++bj)
#pragma unroll
                for (int n = 0; n < 2; ++n) { const int rho = 16 * n + fr, rr = PERM ? perm32(rho) : rho;
                    bfr[bj][n] = *(const bf16x8*)(u.B + (size_t)(128 * bj + 32 * wc + rr) * ldb + k0 + 8 * fq); }
#pragma unroll
            for (int ai = 0; ai < 2; ++ai) {
                bf16x8 af[4];
#pragma unroll
                for (int m = 0; m < 4; ++m) af[m] = *(const bf16x8*)(u.A + (size_t)(128 * ai + 64 * wr + 16 * m + fr) * lda + k0 + 8 * fq);
#pragma unroll
                for (int bj = 0; bj < 2; ++bj)
#pragma unroll
                    for (int m = 0; m < 4; ++m)
#pragma unroll
                        for (int n = 0; n < 2; ++n) acc[ai][bj][m][n] = __builtin_amdgcn_mfma_f32_16x16x32_bf16(bfr[bj][n], af[m], acc[ai][bj][m][n], 0, 0, 0);
            }
        }
        if (!(u.flags & 2)) E(acc, u, wr, wc, fr, fq);
    }
}


namespace pg8 {
constexpr int BK = 64, HALF = 128, HTB = HALF * BK * 2;
__device__ __forceinline__ int lds_byte(int r, int c) { const int st = (r >> 4) * 2 + (c >> 5), rr = r & 15, cc = c & 31, ob = rr * 64 + cc * 2; return st * 1024 + (ob ^ (((ob >> 9) & 1) << 5)); }
__device__ __forceinline__ void stage_rc(int b, int& R, int& C) { const int st = b / 1024, sb = b % 1024, swz = sb ^ (((sb >> 9) & 1) << 5); R = (st >> 1) * 16 + swz / 64; C = (st & 1) * 32 + (swz % 64) / 2; }
template <class Epi, class Sched, bool ALIGN_EPI>
__device__ __forceinline__ void gemm_phase(LAS unsigned char* lds, int lda, int ldb, int K, const Sched& S, const Epi& E) {
    int tid_ = threadIdx.x; asm volatile("" : "+v"(tid_));
    const int tid = tid_, wid = __builtin_amdgcn_readfirstlane(tid >> 6), lane = tid & 63, wr = wid >> 2, wc = wid & 3, fr = lane & 15, fq = lane >> 4;
    const int nt = K / BK;
    unsigned voffA[2], voffB[2];
#pragma unroll
    for (int i = 0; i < 2; ++i) { int R, C; stage_rc(tid * 16 + i * 8192, R, C); const int Rb = Epi::PERM ? ((R & ~31) + perm32(R & 31)) : R;
        voffA[i] = (unsigned)(R * lda + C) * 2u; voffB[i] = (unsigned)(Rb * ldb + C) * 2u; }
    const size_t kstep = (size_t)(BK * 2);
    const size_t hstepA = (size_t)HALF * lda * 2, hstepB = (size_t)HALF * ldb * 2;
    const unsigned ldsw = (unsigned)wid * 1024u;
    const int aoff = lds_byte(wr * 64 + fr, fq * 8), boff = lds_byte(wc * 32 + fr, fq * 8);
#define PG8_SA(b, h) (((b) * 2 + (h)) * HTB)
#define PG8_SB(b, h) ((4 + (b) * 2 + (h)) * HTB)
#define PG8_STAGE(bufoff, gbase, voff) do { _Pragma("unroll") for (int _i = 0; _i < 2; ++_i) \
        __builtin_amdgcn_global_load_lds((const unsigned*)((const char*)(gbase) + (voff)[_i]), (LAS unsigned*)(lds + (bufoff) + ldsw + _i * 8192), 16, 0, 0); } while (0)
#define PG8_LDA(dst, b, h) do { _Pragma("unroll") for (int m = 0; m < 4; ++m) _Pragma("unroll") for (int k = 0; k < 2; ++k) dst[m][k] = *(const LAS bf16x8*)(lds + PG8_SA(b, h) + aoff + m * 2048 + k * 1024); } while (0)
#define PG8_LDB(dst, b, h) do { _Pragma("unroll") for (int n = 0; n < 2; ++n) _Pragma("unroll") for (int k = 0; k < 2; ++k) dst[n][k] = *(const LAS bf16x8*)(lds + PG8_SB(b, h) + boff + n * 2048 + k * 1024); } while (0)
#define PG8_MMA(ai, bj, At, Bt) do { __builtin_amdgcn_s_setprio(1); _Pragma("unroll") for (int m = 0; m < 4; ++m) _Pragma("unroll") for (int n = 0; n < 2; ++n) _Pragma("unroll") for (int k = 0; k < 2; ++k) \
        acc[ai][bj][m][n] = __builtin_amdgcn_mfma_f32_16x16x32_bf16(Bt[n][k], At[m][k], acc[ai][bj][m][n], 0, 0, 0); __builtin_amdgcn_s_setprio(0); } while (0)
#define PG8_WAIT_V(n) asm volatile("s_waitcnt vmcnt(" #n ")" ::: "memory")
#define PG8_WAIT_L(n) asm volatile("s_waitcnt lgkmcnt(" #n ")" ::: "memory")
#define PG8_BAR __builtin_amdgcn_s_barrier()
#define PG8_SCHED __builtin_amdgcn_sched_barrier(0)
#define PG8_ZERO() do { _Pragma("unroll") for (int a = 0; a < 2; ++a) _Pragma("unroll") for (int b = 0; b < 2; ++b) _Pragma("unroll") for (int m = 0; m < 4; ++m) _Pragma("unroll") for (int n = 0; n < 2; ++n) acc[a][b][m][n] = (f32x4){0.f, 0.f, 0.f, 0.f}; } while (0)
    Unit cur, nxt; int ui = 0;
    if (!S.next(0, cur)) return;
    f32x4 acc[2][2][4][2];
    PG8_ZERO();
    bf16x8 At[4][2], B0[2][2], B1[2][2];
    const char* cA = (const char*)cur.A; const char* cB = (const char*)cur.B;
    PG8_STAGE(PG8_SB(0, 0), cB, voffB); PG8_STAGE(PG8_SB(0, 1), cB + hstepB, voffB); PG8_STAGE(PG8_SA(0, 0), cA, voffA); PG8_STAGE(PG8_SA(0, 1), cA + hstepA, voffA);
    if (wr == 1) PG8_BAR;
    PG8_WAIT_V(2); PG8_BAR;
    PG8_STAGE(PG8_SB(1, 0), cB + kstep, voffB); PG8_STAGE(PG8_SA(1, 0), cA + kstep, voffA); PG8_STAGE(PG8_SB(1, 1), cB + hstepB + kstep, voffB);
    PG8_WAIT_V(6); PG8_BAR;
    for (;;) {
        const bool has_next = S.next(ui + 1, nxt);
        const char* nA = has_next ? (const char*)nxt.A : cA; const char* nB = has_next ? (const char*)nxt.B : cB;
        for (int t = 0; t < nt; t += 2) {
            const bool last = (t == nt - 2);
            const char* a1 = cA + (size_t)(t + 1) * kstep;
            const char* a2 = last ? nA : cA + (size_t)(t + 2) * kstep; const char* b2 = last ? nB : cB + (size_t)(t + 2) * kstep;
            const char* a3 = a2 + kstep; const char* b3 = b2 + kstep;
            PG8_LDB(B0, 0, 0); PG8_LDB(B1, 0, 1); PG8_SCHED; PG8_LDA(At, 0, 0); PG8_STAGE(PG8_SA(1, 1), a1 + hstepA, voffA);
            PG8_WAIT_V(8); PG8_WAIT_L(0); PG8_BAR; PG8_MMA(0, 0, At, B0); PG8_MMA(0, 1, At, B1); PG8_BAR; PG8_SCHED;
            PG8_LDA(At, 0, 1); PG8_STAGE(PG8_SB(0, 0), b2, voffB); PG8_STAGE(PG8_SB(0, 1), b2 + hstepB, voffB); PG8_STAGE(PG8_SA(0, 0), a2, voffA);
            PG8_WAIT_V(8); PG8_WAIT_L(0); PG8_BAR; PG8_MMA(1, 0, At, B0); PG8_MMA(1, 1, At, B1); PG8_BAR; PG8_SCHED;
            PG8_LDB(B0, 1, 0); PG8_LDB(B1, 1, 1); PG8_SCHED; PG8_LDA(At, 1, 0); PG8_STAGE(PG8_SA(0, 1), a2 + hstepA, voffA);
            PG8_WAIT_V(8); PG8_WAIT_L(0); PG8_BAR; PG8_MMA(0, 0, At, B0); PG8_MMA(0, 1, At, B1); PG8_BAR; PG8_SCHED;
            PG8_LDA(At, 1, 1); PG8_STAGE(PG8_SB(1, 0), b3, voffB); PG8_STAGE(PG8_SB(1, 1), b3 + hstepB, voffB); PG8_STAGE(PG8_SA(1, 0), a3, voffA);
            PG8_WAIT_V(8); PG8_WAIT_L(0); PG8_BAR; PG8_MMA(1, 0, At, B0); PG8_MMA(1, 1, At, B1); PG8_BAR; PG8_SCHED;
        }
        if constexpr (ALIGN_EPI) { if (wr == 0) PG8_BAR; }
        if (!(cur.flags & 2)) E(acc, cur, wr, wc, fr, fq);
        if (!has_next) break;
        if (!(nxt.flags & 1)) PG8_ZERO();
        cur = nxt; cA = nA; cB = nB; ++ui;
        if constexpr (ALIGN_EPI) { if (wr == 1) PG8_BAR; }
    }
    PG8_WAIT_V(0);
    if constexpr (!ALIGN_EPI) { if (wr == 0) PG8_BAR; }
    PG8_BAR;
#undef PG8_SA
#undef PG8_SB
#undef PG8_STAGE
#undef PG8_LDA
#undef PG8_LDB
#undef PG8_MMA
#undef PG8_WAIT_V
#undef PG8_WAIT_L
#undef PG8_BAR
#undef PG8_SCHED
#undef PG8_ZERO
}
}
#ifndef MK_NAIVE_GEMM
#define MK_NAIVE_GEMM 0
#endif
template <class Sched, class Epi>
__device__ __forceinline__ void run_gemm(LAS unsigned char* lds, int lda, int ldb, int K, const Sched& S, const Epi& E) {
#if MK_NAIVE_GEMM
    gemm_naive<Epi::PERM>(lda, ldb, K, S, E);
#else
    pg8::gemm_phase<Epi, Sched, true>(lds, lda, ldb, K, S, E);
#endif
}

struct SchedProj { const bf16_t* A; const bf16_t* B; int G, c;
    __device__ __forceinline__ bool next(int i, Unit& u) const { const int L = i * G + c; if (L >= 64 * 16) return false;
        const int gid = L / 128, w = L % 128; u.pm = gid * 8 + (w % 8); u.pn = w / 8;
        u.A = A + (size_t)u.pm * 256 * 1024; u.B = B + (size_t)u.pn * 256 * 1024; u.aux = 0; u.flags = 0; return true; } };
struct EpiProj {
    static constexpr bool PERM = true;
    bf16_t *Q, *Kb, *Vt, *Vr, *QI, *KI, *LX, *LG, *GA, *GB; float* WI;
    __device__ __forceinline__ void operator()(const f32x4 (&acc)[2][2][4][2], const Unit& u, int wr, int wc, int fr, int fq) const {
#pragma unroll
        for (int bj = 0; bj < 2; ++bj) {
            const int cg = u.pn * 256 + bj * 128 + wc * 32;
            if (cg >= C_END) continue;
            const int col = cg + 8 * fq;
            bf16_t* dst; int ld, cb; int mode = 0;
            if (cg < C_K) { dst = Q; ld = 512; cb = C_Q; }
            else if (cg < C_V) { dst = Kb; ld = 64; cb = C_K; }
            else if (cg < C_QI) { dst = Vr; ld = 64; cb = C_V; mode = 2; }
            else if (cg < C_KI) { dst = QI; ld = 256; cb = C_QI; }
            else if (cg < C_LX) { dst = KI; ld = 64; cb = C_KI; }
            else if (cg < C_LG) { dst = LX; ld = 512; cb = C_LX; }
            else if (cg < C_GA) { dst = LG; ld = 512; cb = C_LG; }
            else if (cg < C_GB) { dst = GA; ld = 1024; cb = C_GA; mode = 1; }
            else if (cg < C_WI) { dst = GB; ld = 1024; cb = C_GB; mode = 1; }
            else { dst = nullptr; ld = 0; cb = C_WI; mode = 3; }
#pragma unroll
            for (int ai = 0; ai < 2; ++ai)
#pragma unroll
                for (int m = 0; m < 4; ++m) {
                    const int row = u.pm * 256 + ai * 128 + wr * 64 + m * 16 + fr;
                    f32x4 v0 = acc[ai][bj][m][0], v1 = acc[ai][bj][m][1];
                    if (mode == 3) { if (fq == 0) *(f32x4*)(WI + (size_t)row * 4) = v0; continue; }
                    if (mode == 1) {
#pragma unroll
                        for (int e = 0; e < 4; ++e) { v0[e] = sigmoidf_(v0[e]); v1[e] = sigmoidf_(v1[e]); } }
                    u32x4 w; w.x = pk2(v0[0], v0[1]); w.y = pk2(v0[2], v0[3]); w.z = pk2(v1[0], v1[1]); w.w = pk2(v1[2], v1[3]);
                    *(u32x4*)(dst + (size_t)row * ld + (col - cb)) = w;
                    if (mode == 2) {
                        const int b = row / SEQ, t = row % SEQ, d0 = col - cb; bf16_t* vp = Vt + ((size_t)b * 64 + d0) * SEQ + (t & ~15) + vt_pos(t & 15);
                        vp[0 * SEQ] = (bf16_t)(w.x & 0xffff); vp[1 * SEQ] = (bf16_t)(w.x >> 16); vp[2 * SEQ] = (bf16_t)(w.y & 0xffff); vp[3 * SEQ] = (bf16_t)(w.y >> 16);
                        vp[4 * SEQ] = (bf16_t)(w.z & 0xffff); vp[5 * SEQ] = (bf16_t)(w.z >> 16); vp[6 * SEQ] = (bf16_t)(w.w & 0xffff); vp[7 * SEQ] = (bf16_t)(w.w >> 16); }
                }
        }
    }
};

__device__ __forceinline__ unsigned fbits(float f) { return __builtin_bit_cast(unsigned, f); }
__device__ __forceinline__ unsigned sortkey(float f) { const unsigned u = __builtin_bit_cast(unsigned, f); return (u & 0x80000000u) ? ~u : (u | 0x80000000u); }
typedef float f32x16 __attribute__((ext_vector_type(16)));
constexpr int AL_QI = 0, AL_HIST = 16896, AL_MASK = 49792, AL_EQ = 57984, AL_RK = 66176, AL_QST = 74368, AL_FLAG = 74368 + 512, AL_OST = 75008, AL_END = AL_OST + 8 * 4608;
constexpr int QI_STRIDE = 528, HIST_STRIDE = 257, OST_STRIDE = 144;
static_assert(AL_END <= RING_BYTES, "attention LDS map");
__device__ __forceinline__ int crow(int i, int hi) { return (i & 3) + 8 * (i >> 2) + 4 * hi; }
__device__ __forceinline__ void attn_unit(Frame& F, int b, int c, int half) {
    int tid_ = F.tid, w_ = F.wave; asm volatile("" : "+v"(tid_), "+s"(w_));
    const int tid = tid_, lane = tid & 63, w = w_, r32 = lane & 31, hi = lane >> 5;
    const int t0 = 64 * c + 32 * half, nk = 64 * (c + 1), ntile = nk >> 5, tok0 = b * SEQ + t0;
    LAS unsigned char* L = F.lds;
    LAS unsigned* hist = (LAS unsigned*)(L + AL_HIST); LAS unsigned* maskw = (LAS unsigned*)(L + AL_MASK); LAS unsigned* eqw = (LAS unsigned*)(L + AL_EQ);
    LAS float* rkL = (LAS float*)(L + AL_RK); LAS unsigned* qst = (LAS unsigned*)(L + AL_QST); LAS unsigned* flagw = (LAS unsigned*)(L + AL_FLAG);
    const bf16_t* KI = WSP(bf16_t, WS_KI) + (size_t)b * SEQ * 64;
    const bf16_t* Kb = WSP(bf16_t, WS_K) + (size_t)b * SEQ * 64;
    const bf16_t* Vt = WSP(bf16_t, WS_VT) + (size_t)b * 64 * SEQ;
    const bool do_sel = nk > TOPK;
    __syncthreads();
    { const bf16_t* QI = WSP(bf16_t, WS_QI) + (size_t)tok0 * 256;
#pragma unroll
      for (int i = 0; i < 2; ++i) { const int idx = tid + 512 * i, row = idx >> 5, ch = idx & 31;
          *(LAS u32x4*)(L + AL_QI + row * QI_STRIDE + ch * 16) = *(const u32x4*)(QI + (size_t)row * 256 + ch * 8); } }
    if (tid == 0) flagw[0] = 0u;
    if (tid < 32) { qst[tid * 4 + 0] = 0u; qst[tid * 4 + 1] = (unsigned)TOPK; qst[tid * 4 + 2] = 0u; qst[tid * 4 + 3] = 0u; }
    __syncthreads();
#pragma unroll 1
    for (int kt = w; kt < ntile; kt += 8) {
        bf16x8 kf[4]; float ss = 0.f;
        const bf16_t* kp = Kb + (size_t)(32 * kt + r32) * 64 + 8 * hi;
#pragma unroll
        for (int ks = 0; ks < 4; ++ks) { kf[ks] = *(const bf16x8*)(kp + 16 * ks);
#pragma unroll
            for (int e = 0; e < 8; ++e) { const float v = bf2f((unsigned short)kf[ks][e]); ss += v * v; } }
        ss += __shfl_xor(ss, 32);
        if (hi == 0) rkL[32 * kt + r32] = rsqrtf(ss * (1.f / 64.f) + EPS);
    }
    f32x16 sc[8];
    if (do_sel) {
        const f32x4 wv = *(const f32x4*)(WSP(float, WS_WI) + (size_t)(tok0 + r32) * 4) * 0.0625f;
#pragma unroll
        for (int j = 0; j < 8; ++j) {
            const int kt = w + 8 * j;
#pragma unroll
            for (int i = 0; i < 16; ++i) sc[j][i] = 0.f;
            if (kt < ntile) {
                int roff = (32 * kt + r32) * 64 + 8 * hi; asm volatile("" : "+v"(roff));
                int qoff = r32 * QI_STRIDE + hi * 16; asm volatile("" : "+v"(qoff));
                bf16x8 af[4];
#pragma unroll
                for (int ks = 0; ks < 4; ++ks) af[ks] = *(const bf16x8*)(KI + roff + 16 * ks);
#pragma unroll
                for (int h = 0; h < 4; ++h) { f32x16 acc;
#pragma unroll
                    for (int i = 0; i < 16; ++i) acc[i] = 0.f;
#pragma unroll
                    for (int ks = 0; ks < 4; ++ks) { const bf16x8 qf = *(const LAS bf16x8*)(L + AL_QI + qoff + h * 128 + ks * 32);
                        acc = __builtin_amdgcn_mfma_f32_32x32x16_bf16(af[ks], qf, acc, 0, 0, 0); }
#pragma unroll
                    for (int i = 0; i < 16; ++i) sc[j][i] += fmaxf(acc[i], 0.f) * wv[h];
                    __builtin_amdgcn_sched_barrier(0); }
#pragma unroll
                for (int i = 0; i < 16; ++i) sc[j][i] = __builtin_bit_cast(float, sortkey(sc[j][i]));
            }
        }
    }
    unsigned Tq = 0u; bool ordered = false;
    if (do_sel) {
        unsigned prefix = 0u;
#pragma unroll 1
        for (int pass = 0; pass < 4; ++pass) {
            const int shift = 24 - 8 * pass;
            for (int i = tid; i < 32 * HIST_STRIDE; i += NTHREADS) hist[i] = 0u;
            __syncthreads();
#pragma unroll
            for (int j = 0; j < 8; ++j) { const int kt = w + 8 * j;
                if (kt < ntile) {
#pragma unroll
                    for (int i = 0; i < 16; ++i) { const unsigned key = fbits(sc[j][i]);
                        const bool m = (pass == 0) || ((key >> (shift + 8)) == (prefix >> (shift + 8)));
                        if (m) __hip_atomic_fetch_add(hist + r32 * HIST_STRIDE + ((key >> shift) & 255u), 1u, __ATOMIC_RELAXED, __HIP_MEMORY_SCOPE_WORKGROUP); } } }
            __syncthreads();
            {
                const int q = tid >> 4, p = tid & 15, b0 = 16 * (15 - p);
                const unsigned need = qst[q * 4 + 1];
                unsigned s = 0u;
#pragma unroll
                for (int e = 0; e < 16; ++e) s += hist[q * HIST_STRIDE + b0 + e];
                unsigned P = s;
#pragma unroll
                for (int o = 1; o < 16; o <<= 1) { const unsigned t = __shfl_up(P, o, 16); if (p >= o) P += t; }
                const unsigned Pprev = P - s;
                if (P >= need && Pprev < need) { unsigned run = Pprev;
                    for (int e = 15; e >= 0; --e) { const unsigned hc = hist[q * HIST_STRIDE + b0 + e];
                        if (run + hc >= need) { qst[q * 4 + 0] = qst[q * 4 + 0] | ((unsigned)(b0 + e) << shift); qst[q * 4 + 1] = need - run; qst[q * 4 + 2] = hc; break; }
                        run += hc; } }
            }
            __syncthreads();
            prefix = qst[r32 * 4 + 0];
        }
        Tq = prefix;
        const unsigned needq = qst[r32 * 4 + 1], eqc = qst[r32 * 4 + 2];
        if (needq < eqc) flagw[0] = 1u;
        __syncthreads();
        ordered = flagw[0] != 0u;
    }
#pragma unroll
    for (int j = 0; j < 8; ++j) { const int kt = w + 8 * j;
        if (kt < ntile) { unsigned mw = 0xffffffffu, ew = 0u;
            if (do_sel) { mw = 0u;
#pragma unroll
                for (int i = 0; i < 16; ++i) { const unsigned key = fbits(sc[j][i]); const int bit = crow(i, hi);
                    const bool gt = key > Tq, eq = key == Tq;
                    mw |= ((gt || (eq && !ordered)) ? 1u : 0u) << bit; ew |= (eq ? 1u : 0u) << bit; }
                mw |= __shfl_xor(mw, 32); ew |= __shfl_xor(ew, 32); }
            if (hi == 0) { maskw[kt * 32 + r32] = mw; if (ordered) eqw[kt * 32 + r32] = ew; } } }
    __syncthreads();
    if (ordered) {
        if (tid < 32) { const int need = (int)qst[tid * 4 + 1]; int taken = 0;
            for (int kt = 0; kt < ntile; ++kt) { unsigned ww = eqw[kt * 32 + tid]; unsigned add = 0u;
                while (ww != 0u && taken < need) { const unsigned lsb = ww & (0u - ww); add |= lsb; ww ^= lsb; ++taken; }
                maskw[kt * 32 + tid] |= add; } }
        __syncthreads();
    }
    {
        const int h = w; const int tq = t0 + r32;
        bf16x8 qf[4];
        { const bf16_t* Q = WSP(bf16_t, WS_Q) + (size_t)(tok0 + r32) * 512 + h * 64;
          float qv[4][8]; float ss = 0.f;
#pragma unroll
          for (int ks = 0; ks < 4; ++ks) { const bf16x8 v = *(const bf16x8*)(Q + 16 * ks + 8 * hi);
#pragma unroll
              for (int e = 0; e < 8; ++e) { qv[ks][e] = bf2f((unsigned short)v[e]); ss += qv[ks][e] * qv[ks][e]; } }
          ss += __shfl_xor(ss, 32);
          const float rq = rsqrtf(ss * (1.f / 64.f) + EPS) * 0.125f * 1.4426950408889634f;
          const float* qnw = (const float*)F.ap->in[6]; const float* knw = (const float*)F.ap->in[7];
#pragma unroll
          for (int ks = 0; ks < 4; ++ks) { u32x4 pk;
              const f32x4 a0 = *(const f32x4*)(qnw + 16 * ks + 8 * hi), a1 = *(const f32x4*)(qnw + 16 * ks + 8 * hi + 4), b0 = *(const f32x4*)(knw + 16 * ks + 8 * hi), b1 = *(const f32x4*)(knw + 16 * ks + 8 * hi + 4);
              pk.x = pk2(qv[ks][0] * rq * a0.x * b0.x, qv[ks][1] * rq * a0.y * b0.y); pk.y = pk2(qv[ks][2] * rq * a0.z * b0.z, qv[ks][3] * rq * a0.w * b0.w);
              pk.z = pk2(qv[ks][4] * rq * a1.x * b1.x, qv[ks][5] * rq * a1.y * b1.y); pk.w = pk2(qv[ks][6] * rq * a1.z * b1.z, qv[ks][7] * rq * a1.w * b1.w);
              qf[ks] = __builtin_bit_cast(bf16x8, pk); } }
        const float slope2 = exp2f(-(float)(h + 1)) * 1.4426950408889634f;
        float m = -1e30f, l = 0.f; f32x16 o0, o1;
#pragma unroll
        for (int i = 0; i < 16; ++i) { o0[i] = 0.f; o1[i] = 0.f; }
#pragma unroll 1
        for (int kt = 0; kt < ntile; ++kt) {
            bf16x8 kf[4], vf[2][2];
#pragma unroll
            for (int ks = 0; ks < 4; ++ks) kf[ks] = *(const bf16x8*)(Kb + (size_t)(32 * kt + r32) * 64 + 16 * ks + 8 * hi);
#pragma unroll
            for (int db = 0; db < 2; ++db)
#pragma unroll
                for (int s2 = 0; s2 < 2; ++s2) vf[db][s2] = *(const bf16x8*)(Vt + (size_t)(32 * db + r32) * SEQ + 32 * kt + 16 * s2 + 8 * hi);
            f32x16 S;
#pragma unroll
            for (int i = 0; i < 16; ++i) S[i] = 0.f;
#pragma unroll
            for (int ks = 0; ks < 4; ++ks) S = __builtin_amdgcn_mfma_f32_32x32x16_bf16(kf[ks], qf[ks], S, 0, 0, 0);
            const unsigned mw = maskw[kt * 32 + r32] >> (4 * hi);
            const float dbase = (float)(tq - 32 * kt - 4 * hi);
            float mx = -INFINITY;
#pragma unroll
            for (int g = 0; g < 4; ++g) { const f32x4 rk4 = *(const LAS f32x4*)(rkL + 32 * kt + 8 * g + 4 * hi);
#pragma unroll
                for (int e = 0; e < 4; ++e) { const int i = 4 * g + e, ko = e + 8 * g;
                    float v = S[i] * rk4[e] - slope2 * fabsf(dbase - (float)ko);
                    v = ((mw >> ko) & 1u) ? v : -INFINITY; S[i] = v; mx = fmaxf(mx, v); } }
            mx = fmaxf(mx, __shfl_xor(mx, 32));
            const float mn = fmaxf(m, mx), alpha = exp2f(m - mn); m = mn;
            float ps = 0.f;
#pragma unroll
            for (int i = 0; i < 16; ++i) { S[i] = exp2f(S[i] - mn); ps += S[i]; }
            l = l * alpha + ps;
#pragma unroll
            for (int i = 0; i < 16; ++i) { o0[i] *= alpha; o1[i] *= alpha; }
            u32x4 p0, p1;
            p0.x = pk2(S[0], S[1]); p0.y = pk2(S[2], S[3]); p0.z = pk2(S[4], S[5]); p0.w = pk2(S[6], S[7]);
            p1.x = pk2(S[8], S[9]); p1.y = pk2(S[10], S[11]); p1.z = pk2(S[12], S[13]); p1.w = pk2(S[14], S[15]);
            const bf16x8 pf0 = __builtin_bit_cast(bf16x8, p0), pf1 = __builtin_bit_cast(bf16x8, p1);
            o0 = __builtin_amdgcn_mfma_f32_32x32x16_bf16(vf[0][0], pf0, o0, 0, 0, 0); o0 = __builtin_amdgcn_mfma_f32_32x32x16_bf16(vf[0][1], pf1, o0, 0, 0, 0);
            o1 = __builtin_amdgcn_mfma_f32_32x32x16_bf16(vf[1][0], pf0, o1, 0, 0, 0); o1 = __builtin_amdgcn_mfma_f32_32x32x16_bf16(vf[1][1], pf1, o1, 0, 0, 0);
        }
        l += __shfl_xor(l, 32);
        const float inv = 1.f / l;
        LAS unsigned char* stg = L + AL_OST + w * 4608;
#pragma unroll
        for (int g = 0; g < 4; ++g) {
            *(LAS u32x2*)(stg + r32 * OST_STRIDE + (8 * g + 4 * hi) * 2) = (u32x2){pk2(o0[4 * g] * inv, o0[4 * g + 1] * inv), pk2(o0[4 * g + 2] * inv, o0[4 * g + 3] * inv)};
            *(LAS u32x2*)(stg + r32 * OST_STRIDE + (32 + 8 * g + 4 * hi) * 2) = (u32x2){pk2(o1[4 * g] * inv, o1[4 * g + 1] * inv), pk2(o1[4 * g + 2] * inv, o1[4 * g + 3] * inv)}; }
        asm volatile("s_waitcnt lgkmcnt(0)" ::: "memory");
        bf16_t* AO = WSP(bf16_t, WS_AO) + (size_t)tok0 * 512 + h * 64;
#pragma unroll
        for (int it = 0; it < 4; ++it) { const int row = it * 8 + (lane >> 3), ch = lane & 7;
            *(u32x4*)(AO + (size_t)row * 512 + ch * 8) = *(const LAS u32x4*)(stg + row * OST_STRIDE + ch * 16); }
    }
}
__device__ __forceinline__ void attn_phase(Frame& F, int clo, int chi) {
#pragma unroll 1
    for (int p2 = 2 * F.bid; p2 < 512; p2 += ((p2 & 1) ? 2 * F.G - 1 : 1)) { const int p = p2 >> 1, b = p >> 5, jj = p & 31, c1 = jj >> 1, half = jj & 1;
        const int cc = (p2 & 1) ? c1 : 31 - c1; if (cc >= clo && cc < chi) attn_unit(F, b, cc, half); }
}

__device__ __forceinline__ void lru_item_mfma(Frame& F, int item) {
    int tid_ = F.tid, w_ = F.wave; asm volatile("" : "+v"(tid_), "+s"(w_));
    const int tid = tid_, lane = tid & 63, w = w_, c16 = lane & 15, kg = lane >> 4;
    const int b = item >> 5, n = (item >> 2) & 7, q = item & 3;
    LAS float* cwL = (LAS float*)(F.lds);
    LAS float* segL = (LAS float*)(F.lds + 2048);
    const float* conv_w = (const float*)F.ap->in[8]; const float* conv_b = (const float*)F.ap->in[9];
    const float* w_rec = (const float*)F.ap->in[10] + (size_t)n * 4096; const float* w_ing = (const float*)F.ap->in[12] + (size_t)n * 4096;
    __syncthreads();
    if (tid < 256) cwL[tid] = conv_w[(tid >> 6) * 512 + 64 * n + (tid & 63)]; else if (tid < 320) cwL[tid] = conv_b[64 * n + (tid - 256)];
    __syncthreads();
    bf16x8 Bw[3][2];
#pragma unroll
    for (int ks = 0; ks < 2; ++ks) { u32x4 pr, pi, pd;
        float vr[8], vi[8], vd[8];
#pragma unroll
        for (int j = 0; j < 8; ++j) { const int d = 32 * ks + 8 * kg + j; vr[j] = w_rec[d * 64 + 16 * q + c16]; vi[j] = w_ing[d * 64 + 16 * q + c16]; vd[j] = (d == 16 * q + c16) ? 1.f : 0.f; }
        pr.x = pk2(vr[0], vr[1]); pr.y = pk2(vr[2], vr[3]); pr.z = pk2(vr[4], vr[5]); pr.w = pk2(vr[6], vr[7]);
        pi.x = pk2(vi[0], vi[1]); pi.y = pk2(vi[2], vi[3]); pi.z = pk2(vi[4], vi[5]); pi.w = pk2(vi[6], vi[7]);
        pd.x = pk2(vd[0], vd[1]); pd.y = pk2(vd[2], vd[3]); pd.z = pk2(vd[4], vd[5]); pd.w = pk2(vd[6], vd[7]);
        Bw[0][ks] = __builtin_bit_cast(bf16x8, pr); Bw[1][ks] = __builtin_bit_cast(bf16x8, pi); Bw[2][ks] = __builtin_bit_cast(bf16x8, pd); }
    const int chg = 64 * n + 16 * q + c16;
    const float spl8 = -8.f * log1pf(__expf(-((const float*)F.ap->in[14])[chg])), brc = ((const float*)F.ap->in[11])[chg], bin = ((const float*)F.ap->in[13])[chg];
    const bf16_t* LX = WSP(bf16_t, WS_LX) + (size_t)b * SEQ * 512 + 64 * n;
    const bf16_t* LG = WSP(bf16_t, WS_LG) + (size_t)b * SEQ * 512 + 64 * n + 16 * q + c16;
    bf16_t* LO = WSP(bf16_t, WS_LO) + (size_t)b * SEQ * 512 + 64 * n + 16 * q + c16;
    float hc = 0.f;
#pragma unroll 1
    for (int pass = 0; pass < 2; ++pass) {
        float Arun = 1.f, Brun = 0.f;
#pragma unroll 1
        for (int rb = 0; rb < 16; ++rb) {
            const int t0 = 256 * w + 16 * rb;
            bf16x8 afr[2];
#pragma unroll
            for (int ks = 0; ks < 2; ++ks) { const int d0 = 32 * ks + 8 * kg; float xc[8];
                { const f32x4 c0 = *(const LAS f32x4*)(cwL + 256 + d0), c1 = *(const LAS f32x4*)(cwL + 256 + d0 + 4);
                  xc[0] = c0.x; xc[1] = c0.y; xc[2] = c0.z; xc[3] = c0.w; xc[4] = c1.x; xc[5] = c1.y; xc[6] = c1.z; xc[7] = c1.w; }
#pragma unroll
                for (int tap = 0; tap < 4; ++tap) { const int ts = t0 + c16 - 3 + tap;
                    if (ts >= 0) { const u32x4 v = *(const u32x4*)(LX + (size_t)ts * 512 + d0);
                        const f32x4 c0 = *(const LAS f32x4*)(cwL + tap * 64 + d0), c1 = *(const LAS f32x4*)(cwL + tap * 64 + d0 + 4);
                        xc[0] += bflo(v.x) * c0.x; xc[1] += bfhi(v.x) * c0.y; xc[2] += bflo(v.y) * c0.z; xc[3] += bfhi(v.y) * c0.w;
                        xc[4] += bflo(v.z) * c1.x; xc[5] += bfhi(v.z) * c1.y; xc[6] += bflo(v.w) * c1.z; xc[7] += bfhi(v.w) * c1.w; } }
                u32x4 pa; pa.x = pk2(xc[0], xc[1]); pa.y = pk2(xc[2], xc[3]); pa.z = pk2(xc[4], xc[5]); pa.w = pk2(xc[6], xc[7]);
                afr[ks] = __builtin_bit_cast(bf16x8, pa); }
            f32x4 rp = (f32x4){0.f, 0.f, 0.f, 0.f}, ip = rp, xv = rp;
#pragma unroll
            for (int ks = 0; ks < 2; ++ks) { rp = __builtin_amdgcn_mfma_f32_16x16x32_bf16(afr[ks], Bw[0][ks], rp, 0, 0, 0); ip = __builtin_amdgcn_mfma_f32_16x16x32_bf16(afr[ks], Bw[1][ks], ip, 0, 0, 0);
                xv = __builtin_amdgcn_mfma_f32_16x16x32_bf16(afr[ks], Bw[2][ks], xv, 0, 0, 0); }
            float av[4], bv[4];
#pragma unroll
            for (int r = 0; r < 4; ++r) { const float rg = 1.f / (1.f + __expf(-(rp[r] + brc))), ig = 1.f / (1.f + __expf(-(ip[r] + bin)));
                const float la = spl8 * rg; av[r] = __expf(la);
                const float x2 = 2.f * la;
                const float em = -x2 * (1.f + x2 * (0.5f + x2 * (0.16666667f + x2 * (0.041666668f + x2 * (0.0083333338f + x2 * 0.0013888889f)))));
                bv[r] = sqrtf(em) * (ig * xv[r]); }
            float Ag = av[0], Bg = bv[0];
#pragma unroll
            for (int r = 1; r < 4; ++r) { Bg = av[r] * Bg + bv[r]; Ag = Ag * av[r]; }
            const float A0 = __shfl(Ag, c16), B0 = __shfl(Bg, c16), A1 = __shfl(Ag, c16 + 16), B1 = __shfl(Bg, c16 + 16), A2 = __shfl(Ag, c16 + 32), B2 = __shfl(Bg, c16 + 32), A3 = __shfl(Ag, c16 + 48), B3 = __shfl(Bg, c16 + 48);
            const float P2a = A0 * A1, P2b = A1 * B0 + B1, P3a = P2a * A2, P3b = A2 * P2b + B2, Ta = P3a * A3, Tb = A3 * P3b + B3;
            if (pass == 0) { Brun = Ta * Brun + Tb; Arun = Arun * Ta; }
            else {
                const float Pa = kg == 0 ? 1.f : kg == 1 ? A0 : kg == 2 ? P2a : P3a, Pb = kg == 0 ? 0.f : kg == 1 ? B0 : kg == 2 ? P2b : P3b;
                float h = Pa * hc + Pb;
#pragma unroll
                for (int r = 0; r < 4; ++r) { h = av[r] * h + bv[r]; const int t = t0 + 4 * kg + r;
                    const float g = bf2f(LG[(size_t)t * 512]); const float u = 0.7978845608028654f * (g + 0.044715f * g * g * g);
                    const float ge = g / (1.f + __expf(-2.f * u));
                    LO[(size_t)t * 512] = (bf16_t)f2bf(h * ge); }
                hc = Ta * hc + Tb;
            }
        }
        if (pass == 0) {
            if (kg == 0) { segL[(w * 16 + c16) * 2] = Arun; segL[(w * 16 + c16) * 2 + 1] = Brun; }
            __syncthreads();
            hc = 0.f;
            for (int ww = 0; ww < w; ++ww) hc = segL[(ww * 16 + c16) * 2] * hc + segL[(ww * 16 + c16) * 2 + 1];
        }
    }
}
__device__ __forceinline__ void lru_phase(Frame& F) {
#pragma unroll 1
    for (int it = F.bid; it < 256; it += F.G) lru_item_mfma(F, it);
}
struct SchedMerge { const bf16_t *AO, *LO, *WPA, *WPB; int G, c;
    __device__ __forceinline__ bool next(int i, Unit& u) const { const int L = (i >> 1) * G + c; if (L >= 64 * 4) return false; const int sub = i & 1;
        u.pm = L % 64; u.pn = L / 64; u.aux = sub; u.flags = 0;
        u.A = (sub ? LO : AO) + (size_t)u.pm * 256 * 512; u.B = (sub ? WPB : WPA) + (size_t)u.pn * 256 * 512; return true; } };
struct EpiMerge {   static constexpr bool PERM = true;
    bf16_t* MG; const bf16_t *GA, *GB;
    __device__ __forceinline__ void operator()(const f32x4 (&acc)[2][2][4][2], const Unit& u, int wr, int wc, int fr, int fq) const {
        const bf16_t* G = u.aux ? GB : GA;
#pragma unroll
        for (int ai = 0; ai < 2; ++ai)
#pragma unroll
            for (int m = 0; m < 4; ++m)
#pragma unroll
                for (int bj = 0; bj < 2; ++bj) {
                    const size_t off = (size_t)(u.pm * 256 + ai * 128 + wr * 64 + m * 16 + fr) * 1024 + u.pn * 256 + bj * 128 + wc * 32 + 8 * fq;
                    const u32x4 g = *(const u32x4*)(G + off);
                    f32x4 v0 = acc[ai][bj][m][0], v1 = acc[ai][bj][m][1];
                    v0[0] *= bflo(g.x); v0[1] *= bfhi(g.x); v0[2] *= bflo(g.y); v0[3] *= bfhi(g.y); v1[0] *= bflo(g.z); v1[1] *= bfhi(g.z); v1[2] *= bflo(g.w); v1[3] *= bfhi(g.w);
                    if (u.aux) { const u32x4 p = *(const u32x4*)(MG + off);
                        v0[0] += bflo(p.x); v0[1] += bfhi(p.x); v0[2] += bflo(p.y); v0[3] += bfhi(p.y); v1[0] += bflo(p.z); v1[1] += bfhi(p.z); v1[2] += bflo(p.w); v1[3] += bfhi(p.w); }
                    u32x4 w; w.x = pk2(v0[0], v0[1]); w.y = pk2(v0[2], v0[3]); w.z = pk2(v1[0], v1[1]); w.w = pk2(v1[2], v1[3]);
                    *(u32x4*)(MG + off) = w; }
    }
};
struct SchedOut { const bf16_t *A, *B; int G, c;
    __device__ __forceinline__ bool next(int i, Unit& u) const { const int L = i * G + c; if (L >= 64 * 4) return false;
        u.pm = L % 64; u.pn = L / 64; u.aux = 0; u.flags = 0; u.A = A + (size_t)u.pm * 256 * 1024; u.B = B + (size_t)u.pn * 256 * 1024; return true; } };
struct EpiOut {   static constexpr bool PERM = false;
    const float* x; const float* mod; float* out;
    __device__ __forceinline__ void operator()(const f32x4 (&acc)[2][2][4][2], const Unit& u, int wr, int wc, int fr, int fq) const {
        const int b = (u.pm * 256) / SEQ;
#pragma unroll
        for (int bj = 0; bj < 2; ++bj)
#pragma unroll
            for (int n = 0; n < 2; ++n) { const int col = u.pn * 256 + bj * 128 + wc * 32 + 16 * n + 4 * fq; const f32x4 gm = *(const f32x4*)(mod + b * 6144 + 2048 + col);
#pragma unroll
                for (int ai = 0; ai < 2; ++ai)
#pragma unroll
                    for (int m = 0; m < 4; ++m) { const size_t off = (size_t)(u.pm * 256 + ai * 128 + wr * 64 + m * 16 + fr) * 1024 + col;
                        *(f32x4*)(out + off) = *(const f32x4*)(x + off) + gm * acc[ai][bj][m][n]; } }
    }
};

struct TokMeta { int ea, eb; float ca, cb; int re_a, re_b, cls, rc; };
__device__ __forceinline__ int pair_index(int lo, int hi) { return lo * (15 - lo) / 2 + (hi - lo - 1); }

__device__ __forceinline__ void route_phase(Frame& F) {
    int tid_ = F.tid, w_ = F.wave; asm volatile("" : "+v"(tid_), "+s"(w_));
    const int tid = tid_, lane = tid & 63, w = w_, r16 = lane & 15, r8 = lane & 7, kg = lane >> 4;
    LAS float* gsL = (LAS float*)(F.lds);
    LAS float* lgL = (LAS float*)(F.lds + 8192 + w * 2048);
    const float* nw = (const float*)F.ap->in[18];
    const bf16_t* WH = WSP(bf16_t, WS_WRH); const bf16_t* WL = WSP(bf16_t, WS_WRL);
#pragma unroll 1
    for (int blk = F.bid; blk < NTOK / 64; blk += F.G) {
        const int tokb = blk * 64, b = tokb / SEQ; const float* mod = WSP(float, WS_MOD) + b * 6144;
        __syncthreads();
        for (int i = tid; i < 1024; i += NTHREADS) { gsL[i] = nw[i] * (1.f + mod[4096 + i]); gsL[1024 + i] = mod[3072 + i]; }
        __syncthreads();
        const int tok = tokb + 8 * w + r8;
        const float* xr = F.out + (size_t)tok * DM + 8 * kg;
        float ss = 0.f;
#pragma unroll 4
        for (int ks = 0; ks < 32; ++ks) { const f32x4 a = *(const f32x4*)(xr + 32 * ks), c = *(const f32x4*)(xr + 32 * ks + 4);
            ss += (a.x * a.x + a.y * a.y) + (a.z * a.z + a.w * a.w) + (c.x * c.x + c.y * c.y) + (c.z * c.z + c.w * c.w); }
        ss += __shfl_xor(ss, 16); ss += __shfl_xor(ss, 32);
        const float rinv = rsqrtf(ss * (1.f / DM) + EPS);
        f32x4 acc[3];
#pragma unroll
        for (int nb = 0; nb < 3; ++nb) acc[nb] = (f32x4){0.f, 0.f, 0.f, 0.f};
        bf16_t* h2row = WSP(bf16_t, WS_H2T) + (size_t)tok * DM + 8 * kg;
#pragma unroll 2
        for (int ks = 0; ks < 32; ++ks) { const int k0 = 32 * ks + 8 * kg;
            const f32x4 a = *(const f32x4*)(xr + 32 * ks), c = *(const f32x4*)(xr + 32 * ks + 4);
            const f32x4 g0 = *(const LAS f32x4*)(gsL + k0), g1 = *(const LAS f32x4*)(gsL + k0 + 4), s0 = *(const LAS f32x4*)(gsL + 1024 + k0), s1 = *(const LAS f32x4*)(gsL + 1024 + k0 + 4);
            float hv[8]; hv[0] = a.x * rinv * g0.x + s0.x; hv[1] = a.y * rinv * g0.y + s0.y; hv[2] = a.z * rinv * g0.z + s0.z; hv[3] = a.w * rinv * g0.w + s0.w;
            hv[4] = c.x * rinv * g1.x + s1.x; hv[5] = c.y * rinv * g1.y + s1.y; hv[6] = c.z * rinv * g1.z + s1.z; hv[7] = c.w * rinv * g1.w + s1.w;
            unsigned hb[8]; float lo[8];
#pragma unroll
            for (int e = 0; e < 8; ++e) { hb[e] = f2bf(hv[e]); lo[e] = hv[e] - bf2f((unsigned short)hb[e]); }
            u32x4 ph, pl; ph.x = hb[0] | (hb[1] << 16); ph.y = hb[2] | (hb[3] << 16); ph.z = hb[4] | (hb[5] << 16); ph.w = hb[6] | (hb[7] << 16);
            pl.x = pk2(lo[0], lo[1]); pl.y = pk2(lo[2], lo[3]); pl.z = pk2(lo[4], lo[5]); pl.w = pk2(lo[6], lo[7]);
            if (r16 < 8) *(u32x4*)(h2row + 32 * ks) = ph;
            const bf16x8 ah = __builtin_bit_cast(bf16x8, ph), al = __builtin_bit_cast(bf16x8, pl);
#pragma unroll
            for (int nb = 0; nb < 3; ++nb) { const bf16x8 bh = *(const bf16x8*)(WH + (size_t)(16 * nb + r16) * 1024 + k0), bl = *(const bf16x8*)(WL + (size_t)(16 * nb + r16) * 1024 + k0);
                acc[nb] = __builtin_amdgcn_mfma_f32_16x16x32_bf16(ah, bh, acc[nb], 0, 0, 0); acc[nb] = __builtin_amdgcn_mfma_f32_16x16x32_bf16(ah, bl, acc[nb], 0, 0, 0);
                acc[nb] = __builtin_amdgcn_mfma_f32_16x16x32_bf16(al, bh, acc[nb], 0, 0, 0); } }
        if (kg < 2) {
#pragma unroll
            for (int nb = 0; nb < 3; ++nb)
#pragma unroll
                for (int r = 0; r < 4; ++r) lgL[(4 * kg + r) * 48 + 16 * nb + r16] = acc[nb][r]; }
        asm volatile("s_waitcnt lgkmcnt(0)" ::: "memory");
        if (lane < 8) {
            const LAS float* lg = lgL + lane * 48; const float* bg = (const float*)F.ap->in[20]; const float* be = (const float*)F.ap->in[22];
            float gl[4];
#pragma unroll
            for (int i = 0; i < 4; ++i) gl[i] = lg[i] + bg[i];
            int g = 0; float gmx = gl[0];
#pragma unroll
            for (int i = 1; i < 4; ++i) if (gl[i] > gmx) { gmx = gl[i]; g = i; }
            float gs = 0.f;
#pragma unroll
            for (int i = 0; i < 4; ++i) gs += __expf(gl[i] - gmx);
            const float gw = 1.f / gs;
            float el[8];
#pragma unroll
            for (int i = 0; i < 8; ++i) el[i] = lg[4 + g * 8 + i] + be[g * 8 + i];
            int i1 = 0; float v1 = el[0];
#pragma unroll
            for (int i = 1; i < 8; ++i) if (el[i] > v1) { v1 = el[i]; i1 = i; }
            int i2 = -1; float v2 = -INFINITY;
#pragma unroll
            for (int i = 0; i < 8; ++i) if (i != i1 && (i2 < 0 || el[i] > v2)) { v2 = el[i]; i2 = i; }
            const float e2 = __expf(v2 - v1); const float w1v = gw / (1.f + e2), w2v = gw * e2 / (1.f + e2);
            TokMeta mt; const int lo = i1 < i2 ? i1 : i2, hi = i1 < i2 ? i2 : i1;
            mt.ea = g * 8 + lo; mt.eb = g * 8 + hi; mt.ca = (i1 < i2) ? w1v : w2v; mt.cb = (i1 < i2) ? w2v : w1v;
            mt.cls = g * 28 + pair_index(lo, hi);
            unsigned* ctl = (unsigned*)(F.ws + WS_CTL);
            mt.re_a = (int)atomicAdd(ctl + CW_CNTE + mt.ea, 1u); mt.re_b = (int)atomicAdd(ctl + CW_CNTE + mt.eb, 1u); mt.rc = (int)atomicAdd(ctl + CW_CNTC + mt.cls, 1u);
            WSP(TokMeta, WS_META)[tokb + 8 * w + lane] = mt;
        }
    }
}
struct MoeTables { LAS int* ebase; LAS int* cbase; };
__device__ __forceinline__ MoeTables build_tables(Frame& F, int lds_off) {
    MoeTables T; T.ebase = (LAS int*)(F.lds + lds_off); T.cbase = T.ebase + 40;
    const unsigned* ctl = (const unsigned*)(F.ws + WS_CTL);
    __syncthreads();
    if (F.tid == 0) { int a = 0; for (int e = 0; e < NEXP; ++e) { T.ebase[e] = a; a += ((int)__hip_atomic_load(ctl + CW_CNTE + e, __ATOMIC_RELAXED, __HIP_MEMORY_SCOPE_AGENT) + 255) >> 8; } T.ebase[NEXP] = a; }
    if (F.tid == 64) { int a = 0; for (int c = 0; c < NCLS; ++c) { T.cbase[c] = a; a += ((int)__hip_atomic_load(ctl + CW_CNTC + c, __ATOMIC_RELAXED, __HIP_MEMORY_SCOPE_AGENT) + 255) >> 8; } T.cbase[NCLS] = a; }
    __syncthreads();
    return T;
}
__device__ __forceinline__ void sort_phase_naive(Frame& F) {
    const MoeTables T = build_tables(F, RING_BYTES + 4096);
    const int gw = F.bid * NWAVES + F.wave, NGW = F.G * NWAVES;
    bf16_t* A1 = WSP(bf16_t, WS_A1); const bf16_t* H2 = WSP(bf16_t, WS_H2T);
    int* dest2 = WSP(int, WS_DEST2); float* cw = WSP(float, WS_CW); int* tok2 = WSP(int, WS_TOK2);
    for (int tok = gw; tok < NTOK; tok += NGW) {
        const TokMeta mt = WSP(TokMeta, WS_META)[tok];
        const int sa = T.ebase[mt.ea] * 256 + mt.re_a, sb = T.ebase[mt.eb] * 256 + mt.re_b, rc = T.cbase[mt.cls] * 256 + mt.rc;
        const u32x4* src = (const u32x4*)(H2 + (size_t)tok * DM) + F.lane;
        u32x4* da = (u32x4*)(A1 + (size_t)sa * DM) + F.lane; u32x4* db = (u32x4*)(A1 + (size_t)sb * DM) + F.lane;
        const u32x4 v0 = src[0], v1 = src[64];
        da[0] = v0; da[64] = v1; db[0] = v0; db[64] = v1;
        if (F.lane == 0) { dest2[sa] = rc * 512; dest2[sb] = rc * 512 + 256; cw[sa] = mt.ca; cw[sb] = mt.cb; tok2[rc] = tok; }
    }
}

struct SchedMoe1 { const bf16_t *A1, *W13; const LAS int* ebase; const unsigned* cnte; int G, c;
    __device__ __forceinline__ bool next(int i, Unit& u) const { const int L = i * G + c, ntile = ebase[NEXP]; if (L >= ntile * 2) return false;
        const int rt = L >> 1, j = L & 1; int e = 0;
        for (int q = 1; q < NEXP; ++q) e = (ebase[q] <= rt) ? q : e;
        u.pm = rt; u.pn = j; u.flags = 0; u.aux = (int)cnte[e] - 256 * (rt - ebase[e]);
        u.A = A1 + (size_t)rt * 256 * 1024; u.B = W13 + ((size_t)e * 512 + 256 * j) * 1024; return true; } };
struct EpiMoe1 {   static constexpr bool PERM = true;
    bf16_t* act2; const int* dest2; const float* cw;
    __device__ __forceinline__ void operator()(const f32x4 (&acc)[2][2][4][2], const Unit& u, int wr, int wc, int fr, int fq) const {
#pragma unroll
        for (int ai = 0; ai < 2; ++ai)
#pragma unroll
            for (int m = 0; m < 4; ++m) { const int r = ai * 128 + wr * 64 + m * 16 + fr; if (r >= u.aux) continue;
                const int slot = u.pm * 256 + r; const float cs = cw[slot]; const int d = dest2[slot];
                float o[8];
#pragma unroll
                for (int n = 0; n < 2; ++n)
#pragma unroll
                    for (int e = 0; e < 4; ++e) { const float a = acc[ai][0][m][n][e], g = acc[ai][1][m][n][e]; o[4 * n + e] = a * sigmoidf_(a) * g * cs; }
                u32x4 w; w.x = pk2(o[0], o[1]); w.y = pk2(o[2], o[3]); w.z = pk2(o[4], o[5]); w.w = pk2(o[6], o[7]);
                *(u32x4*)(act2 + (size_t)d + 128 * u.pn + 32 * wc + 8 * fq) = w; }
    }
};
struct SchedMoe2 { const bf16_t *act2, *W2; const LAS int* cbase; const unsigned* cntc; int G, c;
    __device__ __forceinline__ bool next(int i, Unit& u) const { const int L = (i >> 1) * G + c, ntile = cbase[NCLS]; if (L >= ntile * 4) return false;
        const int sub = i & 1, rt = L >> 2, pn = L & 3; int cl = 0;
        for (int q = 1; q < NCLS; ++q) cl = (cbase[q] <= rt) ? q : cl;
        const int g = cl / 28; int p = cl % 28, lo = 0; while (p >= 7 - lo) { p -= 7 - lo; ++lo; } const int hi = lo + 1 + p;
        const int e = g * 8 + (sub ? hi : lo);
        u.pm = rt; u.pn = pn; u.flags = sub ? 1 : 2; u.aux = (int)cntc[cl] - 256 * (rt - cbase[cl]);
        u.A = act2 + (size_t)rt * 256 * 512 + 256 * sub; u.B = W2 + ((size_t)e * 1024 + 256 * pn) * 256; return true; } };
struct EpiMoe2 {   static constexpr bool PERM = false;
    float* out; const float* mod; const int* tok2;
    __device__ __forceinline__ void operator()(const f32x4 (&acc)[2][2][4][2], const Unit& u, int wr, int wc, int fr, int fq) const {
#pragma unroll
        for (int ai = 0; ai < 2; ++ai)
#pragma unroll
            for (int m = 0; m < 4; ++m) { const int r = ai * 128 + wr * 64 + m * 16 + fr; if (r >= u.aux) continue;
                const int tok = tok2[u.pm * 256 + r]; const int b = tok / SEQ;
#pragma unroll
                for (int bj = 0; bj < 2; ++bj)
#pragma unroll
                    for (int n = 0; n < 2; ++n) { const int col = u.pn * 256 + bj * 128 + wc * 32 + 16 * n + 4 * fq; const f32x4 gf = *(const f32x4*)(mod + b * 6144 + 5120 + col);
                        float* p = out + (size_t)tok * 1024 + col; *(f32x4*)p = *(const f32x4*)p + gf * acc[ai][bj][m][n]; }
                asm volatile("" ::: "memory"); }
    }
};

constexpr int NPHASE = 10;
template <int LO, int HI> __global__ void __launch_bounds__(NTHREADS, 2) mk_fwd(Args args) {
    extern __shared__ __attribute__((aligned(16))) unsigned char lds[];
    Frame F;
    F.lds = (LAS unsigned char*)lds; F.tid = threadIdx.x; F.lane = F.tid & 63; F.wave = __builtin_amdgcn_readfirstlane(F.tid >> 6); F.G = gridDim.x; F.bid = blockIdx.x;
    F.ap = &args;
    F.out = args.out; F.ws = args.ws;
    volatile LAS unsigned* MISC = (volatile LAS unsigned*)((LAS unsigned char*)lds + MISC_OFF);
    if (F.tid < 32) MISC[F.tid] = 0u;
    __syncthreads();
    unsigned* ctl = (unsigned*)(F.ws + WS_CTL);
    XcdBarrier bar; bar.bar = ctl + CW_BAR; bar.x = 0; bar.st = nullptr;
    if (MK_N_LAUNCHES == 1) bar = xcd_barrier_post(ctl + CW_BAR, MISC + 8);
#define IN(k) (LO <= (k) && (k) < HI)
#define SEAM(k) do { if constexpr (IN(k) && IN((k) + 1)) xcd_barrier(bar); } while (0)
    if constexpr (IN(0)) { p0_phase(F); } SEAM(0);
    if constexpr (IN(1)) { p1a_phase(F); } SEAM(1);
    if constexpr (IN(2)) { SchedProj S{WSP(bf16_t, WS_H), WSP(bf16_t, WS_WIN), F.G, F.bid};
        EpiProj E{WSP(bf16_t, WS_Q), WSP(bf16_t, WS_K), WSP(bf16_t, WS_VT), WSP(bf16_t, WS_VR), WSP(bf16_t, WS_QI), WSP(bf16_t, WS_KI), WSP(bf16_t, WS_LX), WSP(bf16_t, WS_LG), WSP(bf16_t, WS_GA), WSP(bf16_t, WS_GB), WSP(float, WS_WI)};
        run_gemm(F.lds, 1024, 1024, 1024, S, E); } SEAM(2);
    if constexpr (IN(3)) { lru_phase(F); __syncthreads(); attn_phase(F, 0, 32); } SEAM(3);
    if constexpr (IN(4)) { SchedMerge S{WSP(bf16_t, WS_AO), WSP(bf16_t, WS_LO), WSP(bf16_t, WS_WPA), WSP(bf16_t, WS_WPB), F.G, F.bid};
        EpiMerge E{WSP(bf16_t, WS_MG), WSP(bf16_t, WS_GA), WSP(bf16_t, WS_GB)};
        run_gemm(F.lds, 512, 512, 512, S, E); } SEAM(4);
    if constexpr (IN(5)) { SchedOut S{WSP(bf16_t, WS_MG), WSP(bf16_t, WS_WOUT), F.G, F.bid}; EpiOut E{((const float*)F.ap->in[0]), WSP(float, WS_MOD), F.out};
        run_gemm(F.lds, 1024, 1024, 1024, S, E); } SEAM(5);
    if constexpr (IN(6)) { route_phase(F); } SEAM(6);
    if constexpr (IN(7)) { sort_phase_naive(F); } SEAM(7);
    if constexpr (IN(8)) { const MoeTables T = build_tables(F, RING_BYTES + 4096);
        SchedMoe1 S{WSP(bf16_t, WS_A1), WSP(bf16_t, WS_W13), T.ebase, (const unsigned*)(ctl + CW_CNTE), F.G, F.bid}; EpiMoe1 E{WSP(bf16_t, WS_ACT2), WSP(int, WS_DEST2), WSP(float, WS_CW)};
        run_gemm(F.lds, 1024, 1024, 1024, S, E); } SEAM(8);
    if constexpr (IN(9)) { const MoeTables T = build_tables(F, RING_BYTES + 4096);
        SchedMoe2 S{WSP(bf16_t, WS_ACT2), WSP(bf16_t, WS_W2), T.cbase, (const unsigned*)(ctl + CW_CNTC), F.G, F.bid}; EpiMoe2 E{F.out, WSP(float, WS_MOD), WSP(int, WS_TOK2)};
        run_gemm(F.lds, 512, 256, 256, S, E); }
#undef IN
#undef SEAM
}

template <int P> static void launch_phase(int grid, hipStream_t stream, Args a) {
    (void)hipFuncSetAttribute((const void*)mk_fwd<P, P + 1>, hipFuncAttributeMaxDynamicSharedMemorySize, LDS_BYTES);
    a.ph_lo = P; a.ph_hi = P + 1; hipLaunchKernelGGL((mk_fwd<P, P + 1>), dim3(grid), dim3(NTHREADS), LDS_BYTES, stream, a);
}
extern "C" void kernel_launch(void* const* d_in, const int* in_sizes, int n_in, void* d_out, int out_size, void* d_ws, size_t ws_size, hipStream_t stream) {
    static int grid = 0;
    if (grid == 0) {
        if (n_in != 26 || out_size != NTOK * DM || ws_size < WS_END) { fprintf(stderr, "kernel_launch: unexpected shapes (n_in %d out %d ws %zu)\n", n_in, out_size, ws_size); grid = -1; return; }
        int dev = 0, cus = 0, per_cu = 0;
        (void)hipGetDevice(&dev); (void)hipDeviceGetAttribute(&cus, hipDeviceAttributeMultiprocessorCount, dev);
#if MK_N_LAUNCHES == 1
        (void)hipFuncSetAttribute((const void*)mk_fwd<0, NPHASE>, hipFuncAttributeMaxDynamicSharedMemorySize, LDS_BYTES);
        (void)hipOccupancyMaxActiveBlocksPerMultiprocessor(&per_cu, (const void*)mk_fwd<0, NPHASE>, NTHREADS, LDS_BYTES);
#else
        (void)hipOccupancyMaxActiveBlocksPerMultiprocessor(&per_cu, (const void*)mk_fwd<2, 3>, NTHREADS, LDS_BYTES);
#endif
        (void)hipGetLastError();
        if (per_cu < 1) { fprintf(stderr, "kernel_launch: occupancy query says %d blocks per CU\n", per_cu); }
        grid = cus;
    }
    if (grid < 0) return;
    (void)hipMemsetAsync((char*)d_ws + WS_CTL, 0, CTL_ZERO_BYTES, stream);
    Args a{};
    for (int i = 0; i < 26; ++i) a.in[i] = d_in[i];
    a.out = (float*)d_out; a.ws = (unsigned char*)d_ws;
#if MK_N_LAUNCHES == 1
    a.ph_lo = 0; a.ph_hi = NPHASE; hipLaunchKernelGGL((mk_fwd<0, NPHASE>), dim3(grid), dim3(NTHREADS), LDS_BYTES, stream, a);
#else
#ifndef MK_REPMASK
#define MK_REPMASK 0
#endif
    for (int r = 0; r < ((MK_REPMASK & 1) ? 2 : 1); ++r) launch_phase<0>(grid, stream, a);
    for (int r = 0; r < ((MK_REPMASK & 2) ? 2 : 1); ++r) launch_phase<1>(grid, stream, a);
    for (int r = 0; r < ((MK_REPMASK & 4) ? 2 : 1); ++r) launch_phase<2>(grid, stream, a);
    for (int r = 0; r < ((MK_REPMASK & 8) ? 2 : 1); ++r) launch_phase<3>(grid, stream, a);
    for (int r = 0; r < ((MK_REPMASK & 16) ? 2 : 1); ++r) launch_phase<4>(grid, stream, a);
    for (int r = 0; r < ((MK_REPMASK & 32) ? 2 : 1); ++r) launch_phase<5>(grid, stream, a);
    launch_phase<6>(grid, stream, a);
    for (int r = 0; r < ((MK_REPMASK & 128) ? 2 : 1); ++r) launch_phase<7>(grid, stream, a);
    for (int r = 0; r < ((MK_REPMASK & 256) ? 2 : 1); ++r) launch_phase<8>(grid, stream, a);
    launch_phase<9>(grid, stream, a);
    if (MK_REPMASK & 512) { launch_phase<5>(grid, stream, a); launch_phase<9>(grid, stream, a); }
#endif
}
```

```cpp
#include <hip/hip_runtime.h>
#include <cstdint>
#include <cstdio>

#ifndef MK_LEAK
#define MK_LEAK -1
#endif
#ifndef MK_N_LAUNCHES
#define MK_N_LAUNCHES 1
#endif

#define LAS __attribute__((address_space(3)))
#define GAS __attribute__((address_space(1)))
typedef unsigned short bf16_t;
typedef short bf16x8 __attribute__((ext_vector_type(8)));
typedef float f32x4 __attribute__((ext_vector_type(4)));
typedef float f32x2 __attribute__((ext_vector_type(2)));
typedef unsigned u32x4 __attribute__((ext_vector_type(4)));
typedef unsigned u32x2 __attribute__((ext_vector_type(2)));
typedef GAS unsigned gu32;

constexpr int BATCH = 8, SEQ = 2048, DM = 1024, NTOK = BATCH * SEQ;
constexpr int NH = 8, HD = 64, NIH = 4, TOPK = 256, CHUNK = 64;
constexpr int LRUW = 512;
constexpr int NEXP = 32, NGRP = 4, EPG = 8, DFF = 256, NCLS = NGRP * 28;
constexpr int DIN_PAD = 4096;
constexpr float EPS = 1e-6f;
constexpr int C_Q = 0, C_K = 512, C_V = 576, C_QI = 640, C_KI = 896, C_LX = 960, C_LG = 1472, C_WI = 1984, C_PAD = 1988, C_GA = 2048, C_GB = 3072, C_END = 4096;

constexpr size_t MiB = 1u << 20;
constexpr size_t WS_CTL = 0, CTL_ZERO_BYTES = 1 * MiB;
constexpr size_t WS_MOD = 1 * MiB;
constexpr size_t WS_META = 1 * MiB + 512 * 1024;
constexpr size_t WS_WIN = 2 * MiB, WS_WPA = 10 * MiB, WS_WPB = 11 * MiB, WS_WOUT = 12 * MiB, WS_W13 = 14 * MiB, WS_W2 = 46 * MiB;
constexpr size_t WS_WRH = 62 * MiB, WS_WRL = 62 * MiB + 256 * 1024;
constexpr size_t WS_H = 64 * MiB;
constexpr size_t WS_AO = 64 * MiB, WS_LO = 80 * MiB;
constexpr size_t WS_Q = 96 * MiB, WS_QI = 112 * MiB, WS_K = 120 * MiB, WS_KI = 122 * MiB, WS_VT = 124 * MiB, WS_WI = 126 * MiB, WS_VR = 224 * MiB;
constexpr size_t WS_LX = 128 * MiB, WS_LG = 144 * MiB, WS_MG = 128 * MiB;
constexpr size_t WS_GA = 160 * MiB, WS_GB = 192 * MiB;
constexpr size_t WS_A1 = 64 * MiB;
constexpr size_t WS_H2T = 160 * MiB;
constexpr size_t WS_ACT2 = 192 * MiB;
constexpr size_t WS_H8 = 224 * MiB;
constexpr size_t WS_WIN8 = 6 * MiB;
constexpr size_t WS_EINFO = 64 * MiB;
constexpr size_t WS_CLIST = 72 * MiB;
constexpr int LIST_CAP = 16384;
constexpr size_t WS_ROWSQ = 240 * MiB;
constexpr size_t WS_END = 256 * MiB;
constexpr int CW_BAR = 4096, CW_CNTE = 8192, CW_CNTC = 8192 + 32 * 32, CNT_STRIDE = 32, CW_ROWSQ = 16384;

constexpr int NWAVES = 8, NTHREADS = 512;
constexpr int LDS_BYTES = 151552, RING_BYTES = 131072, MISC_OFF = LDS_BYTES - 512, GF_OFF = RING_BYTES, TBL_OFF = RING_BYTES + 16384;

typedef float f32x2_cv __attribute__((ext_vector_type(2)));
typedef __bf16 bf16x2_cv __attribute__((ext_vector_type(2)));
__device__ __forceinline__ unsigned pk2(float lo, float hi) { const f32x2_cv v = {lo, hi}; return __builtin_bit_cast(unsigned, __builtin_convertvector(v, bf16x2_cv)); }
__device__ __forceinline__ unsigned f2bf(float f) { return pk2(f, 0.f) & 0xffffu; }
__device__ __forceinline__ unsigned cvt_pk_bf16(float lo, float hi) { return pk2(lo, hi); }

#define LDS_BARRIER() do { asm volatile("s_waitcnt lgkmcnt(0)" ::: "memory"); __builtin_amdgcn_s_barrier(); asm volatile("" ::: "memory"); } while (0)
__device__ __forceinline__ float relu_f(float x) { float r; asm("v_max_f32 %0, 0, %1" : "=v"(r) : "v"(x)); return r; }
__device__ __forceinline__ float max3f(float a, float b, float c) { float r; asm("v_max3_f32 %0, %1, %2, %3" : "=v"(r) : "v"(a), "v"(b), "v"(c)); return r; }
typedef int v8i32 __attribute__((ext_vector_type(8)));
__device__ __forceinline__ unsigned pk4_fp8(float a, float b, float c, float d) { int w = 0; w = __builtin_amdgcn_cvt_pk_fp8_f32(a, b, w, false); w = __builtin_amdgcn_cvt_pk_fp8_f32(c, d, w, true); return (unsigned)w; }
__device__ __forceinline__ float bf2f(unsigned short b) { return __builtin_bit_cast(float, (unsigned)b << 16); }
__device__ __forceinline__ float bflo(unsigned w) { return __builtin_bit_cast(float, w << 16); }
__device__ __forceinline__ float bfhi(unsigned w) { return __builtin_bit_cast(float, w & 0xffff0000u); }
__device__ __forceinline__ float wave_sum(float v) {
#pragma unroll
    for (int o = 1; o < 64; o <<= 1) v += __shfl_xor(v, o);
    return v;
}
__device__ __forceinline__ float wave_max(float v) {
#pragma unroll
    for (int o = 1; o < 64; o <<= 1) v = fmaxf(v, __shfl_xor(v, o));
    return v;
}
__device__ __forceinline__ int wave_isum(int v) {
#pragma unroll
    for (int o = 1; o < 64; o <<= 1) v += __shfl_xor(v, o);
    return v;
}
__device__ __forceinline__ float sigmoidf_(float x) { return __builtin_amdgcn_rcpf(1.f + __expf(-x)); }
__host__ __device__ __forceinline__ int perm32(int rho) { const int n = rho >> 4, i = rho & 15; return 8 * (i >> 2) + 4 * n + (i & 3); }
__device__ __forceinline__ int vt_pos(int o) { return 8 * ((o >> 2) & 1) + 4 * (o >> 3) + (o & 3); }

#define XB_TMO      128
#define XB_XCNT(j)  (256  + 64 * (j))
#define XB_XSUB(j)  (1280 + 64 * (j))
#define XB_XGEN(j)  (2304 + 64 * (j))
#define XB_TOP      3328
#define XB_TOPGEN   3392
#define XCD_BAR_WORDS 3456
#define XB_SPIN_CAP (1u << 18)
__device__ __forceinline__ unsigned xb_ld(unsigned* p)              { return __hip_atomic_load(p, __ATOMIC_RELAXED, __HIP_MEMORY_SCOPE_AGENT); }
__device__ __forceinline__ unsigned xb_add(unsigned* p, unsigned v) { return __hip_atomic_fetch_add(p, v, __ATOMIC_RELAXED, __HIP_MEMORY_SCOPE_AGENT); }
__device__ __forceinline__ unsigned xb_xcc_id() { return (unsigned)__builtin_amdgcn_s_getreg((3 << 11) | 20) & 0xFu; }
#define XB_SPIN(cond, bar) do { unsigned _sp = 0; while (cond) { __builtin_amdgcn_s_sleep(1); \
    if ((++_sp & 255u) == 0u) { if (xb_ld(&(bar)[XB_TMO])) break; if (_sp > XB_SPIN_CAP) { atomicAdd(&(bar)[XB_TMO], 1u); break; } } } } while (0)
struct XcdBarrier { unsigned* bar; unsigned x; volatile LAS unsigned* st; };
__device__ __forceinline__ XcdBarrier xcd_barrier_post(unsigned* bar, volatile LAS unsigned* st) {
    XcdBarrier b; b.bar = bar; b.x = xb_xcc_id(); b.st = st;
    if (threadIdx.x == 0) (void)xb_add(&bar[XB_XCNT(b.x)], 1u);
    return b;
}
__device__ __forceinline__ void xcd_barrier_complete(unsigned* bar, unsigned x, unsigned& nloc, unsigned& nx) {
    const unsigned G = gridDim.x * gridDim.y * gridDim.z;
    unsigned sum, cnt, mine, sp = 0u;
    for (;;) {
        sum = 0u; cnt = 0u; mine = 0u;
#pragma unroll
        for (unsigned j = 0; j < 16; ++j) { const unsigned c = xb_ld(&bar[XB_XCNT(j)]); sum += c; cnt += (c > 0u) ? 1u : 0u; mine = (j == x) ? c : mine; }
        if (sum == G) break;
        __builtin_amdgcn_s_sleep(1);
        if ((++sp & 255u) == 0u) { if (xb_ld(&bar[XB_TMO])) break; if (sp > XB_SPIN_CAP) { atomicAdd(&bar[XB_TMO], 1u); break; } }
    }
    nloc = mine > 0u ? mine : 1u; nx = cnt > 0u ? cnt : 1u;
}
__device__ __forceinline__ void xcd_barrier(const XcdBarrier& b) {
    asm volatile("s_waitcnt vmcnt(0)" ::: "memory");
    __syncthreads();
    if (threadIdx.x == 0) {
        unsigned* bar = b.bar;
        __builtin_amdgcn_s_waitcnt(0);
        unsigned nloc = b.st[0], nx = b.st[1];
        if (nloc == 0u) { xcd_barrier_complete(bar, b.x, nloc, nx); b.st[0] = nloc; b.st[1] = nx; }
        const unsigned old = xb_add(&bar[XB_XSUB(b.x)], 1u);
        const unsigned gen = old / nloc;
        if (old + 1u == (gen + 1u) * nloc) {
            __builtin_amdgcn_fence(__ATOMIC_RELEASE, "agent");
            asm volatile("s_waitcnt vmcnt(0)" ::: "memory");
            const unsigned og = xb_add(&bar[XB_TOP], 1u);
            const unsigned tg = og / nx;
            if (og + 1u == (tg + 1u) * nx) xb_add(&bar[XB_TOPGEN], 1u);
            else XB_SPIN(xb_ld(&bar[XB_TOPGEN]) == tg, bar);
            __builtin_amdgcn_fence(__ATOMIC_ACQUIRE, "agent");
            xb_add(&bar[XB_XGEN(b.x)], 1u);
            asm volatile("s_waitcnt vmcnt(0)" ::: "memory");
        } else {
            XB_SPIN(xb_ld(&bar[XB_XGEN(b.x)]) == gen, bar);
            __builtin_amdgcn_fence(__ATOMIC_ACQUIRE, "agent");
            asm volatile("s_waitcnt vmcnt(0)" ::: "memory");
        }
    }
    __syncthreads();
}

struct Args { const void* in[26]; float* out; unsigned char* ws; int ph_lo, ph_hi; };
struct Frame {
    LAS unsigned char* lds;
    int tid, lane, wave, G, bid;
    const Args* ap;
    float* out; unsigned char* ws;
};
#define WSP(T, off) ((T*)(F.ws + (off)))

__device__ __forceinline__ void tr_item(const float* __restrict__ src, int ld, int k0, int c0, int nvalid, bf16_t* dst, int ldd, LAS float* scr, int lane) {
    const int c4 = (lane & 7) * 4, rr = lane >> 3;
    if (nvalid == 32 && ((c0 | ld) & 3) == 0) {
        f32x4 v[8];
#pragma unroll
        for (int i = 0; i < 8; ++i) v[i] = *(const f32x4*)(src + (size_t)(k0 + 8 * i + rr) * ld + c0 + c4);
#pragma unroll
        for (int i = 0; i < 8; ++i) { LAS float* p = scr + (8 * i + rr) * 33 + c4; p[0] = v[i].x; p[1] = v[i].y; p[2] = v[i].z; p[3] = v[i].w; }
    } else {
#pragma unroll 8
        for (int i = 0; i < 32; ++i) { const int kk = 2 * i + (lane >> 5), cc = lane & 31;
            scr[kk * 33 + cc] = (cc < nvalid) ? src[(size_t)(k0 + kk) * ld + c0 + cc] : 0.f; }
    }
    asm volatile("s_waitcnt lgkmcnt(0)" ::: "memory");
    const int c = lane & 7;
#pragma unroll
    for (int j = 0; j < 4; ++j) { const int n = (lane >> 3) + 8 * j; const LAS float* s = scr + (8 * c) * 33 + n;
        u32x4 o; o.x = cvt_pk_bf16(s[0 * 33], s[1 * 33]); o.y = cvt_pk_bf16(s[2 * 33], s[3 * 33]); o.z = cvt_pk_bf16(s[4 * 33], s[5 * 33]); o.w = cvt_pk_bf16(s[6 * 33], s[7 * 33]);
        *(u32x4*)(dst + (size_t)n * ldd + k0 + 8 * c) = o; }
    asm volatile("s_waitcnt lgkmcnt(0)" ::: "memory");
}
constexpr float W8_SCALE = 32.f;
__device__ __forceinline__ void tr_item8(const float* __restrict__ src, int ld, int k0, int c0, int nvalid, unsigned char* dst, int ldd, LAS float* scr, int lane) {
    const int c4 = (lane & 7) * 4, rr = lane >> 3;
    if (nvalid == 32 && ((c0 | ld) & 3) == 0) {
        f32x4 v[8];
#pragma unroll
        for (int i = 0; i < 8; ++i) v[i] = *(const f32x4*)(src + (size_t)(k0 + 8 * i + rr) * ld + c0 + c4);
#pragma unroll
        for (int i = 0; i < 8; ++i) { LAS float* p = scr + (8 * i + rr) * 33 + c4; p[0] = v[i].x; p[1] = v[i].y; p[2] = v[i].z; p[3] = v[i].w; }
    } else {
#pragma unroll 8
        for (int i = 0; i < 32; ++i) { const int kk = 2 * i + (lane >> 5), cc = lane & 31;
            scr[kk * 33 + cc] = (cc < nvalid) ? src[(size_t)(k0 + kk) * ld + c0 + cc] : 0.f; }
    }
    asm volatile("s_waitcnt lgkmcnt(0)" ::: "memory");
    const int c = lane & 7;
#pragma unroll
    for (int j = 0; j < 4; ++j) { const int n = (lane >> 3) + 8 * j; const LAS float* s = scr + (8 * c) * 33 + n;
        u32x2 o; o.x = pk4_fp8(s[0 * 33] * W8_SCALE, s[1 * 33] * W8_SCALE, s[2 * 33] * W8_SCALE, s[3 * 33] * W8_SCALE); o.y = pk4_fp8(s[4 * 33] * W8_SCALE, s[5 * 33] * W8_SCALE, s[6 * 33] * W8_SCALE, s[7 * 33] * W8_SCALE);
        *(u32x2*)(dst + (size_t)n * ldd + k0 + 8 * c) = o; }
    asm volatile("s_waitcnt lgkmcnt(0)" ::: "memory");
}
__device__ __forceinline__ void p0_phase(Frame& F) {
    LAS float* cond = (LAS float*)(F.lds + 8 * 8448);
    LAS float* part = (LAS float*)(F.lds + 8 * 8448 + 32768);
    for (int i = F.tid; i < BATCH * DM; i += NTHREADS) { const float v = ((const float*)F.ap->in[1])[i]; cond[i] = v * __builtin_amdgcn_rcpf(1.f + __expf(-v)); }
    __syncthreads();
#pragma unroll 1
    for (int item = F.bid; item < 384; item += F.G) {
        const int col = item * 16 + (F.lane & 15), kq = F.lane >> 4, kb = 128 * F.wave + kq;
        const float* wp = ((const float*)F.ap->in[2]) + (size_t)kb * 6144 + col;
        float wv[32];
#pragma unroll
        for (int i = 0; i < 32; ++i) wv[i] = wp[(size_t)(4 * i) * 6144];
        float acc[8];
#pragma unroll
        for (int b = 0; b < 8; ++b) acc[b] = 0.f;
#pragma unroll
        for (int i = 0; i < 32; ++i) {
#pragma unroll
            for (int b = 0; b < 8; ++b) acc[b] += cond[b * DM + kb + 4 * i] * wv[i]; }
#pragma unroll
        for (int b = 0; b < 8; ++b) { float v = acc[b]; v += __shfl_xor(v, 16); v += __shfl_xor(v, 32); acc[b] = v; }
        if (kq == 0) {
#pragma unroll
            for (int b = 0; b < 8; ++b) part[(F.wave * 8 + b) * 16 + (F.lane & 15)] = acc[b]; }
        __syncthreads();
        if (F.tid < 128) { const int b = F.tid >> 4, c = F.tid & 15; float s = ((const float*)F.ap->in[3])[item * 16 + c];
#pragma unroll
            for (int w = 0; w < 8; ++w) s += part[(w * 8 + b) * 16 + c];
            WSP(float, WS_MOD)[b * 6144 + item * 16 + c] = s; }
        __syncthreads();
    }
    LAS float* scr = (LAS float*)(F.lds + F.wave * 8448);
    const int gw = F.bid * NWAVES + F.wave, NGW = F.G * NWAVES;
    constexpr int I_WIN = 16 * 128, I_WP = 8 * 32, I_WO = 16 * 32, I_W13 = 32 * 256, I_W2 = 32 * 128;
    constexpr int NITEMS = I_WIN + 2 * I_WP + I_WO + I_W13 + I_W2;
    for (int it = gw; it < NITEMS; it += NGW) {
        int r = it;
        if (r < I_WIN) { const int kb = r / 128, nb = r % 128, n0 = 32 * nb; int c0, nv;
            if (n0 < C_LX) { c0 = n0; nv = 32; } else if (n0 < C_WI) { c0 = n0 + 4; nv = 32; } else if (n0 == C_WI) { c0 = 960; nv = 4; } else if (n0 < C_GA) { c0 = 0; nv = 0; } else { c0 = n0 - 60; nv = 32; }
            if (n0 < C_GA) tr_item(((const float*)F.ap->in[5]), 4036, 64 * kb, c0, nv, WSP(bf16_t, WS_WIN) + (size_t)n0 * 1024, 1024, scr, F.lane);
            else tr_item8(((const float*)F.ap->in[5]), 4036, 64 * kb, c0, nv, WSP(unsigned char, WS_WIN8) + (size_t)(n0 - C_GA) * 1024, 1024, scr, F.lane);
            continue; } r -= I_WIN;
        if (r < I_WP) { const int kb = r / 32, nb = r % 32; tr_item(((const float*)F.ap->in[15]), 1024, 64 * kb, 32 * nb, 32, WSP(bf16_t, WS_WPA) + (size_t)(32 * nb) * 512, 512, scr, F.lane); continue; } r -= I_WP;
        if (r < I_WP) { const int kb = r / 32, nb = r % 32; tr_item(((const float*)F.ap->in[16]), 1024, 64 * kb, 32 * nb, 32, WSP(bf16_t, WS_WPB) + (size_t)(32 * nb) * 512, 512, scr, F.lane); continue; } r -= I_WP;
        if (r < I_WO) { const int kb = r / 32, nb = r % 32; tr_item(((const float*)F.ap->in[17]), 1024, 64 * kb, 32 * nb, 32, WSP(bf16_t, WS_WOUT) + (size_t)(32 * nb) * 1024, 1024, scr, F.lane); continue; } r -= I_WO;
        if (r < I_W13) { const int e = r / 256, r2 = r % 256, kb = r2 / 16, nb = r2 % 16, n0 = 32 * nb, j = n0 >> 8, half = (n0 >> 7) & 1, cc0 = n0 & 127;
            const float* src = (half ? ((const float*)F.ap->in[24]) : ((const float*)F.ap->in[23])) + (size_t)e * 1024 * 256;
            tr_item8(src, 256, 64 * kb, 128 * j + cc0, 32, WSP(unsigned char, WS_W13) + ((size_t)e * 512 + n0) * 1024, 1024, scr, F.lane); continue; } r -= I_W13;
        { const int e = r / 128, r2 = r % 128, kb = r2 / 32, nb = r2 % 32;
            tr_item(((const float*)F.ap->in[25]) + (size_t)e * 256 * 1024, 1024, 64 * kb, 32 * nb, 32, WSP(bf16_t, WS_W2) + ((size_t)e * 1024 + 32 * nb) * 256, 256, scr, F.lane); }
    }
    for (int i = F.bid * NTHREADS + F.tid; i < 48 * 1024; i += F.G * NTHREADS) { const int r = i >> 10, k = i & 1023;
        const float v = r < 4 ? ((const float*)F.ap->in[19])[k * 4 + r] : r < 36 ? ((const float*)F.ap->in[21])[k * 32 + (r - 4)] : 0.f;
        const unsigned hi = f2bf(v); const float rem = v - bf2f((unsigned short)hi);
        WSP(bf16_t, WS_WRH)[i] = (bf16_t)hi; WSP(bf16_t, WS_WRL)[i] = (bf16_t)f2bf(rem); }
}

__device__ __forceinline__ void p1a_phase(Frame& F) {
    const int gw = F.bid * NWAVES + F.wave, NGW = F.G * NWAVES;
    const float* mod = WSP(float, WS_MOD);
    bf16_t* H = WSP(bf16_t, WS_H);
    const float* nmw = (const float*)F.ap->in[4];
#pragma unroll 1
    for (int row0 = 4 * gw; row0 < NTOK; row0 += 4 * NGW) {
        const int b = row0 / SEQ;
        f32x4 v[4][4];
#pragma unroll
        for (int r = 0; r < 4; ++r) { const f32x4* xr = (const f32x4*)(((const float*)F.ap->in[0]) + (size_t)(row0 + r) * DM) + F.lane;
#pragma unroll
            for (int j = 0; j < 4; ++j) v[r][j] = xr[64 * j]; }
        f32x4 gg[4], sh[4];
#pragma unroll
        for (int j = 0; j < 4; ++j) { const int col = 4 * F.lane + 256 * j; gg[j] = *(const f32x4*)(nmw + col) * (*(const f32x4*)(mod + b * 6144 + 1024 + col) + 1.f); sh[j] = *(const f32x4*)(mod + b * 6144 + col); }
#pragma unroll
        for (int r = 0; r < 4; ++r) { float s = 0.f;
#pragma unroll
            for (int j = 0; j < 4; ++j) s += (v[r][j].x * v[r][j].x + v[r][j].y * v[r][j].y) + (v[r][j].z * v[r][j].z + v[r][j].w * v[r][j].w);
            const float rinv = rsqrtf(wave_sum(s) * (1.f / DM) + EPS);
            unsigned long long* o8 = (unsigned long long*)(H + (size_t)(row0 + r) * DM) + F.lane;
            unsigned* o4 = (unsigned*)(F.ws + WS_H8 + (size_t)(row0 + r) * DM) + F.lane;
#pragma unroll
            for (int j = 0; j < 4; ++j) { const f32x4 hv = v[r][j] * rinv * gg[j] + sh[j];
                o8[64 * j] = (unsigned long long)cvt_pk_bf16(hv.x, hv.y) | ((unsigned long long)cvt_pk_bf16(hv.z, hv.w) << 32); o4[64 * j] = pk4_fp8(hv.x, hv.y, hv.z, hv.w); } }
    }
}

struct Unit { const bf16_t* A; const bf16_t* B; int pm, pn, aux, flags; const int* gidx; };
template <bool PERM, class Sched, class Epi>
__device__ __forceinline__ void gemm_naive(int lda, int ldb, int K, const Sched& S, const Epi& E) {
    const int tid = threadIdx.x, wid = __builtin_amdgcn_readfirstlane(tid >> 6), lane = tid & 63, wr = wid >> 2, wc = wid & 3, fr = lane & 15, fq = lane >> 4;
    f32x4 acc[2][2][4][2];
    Unit u;
    for (int i = 0; S.next(i, u); ++i) {
        if (!(u.flags & 1)) {
#pragma unroll
            for (int a = 0; a < 2; ++a)
#pragma unroll
                for (int b = 0; b < 2; ++b)
#pragma unroll
                    for (int m = 0; m < 4; ++m)
#pragma unroll
                        for (int n = 0; n < 2; ++n) acc[a][b][m][n] = (f32x4){0.f, 0.f, 0.f, 0.f};
        }
#pragma unroll 1
        for (int k0 = 0; k0 < K; k0 += 32) {
            bf16x8 bfr[2][2];
#pragma unroll
            for (int bj = 0; bj < 2; ++bj)
#pragma unroll
                for (int n = 0; n < 2; ++n) { const int rho = 16 * n + fr, rr = PERM ? perm32(rho) : rho;
                    bfr[bj][n] = *(const bf16x8*)(u.B + (size_t)(128 * bj + 32 * wc + rr) * ldb + k0 + 8 * fq); }
#pragma unroll
            for (int ai = 0; ai < 2; ++ai) {
                bf16x8 af[4];
#pragma unroll
                for (int m = 0; m < 4; ++m) af[m] = *(const bf16x8*)(u.A + (size_t)(128 * ai + 64 * wr + 16 * m + fr) * lda + k0 + 8 * fq);
#pragma unroll
                for (int bj = 0; bj < 2; ++bj)
#pragma unroll
                    for (int m = 0; m < 4; ++m)
#pragma unroll
                        for (int n = 0; n < 2; ++n) acc[ai][bj][m][n] = __builtin_amdgcn_mfma_f32_16x16x32_bf16(bfr[bj][n], af[m], acc[ai][bj][m][n], 0, 0, 0);
            }
        }
        if (!(u.flags & 2)) E(acc, u, wr, wc, fr, fq);
    }
}


namespace pg8 {
constexpr int BK = 64, HALF = 128, HTB = HALF * BK * 2;
__device__ __forceinline__ int lds_byte(int r, int c) { const int st = (r >> 4) * 2 + (c >> 5), rr = r & 15, cc = c & 31, ob = rr * 64 + cc * 2; return st * 1024 + (ob ^ (((ob >> 9) & 1) << 5)); }
__device__ __forceinline__ void stage_rc(int b, int& R, int& C) { const int st = b / 1024, sb = b % 1024, swz = sb ^ (((sb >> 9) & 1) << 5); R = (st >> 1) * 16 + swz / 64; C = (st & 1) * 32 + (swz % 64) / 2; }
template <class Epi, class Sched, bool ALIGN_EPI, bool GATHER = false, bool FP8 = false>
__device__ __forceinline__ void gemm_phase(LAS unsigned char* lds, int lda, int ldb, int K, const Sched& S, const Epi& E) {
    int tid_ = threadIdx.x; asm volatile("" : "+v"(tid_));
    const int tid = tid_, wid = __builtin_amdgcn_readfirstlane(tid >> 6), lane = tid & 63, wr = wid >> 2, wc = wid & 3, fr = lane & 15, fq = lane >> 4;
    const int nt = K / BK;
    unsigned voffA[2], voffB[2];
#pragma unroll
    for (int i = 0; i < 2; ++i) { int R, C; stage_rc(tid * 16 + i * 8192, R, C); const int Rb = Epi::PERM ? ((R & ~31) + perm32(R & 31)) : R;
        voffA[i] = (unsigned)(R * lda + C) * 2u; voffB[i] = (unsigned)(Rb * ldb + C) * 2u; }
    const size_t kstep = (size_t)(BK * 2);
    const size_t hstepA = GATHER ? 0 : (size_t)HALF * lda * 2, hstepB = (size_t)HALF * ldb * 2;
    unsigned gC[2], gN[2], gcol[2];
#pragma unroll
    for (int i_ = 0; i_ < 2; ++i_) { int R_, C_; stage_rc(tid * 16 + i_ * 8192, R_, C_); gcol[i_] = (unsigned)C_ * 2u; }
#define PG8_GOFF(dst, u) do { _Pragma("unroll") for (int h_ = 0; h_ < 2; ++h_) { unsigned pk_ = 0u; _Pragma("unroll") for (int i_ = 0; i_ < 2; ++i_) { int R_, C_; stage_rc(tid * 16 + i_ * 8192, R_, C_); \
        const int row_ = h_ * HALF + R_; const unsigned tok_ = (unsigned)(u).gidx[4 * (row_ < (u).aux ? row_ : 0)]; pk_ |= tok_ << (16 * i_); } dst[h_] = pk_; } } while (0)
    const unsigned ldsw = (unsigned)wid * 1024u;
    const int aoff = FP8 ? lds_byte(wr * 64 + fr, fq * 16) : lds_byte(wr * 64 + fr, fq * 8), boff = FP8 ? lds_byte(wc * 32 + fr, fq * 16) : lds_byte(wc * 32 + fr, fq * 8);
#define PG8_SA(b, h) (((b) * 2 + (h)) * HTB)
#define PG8_SB(b, h) ((4 + (b) * 2 + (h)) * HTB)
#define PG8_STAGE(bufoff, gbase, voff) do { _Pragma("unroll") for (int _i = 0; _i < 2; ++_i) \
        __builtin_amdgcn_global_load_lds((const unsigned*)((const char*)(gbase) + (voff)[_i]), (LAS unsigned*)(lds + (bufoff) + ldsw + _i * 8192), 16, 0, 0); } while (0)
#define PG8_STAGE_A(b, h, gbase, nx) do { if constexpr (GATHER) { const unsigned pk_ = (nx) ? gN[h] : gC[h]; unsigned vo_[2]; vo_[0] = (pk_ & 0xffffu) * (unsigned)(lda * 2) + gcol[0]; vo_[1] = (pk_ >> 16) * (unsigned)(lda * 2) + gcol[1]; PG8_STAGE(PG8_SA(b, h), gbase, vo_); } \
        else PG8_STAGE(PG8_SA(b, h), (gbase) + (h) * hstepA, voffA); } while (0)
#define PG8_LDA8(dst, b, h) do { _Pragma("unroll") for (int m = 0; m < 4; ++m) { const LAS u32x4* p_ = (const LAS u32x4*)(lds + PG8_SA(b, h) + aoff + m * 2048); const u32x4 x_ = p_[0], y_ = p_[1]; \
        dst[m] = __builtin_bit_cast(v8i32, __builtin_shufflevector(x_, y_, 0, 1, 2, 3, 4, 5, 6, 7)); } } while (0)
#define PG8_LDB8(dst, b, h) do { _Pragma("unroll") for (int n = 0; n < 2; ++n) { const LAS u32x4* p_ = (const LAS u32x4*)(lds + PG8_SB(b, h) + boff + n * 2048); const u32x4 x_ = p_[0], y_ = p_[1]; \
        dst[n] = __builtin_bit_cast(v8i32, __builtin_shufflevector(x_, y_, 0, 1, 2, 3, 4, 5, 6, 7)); } } while (0)
#define PG8_MMA8(ai, bj, At, Bt) do { __builtin_amdgcn_s_setprio(1); _Pragma("unroll") for (int m = 0; m < 4; ++m) _Pragma("unroll") for (int n = 0; n < 2; ++n) \
        asm volatile("v_mfma_scale_f32_16x16x128_f8f6f4 %0, %1, %2, %0, %3, %4 op_sel_hi:[0,0,0]" : "+v"(acc[ai][bj][m][n]) : "v"(Bt[n]), "v"(At[m]), "v"(sclW), "v"(sclA));   \
        __builtin_amdgcn_s_setprio(0); } while (0)
#define PG8_LDA(dst, b, h) do { _Pragma("unroll") for (int m = 0; m < 4; ++m) _Pragma("unroll") for (int k = 0; k < 2; ++k) dst[m][k] = *(const LAS bf16x8*)(lds + PG8_SA(b, h) + aoff + m * 2048 + k * 1024); } while (0)
#define PG8_LDB(dst, b, h) do { _Pragma("unroll") for (int n = 0; n < 2; ++n) _Pragma("unroll") for (int k = 0; k < 2; ++k) dst[n][k] = *(const LAS bf16x8*)(lds + PG8_SB(b, h) + boff + n * 2048 + k * 1024); } while (0)
#define PG8_MMA(ai, bj, At, Bt) do { __builtin_amdgcn_s_setprio(1); _Pragma("unroll") for (int m = 0; m < 4; ++m) _Pragma("unroll") for (int n = 0; n < 2; ++n) _Pragma("unroll") for (int k = 0; k < 2; ++k) \
        acc[ai][bj][m][n] = __builtin_amdgcn_mfma_f32_16x16x32_bf16(Bt[n][k], At[m][k], acc[ai][bj][m][n], 0, 0, 0); __builtin_amdgcn_s_setprio(0); } while (0)
#define PG8_WAIT_V(n) asm volatile("s_waitcnt vmcnt(" #n ")" ::: "memory")
#define PG8_WAIT_L(n) asm volatile("s_waitcnt lgkmcnt(" #n ")" ::: "memory")
#define PG8_BAR __builtin_amdgcn_s_barrier()
#define PG8_SCHED __builtin_amdgcn_sched_barrier(0)
#define PG8_ZERO() do { _Pragma("unroll") for (int a = 0; a < 2; ++a) _Pragma("unroll") for (int b = 0; b < 2; ++b) _Pragma("unroll") for (int m = 0; m < 4; ++m) _Pragma("unroll") for (int n = 0; n < 2; ++n) acc[a][b][m][n] = (f32x4){0.f, 0.f, 0.f, 0.f}; } while (0)
    Unit cur, nxt; int ui = 0;
    if (!S.next(0, cur)) return;
    f32x4 acc[2][2][4][2];
    PG8_ZERO();
    bf16x8 At[4][2], B0[2][2], B1[2][2]; v8i32 At8[4], B08[2], B18[2];
    int sclW = 0x7a7a7a7a, sclA = 0x7f7f7f7f; asm volatile("" : "+v"(sclW), "+v"(sclA));
#define PG8_XLDA(b, h) do { if constexpr (FP8) PG8_LDA8(At8, b, h); else PG8_LDA(At, b, h); } while (0)
#define PG8_XLDB0(b, h) do { if constexpr (FP8) PG8_LDB8(B08, b, h); else PG8_LDB(B0, b, h); } while (0)
#define PG8_XLDB1(b, h) do { if constexpr (FP8) PG8_LDB8(B18, b, h); else PG8_LDB(B1, b, h); } while (0)
#define PG8_XMMA0(ai, bj) do { if constexpr (FP8) PG8_MMA8(ai, bj, At8, B08); else PG8_MMA(ai, bj, At, B0); } while (0)
#define PG8_XMMA1(ai, bj) do { if constexpr (FP8) PG8_MMA8(ai, bj, At8, B18); else PG8_MMA(ai, bj, At, B1); } while (0)
    const char* cA = (const char*)cur.A; const char* cB = (const char*)cur.B;
    if constexpr (GATHER) { PG8_GOFF(gC, cur); gN[0] = gC[0]; gN[1] = gC[1]; }
    PG8_STAGE(PG8_SB(0, 0), cB, voffB); PG8_STAGE(PG8_SB(0, 1), cB + hstepB, voffB); PG8_STAGE_A(0, 0, cA, false); PG8_STAGE_A(0, 1, cA, false);
    if (wr == 1) PG8_BAR;
    PG8_WAIT_V(2); PG8_BAR;
    PG8_STAGE(PG8_SB(1, 0), cB + kstep, voffB); PG8_STAGE_A(1, 0, cA + kstep, false); PG8_STAGE(PG8_SB(1, 1), cB + hstepB + kstep, voffB);
    PG8_WAIT_V(6); PG8_BAR;
    for (;;) {
        const bool has_next = S.next(ui + 1, nxt);
        const char* nA = has_next ? (const char*)nxt.A : cA; const char* nB = has_next ? (const char*)nxt.B : cB;
        if constexpr (GATHER) { if (has_next) PG8_GOFF(gN, nxt); }
#pragma unroll 1
        for (int t = 0; t < nt; t += 2) {
            const bool last = (t == nt - 2);
            const char* a1 = cA + (size_t)(t + 1) * kstep;
            const char* a2 = last ? nA : cA + (size_t)(t + 2) * kstep; const char* b2 = last ? nB : cB + (size_t)(t + 2) * kstep;
            const char* a3 = a2 + kstep; const char* b3 = b2 + kstep;
            const bool nx = last && has_next;
            PG8_XLDB0(0, 0); PG8_XLDB1(0, 1); PG8_SCHED; PG8_XLDA(0, 0); PG8_STAGE_A(1, 1, a1, false);
            PG8_WAIT_V(8); PG8_WAIT_L(0); PG8_BAR; PG8_XMMA0(0, 0); PG8_XMMA1(0, 1); PG8_BAR; PG8_SCHED;
            PG8_XLDA(0, 1); PG8_STAGE(PG8_SB(0, 0), b2, voffB); PG8_STAGE(PG8_SB(0, 1), b2 + hstepB, voffB); PG8_STAGE_A(0, 0, a2, nx);
            PG8_WAIT_V(8); PG8_WAIT_L(0); PG8_BAR; PG8_XMMA0(1, 0); PG8_XMMA1(1, 1); PG8_BAR; PG8_SCHED;
            PG8_XLDB0(1, 0); PG8_XLDB1(1, 1); PG8_SCHED; PG8_XLDA(1, 0); PG8_STAGE_A(0, 1, a2, nx);
            PG8_WAIT_V(8); PG8_WAIT_L(0); PG8_BAR; PG8_XMMA0(0, 0); PG8_XMMA1(0, 1); PG8_BAR; PG8_SCHED;
            PG8_XLDA(1, 1); PG8_STAGE(PG8_SB(1, 0), b3, voffB); PG8_STAGE(PG8_SB(1, 1), b3 + hstepB, voffB); PG8_STAGE_A(1, 0, a3, nx);
            PG8_WAIT_V(8); PG8_WAIT_L(0); PG8_BAR; PG8_XMMA0(1, 0); PG8_XMMA1(1, 1); PG8_BAR; PG8_SCHED;
        }
        if constexpr (ALIGN_EPI) { if (wr == 0) PG8_BAR; }
        if constexpr (FP8) asm volatile("s_nop 15\n\ts_nop 7" ::: "memory");
        if (!(cur.flags & 2)) E(acc, cur, wr, wc, fr, fq);
        if (!has_next) break;
        if (!(nxt.flags & 1)) PG8_ZERO();
        cur = nxt; cA = nA; cB = nB; ++ui;
        if constexpr (GATHER) { gC[0] = gN[0]; gC[1] = gN[1]; }
        if constexpr (ALIGN_EPI) { if (wr == 1) PG8_BAR; }
    }
    PG8_WAIT_V(0);
    if constexpr (!ALIGN_EPI) { if (wr == 0) PG8_BAR; }
    PG8_BAR;
#undef PG8_SA
#undef PG8_SB
#undef PG8_STAGE
#undef PG8_XLDA
#undef PG8_XLDB0
#undef PG8_XLDB1
#undef PG8_XMMA0
#undef PG8_XMMA1
#undef PG8_LDA8
#undef PG8_LDB8
#undef PG8_MMA8
#undef PG8_STAGE_A
#undef PG8_GOFF
#undef PG8_LDA
#undef PG8_LDB
#undef PG8_MMA
#undef PG8_WAIT_V
#undef PG8_WAIT_L
#undef PG8_BAR
#undef PG8_SCHED
#undef PG8_ZERO
}
}
#ifndef MK_NAIVE_GEMM
#define MK_NAIVE_GEMM 0
#endif
template <bool GATHER = false, bool FP8 = false, class Sched, class Epi>
__device__ __forceinline__ void run_gemm(LAS unsigned char* lds, int lda, int ldb, int K, const Sched& S, const Epi& E) {
    pg8::gemm_phase<Epi, Sched, true, GATHER, FP8>(lds, lda, ldb, K, S, E);
}

struct SchedProj { const bf16_t* A; const bf16_t* B; int rowu  , pn0  , G, c;
    __device__ __forceinline__ bool next(int i, Unit& u) const { const int L = i * G + c; if (L >= 64 * 8) return false;
        const int gid = L / 64, w = L % 64; u.pm = gid * 8 + (w % 8); u.pn = pn0 + w / 8;
        u.A = A + (size_t)u.pm * 256 * rowu; u.B = B + (size_t)(w / 8) * 256 * rowu; u.aux = 0; u.flags = 0; u.gidx = nullptr; return true; } };
struct EpiProj {
    static constexpr bool PERM = true;
    unsigned char* ws;
    __device__ __forceinline__ void operator()(const f32x4 (&acc)[2][2][4][2], const Unit& u, int wr, int wc, int fr, int fq) const {
#pragma unroll
        for (int bj = 0; bj < 2; ++bj) {
            const int cg = u.pn * 256 + bj * 128 + wc * 32;
            const int col = cg + 8 * fq;
            bf16_t* dst; int ld, cb; int mode = 0;
            bf16_t* const Vt = (bf16_t*)(ws + WS_VT); float* const WI = (float*)(ws + WS_WI);
            if (cg < C_K) { dst = (bf16_t*)(ws + WS_Q); ld = 512; cb = C_Q; }
            else if (cg < C_V) { dst = (bf16_t*)(ws + WS_K); ld = 64; cb = C_K; }
            else if (cg < C_QI) { dst = (bf16_t*)(ws + WS_VR); ld = 64; cb = C_V; mode = 2; }
            else if (cg < C_KI) { dst = (bf16_t*)(ws + WS_QI); ld = 256; cb = C_QI; }
            else if (cg < C_LX) { dst = (bf16_t*)(ws + WS_KI); ld = 64; cb = C_KI; }
            else if (cg < C_LG) { dst = (bf16_t*)(ws + WS_LX); ld = 512; cb = C_LX; }
            else if (cg < C_WI) { dst = (bf16_t*)(ws + WS_LG); ld = 512; cb = C_LG; }
            else if (cg < C_PAD + 28) { dst = nullptr; ld = 0; cb = C_WI; mode = 3; }
            else if (cg < C_GA) continue;
            else if (cg < C_GB) { dst = (bf16_t*)(ws + WS_GA); ld = 1024; cb = C_GA; mode = 1; }
            else { dst = (bf16_t*)(ws + WS_GB); ld = 1024; cb = C_GB; mode = 1; }
#pragma unroll
            for (int ai = 0; ai < 2; ++ai)
#pragma unroll
                for (int m = 0; m < 4; ++m) {
                    const int row = u.pm * 256 + ai * 128 + wr * 64 + m * 16 + fr;
                    f32x4 v0 = acc[ai][bj][m][0], v1 = acc[ai][bj][m][1];
                    if (mode == 3) { if (fq == 0) *(f32x4*)(WI + (size_t)row * 4) = v0; continue; }
                    if (mode == 1) {
#pragma unroll
                        for (int e = 0; e < 4; ++e) { v0[e] = sigmoidf_(v0[e]); v1[e] = sigmoidf_(v1[e]); } }
                    u32x4 w; w.x = pk2(v0[0], v0[1]); w.y = pk2(v0[2], v0[3]); w.z = pk2(v1[0], v1[1]); w.w = pk2(v1[2], v1[3]);
                    if (mode != 2) *(u32x4*)(dst + (size_t)row * ld + (col - cb)) = w;
                    if (mode == 2) {
                        const int b = row / SEQ, t = row % SEQ, d0 = col - cb; bf16_t* vp = Vt + ((size_t)b * 64 + d0) * SEQ + (t & ~15) + vt_pos(t & 15);
                        vp[0 * SEQ] = (bf16_t)(w.x & 0xffff); vp[1 * SEQ] = (bf16_t)(w.x >> 16); vp[2 * SEQ] = (bf16_t)(w.y & 0xffff); vp[3 * SEQ] = (bf16_t)(w.y >> 16);
                        vp[4 * SEQ] = (bf16_t)(w.z & 0xffff); vp[5 * SEQ] = (bf16_t)(w.z >> 16); vp[6 * SEQ] = (bf16_t)(w.w & 0xffff); vp[7 * SEQ] = (bf16_t)(w.w >> 16); }
                }
        }
    }
};

__device__ __forceinline__ unsigned fbits(float f) { return __builtin_bit_cast(unsigned, f); }
__device__ __forceinline__ float bitsf(unsigned u) { return __builtin_bit_cast(float, u); }
__device__ __forceinline__ unsigned bfi_b32(unsigned m, unsigned a, unsigned b) { return __builtin_amdgcn_bitop3_b32(a, b, m, 0xe4); }
__device__ __forceinline__ float xor32_max(float x) { typedef unsigned u32x2_ __attribute__((ext_vector_type(2))); const unsigned u = __builtin_bit_cast(unsigned, x);
    const u32x2_ r = __builtin_amdgcn_permlane32_swap(u, u, false, false); return fmaxf(__builtin_bit_cast(float, r.x), __builtin_bit_cast(float, r.y)); }
__device__ __forceinline__ float sum8_dpp(float s) {
    s += __builtin_bit_cast(float, __builtin_amdgcn_update_dpp(0, __builtin_bit_cast(int, s), 0xB1, 0xf, 0xf, true));
    s += __builtin_bit_cast(float, __builtin_amdgcn_update_dpp(0, __builtin_bit_cast(int, s), 0x4E, 0xf, 0xf, true));
    s += __builtin_bit_cast(float, __builtin_amdgcn_update_dpp(0, __builtin_bit_cast(int, s), 0x141, 0xf, 0xf, true));
    return s; }
__device__ __forceinline__ unsigned sortkey(float f) { const unsigned u = __builtin_bit_cast(unsigned, f); return (u & 0x80000000u) ? ~u : (u | 0x80000000u); }
typedef float f32x16 __attribute__((ext_vector_type(16)));
constexpr int AL_QI = 0, AL_HIST = 16896, AL_MASK = 49792, AL_EQ = 57984, AL_RK = 66176, AL_QST = 74368, AL_FLAG = 74368 + 512, AL_OST = 75008, AL_KV = AL_HIST  , KT_STRIDE = 144, VT_STRIDE = 80, KT_BYTES = 32 * KT_STRIDE, KV_BUF = KT_BYTES + 64 * VT_STRIDE, AL_END = AL_OST + 8 * 4608;
static_assert(2 * KV_BUF <= 32 * 257 * 4, "K/V ring fits the histogram region");
constexpr int QI_STRIDE = 528, HIST_STRIDE = 257, OST_STRIDE = 144;
static_assert(AL_END <= RING_BYTES, "attention LDS map");
__device__ __forceinline__ int crow(int i, int hi) { return (i & 3) + 8 * (i >> 2) + 4 * hi; }
__device__ __forceinline__ void attn_unit(Frame& F, int b, int c, int half) {
    int tid_ = F.tid, w_ = F.wave; asm volatile("" : "+v"(tid_), "+s"(w_));
    const int tid = tid_, lane = tid & 63, w = w_, r32 = lane & 31, hi = lane >> 5;
    const int t0 = 64 * c + 32 * half, nk = 64 * (c + 1), ntile = nk >> 5, tok0 = b * SEQ + t0;
    LAS unsigned char* L = F.lds;
    LAS unsigned* hist = (LAS unsigned*)(L + AL_HIST); LAS unsigned* maskw = (LAS unsigned*)(L + AL_MASK); LAS unsigned* eqw = (LAS unsigned*)(L + AL_EQ);
    LAS float* rkL = (LAS float*)(L + AL_RK); LAS unsigned* qst = (LAS unsigned*)(L + AL_QST); LAS unsigned* flagw = (LAS unsigned*)(L + AL_FLAG);
    const bf16_t* KI = WSP(bf16_t, WS_KI) + (size_t)b * SEQ * 64;
    const bf16_t* Kb = WSP(bf16_t, WS_K) + (size_t)b * SEQ * 64;
    const bf16_t* Vt = WSP(bf16_t, WS_VT) + (size_t)b * 64 * SEQ;
    const bool do_sel = nk > TOPK;
    __syncthreads();
#if MK_LEAK >= 0
    const unsigned long long tu0_ = __builtin_amdgcn_s_memrealtime();
#endif
    { const bf16_t* QI = WSP(bf16_t, WS_QI) + (size_t)tok0 * 256;
#pragma unroll
      for (int i = 0; i < 2; ++i) { const int idx = tid + 512 * i, row = idx >> 5, ch = idx & 31;
          *(LAS u32x4*)(L + AL_QI + row * QI_STRIDE + ch * 16) = *(const u32x4*)(QI + (size_t)row * 256 + ch * 8); } }
    if (tid == 0) flagw[0] = 0u;
    if (tid < 32) { qst[tid * 4 + 0] = 0u; qst[tid * 4 + 1] = (unsigned)TOPK; qst[tid * 4 + 2] = 0u; qst[tid * 4 + 3] = 0u; }
    __syncthreads();
    f32x16 sc[8];
    if (do_sel) {
        const f32x4 wv = *(const f32x4*)(WSP(float, WS_WI) + (size_t)(tok0 + r32) * 4) * 0.0625f;
        bf16x8 afn[4];
        { int roff = (32 * w + r32) * 64 + 8 * hi; asm volatile("" : "+v"(roff));
#pragma unroll
          for (int ks = 0; ks < 4; ++ks) afn[ks] = *(const bf16x8*)(KI + roff + 16 * ks); }
#pragma unroll
        for (int j = 0; j < 8; ++j) {
            const int kt = w + 8 * j;
#pragma unroll
            for (int i = 0; i < 16; ++i) sc[j][i] = 0.f;
            if (kt < ntile) {
                bf16x8 af[4];
#pragma unroll
                for (int ks = 0; ks < 4; ++ks) af[ks] = afn[ks];
                if (j < 7 && kt + 8 < ntile) { int roff = (32 * (kt + 8) + r32) * 64 + 8 * hi; asm volatile("" : "+v"(roff));
#pragma unroll
                    for (int ks = 0; ks < 4; ++ks) afn[ks] = *(const bf16x8*)(KI + roff + 16 * ks); }
                int qoff = r32 * QI_STRIDE + hi * 16; asm volatile("" : "+v"(qoff));
                bf16x8 qA[4], qB[4];
#define ATT_QLD(Q, H) do { _Pragma("unroll") for (int ks = 0; ks < 4; ++ks) Q[ks] = *(const LAS bf16x8*)(L + AL_QI + qoff + (H) * 128 + ks * 32); } while (0)
#define ATT_HEAD(Q, H) do { f32x16 acc; \
                    _Pragma("unroll") for (int i = 0; i < 16; ++i) acc[i] = 0.f; \
                    _Pragma("unroll") for (int ks = 0; ks < 4; ++ks) acc = __builtin_amdgcn_mfma_f32_32x32x16_bf16(af[ks], Q[ks], acc, 0, 0, 0); \
                    asm volatile("s_nop 15\n\ts_nop 7" : "+v"(acc));                \
                    _Pragma("unroll") for (int i = 0; i < 16; ++i) sc[j][i] += relu_f(acc[i]) * wv[H]; \
                    __builtin_amdgcn_sched_barrier(0); } while (0)
                ATT_QLD(qA, 0); ATT_QLD(qB, 1); __builtin_amdgcn_sched_barrier(0);
                ATT_HEAD(qA, 0); ATT_QLD(qA, 2); __builtin_amdgcn_sched_barrier(0);
                ATT_HEAD(qB, 1); ATT_QLD(qB, 3); __builtin_amdgcn_sched_barrier(0);
                ATT_HEAD(qA, 2);
                ATT_HEAD(qB, 3);
#undef ATT_HEAD
#undef ATT_QLD
#pragma unroll
                for (int i = 0; i < 16; ++i) sc[j][i] = __builtin_bit_cast(float, sortkey(sc[j][i]));
            }
        }
    }
    unsigned Tq = 0u; bool ordered = false;
    if (do_sel) {
        unsigned prefix = 0u;
        for (int i = tid; i < 32 * HIST_STRIDE; i += NTHREADS) hist[i] = 0u;
        __syncthreads();
#pragma unroll 1
        for (int pass = 0; pass < 4; ++pass) {
            const int shift = 24 - 8 * pass;
#pragma unroll
            for (int j = 0; j < 8; ++j) { const int kt = w + 8 * j;
                if (kt < ntile) {
#pragma unroll
                    for (int i = 0; i < 16; ++i) { const unsigned key = fbits(sc[j][i]);
                        const bool m = (pass == 0) || ((key >> (shift + 8)) == (prefix >> (shift + 8)));
                        if (m) __hip_atomic_fetch_add(hist + r32 * HIST_STRIDE + ((key >> shift) & 255u), 1u, __ATOMIC_RELAXED, __HIP_MEMORY_SCOPE_WORKGROUP); } } }
            __syncthreads();
            {
                const int q = tid >> 4, p = tid & 15, b0 = 16 * (15 - p);
                const unsigned need = qst[q * 4 + 1];
                unsigned s = 0u, hv[16];
#pragma unroll
                for (int e = 0; e < 16; ++e) { hv[e] = hist[q * HIST_STRIDE + b0 + e]; s += hv[e]; hist[q * HIST_STRIDE + b0 + e] = 0u; }
                unsigned P = s;
#pragma unroll
                for (int o = 1; o < 16; o <<= 1) { const unsigned t = __shfl_up(P, o, 16); if (p >= o) P += t; }
                const unsigned Pprev = P - s;
                if (P >= need && Pprev < need) { unsigned run = Pprev; bool done = false;
#pragma unroll
                    for (int e = 15; e >= 0; --e) { const unsigned hc = hv[e]; if (done) continue;
                        if (run + hc >= need) { done = true; qst[q * 4 + 0] = qst[q * 4 + 0] | ((unsigned)(b0 + e) << shift); qst[q * 4 + 1] = need - run; qst[q * 4 + 2] = hc; }
                        else run += hc; } }
            }
            __syncthreads();
            prefix = qst[r32 * 4 + 0];
        }
        Tq = prefix;
        const unsigned needq = qst[r32 * 4 + 1], eqc = qst[r32 * 4 + 2];
        if (needq < eqc) flagw[0] = 1u;
        __syncthreads();
        ordered = flagw[0] != 0u;
    }
#pragma unroll
    for (int j = 0; j < 8; ++j) { const int kt = w + 8 * j;
        if (kt < ntile) { unsigned mw = 0xffffffffu, ew = 0u;
            if (do_sel) { mw = 0u;
#pragma unroll
                for (int i = 0; i < 16; ++i) { const unsigned key = fbits(sc[j][i]); const int bit = crow(i, hi);
                    const bool gt = key > Tq, eq = key == Tq;
                    mw |= ((gt || (eq && !ordered)) ? 1u : 0u) << bit; ew |= (eq ? 1u : 0u) << bit; }
                mw |= __shfl_xor(mw, 32); ew |= __shfl_xor(ew, 32); }
            if (hi == 0) { maskw[kt * 32 + r32] = mw; if (ordered) eqw[kt * 32 + r32] = ew; } } }
    __syncthreads();
    if (ordered) {
        if (tid < 32) { const int need = (int)qst[tid * 4 + 1]; int taken = 0;
            for (int kt = 0; kt < ntile && taken < need; ++kt) { unsigned ww = eqw[kt * 32 + tid]; if (ww == 0u) continue;
                const int pc = __popc(ww); unsigned add = ww;
                if (taken + pc > need) { add = 0u; while (taken + __popc(add) < need) { const unsigned lsb = ww & (0u - ww); add |= lsb; ww ^= lsb; } }
                taken += __popc(add); maskw[kt * 32 + tid] |= add; } }
        __syncthreads();
    }
#if MK_LEAK >= 0
    const unsigned long long tu1_ = __builtin_amdgcn_s_memrealtime();
#endif
    {
        const int h = w; const int tq = t0 + r32;
        bf16x8 qf[4];
        { const bf16_t* Q = WSP(bf16_t, WS_Q) + (size_t)(tok0 + r32) * 512 + h * 64;
          float qv[4][8]; float ss = 0.f;
#pragma unroll
          for (int ks = 0; ks < 4; ++ks) { const bf16x8 v = *(const bf16x8*)(Q + 16 * ks + 8 * hi);
#pragma unroll
              for (int e = 0; e < 8; ++e) { qv[ks][e] = bf2f((unsigned short)v[e]); ss += qv[ks][e] * qv[ks][e]; } }
          ss += __shfl_xor(ss, 32);
          const float rq = rsqrtf(ss * (1.f / 64.f) + EPS) * 0.125f * 1.4426950408889634f;
          const float* qnw = (const float*)F.ap->in[6]; const float* knw = (const float*)F.ap->in[7];
#pragma unroll
          for (int ks = 0; ks < 4; ++ks) { u32x4 pk;
              const f32x4 a0 = *(const f32x4*)(qnw + 16 * ks + 8 * hi), a1 = *(const f32x4*)(qnw + 16 * ks + 8 * hi + 4), b0 = *(const f32x4*)(knw + 16 * ks + 8 * hi), b1 = *(const f32x4*)(knw + 16 * ks + 8 * hi + 4);
              pk.x = pk2(qv[ks][0] * rq * a0.x * b0.x, qv[ks][1] * rq * a0.y * b0.y); pk.y = pk2(qv[ks][2] * rq * a0.z * b0.z, qv[ks][3] * rq * a0.w * b0.w);
              pk.z = pk2(qv[ks][4] * rq * a1.x * b1.x, qv[ks][5] * rq * a1.y * b1.y); pk.w = pk2(qv[ks][6] * rq * a1.z * b1.z, qv[ks][7] * rq * a1.w * b1.w);
              qf[ks] = __builtin_bit_cast(bf16x8, pk); } }
        const float slope2 = exp2f(-(float)(h + 1)) * 1.4426950408889634f;
        float m = 0.f;
        f32x16 o0, o1, lacc;
#pragma unroll
        for (int i = 0; i < 16; ++i) { o0[i] = 0.f; o1[i] = 0.f; lacc[i] = 0.f; }
        const bf16x8 ones8 = {0x3f80, 0x3f80, 0x3f80, 0x3f80, 0x3f80, 0x3f80, 0x3f80, 0x3f80};
        constexpr int K2_STRIDE = 144, K2_BYTES = 64 * K2_STRIDE, KV2_BUF = 2 * K2_BYTES;
        static_assert(2 * KV2_BUF <= AL_MASK, "K/V ring below the mask words");
        const int npair = c + 1;
        const bf16_t* gK = Kb + (size_t)(tid >> 3) * 64 + (tid & 7) * 8;
        const bf16_t* gV = Vt + (size_t)(tid >> 3) * SEQ + (tid & 7) * 8;
        const int lstK = (tid >> 3) * K2_STRIDE + (tid & 7) * 16;
        LAS unsigned char* kvL = L;
#define ATT_STAGE2(BUF, GK, GV) do { u32x4 w_; \
            { float f_[8] = {bflo(GK.x), bfhi(GK.x), bflo(GK.y), bfhi(GK.y), bflo(GK.z), bfhi(GK.z), bflo(GK.w), bfhi(GK.w)}; \
                float ss_ = (f_[0] * f_[0] + f_[1] * f_[1]) + (f_[2] * f_[2] + f_[3] * f_[3]) + (f_[4] * f_[4] + f_[5] * f_[5]) + (f_[6] * f_[6] + f_[7] * f_[7]); \
                ss_ = sum8_dpp(ss_); \
                const float rk_ = __builtin_amdgcn_rsqf(ss_ * (1.f / 64.f) + EPS); \
                w_.x = cvt_pk_bf16(f_[0] * rk_, f_[1] * rk_); w_.y = cvt_pk_bf16(f_[2] * rk_, f_[3] * rk_); w_.z = cvt_pk_bf16(f_[4] * rk_, f_[5] * rk_); w_.w = cvt_pk_bf16(f_[6] * rk_, f_[7] * rk_); } \
            *(LAS u32x4*)(kvL + (BUF) * KV2_BUF + lstK) = w_; *(LAS u32x4*)(kvL + (BUF) * KV2_BUF + K2_BYTES + lstK) = GV; } while (0)
#define ATT_LOADK(KP) (*(const u32x4*)(gK + (size_t)((KP) < npair ? (KP) : npair - 1) * 4096))
#define ATT_LOADV(KP) (*(const u32x4*)(gV + (size_t)((KP) < npair ? (KP) : npair - 1) * 64))
        u32x4 cK = ATT_LOADK(0), cV = ATT_LOADV(0);
        u32x4 nK = ATT_LOADK(1), nV = ATT_LOADV(1);
        ATT_STAGE2(0, cK, cV);
        float ci[16];
#pragma unroll
        for (int i = 0; i < 16; ++i) ci[i] = slope2 * (float)crow(i, hi);
        const float sq = slope2 * (float)tq;
        __syncthreads();
#define ATT_MAX16(S) do { mx = max3f(mx, S[0], S[1]); mx = max3f(mx, S[2], S[3]); mx = max3f(mx, S[4], S[5]); mx = max3f(mx, S[6], S[7]); mx = max3f(mx, S[8], S[9]); mx = max3f(mx, S[10], S[11]); \
            mx = max3f(mx, S[12], S[13]); mx = max3f(mx, S[14], S[15]); } while (0)
#define ATT_PK(P0, P1, S) do { P0.x = cvt_pk_bf16(S[0], S[1]); P0.y = cvt_pk_bf16(S[2], S[3]); P0.z = cvt_pk_bf16(S[4], S[5]); P0.w = cvt_pk_bf16(S[6], S[7]); \
            P1.x = cvt_pk_bf16(S[8], S[9]); P1.y = cvt_pk_bf16(S[10], S[11]); P1.z = cvt_pk_bf16(S[12], S[13]); P1.w = cvt_pk_bf16(S[14], S[15]); } while (0)
#define ATT_TILE2(KP) do { const int kp_ = (KP); \
            const LAS unsigned char* kb = kvL + (kp_ & 1) * KV2_BUF; \
            const unsigned mw0 = maskw[(2 * kp_) * 32 + r32] >> (4 * hi), mw1 = maskw[(2 * kp_ + 1) * 32 + r32] >> (4 * hi); \
            bf16x8 kf0[4], kf1[4];                                                 \
            _Pragma("unroll") for (int ks = 0; ks < 4; ++ks) { kf0[ks] = *(const LAS bf16x8*)(kb + r32 * K2_STRIDE + ks * 32 + hi * 16); kf1[ks] = *(const LAS bf16x8*)(kb + (32 + r32) * K2_STRIDE + ks * 32 + hi * 16); } \
            __builtin_amdgcn_sched_barrier(0); \
            f32x16 S0, S1; \
            if (kp_ < npair - 1) { const float nmt0 = slope2 * (float)(64 * kp_) - m, nmt1 = nmt0 + slope2 * 32.f;        \
                _Pragma("unroll") for (int i = 0; i < 16; ++i) { const int ko = (i & 3) + 8 * (i >> 2); \
                    const unsigned sel0 = (unsigned)__builtin_amdgcn_sbfe((int)mw0, ko, 1), sel1 = (unsigned)__builtin_amdgcn_sbfe((int)mw1, ko, 1); \
                    S0[i] = bitsf(bfi_b32(sel0, fbits(ci[i] + nmt0), 0xff800000u)); S1[i] = bitsf(bfi_b32(sel1, fbits(ci[i] + nmt1), 0xff800000u)); } } \
            else { const float dbase0 = (float)(tq - 64 * kp_ - 4 * hi), dbase1 = dbase0 - 32.f, sqm = sq - m; \
                _Pragma("unroll") for (int i = 0; i < 16; ++i) { const int ko = (i & 3) + 8 * (i >> 2); \
                    const unsigned sel0 = (unsigned)__builtin_amdgcn_sbfe((int)mw0, ko, 1), sel1 = (unsigned)__builtin_amdgcn_sbfe((int)mw1, ko, 1); \
                    S0[i] = bitsf(bfi_b32(sel0, fbits(sqm - slope2 * fabsf(dbase0 - (float)ko)), 0xff800000u)); S1[i] = bitsf(bfi_b32(sel1, fbits(sqm - slope2 * fabsf(dbase1 - (float)ko)), 0xff800000u)); } } \
            _Pragma("unroll") for (int ks = 0; ks < 4; ++ks) { \
                S0 = __builtin_amdgcn_mfma_f32_32x32x16_bf16(kf0[ks], qf[ks], S0, 0, 0, 0); S1 = __builtin_amdgcn_mfma_f32_32x32x16_bf16(kf1[ks], qf[ks], S1, 0, 0, 0); } \
            asm volatile("s_nop 15\n\ts_nop 7" : "+v"(S0), "+v"(S1));             \
            bf16x8 vf[2][4]; \
            _Pragma("unroll") for (int db = 0; db < 2; ++db) _Pragma("unroll") for (int j4 = 0; j4 < 4; ++j4) vf[db][j4] = *(const LAS bf16x8*)(kb + K2_BYTES + (32 * db + r32) * K2_STRIDE + j4 * 32 + hi * 16); \
            float mx = max3f(S0[0], S0[0], S1[0]); \
            ATT_MAX16(S0); ATT_MAX16(S1); \
            mx = fmaxf(mx, __shfl_xor(mx, 32)); \
            if (__any(mx > 8.f)) {                                             \
                const float dl = fmaxf(mx, 0.f), alpha = __builtin_amdgcn_exp2f(-dl); m += dl; \
                _Pragma("unroll") for (int i = 0; i < 16; ++i) { S0[i] -= dl; S1[i] -= dl; o0[i] *= alpha; o1[i] *= alpha; lacc[i] *= alpha; } } \
            _Pragma("unroll") for (int i = 0; i < 16; ++i) { S0[i] = __builtin_amdgcn_exp2f(S0[i]); S1[i] = __builtin_amdgcn_exp2f(S1[i]); } \
            u32x4 p00, p01, p10, p11; ATT_PK(p00, p01, S0); ATT_PK(p10, p11, S1); \
            const bf16x8 pf00 = __builtin_bit_cast(bf16x8, p00), pf01 = __builtin_bit_cast(bf16x8, p01), pf10 = __builtin_bit_cast(bf16x8, p10), pf11 = __builtin_bit_cast(bf16x8, p11); \
            o0 = __builtin_amdgcn_mfma_f32_32x32x16_bf16(vf[0][0], pf00, o0, 0, 0, 0); o1 = __builtin_amdgcn_mfma_f32_32x32x16_bf16(vf[1][0], pf00, o1, 0, 0, 0); lacc = __builtin_amdgcn_mfma_f32_32x32x16_bf16(ones8, pf00, lacc, 0, 0, 0); \
            o0 = __builtin_amdgcn_mfma_f32_32x32x16_bf16(vf[0][1], pf01, o0, 0, 0, 0); o1 = __builtin_amdgcn_mfma_f32_32x32x16_bf16(vf[1][1], pf01, o1, 0, 0, 0); lacc = __builtin_amdgcn_mfma_f32_32x32x16_bf16(ones8, pf01, lacc, 0, 0, 0); \
            o0 = __builtin_amdgcn_mfma_f32_32x32x16_bf16(vf[0][2], pf10, o0, 0, 0, 0); o1 = __builtin_amdgcn_mfma_f32_32x32x16_bf16(vf[1][2], pf10, o1, 0, 0, 0); lacc = __builtin_amdgcn_mfma_f32_32x32x16_bf16(ones8, pf10, lacc, 0, 0, 0); \
            o0 = __builtin_amdgcn_mfma_f32_32x32x16_bf16(vf[0][3], pf11, o0, 0, 0, 0); o1 = __builtin_amdgcn_mfma_f32_32x32x16_bf16(vf[1][3], pf11, o1, 0, 0, 0); lacc = __builtin_amdgcn_mfma_f32_32x32x16_bf16(ones8, pf11, lacc, 0, 0, 0); \
            } while (0)
#pragma unroll 1
        for (int kp = 0; kp < npair; ++kp) {
            const u32x4 fK = ATT_LOADK(kp + 2), fV = ATT_LOADV(kp + 2);
            ATT_TILE2(kp);
            if (kp + 1 < npair) ATT_STAGE2((kp + 1) & 1, nK, nV);
            LDS_BARRIER();
            nK = fK; nV = fV;
        }
#undef ATT_TILE2
#undef ATT_PK
#undef ATT_MAX16
#undef ATT_LOADK
#undef ATT_LOADV
#undef ATT_STAGE2
        const float inv = __builtin_amdgcn_rcpf(lacc[0]);
        LAS unsigned char* stg = L + AL_OST + w * 4608;
#pragma unroll
        for (int g = 0; g < 4; ++g) {
            *(LAS u32x2*)(stg + r32 * OST_STRIDE + (8 * g + 4 * hi) * 2) = (u32x2){pk2(o0[4 * g] * inv, o0[4 * g + 1] * inv), pk2(o0[4 * g + 2] * inv, o0[4 * g + 3] * inv)};
            *(LAS u32x2*)(stg + r32 * OST_STRIDE + (32 + 8 * g + 4 * hi) * 2) = (u32x2){pk2(o1[4 * g] * inv, o1[4 * g + 1] * inv), pk2(o1[4 * g + 2] * inv, o1[4 * g + 3] * inv)}; }
        asm volatile("s_waitcnt lgkmcnt(0)" ::: "memory");
        bf16_t* AO = WSP(bf16_t, WS_AO) + (size_t)tok0 * 512 + h * 64;
#pragma unroll
        for (int it = 0; it < 4; ++it) { const int row = it * 8 + (lane >> 3), ch = lane & 7;
            *(u32x4*)(AO + (size_t)row * 512 + ch * 8) = *(const LAS u32x4*)(stg + row * OST_STRIDE + ch * 16); }
    }
#if MK_LEAK >= 0
    __syncthreads();
    if (tid == 0) { volatile LAS unsigned* MS = (volatile LAS unsigned*)(F.lds + MISC_OFF); const unsigned long long tu2_ = __builtin_amdgcn_s_memrealtime(); MS[16] += (unsigned)(tu1_ - tu0_); MS[17] += (unsigned)(tu2_ - tu1_); }
#endif
}
__device__ __forceinline__ void attn_phase(Frame& F, int clo, int chi) {
#pragma unroll 1
    for (int p2 = 2 * F.bid; p2 < 512; p2 += ((p2 & 1) ? 2 * F.G - 1 : 1)) { const int p = p2 >> 1, b = p >> 5, jj = p & 31, c1 = jj >> 1, half = jj & 1;
        const int cc = (p2 & 1) ? c1 : 31 - c1; if (cc >= clo && cc < chi) attn_unit(F, b, cc, half); }
}

constexpr int LR_CW = 0, LR_SEG = 2048, LR_AB = 4096;
static_assert(LR_AB + 8 * 16 * 64 * 16 <= MISC_OFF, "LRU LDS map");
__device__ __forceinline__ void lru_item_mfma(Frame& F, int item) {
    int tid_ = F.tid, w_ = F.wave; asm volatile("" : "+v"(tid_), "+s"(w_));
    const int tid = tid_, lane = tid & 63, w = w_, c16 = lane & 15, kg = lane >> 4;
    const int b = item >> 5, n = (item >> 2) & 7, q = item & 3;
    LAS float* cwL = (LAS float*)(F.lds + LR_CW);
    LAS float* segL = (LAS float*)(F.lds + LR_SEG);
    LAS u32x4* abL = (LAS u32x4*)(F.lds + LR_AB) + (size_t)w * 16 * 64 + lane;
    const float* conv_w = (const float*)F.ap->in[8]; const float* conv_b = (const float*)F.ap->in[9];
    const float* w_rec = (const float*)F.ap->in[10] + (size_t)n * 4096; const float* w_ing = (const float*)F.ap->in[12] + (size_t)n * 4096;
    __syncthreads();
    if (tid < 256) cwL[tid] = conv_w[(tid >> 6) * 512 + 64 * n + (tid & 63)]; else if (tid < 320) cwL[tid] = conv_b[64 * n + (tid - 256)];
    bf16x8 Bw[3][2];
#pragma unroll
    for (int ks = 0; ks < 2; ++ks) { u32x4 pr, pi, pd;
        float vr[8], vi[8], vd[8];
#pragma unroll
        for (int j = 0; j < 8; ++j) { const int d = 32 * ks + 8 * kg + j; vr[j] = w_rec[d * 64 + 16 * q + c16]; vi[j] = w_ing[d * 64 + 16 * q + c16]; vd[j] = (d == 16 * q + c16) ? 1.f : 0.f; }
        pr.x = pk2(vr[0], vr[1]); pr.y = pk2(vr[2], vr[3]); pr.z = pk2(vr[4], vr[5]); pr.w = pk2(vr[6], vr[7]);
        pi.x = pk2(vi[0], vi[1]); pi.y = pk2(vi[2], vi[3]); pi.z = pk2(vi[4], vi[5]); pi.w = pk2(vi[6], vi[7]);
        pd.x = pk2(vd[0], vd[1]); pd.y = pk2(vd[2], vd[3]); pd.z = pk2(vd[4], vd[5]); pd.w = pk2(vd[6], vd[7]);
        Bw[0][ks] = __builtin_bit_cast(bf16x8, pr); Bw[1][ks] = __builtin_bit_cast(bf16x8, pi); Bw[2][ks] = __builtin_bit_cast(bf16x8, pd); }
    const int chg = 64 * n + 16 * q + c16;
    const float spl8 = -8.f * log1pf(__expf(-((const float*)F.ap->in[14])[chg])), brc = ((const float*)F.ap->in[11])[chg], bin = ((const float*)F.ap->in[13])[chg];
    const bf16_t* LX = WSP(bf16_t, WS_LX) + (size_t)b * SEQ * 512 + 64 * n + 8 * kg;
    const bf16_t* LG = WSP(bf16_t, WS_LG) + (size_t)b * SEQ * 512 + 64 * n + 16 * q + c16;
    bf16_t* LO = WSP(bf16_t, WS_LO) + (size_t)b * SEQ * 512 + 64 * n + 16 * q + c16;
    __syncthreads();
    u32x4 raw[2][4], rawN[2][4];
#define LRU_LOAD(R, RB) do { const int tb_ = 256 * w + 16 * (RB) + c16 - 3; \
        _Pragma("unroll") for (int ks = 0; ks < 2; ++ks) _Pragma("unroll") for (int tap = 0; tap < 4; ++tap) { const int ts_ = tb_ + tap; \
            R[ks][tap] = *(const u32x4*)(LX + (size_t)(ts_ < 0 ? 0 : ts_) * 512 + 32 * ks); } } while (0)
    LRU_LOAD(raw, 0);
    float Arun = 1.f, Brun = 0.f;
#pragma unroll 1
    for (int rb = 0; rb < 16; ++rb) {
        if (rb < 15) LRU_LOAD(rawN, rb + 1);
        const int tb = 256 * w + 16 * rb + c16 - 3;
        if (w == 0 && rb == 0) {
#pragma unroll
            for (int ks = 0; ks < 2; ++ks)
#pragma unroll
                for (int tap = 0; tap < 4; ++tap) if (tb + tap < 0) raw[ks][tap] = (u32x4){0u, 0u, 0u, 0u}; }
        bf16x8 afr[2];
#pragma unroll
        for (int ks = 0; ks < 2; ++ks) { const int d0 = 32 * ks + 8 * kg; float xc[8];
            { const f32x4 c0 = *(const LAS f32x4*)(cwL + 256 + d0), c1 = *(const LAS f32x4*)(cwL + 256 + d0 + 4);
              xc[0] = c0.x; xc[1] = c0.y; xc[2] = c0.z; xc[3] = c0.w; xc[4] = c1.x; xc[5] = c1.y; xc[6] = c1.z; xc[7] = c1.w; }
#pragma unroll
            for (int tap = 0; tap < 4; ++tap) { const u32x4 v = raw[ks][tap];
                const f32x4 c0 = *(const LAS f32x4*)(cwL + tap * 64 + d0), c1 = *(const LAS f32x4*)(cwL + tap * 64 + d0 + 4);
                xc[0] += bflo(v.x) * c0.x; xc[1] += bfhi(v.x) * c0.y; xc[2] += bflo(v.y) * c0.z; xc[3] += bfhi(v.y) * c0.w;
                xc[4] += bflo(v.z) * c1.x; xc[5] += bfhi(v.z) * c1.y; xc[6] += bflo(v.w) * c1.z; xc[7] += bfhi(v.w) * c1.w; }
            u32x4 pa; pa.x = cvt_pk_bf16(xc[0], xc[1]); pa.y = cvt_pk_bf16(xc[2], xc[3]); pa.z = cvt_pk_bf16(xc[4], xc[5]); pa.w = cvt_pk_bf16(xc[6], xc[7]);
            afr[ks] = __builtin_bit_cast(bf16x8, pa); }
        f32x4 rp = (f32x4){0.f, 0.f, 0.f, 0.f}, ip = rp, xv = rp;
#pragma unroll
        for (int ks = 0; ks < 2; ++ks) { rp = __builtin_amdgcn_mfma_f32_16x16x32_bf16(afr[ks], Bw[0][ks], rp, 0, 0, 0); ip = __builtin_amdgcn_mfma_f32_16x16x32_bf16(afr[ks], Bw[1][ks], ip, 0, 0, 0);
            xv = __builtin_amdgcn_mfma_f32_16x16x32_bf16(afr[ks], Bw[2][ks], xv, 0, 0, 0); }
        float av[4], bv[4]; u32x4 pk;
#pragma unroll
        for (int r = 0; r < 4; ++r) { const float rg = __builtin_amdgcn_rcpf(1.f + __expf(-(rp[r] + brc))), ig = __builtin_amdgcn_rcpf(1.f + __expf(-(ip[r] + bin)));
            const float la = spl8 * rg;
            const float em1 = -la * (1.f + la * (0.5f + la * (0.16666667f + la * (0.041666668f + la * 0.0083333338f))));
            const float em2 = em1 * (2.f - em1);
            const unsigned w2 = cvt_pk_bf16(em1, __builtin_amdgcn_sqrtf(em2) * (ig * xv[r]));
            pk[r] = w2; av[r] = 1.f - bflo(w2); bv[r] = bfhi(w2); }
        abL[rb * 64] = pk;
        float Ag = av[0], Bg = bv[0];
#pragma unroll
        for (int r = 1; r < 4; ++r) { Bg = av[r] * Bg + bv[r]; Ag = Ag * av[r]; }
        const float A0 = __shfl(Ag, c16), B0 = __shfl(Bg, c16), A1 = __shfl(Ag, c16 + 16), B1 = __shfl(Bg, c16 + 16), A2 = __shfl(Ag, c16 + 32), B2 = __shfl(Bg, c16 + 32), A3 = __shfl(Ag, c16 + 48), B3 = __shfl(Bg, c16 + 48);
        const float P2a = A0 * A1, P2b = A1 * B0 + B1, P3a = P2a * A2, P3b = A2 * P2b + B2, Ta = P3a * A3, Tb = A3 * P3b + B3;
        Brun = Ta * Brun + Tb; Arun = Arun * Ta;
#pragma unroll
        for (int ks = 0; ks < 2; ++ks)
#pragma unroll
            for (int tap = 0; tap < 4; ++tap) raw[ks][tap] = rawN[ks][tap];
    }
#undef LRU_LOAD
    if (kg == 0) { segL[(w * 16 + c16) * 2] = Arun; segL[(w * 16 + c16) * 2 + 1] = Brun; }
    __syncthreads();
    float hc = 0.f;
    for (int ww = 0; ww < w; ++ww) hc = segL[(ww * 16 + c16) * 2] * hc + segL[(ww * 16 + c16) * 2 + 1];
#pragma unroll 2
    for (int rb = 0; rb < 16; ++rb) {
        const int t0 = 256 * w + 16 * rb;
        const u32x4 pk = abL[rb * 64];
        float gv[4];
#pragma unroll
        for (int r = 0; r < 4; ++r) gv[r] = bf2f(LG[(size_t)(t0 + 4 * kg + r) * 512]);
        float av[4], bv[4];
#pragma unroll
        for (int r = 0; r < 4; ++r) { av[r] = 1.f - bflo(pk[r]); bv[r] = bfhi(pk[r]); }
        float Ag = av[0], Bg = bv[0];
#pragma unroll
        for (int r = 1; r < 4; ++r) { Bg = av[r] * Bg + bv[r]; Ag = Ag * av[r]; }
        const float A0 = __shfl(Ag, c16), B0 = __shfl(Bg, c16), A1 = __shfl(Ag, c16 + 16), B1 = __shfl(Bg, c16 + 16), A2 = __shfl(Ag, c16 + 32), B2 = __shfl(Bg, c16 + 32), A3 = __shfl(Ag, c16 + 48), B3 = __shfl(Bg, c16 + 48);
        const float P2a = A0 * A1, P2b = A1 * B0 + B1, P3a = P2a * A2, P3b = A2 * P2b + B2, Ta = P3a * A3, Tb = A3 * P3b + B3;
        const float Pa = kg == 0 ? 1.f : kg == 1 ? A0 : kg == 2 ? P2a : P3a, Pb = kg == 0 ? 0.f : kg == 1 ? B0 : kg == 2 ? P2b : P3b;
        float h = Pa * hc + Pb;
#pragma unroll
        for (int r = 0; r < 4; ++r) { h = av[r] * h + bv[r]; const float g = gv[r]; const float u = 0.7978845608028654f * (g + 0.044715f * g * g * g);
            const float ge = g * __builtin_amdgcn_rcpf(1.f + __expf(-2.f * u));
            LO[(size_t)(t0 + 4 * kg + r) * 512] = (bf16_t)f2bf(h * ge); }
        hc = Ta * hc + Tb;
    }
}
__device__ __forceinline__ void lru_phase(Frame& F) {
#pragma unroll 1
    for (int it = F.bid; it < 256; it += F.G) lru_item_mfma(F, it);
}
struct SchedMerge { const bf16_t *AO, *LO, *WPA, *WPB; int G, c;
    __device__ __forceinline__ bool next(int i, Unit& u) const { const int L = (i >> 1) * G + c; if (L >= 64 * 4) return false; const int sub = i & 1;
        u.pm = L % 64; u.pn = L / 64; u.aux = sub; u.flags = 0; u.gidx = nullptr;
        u.A = (sub ? LO : AO) + (size_t)u.pm * 256 * 512; u.B = (sub ? WPB : WPA) + (size_t)u.pn * 256 * 512; return true; } };
struct EpiMerge {   static constexpr bool PERM = true;
    bf16_t* MG; const bf16_t *GA, *GB;
    __device__ __forceinline__ void operator()(const f32x4 (&acc)[2][2][4][2], const Unit& u, int wr, int wc, int fr, int fq) const {
        const bf16_t* G = u.aux ? GB : GA;
        const size_t base = (size_t)(u.pm * 256 + wr * 64 + fr) * 1024 + u.pn * 256 + wc * 32 + 8 * fq;
#pragma unroll
        for (int ai = 0; ai < 2; ++ai) {
            u32x4 g[4][2], p[4][2];
#pragma unroll
            for (int m = 0; m < 4; ++m)
#pragma unroll
                for (int bj = 0; bj < 2; ++bj) g[m][bj] = *(const u32x4*)(G + base + (size_t)(ai * 128 + m * 16) * 1024 + bj * 128);
            if (u.aux) {
#pragma unroll
                for (int m = 0; m < 4; ++m)
#pragma unroll
                    for (int bj = 0; bj < 2; ++bj) p[m][bj] = *(const u32x4*)(MG + base + (size_t)(ai * 128 + m * 16) * 1024 + bj * 128);
            } else {
#pragma unroll
                for (int m = 0; m < 4; ++m)
#pragma unroll
                    for (int bj = 0; bj < 2; ++bj) p[m][bj] = (u32x4){0u, 0u, 0u, 0u};
            }
#pragma unroll
            for (int m = 0; m < 4; ++m)
#pragma unroll
                for (int bj = 0; bj < 2; ++bj) {
                    const u32x4 gg = g[m][bj], pp = p[m][bj];
                    f32x4 v0 = acc[ai][bj][m][0], v1 = acc[ai][bj][m][1];
                    v0[0] = v0[0] * bflo(gg.x) + bflo(pp.x); v0[1] = v0[1] * bfhi(gg.x) + bfhi(pp.x); v0[2] = v0[2] * bflo(gg.y) + bflo(pp.y); v0[3] = v0[3] * bfhi(gg.y) + bfhi(pp.y);
                    v1[0] = v1[0] * bflo(gg.z) + bflo(pp.z); v1[1] = v1[1] * bfhi(gg.z) + bfhi(pp.z); v1[2] = v1[2] * bflo(gg.w) + bflo(pp.w); v1[3] = v1[3] * bfhi(gg.w) + bfhi(pp.w);
                    u32x4 w; w.x = pk2(v0[0], v0[1]); w.y = pk2(v0[2], v0[3]); w.z = pk2(v1[0], v1[1]); w.w = pk2(v1[2], v1[3]);
                    *(u32x4*)(MG + base + (size_t)(ai * 128 + m * 16) * 1024 + bj * 128) = w; }
        }
    }
};
struct SchedOut { const bf16_t *A, *B; int G, c;
    __device__ __forceinline__ bool next(int i, Unit& u) const { const int L = i * G + c; if (L >= 64 * 4) return false;
        u.pm = L % 64; u.pn = L / 64; u.aux = 0; u.flags = 0; u.gidx = nullptr; u.A = A + (size_t)u.pm * 256 * 1024; u.B = B + (size_t)u.pn * 256 * 1024; return true; } };
struct EpiOut {   static constexpr bool PERM = false;
    const float* x; const float* mod; float* out; float* rowsq;
    __device__ __forceinline__ void operator()(const f32x4 (&acc)[2][2][4][2], const Unit& u, int wr, int wc, int fr, int fq) const {
        const int b = (u.pm * 256) / SEQ;
        f32x4 gm[2][2];
#pragma unroll
        for (int bj = 0; bj < 2; ++bj)
#pragma unroll
            for (int n = 0; n < 2; ++n) gm[bj][n] = *(const f32x4*)(mod + b * 6144 + 2048 + u.pn * 256 + bj * 128 + wc * 32 + 16 * n + 4 * fq);
        const size_t base = (size_t)(u.pm * 256 + wr * 64 + fr) * 1024 + u.pn * 256 + wc * 32 + 4 * fq;
#pragma unroll
        for (int ai = 0; ai < 2; ++ai) {
            f32x4 xv[4][2][2];
#pragma unroll
            for (int m = 0; m < 4; ++m)
#pragma unroll
                for (int bj = 0; bj < 2; ++bj)
#pragma unroll
                    for (int n = 0; n < 2; ++n) xv[m][bj][n] = *(const f32x4*)(x + base + (size_t)(ai * 128 + m * 16) * 1024 + bj * 128 + 16 * n);
#pragma unroll
            for (int m = 0; m < 4; ++m) { const int row = u.pm * 256 + ai * 128 + wr * 64 + m * 16 + fr; float ss = 0.f;
#pragma unroll
                for (int bj = 0; bj < 2; ++bj)
#pragma unroll
                    for (int n = 0; n < 2; ++n) { const f32x4 v = xv[m][bj][n] + gm[bj][n] * acc[ai][bj][m][n];
                        *(f32x4*)(out + base + (size_t)(ai * 128 + m * 16) * 1024 + bj * 128 + 16 * n) = v; ss += (v.x * v.x + v.y * v.y) + (v.z * v.z + v.w * v.w); }
                ss += __shfl_xor(ss, 16); ss += __shfl_xor(ss, 32);
                if (fq == 0) rowsq[(size_t)row * 16 + u.pn * 4 + wc] = ss; }
        }
    }
};

struct TokMeta { int ea, eb; float ca, cb; int re_a, re_b, cls, rc; };
__device__ __forceinline__ int pair_index(int lo, int hi) { return lo * (15 - lo) / 2 + (hi - lo - 1); }

constexpr int RL_GS = 0, RL_LG = 8192, RL_W = 8192 + 16384, RW_STRIDE = 1040;
static_assert(RL_W + 2 * 48 * RW_STRIDE + 2048 <= RING_BYTES, "routing LDS map");
__device__ __forceinline__ void route_phase(Frame& F) {
    int tid_ = F.tid, w_ = F.wave; asm volatile("" : "+v"(tid_), "+s"(w_));
    const int tid = tid_, lane = tid & 63, w = w_, r16 = lane & 15, r8 = lane & 7, kg = lane >> 4;
    LAS float* gsL = (LAS float*)(F.lds + RL_GS);
    LAS float* lgL = (LAS float*)(F.lds + RL_LG + (w & 3) * 3072);
    const bool act = w < 4;
    LAS unsigned char* wL = F.lds + RL_W;
    LAS unsigned* hbin = (LAS unsigned*)(F.lds + RL_W + 2 * 48 * RW_STRIDE);
    const float* nw = (const float*)F.ap->in[18];
    const float* rowsq = WSP(float, WS_ROWSQ);
#pragma unroll 1
    for (int blk = F.bid; blk < NTOK / 64; blk += F.G) {
        const int tokb = blk * 64, b = tokb / SEQ; const float* mod = WSP(float, WS_MOD) + b * 6144;
        __syncthreads();
        float gsv[2][3];
#pragma unroll
        for (int i = 0; i < 2; ++i) { gsv[i][0] = nw[tid + 512 * i]; gsv[i][1] = mod[4096 + tid + 512 * i]; gsv[i][2] = mod[3072 + tid + 512 * i]; }
        const int tok = tokb + 16 * (w & 3) + r16;
        const float* xr = F.out + (size_t)tok * DM + 8 * kg;
        f32x4 rsq[4];
        { const f32x4* rp = (const f32x4*)(rowsq + (size_t)tok * 16); rsq[0] = rp[0]; rsq[1] = rp[1]; rsq[2] = rp[2]; rsq[3] = rp[3]; }
        f32x4 xA[8][2], xB[8][2];
#define RT_LOAD(X, QD) do { const float* xq_ = xr + 256 * (QD); _Pragma("unroll") for (int i_ = 0; i_ < 8; ++i_) { X[i_][0] = *(const f32x4*)(xq_ + 32 * i_); X[i_][1] = *(const f32x4*)(xq_ + 32 * i_ + 4); } } while (0)
        if (act) { RT_LOAD(xA, 0); RT_LOAD(xB, 1); }
        const unsigned wvo = (unsigned)(((tid >> 6) * 1024 + 8 * (tid & 63)) * 2);
        const int wlo = (tid >> 6) * RW_STRIDE + (tid & 63) * 16;
#define RT_WLOAD(KH) do { const unsigned char* wb_ = F.ws + WS_WRH + 1024 * (KH); _Pragma("unroll") for (int i_ = 0; i_ < 12; ++i_) \
            wreg[i_] = *(const u32x4*)(wb_ + (size_t)((i_ / 6) * (int)(WS_WRL - WS_WRH) + (i_ % 6) * 8 * 2048) + wvo); } while (0)
#define RT_WSTORE() do { _Pragma("unroll") for (int i_ = 0; i_ < 12; ++i_) *(LAS u32x4*)(wL + wlo + ((i_ / 6) * 48 + (i_ % 6) * 8) * RW_STRIDE) = wreg[i_]; } while (0)
#pragma unroll
        for (int i = 0; i < 2; ++i) { gsL[tid + 512 * i] = gsv[i][0] * (1.f + gsv[i][1]); gsL[1024 + tid + 512 * i] = gsv[i][2]; }
        if (tid < 144) hbin[tid] = 0u;
        const float ssq = (((rsq[0].x + rsq[0].y) + (rsq[0].z + rsq[0].w)) + ((rsq[1].x + rsq[1].y) + (rsq[1].z + rsq[1].w))) + (((rsq[2].x + rsq[2].y) + (rsq[2].z + rsq[2].w)) + ((rsq[3].x + rsq[3].y) + (rsq[3].z + rsq[3].w)));
        const float rinv = rsqrtf(ssq * (1.f / DM) + EPS);
        f32x4 acc[3];
#pragma unroll
        for (int nb = 0; nb < 3; ++nb) acc[nb] = (f32x4){0.f, 0.f, 0.f, 0.f};
        unsigned char* h2row = WSP(unsigned char, WS_H2T) + (size_t)tok * DM + 8 * kg;
#define RT_COMP(X, QD) do { _Pragma("unroll") for (int i_ = 0; i_ < 8; ++i_) { const int kq_ = 256 * (QD) + 32 * i_, k0 = kq_ + 8 * kg, kl_ = 256 * ((QD) & 1) + 32 * i_ + 8 * kg; \
                const f32x4 a = X[i_][0], c = X[i_][1]; \
                const f32x4 g0 = *(const LAS f32x4*)(gsL + k0), g1 = *(const LAS f32x4*)(gsL + k0 + 4), s0 = *(const LAS f32x4*)(gsL + 1024 + k0), s1 = *(const LAS f32x4*)(gsL + 1024 + k0 + 4); \
                float hv[8]; hv[0] = a.x * rinv * g0.x + s0.x; hv[1] = a.y * rinv * g0.y + s0.y; hv[2] = a.z * rinv * g0.z + s0.z; hv[3] = a.w * rinv * g0.w + s0.w; \
                hv[4] = c.x * rinv * g1.x + s1.x; hv[5] = c.y * rinv * g1.y + s1.y; hv[6] = c.z * rinv * g1.z + s1.z; hv[7] = c.w * rinv * g1.w + s1.w; \
                u32x4 ph, pl; ph.x = pk2(hv[0], hv[1]); ph.y = pk2(hv[2], hv[3]); ph.z = pk2(hv[4], hv[5]); ph.w = pk2(hv[6], hv[7]); \
                pl.x = pk2(hv[0] - bflo(ph.x), hv[1] - bfhi(ph.x)); pl.y = pk2(hv[2] - bflo(ph.y), hv[3] - bfhi(ph.y)); pl.z = pk2(hv[4] - bflo(ph.z), hv[5] - bfhi(ph.z)); pl.w = pk2(hv[6] - bflo(ph.w), hv[7] - bfhi(ph.w)); \
                *(u32x2*)(h2row + kq_) = (u32x2){pk4_fp8(hv[0], hv[1], hv[2], hv[3]), pk4_fp8(hv[4], hv[5], hv[6], hv[7])};     \
                const bf16x8 ah = __builtin_bit_cast(bf16x8, ph), al = __builtin_bit_cast(bf16x8, pl); \
                _Pragma("unroll") for (int nb = 0; nb < 3; ++nb) { const LAS unsigned char* wp = wL + (16 * nb + r16) * RW_STRIDE + kl_ * 2; \
                    const bf16x8 bh = *(const LAS bf16x8*)wp, bl = *(const LAS bf16x8*)(wp + 48 * RW_STRIDE); \
                    acc[nb] = __builtin_amdgcn_mfma_f32_16x16x32_bf16(ah, bh, acc[nb], 0, 0, 0); acc[nb] = __builtin_amdgcn_mfma_f32_16x16x32_bf16(ah, bl, acc[nb], 0, 0, 0); \
                    acc[nb] = __builtin_amdgcn_mfma_f32_16x16x32_bf16(al, bh, acc[nb], 0, 0, 0); } \
                __builtin_amdgcn_sched_barrier(0); } } while (0)
#pragma unroll 1
        for (int kh = 0; kh < 2; ++kh) {
            __syncthreads();
            { u32x4 wreg[12]; RT_WLOAD(kh); RT_WSTORE(); }
            __syncthreads();
            if (act) {
                RT_COMP(xA, 2 * kh);
                if (kh == 0) RT_LOAD(xA, 2);
                RT_COMP(xB, 2 * kh + 1);
                if (kh == 0) RT_LOAD(xB, 3);
            }
        }
#undef RT_COMP
#undef RT_WSTORE
#undef RT_WLOAD
#undef RT_LOAD
        if (act) {
#pragma unroll
            for (int nb = 0; nb < 3; ++nb)
#pragma unroll
                for (int r = 0; r < 4; ++r) lgL[(4 * kg + r) * 48 + 16 * nb + r16] = acc[nb][r]; }
        asm volatile("s_waitcnt lgkmcnt(0)" ::: "memory");
        TokMeta mt; mt.ea = 0; mt.eb = 0; mt.ca = 0.f; mt.cb = 0.f; mt.re_a = 0; mt.re_b = 0; mt.cls = 0; mt.rc = 0;
        if (act && lane < 16) {
            const LAS float* lg = lgL + lane * 48; const float* bg = (const float*)F.ap->in[20]; const float* be = (const float*)F.ap->in[22];
            float gl[4];
#pragma unroll
            for (int i = 0; i < 4; ++i) gl[i] = lg[i] + bg[i];
            int g = 0; float gmx = gl[0];
#pragma unroll
            for (int i = 1; i < 4; ++i) if (gl[i] > gmx) { gmx = gl[i]; g = i; }
            float gs = 0.f;
#pragma unroll
            for (int i = 0; i < 4; ++i) gs += __expf(gl[i] - gmx);
            const float gw = 1.f / gs;
            float el[8];
#pragma unroll
            for (int i = 0; i < 8; ++i) el[i] = lg[4 + g * 8 + i] + be[g * 8 + i];
            int i1 = 0; float v1 = el[0];
#pragma unroll
            for (int i = 1; i < 8; ++i) if (el[i] > v1) { v1 = el[i]; i1 = i; }
            int i2 = -1; float v2 = -INFINITY;
#pragma unroll
            for (int i = 0; i < 8; ++i) if (i != i1 && (i2 < 0 || el[i] > v2)) { v2 = el[i]; i2 = i; }
            const float e2 = __expf(v2 - v1); const float w1v = gw / (1.f + e2), w2v = gw * e2 / (1.f + e2);
            const int lo = i1 < i2 ? i1 : i2, hi = i1 < i2 ? i2 : i1;
            mt.ea = g * 8 + lo; mt.eb = g * 8 + hi; mt.ca = (i1 < i2) ? w1v : w2v; mt.cb = (i1 < i2) ? w2v : w1v;
            mt.cls = g * 28 + pair_index(lo, hi);
            mt.re_a = (int)__hip_atomic_fetch_add(hbin + mt.ea, 1u, __ATOMIC_RELAXED, __HIP_MEMORY_SCOPE_WORKGROUP); mt.re_b = (int)__hip_atomic_fetch_add(hbin + mt.eb, 1u, __ATOMIC_RELAXED, __HIP_MEMORY_SCOPE_WORKGROUP);
            mt.rc = (int)__hip_atomic_fetch_add(hbin + 32 + mt.cls, 1u, __ATOMIC_RELAXED, __HIP_MEMORY_SCOPE_WORKGROUP);
        }
        __syncthreads();
        if (tid < 144) { const unsigned cnt = hbin[tid]; unsigned base = 0u;
            if (cnt) base = atomicAdd((unsigned*)(F.ws + WS_CTL) + CW_CNTE + tid * CNT_STRIDE, cnt);
            hbin[160 + tid] = base; }
        __syncthreads();
        if (act && lane < 16) { mt.re_a += (int)hbin[160 + mt.ea]; mt.re_b += (int)hbin[160 + mt.eb]; mt.rc += (int)hbin[160 + 32 + mt.cls];
            const int tk = tokb + 16 * w + lane;
            typedef int i32x4 __attribute__((ext_vector_type(4)));
            WSP(i32x4, WS_EINFO)[(size_t)mt.ea * LIST_CAP + mt.re_a] = (i32x4){tk, (int)fbits(mt.ca), mt.cls, mt.rc};
            WSP(i32x4, WS_EINFO)[(size_t)mt.eb * LIST_CAP + mt.re_b] = (i32x4){tk, (int)fbits(mt.cb), mt.cls | (1 << 16), mt.rc};
            WSP(int, WS_CLIST)[(size_t)mt.cls * LIST_CAP + mt.rc] = tk; }
    }
}
struct MoeTables { LAS int* ebase; LAS int* cbase; LAS int* cnt; LAS unsigned short* trows; LAS unsigned short* tcls; LAS unsigned short* order; };
__device__ __forceinline__ MoeTables tables_view(Frame& F, int lds_off) {
    MoeTables T; T.ebase = (LAS int*)(F.lds + lds_off); T.cbase = T.ebase + 40; T.cnt = T.ebase + 160; T.trows = (LAS unsigned short*)(F.lds + lds_off + 1280); T.tcls = T.trows + 256; T.order = T.trows + 512; return T; }
__device__ __forceinline__ MoeTables build_tables(Frame& F, int lds_off) {
    MoeTables T = tables_view(F, lds_off);
    const unsigned* ctl = (const unsigned*)(F.ws + WS_CTL);
    __syncthreads();
    if (F.tid < 144) T.cnt[F.tid] = (int)__hip_atomic_load(ctl + CW_CNTE + F.tid * CNT_STRIDE, __ATOMIC_RELAXED, __HIP_MEMORY_SCOPE_AGENT);
    __syncthreads();
    { int t_ = F.tid; asm volatile("" : "+v"(t_));
      const int l = t_ & 63;
#define BT_UP(P, O) __builtin_amdgcn_ds_bpermute(((l - (O)) & 63) * 4, (P))
      if (t_ < 64) { const int v = (l < NEXP) ? ((T.cnt[l] + 255) >> 8) : 0; int p = v;
#pragma unroll
          for (int o = 1; o < 64; o <<= 1) { const int t = BT_UP(p, o); if (l >= o) p += t; }
          if (l < NEXP) T.ebase[l] = p - v; if (l == NEXP - 1) T.ebase[NEXP] = p; }
      else if (t_ < 128) { const int v0 = (T.cnt[32 + l] + 255) >> 8, v1 = (l + 64 < NCLS) ? ((T.cnt[32 + 64 + l] + 255) >> 8) : 0; int p0 = v0, p1 = v1;
#pragma unroll
          for (int o = 1; o < 64; o <<= 1) { const int t0 = BT_UP(p0, o), t1 = BT_UP(p1, o); if (l >= o) { p0 += t0; p1 += t1; } }
          const int tot0 = __builtin_amdgcn_ds_bpermute(63 * 4, p0);
          T.cbase[l] = p0 - v0; if (l + 64 < NCLS) T.cbase[64 + l] = tot0 + p1 - v1; if (l + 64 == NCLS - 1) T.cbase[NCLS] = tot0 + p1; }
#undef BT_UP
    }
    __syncthreads();
    if (F.tid < NCLS) { const int n = T.cnt[32 + F.tid], b0 = T.cbase[F.tid], nt = T.cbase[F.tid + 1] - b0;
        for (int t = 0; t < nt; ++t) { const int idx = b0 + t; if (idx < 256) { const int rws = n - 256 * t; T.trows[idx] = (unsigned short)(rws > 256 ? 256 : rws); T.tcls[idx] = (unsigned short)F.tid; } } }
    __syncthreads();
    { const int NT = T.cbase[NCLS] < 256 ? T.cbase[NCLS] : 256;
      if (F.tid < NT) { const int mine = T.trows[F.tid]; int rk = 0;
          for (int j = 0; j < NT; ++j) { const int o = T.trows[j]; rk += (o > mine || (o == mine && j < F.tid)) ? 1 : 0; }
          T.order[rk] = (unsigned short)F.tid; } }
    __syncthreads();
    return T;
}
typedef int i32x4 __attribute__((ext_vector_type(4)));
struct SchedMoe1 { const bf16_t *H2, *W13; const LAS int* ebase; const LAS int* cnte; const int* einfo; int G, c;
    __device__ __forceinline__ bool next(int i, Unit& u) const { const int L = i * G + c, ntile = ebase[NEXP]; if (L >= ntile * 2) return false;
        const int rt = L >> 1, j = L & 1; int e = 0;
        for (int q = 1; q < NEXP; ++q) e = (ebase[q] <= rt) ? q : e;
        const int tl = rt - ebase[e];
        u.pm = e * 64 + tl; u.pn = j; u.flags = 0; u.aux = cnte[e] - 256 * tl; u.gidx = einfo + ((size_t)e * LIST_CAP + 256 * tl) * 4;
        u.A = H2; u.B = W13 + ((size_t)e * 512 + 256 * j) * 512; return true; } };
struct EpiMoe1 {   static constexpr bool PERM = true;
    unsigned char* wsb; const i32x4* einfo; const LAS int* cbase;
    __device__ __forceinline__ void operator()(const f32x4 (&acc)[2][2][4][2], const Unit& u, int wr, int wc, int fr, int fq) const {
        const int e = u.pm >> 6, tl = u.pm & 63;
        i32x4 infs[8];
#pragma unroll
        for (int ai = 0; ai < 2; ++ai)
#pragma unroll
            for (int m = 0; m < 4; ++m) { const int r = ai * 128 + wr * 64 + m * 16 + fr; infs[ai * 4 + m] = einfo[(size_t)e * LIST_CAP + 256 * tl + (r < u.aux ? r : 0)]; }
        unsigned dst[8]; float cs[8];
#pragma unroll
        for (int ai = 0; ai < 2; ++ai)
#pragma unroll
            for (int m = 0; m < 4; ++m) { const int r = ai * 128 + wr * 64 + m * 16 + fr; const i32x4 inf = infs[ai * 4 + m]; cs[ai * 4 + m] = bitsf((unsigned)inf.y); const int cls = inf.z & 0xffff, half = inf.z >> 16;
                const size_t d = ((size_t)cbase[cls] * 256 + inf.w) * 512 + 256 * half + 128 * u.pn + 32 * wc + 8 * fq;
                dst[ai * 4 + m] = (r < u.aux) ? (unsigned)(WS_ACT2 + d * 2) : (unsigned)(WS_META + 16 * (fq + 4 * wc)); }
#pragma unroll
        for (int ai = 0; ai < 2; ++ai)
#pragma unroll
            for (int m = 0; m < 4; ++m) {
                float o[8];
#pragma unroll
                for (int n = 0; n < 2; ++n)
#pragma unroll
                    for (int ee = 0; ee < 4; ++ee) { const float a = acc[ai][0][m][n][ee], g = acc[ai][1][m][n][ee]; o[4 * n + ee] = a * sigmoidf_(a) * g * cs[ai * 4 + m]; }
                u32x4 w; w.x = cvt_pk_bf16(o[0], o[1]); w.y = cvt_pk_bf16(o[2], o[3]); w.z = cvt_pk_bf16(o[4], o[5]); w.w = cvt_pk_bf16(o[6], o[7]);
                *(u32x4*)(wsb + dst[ai * 4 + m]) = w; }
    }
};
struct SchedMoe2 { const bf16_t *act2, *W2; const LAS int* cbase; const LAS int* cntc; const LAS unsigned short* order; const LAS unsigned short* tcls; int G, c;
    __device__ __forceinline__ bool next(int i, Unit& u) const { const int L = (i >> 1) * G + c, ntile = cbase[NCLS]; if (L >= ntile * 4) return false;
        const int sub = i & 1, rk = L >> 2, pn = L & 3;
        const int rt = (ntile <= 256) ? (int)order[rk] : rk;
        int cl = 0;
        if (ntile <= 256) cl = (int)tcls[rt]; else { for (int q = 1; q < NCLS; ++q) cl = (cbase[q] <= rt) ? q : cl; }
        const int g = cl / 28; int p = cl % 28, lo = 0; while (p >= 7 - lo) { p -= 7 - lo; ++lo; } const int hi = lo + 1 + p;
        const int e = g * 8 + (sub ? hi : lo), tl = rt - cbase[cl];
        u.pm = cl * 64 + tl; u.pn = pn; u.flags = sub ? 1 : 2; u.aux = cntc[cl] - 256 * tl; u.gidx = nullptr;
        u.A = act2 + (size_t)rt * 256 * 512 + 256 * sub; u.B = W2 + ((size_t)e * 1024 + 256 * pn) * 256; return true; } };
struct EpiMoe2 {   static constexpr bool PERM = false;
    float* out; const LAS unsigned char* gfL; const int* clist; float* trash;
    __device__ __forceinline__ void operator()(const f32x4 (&acc)[2][2][4][2], const Unit& u, int wr, int wc, int fr, int fq) const {
        const int cl = u.pm >> 6, tl = u.pm & 63;
        int tk[8];
#pragma unroll
        for (int ai = 0; ai < 2; ++ai)
#pragma unroll
            for (int m = 0; m < 4; ++m) { const int r = ai * 128 + wr * 64 + m * 16 + fr; tk[ai * 4 + m] = (r < u.aux) ? clist[(size_t)cl * LIST_CAP + 256 * tl + r] : -1; }
        const int colb = u.pn * 256 + wc * 32 + 4 * fq;
#pragma unroll
        for (int ai = 0; ai < 2; ++ai) {
            f32x4 v[4][2][2];
#pragma unroll
            for (int m = 0; m < 4; ++m) { const int tok = tk[ai * 4 + m]; const float* p = (tok < 0) ? trash + 4 * fq : out + (size_t)tok * 1024 + colb;
#pragma unroll
                for (int bj = 0; bj < 2; ++bj)
#pragma unroll
                    for (int n = 0; n < 2; ++n) v[m][bj][n] = *(const f32x4*)(p + bj * 128 + n * 16); }
#pragma unroll
            for (int m = 0; m < 4; ++m) { const int tok = tk[ai * 4 + m]; const int b = (tok < 0 ? 0 : tok) / SEQ; float* p = (tok < 0) ? trash + 4 * fq : out + (size_t)tok * 1024 + colb;
#pragma unroll
                for (int bj = 0; bj < 2; ++bj)
#pragma unroll
                    for (int n = 0; n < 2; ++n) { const u32x2 gw = *(const LAS u32x2*)(gfL + (b * 1024 + colb + bj * 128 + n * 16) * 2); const f32x4 gf = {bflo(gw.x), bfhi(gw.x), bflo(gw.y), bfhi(gw.y)};
                        *(f32x4*)(p + bj * 128 + n * 16) = v[m][bj][n] + gf * acc[ai][bj][m][n]; } }
        }
    }
};

constexpr int NPHASE = 9;
template <int LO, int HI> __global__ void __launch_bounds__(NTHREADS, 2) mk_fwd(Args args) {
    extern __shared__ __attribute__((aligned(16))) unsigned char lds[];
    Frame F;
    F.lds = (LAS unsigned char*)lds; F.tid = threadIdx.x; F.lane = F.tid & 63; F.wave = __builtin_amdgcn_readfirstlane(F.tid >> 6); F.G = gridDim.x; F.bid = blockIdx.x;
    F.ap = &args;
    F.out = args.out; F.ws = args.ws;
    volatile LAS unsigned* MISC = (volatile LAS unsigned*)((LAS unsigned char*)lds + MISC_OFF);
    if (F.tid < 32) MISC[F.tid] = 0u;
    __syncthreads();
    unsigned* ctl = (unsigned*)(F.ws + WS_CTL);
    XcdBarrier bar; bar.bar = ctl + CW_BAR; bar.x = 0; bar.st = nullptr;
    if (MK_N_LAUNCHES == 1) bar = xcd_barrier_post(ctl + CW_BAR, MISC + 8);
#define IN(k) (LO <= (k) && (k) < HI)
#define SEAM(k) do { if constexpr (IN(k) && IN((k) + 1)) xcd_barrier(bar); } while (0)
#ifndef MK_LEAK
#define MK_LEAK -1
#endif
    unsigned long long ts_[12];
#define STAMP(k) do { if (MK_LEAK >= 0) ts_[k] = __builtin_amdgcn_s_memrealtime(); } while (0)
    STAMP(0);
    if constexpr (IN(0)) { p0_phase(F); } SEAM(0); STAMP(1);
    if constexpr (IN(1)) { p1a_phase(F); } SEAM(1); STAMP(2);
    if constexpr (IN(2)) { EpiProj E{F.ws};
        { SchedProj S{WSP(bf16_t, WS_H), WSP(bf16_t, WS_WIN), 1024, 0, F.G, F.bid}; run_gemm(F.lds, 1024, 1024, 1024, S, E); }
        { SchedProj S{WSP(bf16_t, WS_H8), WSP(bf16_t, WS_WIN8), 512, 8, F.G, F.bid}; run_gemm<false, true>(F.lds, 512, 512, 512, S, E); } }
    SEAM(2);
    unsigned long long tlru_ = 0;
    if constexpr (IN(3)) { lru_phase(F); __syncthreads(); if (MK_LEAK >= 0) tlru_ = __builtin_amdgcn_s_memrealtime(); attn_phase(F, 0, 32); } SEAM(3); STAMP(4);
    if constexpr (IN(4)) { SchedMerge S{WSP(bf16_t, WS_AO), WSP(bf16_t, WS_LO), WSP(bf16_t, WS_WPA), WSP(bf16_t, WS_WPB), F.G, F.bid};
        EpiMerge E{WSP(bf16_t, WS_MG), WSP(bf16_t, WS_GA), WSP(bf16_t, WS_GB)};
        run_gemm(F.lds, 512, 512, 512, S, E); } SEAM(4); STAMP(5);
    if constexpr (IN(5)) { SchedOut S{WSP(bf16_t, WS_MG), WSP(bf16_t, WS_WOUT), F.G, F.bid}; EpiOut E{((const float*)F.ap->in[0]), WSP(float, WS_MOD), F.out, WSP(float, WS_ROWSQ)};
        run_gemm(F.lds, 1024, 1024, 1024, S, E); } SEAM(5); STAMP(6);
    if constexpr (IN(6)) { route_phase(F); } SEAM(6); STAMP(7);
    if constexpr (IN(7)) { const MoeTables T = build_tables(F, TBL_OFF);
        SchedMoe1 S{WSP(bf16_t, WS_H2T), WSP(bf16_t, WS_W13), T.ebase, T.cnt, WSP(int, WS_EINFO), F.G, F.bid}; EpiMoe1 E{F.ws, WSP(i32x4, WS_EINFO), T.cbase};
        run_gemm<true, true>(F.lds, 512, 512, 512, S, E); } SEAM(7); STAMP(8);
    if constexpr (IN(8)) { const MoeTables T = (MK_N_LAUNCHES == 1 && IN(7)) ? tables_view(F, TBL_OFF) : build_tables(F, TBL_OFF);
        SchedMoe2 S{WSP(bf16_t, WS_ACT2), WSP(bf16_t, WS_W2), T.cbase, T.cnt + 32, T.order, T.tcls, F.G, F.bid}; EpiMoe2 E{F.out, F.lds + GF_OFF, WSP(int, WS_CLIST), WSP(float, WS_META)};
        for (int i = F.tid; i < 4096; i += NTHREADS) { const int b = i >> 9, c2 = (i & 511) * 2; const float* gp = WSP(float, WS_MOD) + b * 6144 + 5120 + c2; *(LAS unsigned*)(F.lds + GF_OFF + (b * 1024 + c2) * 2) = pk2(gp[0], gp[1]); }
        __syncthreads();
        run_gemm(F.lds, 512, 256, 256, S, E); }
    STAMP(9);
    if (MK_LEAK >= 0 && F.bid == 0 && F.tid == 0) { asm volatile("s_waitcnt vmcnt(0)" ::: "memory");
        unsigned long long d = 0;
        if (MK_LEAK < 10) d = ts_[MK_LEAK + 1] - ts_[MK_LEAK]; else if (MK_LEAK == 10) d = tlru_ - ts_[3]; else if (MK_LEAK == 11) d = MISC[16]; else if (MK_LEAK == 12) d = MISC[17]; else if (MK_LEAK == 13) d = MISC[18]; else if (MK_LEAK == 14) d = MISC[19]; else if (MK_LEAK == 15) d = MISC[20];
        F.out[0] = (float)d * 0.01f; }
#undef IN
#undef SEAM
}

template <int P> static void launch_phase(int grid, hipStream_t stream, Args a) {
    (void)hipFuncSetAttribute((const void*)mk_fwd<P, P + 1>, hipFuncAttributeMaxDynamicSharedMemorySize, LDS_BYTES);
    a.ph_lo = P; a.ph_hi = P + 1; hipLaunchKernelGGL((mk_fwd<P, P + 1>), dim3(grid), dim3(NTHREADS), LDS_BYTES, stream, a);
}
extern "C" void kernel_launch(void* const* d_in, const int* in_sizes, int n_in, void* d_out, int out_size, void* d_ws, size_t ws_size, hipStream_t stream) {
    static int grid = 0;
    if (grid == 0) {
        if (n_in != 26 || out_size != NTOK * DM || ws_size < WS_END) { fprintf(stderr, "kernel_launch: unexpected shapes (n_in %d out %d ws %zu)\n", n_in, out_size, ws_size); grid = -1; return; }
        int dev = 0, cus = 0, per_cu = 0;
        (void)hipGetDevice(&dev); (void)hipDeviceGetAttribute(&cus, hipDeviceAttributeMultiprocessorCount, dev);
#if MK_N_LAUNCHES == 1
        (void)hipFuncSetAttribute((const void*)mk_fwd<0, NPHASE>, hipFuncAttributeMaxDynamicSharedMemorySize, LDS_BYTES);
        (void)hipOccupancyMaxActiveBlocksPerMultiprocessor(&per_cu, (const void*)mk_fwd<0, NPHASE>, NTHREADS, LDS_BYTES);
#else
        (void)hipOccupancyMaxActiveBlocksPerMultiprocessor(&per_cu, (const void*)mk_fwd<2, 3>, NTHREADS, LDS_BYTES);
#endif
        (void)hipGetLastError();
        if (per_cu < 1) { fprintf(stderr, "kernel_launch: occupancy query says %d blocks per CU\n", per_cu); }
        grid = cus;
    }
    if (grid < 0) return;
    (void)hipMemsetAsync((char*)d_ws + WS_CTL, 0, CTL_ZERO_BYTES, stream);
    Args a{};
    for (int i = 0; i < 26; ++i) a.in[i] = d_in[i];
    a.out = (float*)d_out; a.ws = (unsigned char*)d_ws;
#if MK_N_LAUNCHES == 1
    a.ph_lo = 0; a.ph_hi = NPHASE; hipLaunchKernelGGL((mk_fwd<0, NPHASE>), dim3(grid), dim3(NTHREADS), LDS_BYTES, stream, a);
#else
#ifndef MK_REPMASK
#define MK_REPMASK 0
#endif
    for (int r = 0; r < ((MK_REPMASK & 1) ? 2 : 1); ++r) launch_phase<0>(grid, stream, a);
    for (int r = 0; r < ((MK_REPMASK & 2) ? 2 : 1); ++r) launch_phase<1>(grid, stream, a);
    for (int r = 0; r < ((MK_REPMASK & 4) ? 2 : 1); ++r) launch_phase<2>(grid, stream, a);
    for (int r = 0; r < ((MK_REPMASK & 8) ? 2 : 1); ++r) launch_phase<3>(grid, stream, a);
    for (int r = 0; r < ((MK_REPMASK & 16) ? 2 : 1); ++r) launch_phase<4>(grid, stream, a);
    for (int r = 0; r < ((MK_REPMASK & 32) ? 2 : 1); ++r) launch_phase<5>(grid, stream, a);
    launch_phase<6>(grid, stream, a);
    for (int r = 0; r < ((MK_REPMASK & 128) ? 2 : 1); ++r) launch_phase<7>(grid, stream, a);
    for (int r = 0; r < ((MK_REPMASK & 256) ? 2 : 1); ++r) launch_phase<8>(grid, stream, a);
    launch_phase<9>(grid, stream, a);
    if (MK_REPMASK & 512) { launch_phase<5>(grid, stream, a); launch_phase<9>(grid, stream, a); }
#endif
}
```

```cpp
#include <hip/hip_runtime.h>
#include <cstdint>
#include <cstdio>

#ifndef MK_LEAK
#define MK_LEAK -1
#endif
#ifndef MK_N_LAUNCHES
#define MK_N_LAUNCHES 1
#endif

#define LAS __attribute__((address_space(3)))
#define GAS __attribute__((address_space(1)))
typedef unsigned short bf16_t;
typedef short bf16x8 __attribute__((ext_vector_type(8)));
typedef float f32x4 __attribute__((ext_vector_type(4)));
typedef float f32x2 __attribute__((ext_vector_type(2)));
typedef unsigned u32x4 __attribute__((ext_vector_type(4)));
typedef unsigned u32x2 __attribute__((ext_vector_type(2)));
typedef GAS unsigned gu32;

constexpr int BATCH = 8, SEQ = 2048, DM = 1024, NTOK = BATCH * SEQ;
constexpr int NH = 8, HD = 64, NIH = 4, TOPK = 256, CHUNK = 64;
constexpr int LRUW = 512;
constexpr int NEXP = 32, NGRP = 4, EPG = 8, DFF = 256, NCLS = NGRP * 28;
constexpr int DIN_PAD = 4096;
constexpr float EPS = 1e-6f;
constexpr int C_Q = 0, C_K = 512, C_V = 576, C_QI = 640, C_KI = 896, C_LX = 960, C_LG = 1472, C_WI = 1984, C_PAD = 1988, C_GA = 2048, C_GB = 3072, C_END = 4096;

constexpr size_t MiB = 1u << 20;
constexpr size_t WS_CTL = 0, CTL_ZERO_BYTES = 1 * MiB;
constexpr size_t WS_MOD = 1 * MiB;
constexpr size_t WS_META = 1 * MiB + 512 * 1024;
constexpr size_t WS_WIN = 2 * MiB, WS_WPA = 10 * MiB, WS_WPB = 11 * MiB, WS_WOUT = 12 * MiB, WS_W13 = 14 * MiB, WS_W2 = 46 * MiB;
constexpr size_t WS_WRH = 62 * MiB, WS_WRL = 62 * MiB + 256 * 1024;
constexpr size_t WS_H = 64 * MiB;
constexpr size_t WS_AO = 64 * MiB, WS_LO = 80 * MiB;
constexpr size_t WS_Q = 96 * MiB, WS_QI = 112 * MiB, WS_K = 120 * MiB, WS_KI = 122 * MiB, WS_VT = 124 * MiB, WS_WI = 126 * MiB, WS_VR = 224 * MiB;
constexpr size_t WS_LX = 128 * MiB, WS_LG = 144 * MiB, WS_MG = 128 * MiB;
constexpr size_t WS_GA = 160 * MiB, WS_GB = 192 * MiB;
constexpr size_t WS_A1 = 64 * MiB;
constexpr size_t WS_H2T = 160 * MiB;
constexpr size_t WS_ACT2 = 192 * MiB;
constexpr size_t WS_H8 = 224 * MiB;
constexpr size_t WS_WIN8 = 6 * MiB;
constexpr size_t WS_EINFO = 64 * MiB;
constexpr size_t WS_CLIST = 72 * MiB;
constexpr int LIST_CAP = 16384;
constexpr size_t WS_ROWSQ = 240 * MiB;
constexpr size_t WS_END = 256 * MiB;
constexpr int CW_BAR = 4096, CW_CNTE = 8192, CW_CNTC = 8192 + 32 * 32, CNT_STRIDE = 32, CW_ROWSQ = 16384;

constexpr int NWAVES = 8, NTHREADS = 512;
constexpr int LDS_BYTES = 151552, RING_BYTES = 131072, MISC_OFF = LDS_BYTES - 512, GF_OFF = RING_BYTES, TBL_OFF = RING_BYTES + 16384;

typedef float f32x2_cv __attribute__((ext_vector_type(2)));
typedef __bf16 bf16x2_cv __attribute__((ext_vector_type(2)));
__device__ __forceinline__ unsigned pk2(float lo, float hi) { const f32x2_cv v = {lo, hi}; return __builtin_bit_cast(unsigned, __builtin_convertvector(v, bf16x2_cv)); }
__device__ __forceinline__ unsigned f2bf(float f) { return pk2(f, 0.f) & 0xffffu; }
__device__ __forceinline__ unsigned cvt_pk_bf16(float lo, float hi) { return pk2(lo, hi); }

#define LDS_BARRIER() do { asm volatile("s_waitcnt lgkmcnt(0)" ::: "memory"); __builtin_amdgcn_s_barrier(); asm volatile("" ::: "memory"); } while (0)
__device__ __forceinline__ float relu_f(float x) { float r; asm("v_max_f32 %0, 0, %1" : "=v"(r) : "v"(x)); return r; }
__device__ __forceinline__ float max3f(float a, float b, float c) { float r; asm("v_max3_f32 %0, %1, %2, %3" : "=v"(r) : "v"(a), "v"(b), "v"(c)); return r; }
typedef int v8i32 __attribute__((ext_vector_type(8)));
__device__ __forceinline__ unsigned pk4_fp8(float a, float b, float c, float d) { int w = 0; w = __builtin_amdgcn_cvt_pk_fp8_f32(a, b, w, false); w = __builtin_amdgcn_cvt_pk_fp8_f32(c, d, w, true); return (unsigned)w; }
__device__ __forceinline__ float bf2f(unsigned short b) { return __builtin_bit_cast(float, (unsigned)b << 16); }
__device__ __forceinline__ float bflo(unsigned w) { return __builtin_bit_cast(float, w << 16); }
__device__ __forceinline__ float bfhi(unsigned w) { return __builtin_bit_cast(float, w & 0xffff0000u); }
__device__ __forceinline__ float wave_sum(float v) {
#pragma unroll
    for (int o = 1; o < 64; o <<= 1) v += __shfl_xor(v, o);
    return v;
}
__device__ __forceinline__ float wave_max(float v) {
#pragma unroll
    for (int o = 1; o < 64; o <<= 1) v = fmaxf(v, __shfl_xor(v, o));
    return v;
}
__device__ __forceinline__ int wave_isum(int v) {
#pragma unroll
    for (int o = 1; o < 64; o <<= 1) v += __shfl_xor(v, o);
    return v;
}
__device__ __forceinline__ float sigmoidf_(float x) { return __builtin_amdgcn_rcpf(1.f + __expf(-x)); }
__host__ __device__ __forceinline__ int perm32(int rho) { const int n = rho >> 4, i = rho & 15; return 8 * (i >> 2) + 4 * n + (i & 3); }
__device__ __forceinline__ int vt_pos(int o) { return 8 * ((o >> 2) & 1) + 4 * (o >> 3) + (o & 3); }

#define XB_TMO      128
#define XB_XCNT(j)  (256  + 64 * (j))
#define XB_XSUB(j)  (1280 + 64 * (j))
#define XB_XGEN(j)  (2304 + 64 * (j))
#define XB_TOP      3328
#define XB_TOPGEN   3392
#define XCD_BAR_WORDS 3456
#define XB_SPIN_CAP (1u << 18)
__device__ __forceinline__ unsigned xb_ld(unsigned* p)              { return __hip_atomic_load(p, __ATOMIC_RELAXED, __HIP_MEMORY_SCOPE_AGENT); }
__device__ __forceinline__ unsigned xb_add(unsigned* p, unsigned v) { return __hip_atomic_fetch_add(p, v, __ATOMIC_RELAXED, __HIP_MEMORY_SCOPE_AGENT); }
__device__ __forceinline__ unsigned xb_xcc_id() { return (unsigned)__builtin_amdgcn_s_getreg((3 << 11) | 20) & 0xFu; }
#define XB_SPIN(cond, bar) do { unsigned _sp = 0; while (cond) { __builtin_amdgcn_s_sleep(1); \
    if ((++_sp & 255u) == 0u) { if (xb_ld(&(bar)[XB_TMO])) break; if (_sp > XB_SPIN_CAP) { atomicAdd(&(bar)[XB_TMO], 1u); break; } } } } while (0)
struct XcdBarrier { unsigned* bar; unsigned x; volatile LAS unsigned* st; };
__device__ __forceinline__ XcdBarrier xcd_barrier_post(unsigned* bar, volatile LAS unsigned* st) {
    XcdBarrier b; b.bar = bar; b.x = xb_xcc_id(); b.st = st;
    if (threadIdx.x == 0) (void)xb_add(&bar[XB_XCNT(b.x)], 1u);
    return b;
}
__device__ __forceinline__ void xcd_barrier_complete(unsigned* bar, unsigned x, unsigned& nloc, unsigned& nx) {
    const unsigned G = gridDim.x * gridDim.y * gridDim.z;
    unsigned sum, cnt, mine, sp = 0u;
    for (;;) {
        sum = 0u; cnt = 0u; mine = 0u;
#pragma unroll
        for (unsigned j = 0; j < 16; ++j) { const unsigned c = xb_ld(&bar[XB_XCNT(j)]); sum += c; cnt += (c > 0u) ? 1u : 0u; mine = (j == x) ? c : mine; }
        if (sum == G) break;
        __builtin_amdgcn_s_sleep(1);
        if ((++sp & 255u) == 0u) { if (xb_ld(&bar[XB_TMO])) break; if (sp > XB_SPIN_CAP) { atomicAdd(&bar[XB_TMO], 1u); break; } }
    }
    nloc = mine > 0u ? mine : 1u; nx = cnt > 0u ? cnt : 1u;
}
__device__ __forceinline__ void xcd_barrier(const XcdBarrier& b) {
    asm volatile("s_waitcnt vmcnt(0)" ::: "memory");
    __syncthreads();
    if (threadIdx.x == 0) {
        unsigned* bar = b.bar;
        __builtin_amdgcn_s_waitcnt(0);
        unsigned nloc = b.st[0], nx = b.st[1];
        if (nloc == 0u) { xcd_barrier_complete(bar, b.x, nloc, nx); b.st[0] = nloc; b.st[1] = nx; }
        const unsigned old = xb_add(&bar[XB_XSUB(b.x)], 1u);
        const unsigned gen = old / nloc;
        if (old + 1u == (gen + 1u) * nloc) {
            __builtin_amdgcn_fence(__ATOMIC_RELEASE, "agent");
            asm volatile("s_waitcnt vmcnt(0)" ::: "memory");
            const unsigned og = xb_add(&bar[XB_TOP], 1u);
            const unsigned tg = og / nx;
            if (og + 1u == (tg + 1u) * nx) xb_add(&bar[XB_TOPGEN], 1u);
            else XB_SPIN(xb_ld(&bar[XB_TOPGEN]) == tg, bar);
            __builtin_amdgcn_fence(__ATOMIC_ACQUIRE, "agent");
            xb_add(&bar[XB_XGEN(b.x)], 1u);
            asm volatile("s_waitcnt vmcnt(0)" ::: "memory");
        } else {
            XB_SPIN(xb_ld(&bar[XB_XGEN(b.x)]) == gen, bar);
            __builtin_amdgcn_fence(__ATOMIC_ACQUIRE, "agent");
            asm volatile("s_waitcnt vmcnt(0)" ::: "memory");
        }
    }
    __syncthreads();
}

struct Args { const void* in[26]; float* out; unsigned char* ws; int ph_lo, ph_hi; };
struct Frame {
    LAS unsigned char* lds;
    int tid, lane, wave, G, bid;
    const Args* ap;
    float* out; unsigned char* ws;
};
#define WSP(T, off) ((T*)(F.ws + (off)))

__device__ __forceinline__ void tr_item(const float* __restrict__ src, int ld, int k0, int c0, int nvalid, bf16_t* dst, int ldd, LAS float* scr, int lane) {
    const int c4 = (lane & 7) * 4, rr = lane >> 3;
    if (nvalid == 32 && ((c0 | ld) & 3) == 0) {
        f32x4 v[8];
#pragma unroll
        for (int i = 0; i < 8; ++i) v[i] = *(const f32x4*)(src + (size_t)(k0 + 8 * i + rr) * ld + c0 + c4);
#pragma unroll
        for (int i = 0; i < 8; ++i) { LAS float* p = scr + (8 * i + rr) * 33 + c4; p[0] = v[i].x; p[1] = v[i].y; p[2] = v[i].z; p[3] = v[i].w; }
    } else {
#pragma unroll 8
        for (int i = 0; i < 32; ++i) { const int kk = 2 * i + (lane >> 5), cc = lane & 31;
            scr[kk * 33 + cc] = (cc < nvalid) ? src[(size_t)(k0 + kk) * ld + c0 + cc] : 0.f; }
    }
    asm volatile("s_waitcnt lgkmcnt(0)" ::: "memory");
    const int c = lane & 7;
#pragma unroll
    for (int j = 0; j < 4; ++j) { const int n = (lane >> 3) + 8 * j; const LAS float* s = scr + (8 * c) * 33 + n;
        u32x4 o; o.x = cvt_pk_bf16(s[0 * 33], s[1 * 33]); o.y = cvt_pk_bf16(s[2 * 33], s[3 * 33]); o.z = cvt_pk_bf16(s[4 * 33], s[5 * 33]); o.w = cvt_pk_bf16(s[6 * 33], s[7 * 33]);
        *(u32x4*)(dst + (size_t)n * ldd + k0 + 8 * c) = o; }
    asm volatile("s_waitcnt lgkmcnt(0)" ::: "memory");
}
constexpr float W8_SCALE = 32.f;
__device__ __forceinline__ void tr_item8(const float* __restrict__ src, int ld, int k0, int c0, int nvalid, unsigned char* dst, int ldd, LAS float* scr, int lane) {
    const int c4 = (lane & 7) * 4, rr = lane >> 3;
    if (nvalid == 32 && ((c0 | ld) & 3) == 0) {
        f32x4 v[8];
#pragma unroll
        for (int i = 0; i < 8; ++i) v[i] = *(const f32x4*)(src + (size_t)(k0 + 8 * i + rr) * ld + c0 + c4);
#pragma unroll
        for (int i = 0; i < 8; ++i) { LAS float* p = scr + (8 * i + rr) * 33 + c4; p[0] = v[i].x; p[1] = v[i].y; p[2] = v[i].z; p[3] = v[i].w; }
    } else {
#pragma unroll 8
        for (int i = 0; i < 32; ++i) { const int kk = 2 * i + (lane >> 5), cc = lane & 31;
            scr[kk * 33 + cc] = (cc < nvalid) ? src[(size_t)(k0 + kk) * ld + c0 + cc] : 0.f; }
    }
    asm volatile("s_waitcnt lgkmcnt(0)" ::: "memory");
    const int c = lane & 7;
#pragma unroll
    for (int j = 0; j < 4; ++j) { const int n = (lane >> 3) + 8 * j; const LAS float* s = scr + (8 * c) * 33 + n;
        u32x2 o; o.x = pk4_fp8(s[0 * 33] * W8_SCALE, s[1 * 33] * W8_SCALE, s[2 * 33] * W8_SCALE, s[3 * 33] * W8_SCALE); o.y = pk4_fp8(s[4 * 33] * W8_SCALE, s[5 * 33] * W8_SCALE, s[6 * 33] * W8_SCALE, s[7 * 33] * W8_SCALE);
        *(u32x2*)(dst + (size_t)n * ldd + k0 + 8 * c) = o; }
    asm volatile("s_waitcnt lgkmcnt(0)" ::: "memory");
}
__device__ __forceinline__ void p0_phase(Frame& F) {
    LAS float* cond = (LAS float*)(F.lds + 8 * 8448);
    LAS float* part = (LAS float*)(F.lds + 8 * 8448 + 32768);
    for (int i = F.tid; i < BATCH * DM; i += NTHREADS) { const float v = ((const float*)F.ap->in[1])[i]; cond[i] = v * __builtin_amdgcn_rcpf(1.f + __expf(-v)); }
    __syncthreads();
#pragma unroll 1
    for (int item = F.bid; item < 384; item += F.G) {
        const int col = item * 16 + (F.lane & 15), kq = F.lane >> 4, kb = 128 * F.wave + kq;
        const float* wp = ((const float*)F.ap->in[2]) + (size_t)kb * 6144 + col;
        float wv[32];
#pragma unroll
        for (int i = 0; i < 32; ++i) wv[i] = wp[(size_t)(4 * i) * 6144];
        float acc[8];
#pragma unroll
        for (int b = 0; b < 8; ++b) acc[b] = 0.f;
#pragma unroll
        for (int i = 0; i < 32; ++i) {
#pragma unroll
            for (int b = 0; b < 8; ++b) acc[b] += cond[b * DM + kb + 4 * i] * wv[i]; }
#pragma unroll
        for (int b = 0; b < 8; ++b) { float v = acc[b]; v += __shfl_xor(v, 16); v += __shfl_xor(v, 32); acc[b] = v; }
        if (kq == 0) {
#pragma unroll
            for (int b = 0; b < 8; ++b) part[(F.wave * 8 + b) * 16 + (F.lane & 15)] = acc[b]; }
        __syncthreads();
        if (F.tid < 128) { const int b = F.tid >> 4, c = F.tid & 15; float s = ((const float*)F.ap->in[3])[item * 16 + c];
#pragma unroll
            for (int w = 0; w < 8; ++w) s += part[(w * 8 + b) * 16 + c];
            WSP(float, WS_MOD)[b * 6144 + item * 16 + c] = s; }
        __syncthreads();
    }
    LAS float* scr = (LAS float*)(F.lds + F.wave * 8448);
    const int gw = F.bid * NWAVES + F.wave, NGW = F.G * NWAVES;
    constexpr int I_WIN = 16 * 128, I_WP = 8 * 32, I_WO = 16 * 32, I_W13 = 32 * 256, I_W2 = 32 * 128;
    constexpr int NITEMS = I_WIN + 2 * I_WP + I_WO + I_W13 + I_W2;
    for (int it = gw; it < NITEMS; it += NGW) {
        int r = it;
        if (r < I_WIN) { const int kb = r / 128, nb = r % 128, n0 = 32 * nb; int c0, nv;
            if (n0 < C_LX) { c0 = n0; nv = 32; } else if (n0 < C_WI) { c0 = n0 + 4; nv = 32; } else if (n0 == C_WI) { c0 = 960; nv = 4; } else if (n0 < C_GA) { c0 = 0; nv = 0; } else { c0 = n0 - 60; nv = 32; }
            if (n0 < C_GA) tr_item(((const float*)F.ap->in[5]), 4036, 64 * kb, c0, nv, WSP(bf16_t, WS_WIN) + (size_t)n0 * 1024, 1024, scr, F.lane);
            else tr_item8(((const float*)F.ap->in[5]), 4036, 64 * kb, c0, nv, WSP(unsigned char, WS_WIN8) + (size_t)(n0 - C_GA) * 1024, 1024, scr, F.lane);
            continue; } r -= I_WIN;
        if (r < I_WP) { const int kb = r / 32, nb = r % 32; tr_item(((const float*)F.ap->in[15]), 1024, 64 * kb, 32 * nb, 32, WSP(bf16_t, WS_WPA) + (size_t)(32 * nb) * 512, 512, scr, F.lane); continue; } r -= I_WP;
        if (r < I_WP) { const int kb = r / 32, nb = r % 32; tr_item(((const float*)F.ap->in[16]), 1024, 64 * kb, 32 * nb, 32, WSP(bf16_t, WS_WPB) + (size_t)(32 * nb) * 512, 512, scr, F.lane); continue; } r -= I_WP;
        if (r < I_WO) { const int kb = r / 32, nb = r % 32; tr_item(((const float*)F.ap->in[17]), 1024, 64 * kb, 32 * nb, 32, WSP(bf16_t, WS_WOUT) + (size_t)(32 * nb) * 1024, 1024, scr, F.lane); continue; } r -= I_WO;
        if (r < I_W13) { const int e = r / 256, r2 = r % 256, kb = r2 / 16, nb = r2 % 16, n0 = 32 * nb, j = n0 >> 8, half = (n0 >> 7) & 1, cc0 = n0 & 127;
            const float* src = (half ? ((const float*)F.ap->in[24]) : ((const float*)F.ap->in[23])) + (size_t)e * 1024 * 256;
            tr_item8(src, 256, 64 * kb, 128 * j + cc0, 32, WSP(unsigned char, WS_W13) + ((size_t)e * 512 + n0) * 1024, 1024, scr, F.lane); continue; } r -= I_W13;
        { const int e = r / 128, r2 = r % 128, kb = r2 / 32, nb = r2 % 32;
            tr_item(((const float*)F.ap->in[25]) + (size_t)e * 256 * 1024, 1024, 64 * kb, 32 * nb, 32, WSP(bf16_t, WS_W2) + ((size_t)e * 1024 + 32 * nb) * 256, 256, scr, F.lane); }
    }
    for (int i = F.bid * NTHREADS + F.tid; i < 48 * 1024; i += F.G * NTHREADS) { const int r = i >> 10, k = i & 1023;
        const float v = r < 4 ? ((const float*)F.ap->in[19])[k * 4 + r] : r < 36 ? ((const float*)F.ap->in[21])[k * 32 + (r - 4)] : 0.f;
        const unsigned hi = f2bf(v); const float rem = v - bf2f((unsigned short)hi);
        WSP(bf16_t, WS_WRH)[i] = (bf16_t)hi; WSP(bf16_t, WS_WRL)[i] = (bf16_t)f2bf(rem); }
}

__device__ __forceinline__ void p1a_phase(Frame& F) {
    const int gw = F.bid * NWAVES + F.wave, NGW = F.G * NWAVES;
    const float* mod = WSP(float, WS_MOD);
    bf16_t* H = WSP(bf16_t, WS_H);
    const float* nmw = (const float*)F.ap->in[4];
#pragma unroll 1
    for (int row0 = 4 * gw; row0 < NTOK; row0 += 4 * NGW) {
        const int b = row0 / SEQ;
        f32x4 v[4][4];
#pragma unroll
        for (int r = 0; r < 4; ++r) { const f32x4* xr = (const f32x4*)(((const float*)F.ap->in[0]) + (size_t)(row0 + r) * DM) + F.lane;
#pragma unroll
            for (int j = 0; j < 4; ++j) v[r][j] = xr[64 * j]; }
        f32x4 gg[4], sh[4];
#pragma unroll
        for (int j = 0; j < 4; ++j) { const int col = 4 * F.lane + 256 * j; gg[j] = *(const f32x4*)(nmw + col) * (*(const f32x4*)(mod + b * 6144 + 1024 + col) + 1.f); sh[j] = *(const f32x4*)(mod + b * 6144 + col); }
#pragma unroll
        for (int r = 0; r < 4; ++r) { float s = 0.f;
#pragma unroll
            for (int j = 0; j < 4; ++j) s += (v[r][j].x * v[r][j].x + v[r][j].y * v[r][j].y) + (v[r][j].z * v[r][j].z + v[r][j].w * v[r][j].w);
            const float rinv = rsqrtf(wave_sum(s) * (1.f / DM) + EPS);
            unsigned long long* o8 = (unsigned long long*)(H + (size_t)(row0 + r) * DM) + F.lane;
            unsigned* o4 = (unsigned*)(F.ws + WS_H8 + (size_t)(row0 + r) * DM) + F.lane;
#pragma unroll
            for (int j = 0; j < 4; ++j) { const f32x4 hv = v[r][j] * rinv * gg[j] + sh[j];
                o8[64 * j] = (unsigned long long)cvt_pk_bf16(hv.x, hv.y) | ((unsigned long long)cvt_pk_bf16(hv.z, hv.w) << 32); o4[64 * j] = pk4_fp8(hv.x, hv.y, hv.z, hv.w); } }
    }
}

struct Unit { const bf16_t* A; const bf16_t* B; int pm, pn, aux, flags; const int* gidx; };
template <bool PERM, class Sched, class Epi>
__device__ __forceinline__ void gemm_naive(int lda, int ldb, int K, const Sched& S, const Epi& E) {
    const int tid = threadIdx.x, wid = __builtin_amdgcn_readfirstlane(tid >> 6), lane = tid & 63, wr = wid >> 2, wc = wid & 3, fr = lane & 15, fq = lane >> 4;
    f32x4 acc[2][2][4][2];
    Unit u;
    for (int i = 0; S.next(i, u); ++i) {
        if (!(u.flags & 1)) {
#pragma unroll
            for (int a = 0; a < 2; ++a)
#pragma unroll
                for (int b = 0; b < 2; ++b)
#pragma unroll
                    for (int m = 0; m < 4; ++m)
#pragma unroll
                        for (int n = 0; n < 2; ++n) acc[a][b][m][n] = (f32x4){0.f, 0.f, 0.f, 0.f};
        }
#pragma unroll 1
        for (int k0 = 0; k0 < K; k0 += 32) {
            bf16x8 bfr[2][2];
#pragma unroll
            for (int bj = 0; bj < 2; ++bj)
#pragma unroll
                for (int n = 0; n < 2; ++n) { const int rho = 16 * n + fr, rr = PERM ? perm32(rho) : rho;
                    bfr[bj][n] = *(const bf16x8*)(u.B + (size_t)(128 * bj + 32 * wc + rr) * ldb + k0 + 8 * fq); }
#pragma unroll
            for (int ai = 0; ai < 2; ++ai) {
                bf16x8 af[4];
#pragma unroll
                for (int m = 0; m < 4; ++m) af[m] = *(const bf16x8*)(u.A + (size_t)(128 * ai + 64 * wr + 16 * m + fr) * lda + k0 + 8 * fq);
#pragma unroll
                for (int bj = 0; bj < 2; ++bj)
#pragma unroll
                    for (int m = 0; m < 4; ++m)
#pragma unroll
                        for (int n = 0; n < 2; ++n) acc[ai][bj][m][n] = __builtin_amdgcn_mfma_f32_16x16x32_bf16(bfr[bj][n], af[m], acc[ai][bj][m][n], 0, 0, 0);
            }
        }
        if (!(u.flags & 2)) E(acc, u, wr, wc, fr, fq);
    }
}


namespace pg8 {
constexpr int BK = 64, HALF = 128, HTB = HALF * BK * 2;
__device__ __forceinline__ int lds_byte(int r, int c) { const int st = (r >> 4) * 2 + (c >> 5), rr = r & 15, cc = c & 31, ob = rr * 64 + cc * 2; return st * 1024 + (ob ^ (((ob >> 9) & 1) << 5)); }
__device__ __forceinline__ void stage_rc(int b, int& R, int& C) { const int st = b / 1024, sb = b % 1024, swz = sb ^ (((sb >> 9) & 1) << 5); R = (st >> 1) * 16 + swz / 64; C = (st & 1) * 32 + (swz % 64) / 2; }
template <class Epi, class Sched, bool ALIGN_EPI, bool GATHER = false, bool FP8 = false>
__device__ __forceinline__ void gemm_phase(LAS unsigned char* lds, int lda, int ldb, int K, const Sched& S, const Epi& E) {
    int tid_ = threadIdx.x; asm volatile("" : "+v"(tid_));
    const int tid = tid_, wid = __builtin_amdgcn_readfirstlane(tid >> 6), lane = tid & 63, wr = wid >> 2, wc = wid & 3, fr = lane & 15, fq = lane >> 4;
    const int nt = K / BK;
    unsigned voffA[2], voffB[2];
#pragma unroll
    for (int i = 0; i < 2; ++i) { int R, C; stage_rc(tid * 16 + i * 8192, R, C); const int Rb = Epi::PERM ? ((R & ~31) + perm32(R & 31)) : R;
        voffA[i] = (unsigned)(R * lda + C) * 2u; voffB[i] = (unsigned)(Rb * ldb + C) * 2u; }
    const size_t kstep = (size_t)(BK * 2);
    const size_t hstepA = GATHER ? 0 : (size_t)HALF * lda * 2, hstepB = (size_t)HALF * ldb * 2;
    unsigned gC[2], gN[2], gcol[2];
#pragma unroll
    for (int i_ = 0; i_ < 2; ++i_) { int R_, C_; stage_rc(tid * 16 + i_ * 8192, R_, C_); gcol[i_] = (unsigned)C_ * 2u; }
#define PG8_GOFF(dst, u) do { _Pragma("unroll") for (int h_ = 0; h_ < 2; ++h_) { unsigned pk_ = 0u; _Pragma("unroll") for (int i_ = 0; i_ < 2; ++i_) { int R_, C_; stage_rc(tid * 16 + i_ * 8192, R_, C_); \
        const int row_ = h_ * HALF + R_; const unsigned tok_ = (unsigned)(u).gidx[4 * (row_ < (u).aux ? row_ : 0)]; pk_ |= tok_ << (16 * i_); } dst[h_] = pk_; } } while (0)
    const unsigned ldsw = (unsigned)wid * 1024u;
    const int aoff = FP8 ? lds_byte(wr * 64 + fr, fq * 16) : lds_byte(wr * 64 + fr, fq * 8), boff = FP8 ? lds_byte(wc * 32 + fr, fq * 16) : lds_byte(wc * 32 + fr, fq * 8);
#define PG8_SA(b, h) (((b) * 2 + (h)) * HTB)
#define PG8_SB(b, h) ((4 + (b) * 2 + (h)) * HTB)
#define PG8_STAGE(bufoff, gbase, voff) do { _Pragma("unroll") for (int _i = 0; _i < 2; ++_i) \
        __builtin_amdgcn_global_load_lds((const unsigned*)((const char*)(gbase) + (voff)[_i]), (LAS unsigned*)(lds + (bufoff) + ldsw + _i * 8192), 16, 0, 0); } while (0)
#define PG8_STAGE_A(b, h, gbase, nx) do { if constexpr (GATHER) { const unsigned pk_ = (nx) ? gN[h] : gC[h]; unsigned vo_[2]; vo_[0] = (pk_ & 0xffffu) * (unsigned)(lda * 2) + gcol[0]; vo_[1] = (pk_ >> 16) * (unsigned)(lda * 2) + gcol[1]; PG8_STAGE(PG8_SA(b, h), gbase, vo_); } \
        else PG8_STAGE(PG8_SA(b, h), (gbase) + (h) * hstepA, voffA); } while (0)
#define PG8_LDA8(dst, b, h) do { _Pragma("unroll") for (int m = 0; m < 4; ++m) { const LAS u32x4* p_ = (const LAS u32x4*)(lds + PG8_SA(b, h) + aoff + m * 2048); const u32x4 x_ = p_[0], y_ = p_[1]; \
        dst[m] = __builtin_bit_cast(v8i32, __builtin_shufflevector(x_, y_, 0, 1, 2, 3, 4, 5, 6, 7)); } } while (0)
#define PG8_LDB8(dst, b, h) do { _Pragma("unroll") for (int n = 0; n < 2; ++n) { const LAS u32x4* p_ = (const LAS u32x4*)(lds + PG8_SB(b, h) + boff + n * 2048); const u32x4 x_ = p_[0], y_ = p_[1]; \
        dst[n] = __builtin_bit_cast(v8i32, __builtin_shufflevector(x_, y_, 0, 1, 2, 3, 4, 5, 6, 7)); } } while (0)
#define PG8_MMA8(ai, bj, At, Bt) do { __builtin_amdgcn_s_setprio(1); _Pragma("unroll") for (int m = 0; m < 4; ++m) _Pragma("unroll") for (int n = 0; n < 2; ++n) \
        asm volatile("v_mfma_scale_f32_16x16x128_f8f6f4 %0, %1, %2, %0, %3, %4 op_sel_hi:[0,0,0]" : "+v"(acc[ai][bj][m][n]) : "v"(Bt[n]), "v"(At[m]), "v"(sclW), "v"(sclA));   \
        __builtin_amdgcn_s_setprio(0); } while (0)
#define PG8_LDA(dst, b, h) do { _Pragma("unroll") for (int m = 0; m < 4; ++m) _Pragma("unroll") for (int k = 0; k < 2; ++k) dst[m][k] = *(const LAS bf16x8*)(lds + PG8_SA(b, h) + aoff + m * 2048 + k * 1024); } while (0)
#define PG8_LDB(dst, b, h) do { _Pragma("unroll") for (int n = 0; n < 2; ++n) _Pragma("unroll") for (int k = 0; k < 2; ++k) dst[n][k] = *(const LAS bf16x8*)(lds + PG8_SB(b, h) + boff + n * 2048 + k * 1024); } while (0)
#define PG8_MMA(ai, bj, At, Bt) do { __builtin_amdgcn_s_setprio(1); _Pragma("unroll") for (int m = 0; m < 4; ++m) _Pragma("unroll") for (int n = 0; n < 2; ++n) _Pragma("unroll") for (int k = 0; k < 2; ++k) \
        acc[ai][bj][m][n] = __builtin_amdgcn_mfma_f32_16x16x32_bf16(Bt[n][k], At[m][k], acc[ai][bj][m][n], 0, 0, 0); __builtin_amdgcn_s_setprio(0); } while (0)
#define PG8_WAIT_V(n) asm volatile("s_waitcnt vmcnt(" #n ")" ::: "memory")
#define PG8_WAIT_L(n) asm volatile("s_waitcnt lgkmcnt(" #n ")" ::: "memory")
#define PG8_BAR __builtin_amdgcn_s_barrier()
#define PG8_SCHED __builtin_amdgcn_sched_barrier(0)
#define PG8_ZERO() do { _Pragma("unroll") for (int a = 0; a < 2; ++a) _Pragma("unroll") for (int b = 0; b < 2; ++b) _Pragma("unroll") for (int m = 0; m < 4; ++m) _Pragma("unroll") for (int n = 0; n < 2; ++n) acc[a][b][m][n] = (f32x4){0.f, 0.f, 0.f, 0.f}; } while (0)
    Unit cur, nxt; int ui = 0;
    if (!S.next(0, cur)) return;
    f32x4 acc[2][2][4][2];
    PG8_ZERO();
    bf16x8 At[4][2], B0[2][2], B1[2][2]; v8i32 At8[4], B08[2], B18[2];
    int sclW = 0x7a7a7a7a, sclA = 0x7f7f7f7f; asm volatile("" : "+v"(sclW), "+v"(sclA));
#define PG8_XLDA(b, h) do { if constexpr (FP8) PG8_LDA8(At8, b, h); else PG8_LDA(At, b, h); } while (0)
#define PG8_XLDB0(b, h) do { if constexpr (FP8) PG8_LDB8(B08, b, h); else PG8_LDB(B0, b, h); } while (0)
#define PG8_XLDB1(b, h) do { if constexpr (FP8) PG8_LDB8(B18, b, h); else PG8_LDB(B1, b, h); } while (0)
#define PG8_XMMA0(ai, bj) do { if constexpr (FP8) PG8_MMA8(ai, bj, At8, B08); else PG8_MMA(ai, bj, At, B0); } while (0)
#define PG8_XMMA1(ai, bj) do { if constexpr (FP8) PG8_MMA8(ai, bj, At8, B18); else PG8_MMA(ai, bj, At, B1); } while (0)
    const char* cA = (const char*)cur.A; const char* cB = (const char*)cur.B;
    if constexpr (GATHER) { PG8_GOFF(gC, cur); gN[0] = gC[0]; gN[1] = gC[1]; }
    PG8_STAGE(PG8_SB(0, 0), cB, voffB); PG8_STAGE(PG8_SB(0, 1), cB + hstepB, voffB); PG8_STAGE_A(0, 0, cA, false); PG8_STAGE_A(0, 1, cA, false);
    if (wr == 1) PG8_BAR;
    PG8_WAIT_V(2); PG8_BAR;
    PG8_STAGE(PG8_SB(1, 0), cB + kstep, voffB); PG8_STAGE_A(1, 0, cA + kstep, false); PG8_STAGE(PG8_SB(1, 1), cB + hstepB + kstep, voffB);
    PG8_WAIT_V(6); PG8_BAR;
    int pre_tk[8];
    for (;;) {
        const bool has_next = S.next(ui + 1, nxt);
        if constexpr (Epi::PRE) { if (!(cur.flags & 1)) E.prefetch(pre_tk, cur, wr, wc, fr, fq); }
        const char* nA = has_next ? (const char*)nxt.A : cA; const char* nB = has_next ? (const char*)nxt.B : cB;
        if constexpr (GATHER) { if (has_next) PG8_GOFF(gN, nxt); }
#pragma unroll 1
        for (int t = 0; t < nt; t += 2) {
            const bool last = (t == nt - 2);
            const char* a1 = cA + (size_t)(t + 1) * kstep;
            const char* a2 = last ? nA : cA + (size_t)(t + 2) * kstep; const char* b2 = last ? nB : cB + (size_t)(t + 2) * kstep;
            const char* a3 = a2 + kstep; const char* b3 = b2 + kstep;
            const bool nx = last && has_next;
            PG8_XLDB0(0, 0); PG8_XLDB1(0, 1); PG8_SCHED; PG8_XLDA(0, 0); PG8_STAGE_A(1, 1, a1, false);
            PG8_WAIT_V(8); PG8_WAIT_L(0); PG8_BAR; PG8_XMMA0(0, 0); PG8_XMMA1(0, 1); PG8_BAR; PG8_SCHED;
            PG8_XLDA(0, 1); PG8_STAGE(PG8_SB(0, 0), b2, voffB); PG8_STAGE(PG8_SB(0, 1), b2 + hstepB, voffB); PG8_STAGE_A(0, 0, a2, nx);
            PG8_WAIT_V(8); PG8_WAIT_L(0); PG8_BAR; PG8_XMMA0(1, 0); PG8_XMMA1(1, 1); PG8_BAR; PG8_SCHED;
            PG8_XLDB0(1, 0); PG8_XLDB1(1, 1); PG8_SCHED; PG8_XLDA(1, 0); PG8_STAGE_A(0, 1, a2, nx);
            PG8_WAIT_V(8); PG8_WAIT_L(0); PG8_BAR; PG8_XMMA0(0, 0); PG8_XMMA1(0, 1); PG8_BAR; PG8_SCHED;
            PG8_XLDA(1, 1); PG8_STAGE(PG8_SB(1, 0), b3, voffB); PG8_STAGE(PG8_SB(1, 1), b3 + hstepB, voffB); PG8_STAGE_A(1, 0, a3, nx);
            PG8_WAIT_V(8); PG8_WAIT_L(0); PG8_BAR; PG8_XMMA0(1, 0); PG8_XMMA1(1, 1); PG8_BAR; PG8_SCHED;
        }
        if constexpr (ALIGN_EPI) { if (wr == 0) PG8_BAR; }
        if constexpr (FP8) asm volatile("s_nop 15\n\ts_nop 7" ::: "memory");
        if (!(cur.flags & 2)) { if constexpr (Epi::PRE) E(acc, cur, wr, wc, fr, fq, pre_tk); else E(acc, cur, wr, wc, fr, fq); }
        if (!has_next) break;
        if (!(nxt.flags & 1)) PG8_ZERO();
        cur = nxt; cA = nA; cB = nB; ++ui;
        if constexpr (GATHER) { gC[0] = gN[0]; gC[1] = gN[1]; }
        if constexpr (ALIGN_EPI) { if (wr == 1) PG8_BAR; }
    }
    PG8_WAIT_V(0);
    if constexpr (!ALIGN_EPI) { if (wr == 0) PG8_BAR; }
    PG8_BAR;
#undef PG8_SA
#undef PG8_SB
#undef PG8_STAGE
#undef PG8_XLDA
#undef PG8_XLDB0
#undef PG8_XLDB1
#undef PG8_XMMA0
#undef PG8_XMMA1
#undef PG8_LDA8
#undef PG8_LDB8
#undef PG8_MMA8
#undef PG8_STAGE_A
#undef PG8_GOFF
#undef PG8_LDA
#undef PG8_LDB
#undef PG8_MMA
#undef PG8_WAIT_V
#undef PG8_WAIT_L
#undef PG8_BAR
#undef PG8_SCHED
#undef PG8_ZERO
}
}
#ifndef MK_NAIVE_GEMM
#define MK_NAIVE_GEMM 0
#endif
template <bool GATHER = false, bool FP8 = false, class Sched, class Epi>
__device__ __forceinline__ void run_gemm(LAS unsigned char* lds, int lda, int ldb, int K, const Sched& S, const Epi& E) {
    pg8::gemm_phase<Epi, Sched, true, GATHER, FP8>(lds, lda, ldb, K, S, E);
}

struct SchedProj { const bf16_t* A; const bf16_t* B; int rowu  , pn0  , G, c;
    __device__ __forceinline__ bool next(int i, Unit& u) const { const int L = i * G + c; if (L >= 64 * 8) return false;
        const int gid = L / 64, w = L % 64; u.pm = gid * 8 + (w % 8); u.pn = pn0 + w / 8;
        u.A = A + (size_t)u.pm * 256 * rowu; u.B = B + (size_t)(w / 8) * 256 * rowu; u.aux = 0; u.flags = 0; u.gidx = nullptr; return true; } };
struct EpiProj {
    static constexpr bool PERM = true; static constexpr bool PRE = false;
    unsigned char* ws;
    __device__ __forceinline__ void operator()(const f32x4 (&acc)[2][2][4][2], const Unit& u, int wr, int wc, int fr, int fq) const {
#pragma unroll
        for (int bj = 0; bj < 2; ++bj) {
            const int cg = u.pn * 256 + bj * 128 + wc * 32;
            const int col = cg + 8 * fq;
            bf16_t* dst; int ld, cb; int mode = 0;
            bf16_t* const Vt = (bf16_t*)(ws + WS_VT); float* const WI = (float*)(ws + WS_WI);
            if (cg < C_K) { dst = (bf16_t*)(ws + WS_Q); ld = 512; cb = C_Q; }
            else if (cg < C_V) { dst = (bf16_t*)(ws + WS_K); ld = 64; cb = C_K; }
            else if (cg < C_QI) { dst = (bf16_t*)(ws + WS_VR); ld = 64; cb = C_V; mode = 2; }
            else if (cg < C_KI) { dst = (bf16_t*)(ws + WS_QI); ld = 256; cb = C_QI; }
            else if (cg < C_LX) { dst = (bf16_t*)(ws + WS_KI); ld = 64; cb = C_KI; }
            else if (cg < C_LG) { dst = (bf16_t*)(ws + WS_LX); ld = 512; cb = C_LX; }
            else if (cg < C_WI) { dst = (bf16_t*)(ws + WS_LG); ld = 512; cb = C_LG; }
            else if (cg < C_PAD + 28) { dst = nullptr; ld = 0; cb = C_WI; mode = 3; }
            else if (cg < C_GA) continue;
            else if (cg < C_GB) { dst = (bf16_t*)(ws + WS_GA); ld = 1024; cb = C_GA; mode = 1; }
            else { dst = (bf16_t*)(ws + WS_GB); ld = 1024; cb = C_GB; mode = 1; }
#pragma unroll
            for (int ai = 0; ai < 2; ++ai)
#pragma unroll
                for (int m = 0; m < 4; ++m) {
                    const int row = u.pm * 256 + ai * 128 + wr * 64 + m * 16 + fr;
                    f32x4 v0 = acc[ai][bj][m][0], v1 = acc[ai][bj][m][1];
                    if (mode == 3) { if (fq == 0) *(f32x4*)(WI + (size_t)row * 4) = v0; continue; }
                    if (mode == 1) {
#pragma unroll
                        for (int e = 0; e < 4; ++e) { v0[e] = sigmoidf_(v0[e]); v1[e] = sigmoidf_(v1[e]); } }
                    u32x4 w; w.x = pk2(v0[0], v0[1]); w.y = pk2(v0[2], v0[3]); w.z = pk2(v1[0], v1[1]); w.w = pk2(v1[2], v1[3]);
                    if (mode != 2) *(u32x4*)(dst + (size_t)row * ld + (col - cb)) = w;
                    if (mode == 2) {
                        const int b = row / SEQ, t = row % SEQ, d0 = col - cb; bf16_t* vp = Vt + ((size_t)b * 64 + d0) * SEQ + (t & ~15) + vt_pos(t & 15);
                        vp[0 * SEQ] = (bf16_t)(w.x & 0xffff); vp[1 * SEQ] = (bf16_t)(w.x >> 16); vp[2 * SEQ] = (bf16_t)(w.y & 0xffff); vp[3 * SEQ] = (bf16_t)(w.y >> 16);
                        vp[4 * SEQ] = (bf16_t)(w.z & 0xffff); vp[5 * SEQ] = (bf16_t)(w.z >> 16); vp[6 * SEQ] = (bf16_t)(w.w & 0xffff); vp[7 * SEQ] = (bf16_t)(w.w >> 16); }
                }
        }
    }
};

__device__ __forceinline__ unsigned fbits(float f) { return __builtin_bit_cast(unsigned, f); }
__device__ __forceinline__ float bitsf(unsigned u) { return __builtin_bit_cast(float, u); }
__device__ __forceinline__ unsigned bfi_b32(unsigned m, unsigned a, unsigned b) { return __builtin_amdgcn_bitop3_b32(a, b, m, 0xe4); }
__device__ __forceinline__ float xor32_max(float x) { typedef unsigned u32x2_ __attribute__((ext_vector_type(2))); const unsigned u = __builtin_bit_cast(unsigned, x);
    const u32x2_ r = __builtin_amdgcn_permlane32_swap(u, u, false, false); return fmaxf(__builtin_bit_cast(float, r.x), __builtin_bit_cast(float, r.y)); }
__device__ __forceinline__ float sum8_dpp(float s) {
    s += __builtin_bit_cast(float, __builtin_amdgcn_update_dpp(0, __builtin_bit_cast(int, s), 0xB1, 0xf, 0xf, true));
    s += __builtin_bit_cast(float, __builtin_amdgcn_update_dpp(0, __builtin_bit_cast(int, s), 0x4E, 0xf, 0xf, true));
    s += __builtin_bit_cast(float, __builtin_amdgcn_update_dpp(0, __builtin_bit_cast(int, s), 0x141, 0xf, 0xf, true));
    return s; }
__device__ __forceinline__ unsigned sortkey(float f) { const unsigned u = __builtin_bit_cast(unsigned, f); return (u & 0x80000000u) ? ~u : (u | 0x80000000u); }
typedef float f32x16 __attribute__((ext_vector_type(16)));
constexpr int AL_QI = 0, AL_HIST = 16896, AL_MASK = 49792, AL_EQ = 57984, AL_RK = 66176, AL_QST = 74368, AL_FLAG = 74368 + 512, AL_OST = 75008, AL_KV = AL_HIST  , KT_STRIDE = 144, VT_STRIDE = 80, KT_BYTES = 32 * KT_STRIDE, KV_BUF = KT_BYTES + 64 * VT_STRIDE, AL_END = AL_OST + 8 * 4608;
static_assert(2 * KV_BUF <= 32 * 257 * 4, "K/V ring fits the histogram region");
constexpr int QI_STRIDE = 528, HIST_STRIDE = 257, OST_STRIDE = 144;
static_assert(AL_END <= RING_BYTES, "attention LDS map");
__device__ __forceinline__ int crow(int i, int hi) { return (i & 3) + 8 * (i >> 2) + 4 * hi; }
__device__ __forceinline__ void attn_unit(Frame& F, int b, int c, int half) {
    int tid_ = F.tid, w_ = F.wave; asm volatile("" : "+v"(tid_), "+s"(w_));
    const int tid = tid_, lane = tid & 63, w = w_, r32 = lane & 31, hi = lane >> 5;
    const int t0 = 64 * c + 32 * half, nk = 64 * (c + 1), ntile = nk >> 5, tok0 = b * SEQ + t0;
    LAS unsigned char* L = F.lds;
    LAS unsigned* hist = (LAS unsigned*)(L + AL_HIST); LAS unsigned* maskw = (LAS unsigned*)(L + AL_MASK); LAS unsigned* eqw = (LAS unsigned*)(L + AL_EQ);
    LAS float* rkL = (LAS float*)(L + AL_RK); LAS unsigned* qst = (LAS unsigned*)(L + AL_QST); LAS unsigned* flagw = (LAS unsigned*)(L + AL_FLAG);
    const bf16_t* KI = WSP(bf16_t, WS_KI) + (size_t)b * SEQ * 64;
    const bf16_t* Kb = WSP(bf16_t, WS_K) + (size_t)b * SEQ * 64;
    const bf16_t* Vt = WSP(bf16_t, WS_VT) + (size_t)b * 64 * SEQ;
    const bool do_sel = nk > TOPK;
    __syncthreads();
#if MK_LEAK >= 0
    const unsigned long long tu0_ = __builtin_amdgcn_s_memrealtime();
#endif
    { const bf16_t* QI = WSP(bf16_t, WS_QI) + (size_t)tok0 * 256;
#pragma unroll
      for (int i = 0; i < 2; ++i) { const int idx = tid + 512 * i, row = idx >> 5, ch = idx & 31;
          *(LAS u32x4*)(L + AL_QI + row * QI_STRIDE + ch * 16) = *(const u32x4*)(QI + (size_t)row * 256 + ch * 8); } }
    if (tid == 0) flagw[0] = 0u;
    if (tid < 32) { qst[tid * 4 + 0] = 0u; qst[tid * 4 + 1] = (unsigned)TOPK; qst[tid * 4 + 2] = 0u; qst[tid * 4 + 3] = 0u; }
    __syncthreads();
    f32x16 sc[8];
    if (do_sel) {
        const f32x4 wv = *(const f32x4*)(WSP(float, WS_WI) + (size_t)(tok0 + r32) * 4) * 0.0625f;
        bf16x8 afn[4];
        { int roff = (32 * w + r32) * 64 + 8 * hi; asm volatile("" : "+v"(roff));
#pragma unroll
          for (int ks = 0; ks < 4; ++ks) afn[ks] = *(const bf16x8*)(KI + roff + 16 * ks); }
#pragma unroll
        for (int j = 0; j < 8; ++j) {
            const int kt = w + 8 * j;
#pragma unroll
            for (int i = 0; i < 16; ++i) sc[j][i] = 0.f;
            if (kt < ntile) {
                bf16x8 af[4];
#pragma unroll
                for (int ks = 0; ks < 4; ++ks) af[ks] = afn[ks];
                if (j < 7 && kt + 8 < ntile) { int roff = (32 * (kt + 8) + r32) * 64 + 8 * hi; asm volatile("" : "+v"(roff));
#pragma unroll
                    for (int ks = 0; ks < 4; ++ks) afn[ks] = *(const bf16x8*)(KI + roff + 16 * ks); }
                int qoff = r32 * QI_STRIDE + hi * 16; asm volatile("" : "+v"(qoff));
                bf16x8 qA[4], qB[4];
#define ATT_QLD(Q, H) do { _Pragma("unroll") for (int ks = 0; ks < 4; ++ks) Q[ks] = *(const LAS bf16x8*)(L + AL_QI + qoff + (H) * 128 + ks * 32); } while (0)
#define ATT_HEAD(Q, H) do { f32x16 acc; \
                    _Pragma("unroll") for (int i = 0; i < 16; ++i) acc[i] = 0.f; \
                    _Pragma("unroll") for (int ks = 0; ks < 4; ++ks) acc = __builtin_amdgcn_mfma_f32_32x32x16_bf16(af[ks], Q[ks], acc, 0, 0, 0); \
                    asm volatile("s_nop 15\n\ts_nop 7" : "+v"(acc));                \
                    _Pragma("unroll") for (int i = 0; i < 16; ++i) sc[j][i] += relu_f(acc[i]) * wv[H]; \
                    __builtin_amdgcn_sched_barrier(0); } while (0)
                ATT_QLD(qA, 0); ATT_QLD(qB, 1); __builtin_amdgcn_sched_barrier(0);
                ATT_HEAD(qA, 0); ATT_QLD(qA, 2); __builtin_amdgcn_sched_barrier(0);
                ATT_HEAD(qB, 1); ATT_QLD(qB, 3); __builtin_amdgcn_sched_barrier(0);
                ATT_HEAD(qA, 2);
                ATT_HEAD(qB, 3);
#undef ATT_HEAD
#undef ATT_QLD
#pragma unroll
                for (int i = 0; i < 16; ++i) sc[j][i] = __builtin_bit_cast(float, sortkey(sc[j][i]));
            }
        }
    }
    unsigned Tq = 0u; bool ordered = false;
    if (do_sel) {
        unsigned prefix = 0u;
        for (int i = tid; i < 32 * HIST_STRIDE; i += NTHREADS) hist[i] = 0u;
        __syncthreads();
#pragma unroll 1
        for (int pass = 0; pass < 4; ++pass) {
            const int shift = 24 - 8 * pass;
#pragma unroll
            for (int j = 0; j < 8; ++j) { const int kt = w + 8 * j;
                if (kt < ntile) {
#pragma unroll
                    for (int i = 0; i < 16; ++i) { const unsigned key = fbits(sc[j][i]);
                        const bool m = (pass == 0) || ((key >> (shift + 8)) == (prefix >> (shift + 8)));
                        if (m) __hip_atomic_fetch_add(hist + r32 * HIST_STRIDE + ((key >> shift) & 255u), 1u, __ATOMIC_RELAXED, __HIP_MEMORY_SCOPE_WORKGROUP); } } }
            __syncthreads();
            {
                const int q = tid >> 4, p = tid & 15, b0 = 16 * (15 - p);
                const unsigned need = qst[q * 4 + 1];
                unsigned s = 0u, hv[16];
#pragma unroll
                for (int e = 0; e < 16; ++e) { hv[e] = hist[q * HIST_STRIDE + b0 + e]; s += hv[e]; hist[q * HIST_STRIDE + b0 + e] = 0u; }
                unsigned P = s;
#pragma unroll
                for (int o = 1; o < 16; o <<= 1) { const unsigned t = __shfl_up(P, o, 16); if (p >= o) P += t; }
                const unsigned Pprev = P - s;
                if (P >= need && Pprev < need) { unsigned run = Pprev; bool done = false;
#pragma unroll
                    for (int e = 15; e >= 0; --e) { const unsigned hc = hv[e]; if (done) continue;
                        if (run + hc >= need) { done = true; qst[q * 4 + 0] = qst[q * 4 + 0] | ((unsigned)(b0 + e) << shift); qst[q * 4 + 1] = need - run; qst[q * 4 + 2] = hc; }
                        else run += hc; } }
            }
            __syncthreads();
            prefix = qst[r32 * 4 + 0];
        }
        Tq = prefix;
        const unsigned needq = qst[r32 * 4 + 1], eqc = qst[r32 * 4 + 2];
        if (needq < eqc) flagw[0] = 1u;
        __syncthreads();
        ordered = flagw[0] != 0u;
    }
#pragma unroll
    for (int j = 0; j < 8; ++j) { const int kt = w + 8 * j;
        if (kt < ntile) { unsigned mw = 0xffffffffu, ew = 0u;
            if (do_sel) { mw = 0u;
#pragma unroll
                for (int i = 0; i < 16; ++i) { const unsigned key = fbits(sc[j][i]); const int bit = crow(i, hi);
                    const bool gt = key > Tq, eq = key == Tq;
                    mw |= ((gt || (eq && !ordered)) ? 1u : 0u) << bit; ew |= (eq ? 1u : 0u) << bit; }
                mw |= __shfl_xor(mw, 32); ew |= __shfl_xor(ew, 32); }
            if (hi == 0) { maskw[kt * 32 + r32] = mw; if (ordered) eqw[kt * 32 + r32] = ew; } } }
    __syncthreads();
    if (ordered) {
        if (tid < 32) { const int need = (int)qst[tid * 4 + 1]; int taken = 0;
            for (int kt = 0; kt < ntile && taken < need; ++kt) { unsigned ww = eqw[kt * 32 + tid]; if (ww == 0u) continue;
                const int pc = __popc(ww); unsigned add = ww;
                if (taken + pc > need) { add = 0u; while (taken + __popc(add) < need) { const unsigned lsb = ww & (0u - ww); add |= lsb; ww ^= lsb; } }
                taken += __popc(add); maskw[kt * 32 + tid] |= add; } }
        __syncthreads();
    }
#if MK_LEAK >= 0
    const unsigned long long tu1_ = __builtin_amdgcn_s_memrealtime();
#endif
    {
        const int h = w; const int tq = t0 + r32;
        bf16x8 qf[4];
        { const bf16_t* Q = WSP(bf16_t, WS_Q) + (size_t)(tok0 + r32) * 512 + h * 64;
          float qv[4][8]; float ss = 0.f;
#pragma unroll
          for (int ks = 0; ks < 4; ++ks) { const bf16x8 v = *(const bf16x8*)(Q + 16 * ks + 8 * hi);
#pragma unroll
              for (int e = 0; e < 8; ++e) { qv[ks][e] = bf2f((unsigned short)v[e]); ss += qv[ks][e] * qv[ks][e]; } }
          ss += __shfl_xor(ss, 32);
          const float rq = rsqrtf(ss * (1.f / 64.f) + EPS) * 0.125f * 1.4426950408889634f;
          const float* qnw = (const float*)F.ap->in[6]; const float* knw = (const float*)F.ap->in[7];
#pragma unroll
          for (int ks = 0; ks < 4; ++ks) { u32x4 pk;
              const f32x4 a0 = *(const f32x4*)(qnw + 16 * ks + 8 * hi), a1 = *(const f32x4*)(qnw + 16 * ks + 8 * hi + 4), b0 = *(const f32x4*)(knw + 16 * ks + 8 * hi), b1 = *(const f32x4*)(knw + 16 * ks + 8 * hi + 4);
              pk.x = pk2(qv[ks][0] * rq * a0.x * b0.x, qv[ks][1] * rq * a0.y * b0.y); pk.y = pk2(qv[ks][2] * rq * a0.z * b0.z, qv[ks][3] * rq * a0.w * b0.w);
              pk.z = pk2(qv[ks][4] * rq * a1.x * b1.x, qv[ks][5] * rq * a1.y * b1.y); pk.w = pk2(qv[ks][6] * rq * a1.z * b1.z, qv[ks][7] * rq * a1.w * b1.w);
              qf[ks] = __builtin_bit_cast(bf16x8, pk); } }
        const float slope2 = exp2f(-(float)(h + 1)) * 1.4426950408889634f;
        float m = 0.f;
        f32x16 o0, o1, lacc;
#pragma unroll
        for (int i = 0; i < 16; ++i) { o0[i] = 0.f; o1[i] = 0.f; lacc[i] = 0.f; }
        const bf16x8 ones8 = {0x3f80, 0x3f80, 0x3f80, 0x3f80, 0x3f80, 0x3f80, 0x3f80, 0x3f80};
        constexpr int K2_STRIDE = 144, K2_BYTES = 64 * K2_STRIDE, KV2_BUF = 2 * K2_BYTES;
        static_assert(2 * KV2_BUF <= AL_MASK, "K/V ring below the mask words");
        const int npair = c + 1;
        const bf16_t* gK = Kb + (size_t)(tid >> 3) * 64 + (tid & 7) * 8;
        const bf16_t* gV = Vt + (size_t)(tid >> 3) * SEQ + (tid & 7) * 8;
        const int lstK = (tid >> 3) * K2_STRIDE + (tid & 7) * 16;
        LAS unsigned char* kvL = L;
#define ATT_STAGE2(BUF, GK, GV) do { u32x4 w_; \
            { float f_[8] = {bflo(GK.x), bfhi(GK.x), bflo(GK.y), bfhi(GK.y), bflo(GK.z), bfhi(GK.z), bflo(GK.w), bfhi(GK.w)}; \
                float ss_ = (f_[0] * f_[0] + f_[1] * f_[1]) + (f_[2] * f_[2] + f_[3] * f_[3]) + (f_[4] * f_[4] + f_[5] * f_[5]) + (f_[6] * f_[6] + f_[7] * f_[7]); \
                ss_ = sum8_dpp(ss_); \
                const float rk_ = __builtin_amdgcn_rsqf(ss_ * (1.f / 64.f) + EPS); \
                w_.x = cvt_pk_bf16(f_[0] * rk_, f_[1] * rk_); w_.y = cvt_pk_bf16(f_[2] * rk_, f_[3] * rk_); w_.z = cvt_pk_bf16(f_[4] * rk_, f_[5] * rk_); w_.w = cvt_pk_bf16(f_[6] * rk_, f_[7] * rk_); } \
            *(LAS u32x4*)(kvL + (BUF) * KV2_BUF + lstK) = w_; *(LAS u32x4*)(kvL + (BUF) * KV2_BUF + K2_BYTES + lstK) = GV; } while (0)
#define ATT_LOADK(KP) (*(const u32x4*)(gK + (size_t)((KP) < npair ? (KP) : npair - 1) * 4096))
#define ATT_LOADV(KP) (*(const u32x4*)(gV + (size_t)((KP) < npair ? (KP) : npair - 1) * 64))
        u32x4 cK = ATT_LOADK(0), cV = ATT_LOADV(0);
        u32x4 nK = ATT_LOADK(1), nV = ATT_LOADV(1);
        ATT_STAGE2(0, cK, cV);
        float ci[16];
#pragma unroll
        for (int i = 0; i < 16; ++i) ci[i] = slope2 * (float)crow(i, hi);
        const float sq = slope2 * (float)tq;
        __syncthreads();
#define ATT_MAX16(S) do { mx = max3f(mx, S[0], S[1]); mx = max3f(mx, S[2], S[3]); mx = max3f(mx, S[4], S[5]); mx = max3f(mx, S[6], S[7]); mx = max3f(mx, S[8], S[9]); mx = max3f(mx, S[10], S[11]); \
            mx = max3f(mx, S[12], S[13]); mx = max3f(mx, S[14], S[15]); } while (0)
#define ATT_PK(P0, P1, S) do { P0.x = cvt_pk_bf16(S[0], S[1]); P0.y = cvt_pk_bf16(S[2], S[3]); P0.z = cvt_pk_bf16(S[4], S[5]); P0.w = cvt_pk_bf16(S[6], S[7]); \
            P1.x = cvt_pk_bf16(S[8], S[9]); P1.y = cvt_pk_bf16(S[10], S[11]); P1.z = cvt_pk_bf16(S[12], S[13]); P1.w = cvt_pk_bf16(S[14], S[15]); } while (0)
#define ATT_TILE2(KP) do { const int kp_ = (KP); \
            const LAS unsigned char* kb = kvL + (kp_ & 1) * KV2_BUF; \
            const unsigned mw0 = maskw[(2 * kp_) * 32 + r32] >> (4 * hi), mw1 = maskw[(2 * kp_ + 1) * 32 + r32] >> (4 * hi); \
            bf16x8 kf0[4], kf1[4];                                                 \
            _Pragma("unroll") for (int ks = 0; ks < 4; ++ks) { kf0[ks] = *(const LAS bf16x8*)(kb + r32 * K2_STRIDE + ks * 32 + hi * 16); kf1[ks] = *(const LAS bf16x8*)(kb + (32 + r32) * K2_STRIDE + ks * 32 + hi * 16); } \
            __builtin_amdgcn_sched_barrier(0); \
            f32x16 S0, S1; \
            if (kp_ < npair - 1) { const float nmt0 = slope2 * (float)(64 * kp_) - m, nmt1 = nmt0 + slope2 * 32.f;        \
                _Pragma("unroll") for (int i = 0; i < 16; ++i) { const int ko = (i & 3) + 8 * (i >> 2); \
                    const unsigned sel0 = (unsigned)__builtin_amdgcn_sbfe((int)mw0, ko, 1), sel1 = (unsigned)__builtin_amdgcn_sbfe((int)mw1, ko, 1); \
                    S0[i] = bitsf(bfi_b32(sel0, fbits(ci[i] + nmt0), 0xff800000u)); S1[i] = bitsf(bfi_b32(sel1, fbits(ci[i] + nmt1), 0xff800000u)); } } \
            else { const float dbase0 = (float)(tq - 64 * kp_ - 4 * hi), dbase1 = dbase0 - 32.f, sqm = sq - m; \
                _Pragma("unroll") for (int i = 0; i < 16; ++i) { const int ko = (i & 3) + 8 * (i >> 2); \
                    const unsigned sel0 = (unsigned)__builtin_amdgcn_sbfe((int)mw0, ko, 1), sel1 = (unsigned)__builtin_amdgcn_sbfe((int)mw1, ko, 1); \
                    S0[i] = bitsf(bfi_b32(sel0, fbits(sqm - slope2 * fabsf(dbase0 - (float)ko)), 0xff800000u)); S1[i] = bitsf(bfi_b32(sel1, fbits(sqm - slope2 * fabsf(dbase1 - (float)ko)), 0xff800000u)); } } \
            _Pragma("unroll") for (int ks = 0; ks < 4; ++ks) { \
                S0 = __builtin_amdgcn_mfma_f32_32x32x16_bf16(kf0[ks], qf[ks], S0, 0, 0, 0); S1 = __builtin_amdgcn_mfma_f32_32x32x16_bf16(kf1[ks], qf[ks], S1, 0, 0, 0); } \
            asm volatile("s_nop 15\n\ts_nop 7" : "+v"(S0), "+v"(S1));             \
            bf16x8 vf[2][4]; \
            _Pragma("unroll") for (int db = 0; db < 2; ++db) _Pragma("unroll") for (int j4 = 0; j4 < 4; ++j4) vf[db][j4] = *(const LAS bf16x8*)(kb + K2_BYTES + (32 * db + r32) * K2_STRIDE + j4 * 32 + hi * 16); \
            float mx = max3f(S0[0], S0[0], S1[0]); \
            ATT_MAX16(S0); ATT_MAX16(S1); \
            mx = fmaxf(mx, __shfl_xor(mx, 32)); \
            if (__any(mx > 8.f)) {                                             \
                const float dl = fmaxf(mx, 0.f), alpha = __builtin_amdgcn_exp2f(-dl); m += dl; \
                _Pragma("unroll") for (int i = 0; i < 16; ++i) { S0[i] -= dl; S1[i] -= dl; o0[i] *= alpha; o1[i] *= alpha; lacc[i] *= alpha; } } \
            _Pragma("unroll") for (int i = 0; i < 16; ++i) { S0[i] = __builtin_amdgcn_exp2f(S0[i]); S1[i] = __builtin_amdgcn_exp2f(S1[i]); } \
            u32x4 p00, p01, p10, p11; ATT_PK(p00, p01, S0); ATT_PK(p10, p11, S1); \
            const bf16x8 pf00 = __builtin_bit_cast(bf16x8, p00), pf01 = __builtin_bit_cast(bf16x8, p01), pf10 = __builtin_bit_cast(bf16x8, p10), pf11 = __builtin_bit_cast(bf16x8, p11); \
            o0 = __builtin_amdgcn_mfma_f32_32x32x16_bf16(vf[0][0], pf00, o0, 0, 0, 0); o1 = __builtin_amdgcn_mfma_f32_32x32x16_bf16(vf[1][0], pf00, o1, 0, 0, 0); lacc = __builtin_amdgcn_mfma_f32_32x32x16_bf16(ones8, pf00, lacc, 0, 0, 0); \
            o0 = __builtin_amdgcn_mfma_f32_32x32x16_bf16(vf[0][1], pf01, o0, 0, 0, 0); o1 = __builtin_amdgcn_mfma_f32_32x32x16_bf16(vf[1][1], pf01, o1, 0, 0, 0); lacc = __builtin_amdgcn_mfma_f32_32x32x16_bf16(ones8, pf01, lacc, 0, 0, 0); \
            o0 = __builtin_amdgcn_mfma_f32_32x32x16_bf16(vf[0][2], pf10, o0, 0, 0, 0); o1 = __builtin_amdgcn_mfma_f32_32x32x16_bf16(vf[1][2], pf10, o1, 0, 0, 0); lacc = __builtin_amdgcn_mfma_f32_32x32x16_bf16(ones8, pf10, lacc, 0, 0, 0); \
            o0 = __builtin_amdgcn_mfma_f32_32x32x16_bf16(vf[0][3], pf11, o0, 0, 0, 0); o1 = __builtin_amdgcn_mfma_f32_32x32x16_bf16(vf[1][3], pf11, o1, 0, 0, 0); lacc = __builtin_amdgcn_mfma_f32_32x32x16_bf16(ones8, pf11, lacc, 0, 0, 0); \
            } while (0)
#pragma unroll 1
        for (int kp = 0; kp < npair; ++kp) {
            const u32x4 fK = ATT_LOADK(kp + 2), fV = ATT_LOADV(kp + 2);
            ATT_TILE2(kp);
            if (kp + 1 < npair) ATT_STAGE2((kp + 1) & 1, nK, nV);
            LDS_BARRIER();
            nK = fK; nV = fV;
        }
#undef ATT_TILE2
#undef ATT_PK
#undef ATT_MAX16
#undef ATT_LOADK
#undef ATT_LOADV
#undef ATT_STAGE2
        const float inv = __builtin_amdgcn_rcpf(lacc[0]);
        LAS unsigned char* stg = L + AL_OST + w * 4608;
#pragma unroll
        for (int g = 0; g < 4; ++g) {
            *(LAS u32x2*)(stg + r32 * OST_STRIDE + (8 * g + 4 * hi) * 2) = (u32x2){pk2(o0[4 * g] * inv, o0[4 * g + 1] * inv), pk2(o0[4 * g + 2] * inv, o0[4 * g + 3] * inv)};
            *(LAS u32x2*)(stg + r32 * OST_STRIDE + (32 + 8 * g + 4 * hi) * 2) = (u32x2){pk2(o1[4 * g] * inv, o1[4 * g + 1] * inv), pk2(o1[4 * g + 2] * inv, o1[4 * g + 3] * inv)}; }
        asm volatile("s_waitcnt lgkmcnt(0)" ::: "memory");
        bf16_t* AO = WSP(bf16_t, WS_AO) + (size_t)tok0 * 512 + h * 64;
#pragma unroll
        for (int it = 0; it < 4; ++it) { const int row = it * 8 + (lane >> 3), ch = lane & 7;
            *(u32x4*)(AO + (size_t)row * 512 + ch * 8) = *(const LAS u32x4*)(stg + row * OST_STRIDE + ch * 16); }
    }
#if MK_LEAK >= 0
    __syncthreads();
    if (tid == 0) { volatile LAS unsigned* MS = (volatile LAS unsigned*)(F.lds + MISC_OFF); const unsigned long long tu2_ = __builtin_amdgcn_s_memrealtime(); MS[16] += (unsigned)(tu1_ - tu0_); MS[17] += (unsigned)(tu2_ - tu1_); }
#endif
}
__device__ __forceinline__ void attn_phase(Frame& F, int clo, int chi) {
#pragma unroll 1
    for (int p2 = 2 * F.bid; p2 < 512; p2 += ((p2 & 1) ? 2 * F.G - 1 : 1)) { const int p = p2 >> 1, b = p >> 5, jj = p & 31, c1 = jj >> 1, half = jj & 1;
        const int cc = (p2 & 1) ? c1 : 31 - c1; if (cc >= clo && cc < chi) attn_unit(F, b, cc, half); }
}

constexpr int LR_CW = 0, LR_SEG = 2048, LR_AB = 4096;
static_assert(LR_AB + 8 * 16 * 64 * 16 <= MISC_OFF, "LRU LDS map");
__device__ __forceinline__ void lru_item_mfma(Frame& F, int item) {
    int tid_ = F.tid, w_ = F.wave; asm volatile("" : "+v"(tid_), "+s"(w_));
    const int tid = tid_, lane = tid & 63, w = w_, c16 = lane & 15, kg = lane >> 4;
    const int b = item >> 5, n = (item >> 2) & 7, q = item & 3;
    LAS float* cwL = (LAS float*)(F.lds + LR_CW);
    LAS float* segL = (LAS float*)(F.lds + LR_SEG);
    LAS u32x4* abL = (LAS u32x4*)(F.lds + LR_AB) + (size_t)w * 16 * 64 + lane;
    const float* conv_w = (const float*)F.ap->in[8]; const float* conv_b = (const float*)F.ap->in[9];
    const float* w_rec = (const float*)F.ap->in[10] + (size_t)n * 4096; const float* w_ing = (const float*)F.ap->in[12] + (size_t)n * 4096;
    __syncthreads();
    if (tid < 256) cwL[tid] = conv_w[(tid >> 6) * 512 + 64 * n + (tid & 63)]; else if (tid < 320) cwL[tid] = conv_b[64 * n + (tid - 256)];
    bf16x8 Bw[3][2];
#pragma unroll
    for (int ks = 0; ks < 2; ++ks) { u32x4 pr, pi, pd;
        float vr[8], vi[8], vd[8];
#pragma unroll
        for (int j = 0; j < 8; ++j) { const int d = 32 * ks + 8 * kg + j; vr[j] = w_rec[d * 64 + 16 * q + c16]; vi[j] = w_ing[d * 64 + 16 * q + c16]; vd[j] = (d == 16 * q + c16) ? 1.f : 0.f; }
        pr.x = pk2(vr[0], vr[1]); pr.y = pk2(vr[2], vr[3]); pr.z = pk2(vr[4], vr[5]); pr.w = pk2(vr[6], vr[7]);
        pi.x = pk2(vi[0], vi[1]); pi.y = pk2(vi[2], vi[3]); pi.z = pk2(vi[4], vi[5]); pi.w = pk2(vi[6], vi[7]);
        pd.x = pk2(vd[0], vd[1]); pd.y = pk2(vd[2], vd[3]); pd.z = pk2(vd[4], vd[5]); pd.w = pk2(vd[6], vd[7]);
        Bw[0][ks] = __builtin_bit_cast(bf16x8, pr); Bw[1][ks] = __builtin_bit_cast(bf16x8, pi); Bw[2][ks] = __builtin_bit_cast(bf16x8, pd); }
    const int chg = 64 * n + 16 * q + c16;
    const float spl8 = -8.f * log1pf(__expf(-((const float*)F.ap->in[14])[chg])), brc = ((const float*)F.ap->in[11])[chg], bin = ((const float*)F.ap->in[13])[chg];
    const bf16_t* LX = WSP(bf16_t, WS_LX) + (size_t)b * SEQ * 512 + 64 * n + 8 * kg;
    const bf16_t* LG = WSP(bf16_t, WS_LG) + (size_t)b * SEQ * 512 + 64 * n + 16 * q + c16;
    bf16_t* LO = WSP(bf16_t, WS_LO) + (size_t)b * SEQ * 512 + 64 * n + 16 * q + c16;
    __syncthreads();
    u32x4 raw[2][4], rawN[2][4];
#define LRU_LOAD(R, RB) do { const int tb_ = 256 * w + 16 * (RB) + c16 - 3; \
        _Pragma("unroll") for (int ks = 0; ks < 2; ++ks) _Pragma("unroll") for (int tap = 0; tap < 4; ++tap) { const int ts_ = tb_ + tap; \
            R[ks][tap] = *(const u32x4*)(LX + (size_t)(ts_ < 0 ? 0 : ts_) * 512 + 32 * ks); } } while (0)
    LRU_LOAD(raw, 0);
    float Arun = 1.f, Brun = 0.f;
#pragma unroll 1
    for (int rb = 0; rb < 16; ++rb) {
        if (rb < 15) LRU_LOAD(rawN, rb + 1);
        const int tb = 256 * w + 16 * rb + c16 - 3;
        if (w == 0 && rb == 0) {
#pragma unroll
            for (int ks = 0; ks < 2; ++ks)
#pragma unroll
                for (int tap = 0; tap < 4; ++tap) if (tb + tap < 0) raw[ks][tap] = (u32x4){0u, 0u, 0u, 0u}; }
        bf16x8 afr[2];
#pragma unroll
        for (int ks = 0; ks < 2; ++ks) { const int d0 = 32 * ks + 8 * kg; float xc[8];
            { const f32x4 c0 = *(const LAS f32x4*)(cwL + 256 + d0), c1 = *(const LAS f32x4*)(cwL + 256 + d0 + 4);
              xc[0] = c0.x; xc[1] = c0.y; xc[2] = c0.z; xc[3] = c0.w; xc[4] = c1.x; xc[5] = c1.y; xc[6] = c1.z; xc[7] = c1.w; }
#pragma unroll
            for (int tap = 0; tap < 4; ++tap) { const u32x4 v = raw[ks][tap];
                const f32x4 c0 = *(const LAS f32x4*)(cwL + tap * 64 + d0), c1 = *(const LAS f32x4*)(cwL + tap * 64 + d0 + 4);
                xc[0] += bflo(v.x) * c0.x; xc[1] += bfhi(v.x) * c0.y; xc[2] += bflo(v.y) * c0.z; xc[3] += bfhi(v.y) * c0.w;
                xc[4] += bflo(v.z) * c1.x; xc[5] += bfhi(v.z) * c1.y; xc[6] += bflo(v.w) * c1.z; xc[7] += bfhi(v.w) * c1.w; }
            u32x4 pa; pa.x = cvt_pk_bf16(xc[0], xc[1]); pa.y = cvt_pk_bf16(xc[2], xc[3]); pa.z = cvt_pk_bf16(xc[4], xc[5]); pa.w = cvt_pk_bf16(xc[6], xc[7]);
            afr[ks] = __builtin_bit_cast(bf16x8, pa); }
        f32x4 rp = (f32x4){0.f, 0.f, 0.f, 0.f}, ip = rp, xv = rp;
#pragma unroll
        for (int ks = 0; ks < 2; ++ks) { rp = __builtin_amdgcn_mfma_f32_16x16x32_bf16(afr[ks], Bw[0][ks], rp, 0, 0, 0); ip = __builtin_amdgcn_mfma_f32_16x16x32_bf16(afr[ks], Bw[1][ks], ip, 0, 0, 0);
            xv = __builtin_amdgcn_mfma_f32_16x16x32_bf16(afr[ks], Bw[2][ks], xv, 0, 0, 0); }
        float av[4], bv[4]; u32x4 pk;
#pragma unroll
        for (int r = 0; r < 4; ++r) { const float rg = __builtin_amdgcn_rcpf(1.f + __expf(-(rp[r] + brc))), ig = __builtin_amdgcn_rcpf(1.f + __expf(-(ip[r] + bin)));
            const float la = spl8 * rg;
            const float em1 = -la * (1.f + la * (0.5f + la * (0.16666667f + la * (0.041666668f + la * 0.0083333338f))));
            const float em2 = em1 * (2.f - em1);
            const unsigned w2 = cvt_pk_bf16(em1, __builtin_amdgcn_sqrtf(em2) * (ig * xv[r]));
            pk[r] = w2; av[r] = 1.f - bflo(w2); bv[r] = bfhi(w2); }
        abL[rb * 64] = pk;
        float Ag = av[0], Bg = bv[0];
#pragma unroll
        for (int r = 1; r < 4; ++r) { Bg = av[r] * Bg + bv[r]; Ag = Ag * av[r]; }
        const float A0 = __shfl(Ag, c16), B0 = __shfl(Bg, c16), A1 = __shfl(Ag, c16 + 16), B1 = __shfl(Bg, c16 + 16), A2 = __shfl(Ag, c16 + 32), B2 = __shfl(Bg, c16 + 32), A3 = __shfl(Ag, c16 + 48), B3 = __shfl(Bg, c16 + 48);
        const float P2a = A0 * A1, P2b = A1 * B0 + B1, P3a = P2a * A2, P3b = A2 * P2b + B2, Ta = P3a * A3, Tb = A3 * P3b + B3;
        Brun = Ta * Brun + Tb; Arun = Arun * Ta;
#pragma unroll
        for (int ks = 0; ks < 2; ++ks)
#pragma unroll
            for (int tap = 0; tap < 4; ++tap) raw[ks][tap] = rawN[ks][tap];
    }
#undef LRU_LOAD
    if (kg == 0) { segL[(w * 16 + c16) * 2] = Arun; segL[(w * 16 + c16) * 2 + 1] = Brun; }
    __syncthreads();
    float hc = 0.f;
    for (int ww = 0; ww < w; ++ww) hc = segL[(ww * 16 + c16) * 2] * hc + segL[(ww * 16 + c16) * 2 + 1];
#pragma unroll 2
    for (int rb = 0; rb < 16; ++rb) {
        const int t0 = 256 * w + 16 * rb;
        const u32x4 pk = abL[rb * 64];
        float gv[4];
#pragma unroll
        for (int r = 0; r < 4; ++r) gv[r] = bf2f(LG[(size_t)(t0 + 4 * kg + r) * 512]);
        float av[4], bv[4];
#pragma unroll
        for (int r = 0; r < 4; ++r) { av[r] = 1.f - bflo(pk[r]); bv[r] = bfhi(pk[r]); }
        float Ag = av[0], Bg = bv[0];
#pragma unroll
        for (int r = 1; r < 4; ++r) { Bg = av[r] * Bg + bv[r]; Ag = Ag * av[r]; }
        const float A0 = __shfl(Ag, c16), B0 = __shfl(Bg, c16), A1 = __shfl(Ag, c16 + 16), B1 = __shfl(Bg, c16 + 16), A2 = __shfl(Ag, c16 + 32), B2 = __shfl(Bg, c16 + 32), A3 = __shfl(Ag, c16 + 48), B3 = __shfl(Bg, c16 + 48);
        const float P2a = A0 * A1, P2b = A1 * B0 + B1, P3a = P2a * A2, P3b = A2 * P2b + B2, Ta = P3a * A3, Tb = A3 * P3b + B3;
        const float Pa = kg == 0 ? 1.f : kg == 1 ? A0 : kg == 2 ? P2a : P3a, Pb = kg == 0 ? 0.f : kg == 1 ? B0 : kg == 2 ? P2b : P3b;
        float h = Pa * hc + Pb;
#pragma unroll
        for (int r = 0; r < 4; ++r) { h = av[r] * h + bv[r]; const float g = gv[r]; const float u = 0.7978845608028654f * (g + 0.044715f * g * g * g);
            const float ge = g * __builtin_amdgcn_rcpf(1.f + __expf(-2.f * u));
            LO[(size_t)(t0 + 4 * kg + r) * 512] = (bf16_t)f2bf(h * ge); }
        hc = Ta * hc + Tb;
    }
}
__device__ __forceinline__ void lru_phase(Frame& F) {
#pragma unroll 1
    for (int it = F.bid; it < 256; it += F.G) lru_item_mfma(F, it);
}
struct SchedMerge { const bf16_t *AO, *LO, *WPA, *WPB; int G, c;
    __device__ __forceinline__ bool next(int i, Unit& u) const { const int L = (i >> 1) * G + c; if (L >= 64 * 4) return false; const int sub = i & 1;
        u.pm = L % 64; u.pn = L / 64; u.aux = sub; u.flags = 0; u.gidx = nullptr;
        u.A = (sub ? LO : AO) + (size_t)u.pm * 256 * 512; u.B = (sub ? WPB : WPA) + (size_t)u.pn * 256 * 512; return true; } };
struct EpiMerge {   static constexpr bool PERM = true; static constexpr bool PRE = false;
    bf16_t* MG; const bf16_t *GA, *GB;
    __device__ __forceinline__ void operator()(const f32x4 (&acc)[2][2][4][2], const Unit& u, int wr, int wc, int fr, int fq) const {
        const bf16_t* G = u.aux ? GB : GA;
        const size_t base = (size_t)(u.pm * 256 + wr * 64 + fr) * 1024 + u.pn * 256 + wc * 32 + 8 * fq;
#pragma unroll
        for (int ai = 0; ai < 2; ++ai) {
            u32x4 g[4][2], p[4][2];
#pragma unroll
            for (int m = 0; m < 4; ++m)
#pragma unroll
                for (int bj = 0; bj < 2; ++bj) g[m][bj] = *(const u32x4*)(G + base + (size_t)(ai * 128 + m * 16) * 1024 + bj * 128);
            if (u.aux) {
#pragma unroll
                for (int m = 0; m < 4; ++m)
#pragma unroll
                    for (int bj = 0; bj < 2; ++bj) p[m][bj] = *(const u32x4*)(MG + base + (size_t)(ai * 128 + m * 16) * 1024 + bj * 128);
            } else {
#pragma unroll
                for (int m = 0; m < 4; ++m)
#pragma unroll
                    for (int bj = 0; bj < 2; ++bj) p[m][bj] = (u32x4){0u, 0u, 0u, 0u};
            }
#pragma unroll
            for (int m = 0; m < 4; ++m)
#pragma unroll
                for (int bj = 0; bj < 2; ++bj) {
                    const u32x4 gg = g[m][bj], pp = p[m][bj];
                    f32x4 v0 = acc[ai][bj][m][0], v1 = acc[ai][bj][m][1];
                    v0[0] = v0[0] * bflo(gg.x) + bflo(pp.x); v0[1] = v0[1] * bfhi(gg.x) + bfhi(pp.x); v0[2] = v0[2] * bflo(gg.y) + bflo(pp.y); v0[3] = v0[3] * bfhi(gg.y) + bfhi(pp.y);
                    v1[0] = v1[0] * bflo(gg.z) + bflo(pp.z); v1[1] = v1[1] * bfhi(gg.z) + bfhi(pp.z); v1[2] = v1[2] * bflo(gg.w) + bflo(pp.w); v1[3] = v1[3] * bfhi(gg.w) + bfhi(pp.w);
                    u32x4 w; w.x = pk2(v0[0], v0[1]); w.y = pk2(v0[2], v0[3]); w.z = pk2(v1[0], v1[1]); w.w = pk2(v1[2], v1[3]);
                    *(u32x4*)(MG + base + (size_t)(ai * 128 + m * 16) * 1024 + bj * 128) = w; }
        }
    }
};
struct SchedOut { const bf16_t *A, *B; int G, c;
    __device__ __forceinline__ bool next(int i, Unit& u) const { const int L = i * G + c; if (L >= 64 * 4) return false;
        u.pm = L % 64; u.pn = L / 64; u.aux = 0; u.flags = 0; u.gidx = nullptr; u.A = A + (size_t)u.pm * 256 * 1024; u.B = B + (size_t)u.pn * 256 * 1024; return true; } };
struct EpiOut {   static constexpr bool PERM = false; static constexpr bool PRE = false;
    const float* x; const float* mod; float* out; float* rowsq;
    __device__ __forceinline__ void operator()(const f32x4 (&acc)[2][2][4][2], const Unit& u, int wr, int wc, int fr, int fq) const {
        const int b = (u.pm * 256) / SEQ;
        f32x4 gm[2][2];
#pragma unroll
        for (int bj = 0; bj < 2; ++bj)
#pragma unroll
            for (int n = 0; n < 2; ++n) gm[bj][n] = *(const f32x4*)(mod + b * 6144 + 2048 + u.pn * 256 + bj * 128 + wc * 32 + 16 * n + 4 * fq);
        const size_t base = (size_t)(u.pm * 256 + wr * 64 + fr) * 1024 + u.pn * 256 + wc * 32 + 4 * fq;
#pragma unroll
        for (int ai = 0; ai < 2; ++ai) {
            f32x4 xv[4][2][2];
#pragma unroll
            for (int m = 0; m < 4; ++m)
#pragma unroll
                for (int bj = 0; bj < 2; ++bj)
#pragma unroll
                    for (int n = 0; n < 2; ++n) xv[m][bj][n] = *(const f32x4*)(x + base + (size_t)(ai * 128 + m * 16) * 1024 + bj * 128 + 16 * n);
#pragma unroll
            for (int m = 0; m < 4; ++m) { const int row = u.pm * 256 + ai * 128 + wr * 64 + m * 16 + fr; float ss = 0.f;
#pragma unroll
                for (int bj = 0; bj < 2; ++bj)
#pragma unroll
                    for (int n = 0; n < 2; ++n) { const f32x4 v = xv[m][bj][n] + gm[bj][n] * acc[ai][bj][m][n];
                        *(f32x4*)(out + base + (size_t)(ai * 128 + m * 16) * 1024 + bj * 128 + 16 * n) = v; ss += (v.x * v.x + v.y * v.y) + (v.z * v.z + v.w * v.w); }
                ss += __shfl_xor(ss, 16); ss += __shfl_xor(ss, 32);
                if (fq == 0) rowsq[(size_t)row * 16 + u.pn * 4 + wc] = ss; }
        }
    }
};

struct TokMeta { int ea, eb; float ca, cb; int re_a, re_b, cls, rc; };
__device__ __forceinline__ int pair_index(int lo, int hi) { return lo * (15 - lo) / 2 + (hi - lo - 1); }

constexpr int RL_GS = 0, RL_LG = 8192, RL_W = 8192 + 16384, RW_STRIDE = 1040;
static_assert(RL_W + 2 * 48 * RW_STRIDE + 2048 <= RING_BYTES, "routing LDS map");
__device__ __forceinline__ void route_phase(Frame& F) {
    int tid_ = F.tid, w_ = F.wave; asm volatile("" : "+v"(tid_), "+s"(w_));
    const int tid = tid_, lane = tid & 63, w = w_, r16 = lane & 15, r8 = lane & 7, kg = lane >> 4;
    LAS float* gsL = (LAS float*)(F.lds + RL_GS);
    LAS float* lgL = (LAS float*)(F.lds + RL_LG + (w & 3) * 3072);
    const bool act = w < 4;
    LAS unsigned char* wL = F.lds + RL_W;
    LAS unsigned* hbin = (LAS unsigned*)(F.lds + RL_W + 2 * 48 * RW_STRIDE);
    const float* nw = (const float*)F.ap->in[18];
    const float* rowsq = WSP(float, WS_ROWSQ);
#pragma unroll 1
    for (int blk = F.bid; blk < NTOK / 64; blk += F.G) {
        const int tokb = blk * 64, b = tokb / SEQ; const float* mod = WSP(float, WS_MOD) + b * 6144;
        __syncthreads();
        float gsv[2][3];
#pragma unroll
        for (int i = 0; i < 2; ++i) { gsv[i][0] = nw[tid + 512 * i]; gsv[i][1] = mod[4096 + tid + 512 * i]; gsv[i][2] = mod[3072 + tid + 512 * i]; }
        const int tok = tokb + 16 * (w & 3) + r16;
        const float* xr = F.out + (size_t)tok * DM + 8 * kg;
        f32x4 rsq[4];
        { const f32x4* rp = (const f32x4*)(rowsq + (size_t)tok * 16); rsq[0] = rp[0]; rsq[1] = rp[1]; rsq[2] = rp[2]; rsq[3] = rp[3]; }
        f32x4 xA[8][2], xB[8][2];
#define RT_LOAD(X, QD) do { const float* xq_ = xr + 256 * (QD); _Pragma("unroll") for (int i_ = 0; i_ < 8; ++i_) { X[i_][0] = *(const f32x4*)(xq_ + 32 * i_); X[i_][1] = *(const f32x4*)(xq_ + 32 * i_ + 4); } } while (0)
        if (act) { RT_LOAD(xA, 0); RT_LOAD(xB, 1); }
        const unsigned wvo = (unsigned)(((tid >> 6) * 1024 + 8 * (tid & 63)) * 2);
        const int wlo = (tid >> 6) * RW_STRIDE + (tid & 63) * 16;
#define RT_WLOAD(KH) do { const unsigned char* wb_ = F.ws + WS_WRH + 1024 * (KH); _Pragma("unroll") for (int i_ = 0; i_ < 12; ++i_) \
            wreg[i_] = *(const u32x4*)(wb_ + (size_t)((i_ / 6) * (int)(WS_WRL - WS_WRH) + (i_ % 6) * 8 * 2048) + wvo); } while (0)
#define RT_WSTORE() do { _Pragma("unroll") for (int i_ = 0; i_ < 12; ++i_) *(LAS u32x4*)(wL + wlo + ((i_ / 6) * 48 + (i_ % 6) * 8) * RW_STRIDE) = wreg[i_]; } while (0)
#pragma unroll
        for (int i = 0; i < 2; ++i) { gsL[tid + 512 * i] = gsv[i][0] * (1.f + gsv[i][1]); gsL[1024 + tid + 512 * i] = gsv[i][2]; }
        if (tid < 144) hbin[tid] = 0u;
        const float ssq = (((rsq[0].x + rsq[0].y) + (rsq[0].z + rsq[0].w)) + ((rsq[1].x + rsq[1].y) + (rsq[1].z + rsq[1].w))) + (((rsq[2].x + rsq[2].y) + (rsq[2].z + rsq[2].w)) + ((rsq[3].x + rsq[3].y) + (rsq[3].z + rsq[3].w)));
        const float rinv = rsqrtf(ssq * (1.f / DM) + EPS);
        f32x4 acc[3];
#pragma unroll
        for (int nb = 0; nb < 3; ++nb) acc[nb] = (f32x4){0.f, 0.f, 0.f, 0.f};
        unsigned char* h2row = WSP(unsigned char, WS_H2T) + (size_t)tok * DM + 8 * kg;
#define RT_COMP(X, QD) do { _Pragma("unroll") for (int i_ = 0; i_ < 8; ++i_) { const int kq_ = 256 * (QD) + 32 * i_, k0 = kq_ + 8 * kg, kl_ = 256 * ((QD) & 1) + 32 * i_ + 8 * kg; \
                const f32x4 a = X[i_][0], c = X[i_][1]; \
                const f32x4 g0 = *(const LAS f32x4*)(gsL + k0), g1 = *(const LAS f32x4*)(gsL + k0 + 4), s0 = *(const LAS f32x4*)(gsL + 1024 + k0), s1 = *(const LAS f32x4*)(gsL + 1024 + k0 + 4); \
                float hv[8]; hv[0] = a.x * rinv * g0.x + s0.x; hv[1] = a.y * rinv * g0.y + s0.y; hv[2] = a.z * rinv * g0.z + s0.z; hv[3] = a.w * rinv * g0.w + s0.w; \
                hv[4] = c.x * rinv * g1.x + s1.x; hv[5] = c.y * rinv * g1.y + s1.y; hv[6] = c.z * rinv * g1.z + s1.z; hv[7] = c.w * rinv * g1.w + s1.w; \
                u32x4 ph, pl; ph.x = pk2(hv[0], hv[1]); ph.y = pk2(hv[2], hv[3]); ph.z = pk2(hv[4], hv[5]); ph.w = pk2(hv[6], hv[7]); \
                pl.x = pk2(hv[0] - bflo(ph.x), hv[1] - bfhi(ph.x)); pl.y = pk2(hv[2] - bflo(ph.y), hv[3] - bfhi(ph.y)); pl.z = pk2(hv[4] - bflo(ph.z), hv[5] - bfhi(ph.z)); pl.w = pk2(hv[6] - bflo(ph.w), hv[7] - bfhi(ph.w)); \
                *(u32x2*)(h2row + kq_) = (u32x2){pk4_fp8(hv[0], hv[1], hv[2], hv[3]), pk4_fp8(hv[4], hv[5], hv[6], hv[7])};     \
                const bf16x8 ah = __builtin_bit_cast(bf16x8, ph), al = __builtin_bit_cast(bf16x8, pl); \
                _Pragma("unroll") for (int nb = 0; nb < 3; ++nb) { const LAS unsigned char* wp = wL + (16 * nb + r16) * RW_STRIDE + kl_ * 2; \
                    const bf16x8 bh = *(const LAS bf16x8*)wp, bl = *(const LAS bf16x8*)(wp + 48 * RW_STRIDE); \
                    acc[nb] = __builtin_amdgcn_mfma_f32_16x16x32_bf16(ah, bh, acc[nb], 0, 0, 0); acc[nb] = __builtin_amdgcn_mfma_f32_16x16x32_bf16(ah, bl, acc[nb], 0, 0, 0); \
                    acc[nb] = __builtin_amdgcn_mfma_f32_16x16x32_bf16(al, bh, acc[nb], 0, 0, 0); } \
                __builtin_amdgcn_sched_barrier(0); } } while (0)
#pragma unroll 1
        for (int kh = 0; kh < 2; ++kh) {
            __syncthreads();
            { u32x4 wreg[12]; RT_WLOAD(kh); RT_WSTORE(); }
            __syncthreads();
            if (act) {
                RT_COMP(xA, 2 * kh);
                if (kh == 0) RT_LOAD(xA, 2);
                RT_COMP(xB, 2 * kh + 1);
                if (kh == 0) RT_LOAD(xB, 3);
            }
        }
#undef RT_COMP
#undef RT_WSTORE
#undef RT_WLOAD
#undef RT_LOAD
        if (act) {
#pragma unroll
            for (int nb = 0; nb < 3; ++nb)
#pragma unroll
                for (int r = 0; r < 4; ++r) lgL[(4 * kg + r) * 48 + 16 * nb + r16] = acc[nb][r]; }
        asm volatile("s_waitcnt lgkmcnt(0)" ::: "memory");
        TokMeta mt; mt.ea = 0; mt.eb = 0; mt.ca = 0.f; mt.cb = 0.f; mt.re_a = 0; mt.re_b = 0; mt.cls = 0; mt.rc = 0;
        if (act && lane < 16) {
            const LAS float* lg = lgL + lane * 48; const float* bg = (const float*)F.ap->in[20]; const float* be = (const float*)F.ap->in[22];
            float gl[4];
#pragma unroll
            for (int i = 0; i < 4; ++i) gl[i] = lg[i] + bg[i];
            int g = 0; float gmx = gl[0];
#pragma unroll
            for (int i = 1; i < 4; ++i) if (gl[i] > gmx) { gmx = gl[i]; g = i; }
            float gs = 0.f;
#pragma unroll
            for (int i = 0; i < 4; ++i) gs += __expf(gl[i] - gmx);
            const float gw = 1.f / gs;
            float el[8];
#pragma unroll
            for (int i = 0; i < 8; ++i) el[i] = lg[4 + g * 8 + i] + be[g * 8 + i];
            int i1 = 0; float v1 = el[0];
#pragma unroll
            for (int i = 1; i < 8; ++i) if (el[i] > v1) { v1 = el[i]; i1 = i; }
            int i2 = -1; float v2 = -INFINITY;
#pragma unroll
            for (int i = 0; i < 8; ++i) if (i != i1 && (i2 < 0 || el[i] > v2)) { v2 = el[i]; i2 = i; }
            const float e2 = __expf(v2 - v1); const float w1v = gw / (1.f + e2), w2v = gw * e2 / (1.f + e2);
            const int lo = i1 < i2 ? i1 : i2, hi = i1 < i2 ? i2 : i1;
            mt.ea = g * 8 + lo; mt.eb = g * 8 + hi; mt.ca = (i1 < i2) ? w1v : w2v; mt.cb = (i1 < i2) ? w2v : w1v;
            mt.cls = g * 28 + pair_index(lo, hi);
            mt.re_a = (int)__hip_atomic_fetch_add(hbin + mt.ea, 1u, __ATOMIC_RELAXED, __HIP_MEMORY_SCOPE_WORKGROUP); mt.re_b = (int)__hip_atomic_fetch_add(hbin + mt.eb, 1u, __ATOMIC_RELAXED, __HIP_MEMORY_SCOPE_WORKGROUP);
            mt.rc = (int)__hip_atomic_fetch_add(hbin + 32 + mt.cls, 1u, __ATOMIC_RELAXED, __HIP_MEMORY_SCOPE_WORKGROUP);
        }
        __syncthreads();
        if (tid < 144) { const unsigned cnt = hbin[tid]; unsigned base = 0u;
            if (cnt) base = atomicAdd((unsigned*)(F.ws + WS_CTL) + CW_CNTE + tid * CNT_STRIDE, cnt);
            hbin[160 + tid] = base; }
        __syncthreads();
        if (act && lane < 16) { mt.re_a += (int)hbin[160 + mt.ea]; mt.re_b += (int)hbin[160 + mt.eb]; mt.rc += (int)hbin[160 + 32 + mt.cls];
            const int tk = tokb + 16 * w + lane;
            typedef int i32x4 __attribute__((ext_vector_type(4)));
            WSP(i32x4, WS_EINFO)[(size_t)mt.ea * LIST_CAP + mt.re_a] = (i32x4){tk, (int)fbits(mt.ca), mt.cls, mt.rc};
            WSP(i32x4, WS_EINFO)[(size_t)mt.eb * LIST_CAP + mt.re_b] = (i32x4){tk, (int)fbits(mt.cb), mt.cls | (1 << 16), mt.rc};
            WSP(int, WS_CLIST)[(size_t)mt.cls * LIST_CAP + mt.rc] = tk; }
    }
}
struct MoeTables { LAS int* ebase; LAS int* cbase; LAS int* cnt; LAS unsigned short* trows; LAS unsigned short* tcls; LAS unsigned short* order; };
__device__ __forceinline__ MoeTables tables_view(Frame& F, int lds_off) {
    MoeTables T; T.ebase = (LAS int*)(F.lds + lds_off); T.cbase = T.ebase + 40; T.cnt = T.ebase + 160; T.trows = (LAS unsigned short*)(F.lds + lds_off + 1280); T.tcls = T.trows + 256; T.order = T.trows + 512; return T; }
__device__ __forceinline__ MoeTables build_tables(Frame& F, int lds_off) {
    MoeTables T = tables_view(F, lds_off);
    const unsigned* ctl = (const unsigned*)(F.ws + WS_CTL);
    __syncthreads();
    if (F.tid < 144) T.cnt[F.tid] = (int)__hip_atomic_load(ctl + CW_CNTE + F.tid * CNT_STRIDE, __ATOMIC_RELAXED, __HIP_MEMORY_SCOPE_AGENT);
    __syncthreads();
    { int t_ = F.tid; asm volatile("" : "+v"(t_));
      const int l = t_ & 63;
#define BT_UP(P, O) __builtin_amdgcn_ds_bpermute(((l - (O)) & 63) * 4, (P))
      if (t_ < 64) { const int v = (l < NEXP) ? ((T.cnt[l] + 255) >> 8) : 0; int p = v;
#pragma unroll
          for (int o = 1; o < 64; o <<= 1) { const int t = BT_UP(p, o); if (l >= o) p += t; }
          if (l < NEXP) T.ebase[l] = p - v; if (l == NEXP - 1) T.ebase[NEXP] = p; }
      else if (t_ < 128) { const int v0 = (T.cnt[32 + l] + 255) >> 8, v1 = (l + 64 < NCLS) ? ((T.cnt[32 + 64 + l] + 255) >> 8) : 0; int p0 = v0, p1 = v1;
#pragma unroll
          for (int o = 1; o < 64; o <<= 1) { const int t0 = BT_UP(p0, o), t1 = BT_UP(p1, o); if (l >= o) { p0 += t0; p1 += t1; } }
          const int tot0 = __builtin_amdgcn_ds_bpermute(63 * 4, p0);
          T.cbase[l] = p0 - v0; if (l + 64 < NCLS) T.cbase[64 + l] = tot0 + p1 - v1; if (l + 64 == NCLS - 1) T.cbase[NCLS] = tot0 + p1; }
#undef BT_UP
    }
    __syncthreads();
    if (F.tid < NCLS) { const int n = T.cnt[32 + F.tid], b0 = T.cbase[F.tid], nt = T.cbase[F.tid + 1] - b0;
        for (int t = 0; t < nt; ++t) { const int idx = b0 + t; if (idx < 256) { const int rws = n - 256 * t; T.trows[idx] = (unsigned short)(rws > 256 ? 256 : rws); T.tcls[idx] = (unsigned short)F.tid; } } }
    __syncthreads();
    { const int NT = T.cbase[NCLS] < 256 ? T.cbase[NCLS] : 256;
      if (F.tid < NT) { const int mine = T.trows[F.tid]; int rk = 0;
          for (int j = 0; j < NT; ++j) { const int o = T.trows[j]; rk += (o > mine || (o == mine && j < F.tid)) ? 1 : 0; }
          T.order[rk] = (unsigned short)F.tid; } }
    __syncthreads();
    return T;
}
typedef int i32x4 __attribute__((ext_vector_type(4)));
struct SchedMoe1 { const bf16_t *H2, *W13; const LAS int* ebase; const LAS int* cnte; const int* einfo; int G, c;
    __device__ __forceinline__ bool next(int i, Unit& u) const { const int L = i * G + c, ntile = ebase[NEXP]; if (L >= ntile * 2) return false;
        const int rt = L >> 1, j = L & 1; int e = 0;
        for (int q = 1; q < NEXP; ++q) e = (ebase[q] <= rt) ? q : e;
        const int tl = rt - ebase[e];
        u.pm = e * 64 + tl; u.pn = j; u.flags = 0; u.aux = cnte[e] - 256 * tl; u.gidx = einfo + ((size_t)e * LIST_CAP + 256 * tl) * 4;
        u.A = H2; u.B = W13 + ((size_t)e * 512 + 256 * j) * 512; return true; } };
struct EpiMoe1 {   static constexpr bool PERM = true; static constexpr bool PRE = false;
    unsigned char* wsb; const i32x4* einfo; const LAS int* cbase;
    __device__ __forceinline__ void operator()(const f32x4 (&acc)[2][2][4][2], const Unit& u, int wr, int wc, int fr, int fq) const {
        const int e = u.pm >> 6, tl = u.pm & 63;
        i32x4 infs[8];
#pragma unroll
        for (int ai = 0; ai < 2; ++ai)
#pragma unroll
            for (int m = 0; m < 4; ++m) { const int r = ai * 128 + wr * 64 + m * 16 + fr; infs[ai * 4 + m] = einfo[(size_t)e * LIST_CAP + 256 * tl + (r < u.aux ? r : 0)]; }
        unsigned dst[8]; float cs[8];
#pragma unroll
        for (int ai = 0; ai < 2; ++ai)
#pragma unroll
            for (int m = 0; m < 4; ++m) { const int r = ai * 128 + wr * 64 + m * 16 + fr; const i32x4 inf = infs[ai * 4 + m]; cs[ai * 4 + m] = bitsf((unsigned)inf.y); const int cls = inf.z & 0xffff, half = inf.z >> 16;
                const size_t d = ((size_t)cbase[cls] * 256 + inf.w) * 512 + 256 * half + 128 * u.pn + 32 * wc + 8 * fq;
                dst[ai * 4 + m] = (r < u.aux) ? (unsigned)(WS_ACT2 + d * 2) : (unsigned)(WS_META + 16 * (fq + 4 * wc)); }
#pragma unroll
        for (int ai = 0; ai < 2; ++ai)
#pragma unroll
            for (int m = 0; m < 4; ++m) {
                float o[8];
#pragma unroll
                for (int n = 0; n < 2; ++n)
#pragma unroll
                    for (int ee = 0; ee < 4; ++ee) { const float a = acc[ai][0][m][n][ee], g = acc[ai][1][m][n][ee]; o[4 * n + ee] = a * sigmoidf_(a) * g * cs[ai * 4 + m]; }
                u32x4 w; w.x = cvt_pk_bf16(o[0], o[1]); w.y = cvt_pk_bf16(o[2], o[3]); w.z = cvt_pk_bf16(o[4], o[5]); w.w = cvt_pk_bf16(o[6], o[7]);
                *(u32x4*)(wsb + dst[ai * 4 + m]) = w; }
    }
};
struct SchedMoe2 { const bf16_t *act2, *W2; const LAS int* cbase; const LAS int* cntc; const LAS unsigned short* order; const LAS unsigned short* tcls; int G, c;
    __device__ __forceinline__ bool next(int i, Unit& u) const { const int L = (i >> 1) * G + c, ntile = cbase[NCLS]; if (L >= ntile * 4) return false;
        const int sub = i & 1, rk = L >> 2, pn = L & 3;
        const int rt = (ntile <= 256) ? (int)order[rk] : rk;
        int cl = 0;
        if (ntile <= 256) cl = (int)tcls[rt]; else { for (int q = 1; q < NCLS; ++q) cl = (cbase[q] <= rt) ? q : cl; }
        const int g = cl / 28; int p = cl % 28, lo = 0; while (p >= 7 - lo) { p -= 7 - lo; ++lo; } const int hi = lo + 1 + p;
        const int e = g * 8 + (sub ? hi : lo), tl = rt - cbase[cl];
        u.pm = cl * 64 + tl; u.pn = pn; u.flags = sub ? 1 : 2; u.aux = cntc[cl] - 256 * tl; u.gidx = nullptr;
        u.A = act2 + (size_t)rt * 256 * 512 + 256 * sub; u.B = W2 + ((size_t)e * 1024 + 256 * pn) * 256; return true; } };
struct EpiMoe2 {   static constexpr bool PERM = false; static constexpr bool PRE = true;
    float* out; const LAS unsigned char* gfL; const int* clist; float* trash;
    __device__ __forceinline__ void prefetch(int (&tk)[8], const Unit& u, int wr, int wc, int fr, int fq) const {
        const int cl = u.pm >> 6, tl = u.pm & 63;
#pragma unroll
        for (int ai = 0; ai < 2; ++ai)
#pragma unroll
            for (int m = 0; m < 4; ++m) { const int r = ai * 128 + wr * 64 + m * 16 + fr; tk[ai * 4 + m] = (r < u.aux) ? clist[(size_t)cl * LIST_CAP + 256 * tl + r] : -1; }
    }
    __device__ __forceinline__ void operator()(const f32x4 (&acc)[2][2][4][2], const Unit& u, int wr, int wc, int fr, int fq, const int (&tk)[8]) const {
        const int colb = u.pn * 256 + wc * 32 + 4 * fq;
#pragma unroll
        for (int ai = 0; ai < 2; ++ai) {
            f32x4 v[4][2][2];
#pragma unroll
            for (int m = 0; m < 4; ++m) { const int tok = tk[ai * 4 + m]; const float* p = (tok < 0) ? trash + 4 * fq : out + (size_t)tok * 1024 + colb;
#pragma unroll
                for (int bj = 0; bj < 2; ++bj)
#pragma unroll
                    for (int n = 0; n < 2; ++n) v[m][bj][n] = *(const f32x4*)(p + bj * 128 + n * 16); }
#pragma unroll
            for (int m = 0; m < 4; ++m) { const int tok = tk[ai * 4 + m]; const int b = (tok < 0 ? 0 : tok) / SEQ; float* p = (tok < 0) ? trash + 4 * fq : out + (size_t)tok * 1024 + colb;
#pragma unroll
                for (int bj = 0; bj < 2; ++bj)
#pragma unroll
                    for (int n = 0; n < 2; ++n) { const u32x2 gw = *(const LAS u32x2*)(gfL + (b * 1024 + colb + bj * 128 + n * 16) * 2); const f32x4 gf = {bflo(gw.x), bfhi(gw.x), bflo(gw.y), bfhi(gw.y)};
                        *(f32x4*)(p + bj * 128 + n * 16) = v[m][bj][n] + gf * acc[ai][bj][m][n]; } }
        }
    }
};

constexpr int NPHASE = 9;
template <int LO, int HI> __global__ void __launch_bounds__(NTHREADS, 2) mk_fwd(Args args) {
    extern __shared__ __attribute__((aligned(16))) unsigned char lds[];
    Frame F;
    F.lds = (LAS unsigned char*)lds; F.tid = threadIdx.x; F.lane = F.tid & 63; F.wave = __builtin_amdgcn_readfirstlane(F.tid >> 6); F.G = gridDim.x; F.bid = blockIdx.x;
    F.ap = &args;
    F.out = args.out; F.ws = args.ws;
    volatile LAS unsigned* MISC = (volatile LAS unsigned*)((LAS unsigned char*)lds + MISC_OFF);
    if (F.tid < 32) MISC[F.tid] = 0u;
    __syncthreads();
    unsigned* ctl = (unsigned*)(F.ws + WS_CTL);
    XcdBarrier bar; bar.bar = ctl + CW_BAR; bar.x = 0; bar.st = nullptr;
    if (MK_N_LAUNCHES == 1) bar = xcd_barrier_post(ctl + CW_BAR, MISC + 8);
#define IN(k) (LO <= (k) && (k) < HI)
#define SEAM(k) do { if constexpr (IN(k) && IN((k) + 1)) xcd_barrier(bar); } while (0)
#ifndef MK_LEAK
#define MK_LEAK -1
#endif
    unsigned long long ts_[12];
#define STAMP(k) do { if (MK_LEAK >= 0) ts_[k] = __builtin_amdgcn_s_memrealtime(); } while (0)
    STAMP(0);
    if constexpr (IN(0)) { p0_phase(F); } SEAM(0); STAMP(1);
    if constexpr (IN(1)) { p1a_phase(F); } SEAM(1); STAMP(2);
    if constexpr (IN(2)) { EpiProj E{F.ws};
        { SchedProj S{WSP(bf16_t, WS_H), WSP(bf16_t, WS_WIN), 1024, 0, F.G, F.bid}; run_gemm(F.lds, 1024, 1024, 1024, S, E); }
        { SchedProj S{WSP(bf16_t, WS_H8), WSP(bf16_t, WS_WIN8), 512, 8, F.G, F.bid}; run_gemm<false, true>(F.lds, 512, 512, 512, S, E); } }
    SEAM(2);
    unsigned long long tlru_ = 0;
    if constexpr (IN(3)) { lru_phase(F); __syncthreads(); if (MK_LEAK >= 0) tlru_ = __builtin_amdgcn_s_memrealtime(); attn_phase(F, 0, 32); } SEAM(3); STAMP(4);
    if constexpr (IN(4)) { SchedMerge S{WSP(bf16_t, WS_AO), WSP(bf16_t, WS_LO), WSP(bf16_t, WS_WPA), WSP(bf16_t, WS_WPB), F.G, F.bid};
        EpiMerge E{WSP(bf16_t, WS_MG), WSP(bf16_t, WS_GA), WSP(bf16_t, WS_GB)};
        run_gemm(F.lds, 512, 512, 512, S, E); } SEAM(4); STAMP(5);
    if constexpr (IN(5)) { SchedOut S{WSP(bf16_t, WS_MG), WSP(bf16_t, WS_WOUT), F.G, F.bid}; EpiOut E{((const float*)F.ap->in[0]), WSP(float, WS_MOD), F.out, WSP(float, WS_ROWSQ)};
        run_gemm(F.lds, 1024, 1024, 1024, S, E); } SEAM(5); STAMP(6);
    if constexpr (IN(6)) { route_phase(F); } SEAM(6); STAMP(7);
    if constexpr (IN(7)) { const MoeTables T = build_tables(F, TBL_OFF);
        SchedMoe1 S{WSP(bf16_t, WS_H2T), WSP(bf16_t, WS_W13), T.ebase, T.cnt, WSP(int, WS_EINFO), F.G, F.bid}; EpiMoe1 E{F.ws, WSP(i32x4, WS_EINFO), T.cbase};
        run_gemm<true, true>(F.lds, 512, 512, 512, S, E); } SEAM(7); STAMP(8);
    if constexpr (IN(8)) { const MoeTables T = (MK_N_LAUNCHES == 1 && IN(7)) ? tables_view(F, TBL_OFF) : build_tables(F, TBL_OFF);
        SchedMoe2 S{WSP(bf16_t, WS_ACT2), WSP(bf16_t, WS_W2), T.cbase, T.cnt + 32, T.order, T.tcls, F.G, F.bid}; EpiMoe2 E{F.out, F.lds + GF_OFF, WSP(int, WS_CLIST), WSP(float, WS_META)};
        for (int i = F.tid; i < 4096; i += NTHREADS) { const int b = i >> 9, c2 = (i & 511) * 2; const float* gp = WSP(float, WS_MOD) + b * 6144 + 5120 + c2; *(LAS unsigned*)(F.lds + GF_OFF + (b * 1024 + c2) * 2) = pk2(gp[0], gp[1]); }
        __syncthreads();
        run_gemm(F.lds, 512, 256, 256, S, E); }
    STAMP(9);
    if (MK_LEAK >= 0 && F.bid == 0 && F.tid == 0) { asm volatile("s_waitcnt vmcnt(0)" ::: "memory");
        unsigned long long d = 0;
        if (MK_LEAK < 10) d = ts_[MK_LEAK + 1] - ts_[MK_LEAK]; else if (MK_LEAK == 10) d = tlru_ - ts_[3]; else if (MK_LEAK == 11) d = MISC[16]; else if (MK_LEAK == 12) d = MISC[17]; else if (MK_LEAK == 13) d = MISC[18]; else if (MK_LEAK == 14) d = MISC[19]; else if (MK_LEAK == 15) d = MISC[20];
        F.out[0] = (float)d * 0.01f; }
#undef IN
#undef SEAM
}

template <int P> static void launch_phase(int grid, hipStream_t stream, Args a) {
    (void)hipFuncSetAttribute((const void*)mk_fwd<P, P + 1>, hipFuncAttributeMaxDynamicSharedMemorySize, LDS_BYTES);
    a.ph_lo = P; a.ph_hi = P + 1; hipLaunchKernelGGL((mk_fwd<P, P + 1>), dim3(grid), dim3(NTHREADS), LDS_BYTES, stream, a);
}
extern "C" void kernel_launch(void* const* d_in, const int* in_sizes, int n_in, void* d_out, int out_size, void* d_ws, size_t ws_size, hipStream_t stream) {
    static int grid = 0;
    if (grid == 0) {
        if (n_in != 26 || out_size != NTOK * DM || ws_size < WS_END) { fprintf(stderr, "kernel_launch: unexpected shapes (n_in %d out %d ws %zu)\n", n_in, out_size, ws_size); grid = -1; return; }
        int dev = 0, cus = 0, per_cu = 0;
        (void)hipGetDevice(&dev); (void)hipDeviceGetAttribute(&cus, hipDeviceAttributeMultiprocessorCount, dev);
#if MK_N_LAUNCHES == 1
        (void)hipFuncSetAttribute((const void*)mk_fwd<0, NPHASE>, hipFuncAttributeMaxDynamicSharedMemorySize, LDS_BYTES);
        (void)hipOccupancyMaxActiveBlocksPerMultiprocessor(&per_cu, (const void*)mk_fwd<0, NPHASE>, NTHREADS, LDS_BYTES);
#else
        (void)hipOccupancyMaxActiveBlocksPerMultiprocessor(&per_cu, (const void*)mk_fwd<2, 3>, NTHREADS, LDS_BYTES);
#endif
        (void)hipGetLastError();
        if (per_cu < 1) { fprintf(stderr, "kernel_launch: occupancy query says %d blocks per CU\n", per_cu); }
        grid = cus;
    }
    if (grid < 0) return;
    (void)hipMemsetAsync((char*)d_ws + WS_CTL, 0, CTL_ZERO_BYTES, stream);
    Args a{};
    for (int i = 0; i < 26; ++i) a.in[i] = d_in[i];
    a.out = (float*)d_out; a.ws = (unsigned char*)d_ws;
#if MK_N_LAUNCHES == 1
    a.ph_lo = 0; a.ph_hi = NPHASE; hipLaunchKernelGGL((mk_fwd<0, NPHASE>), dim3(grid), dim3(NTHREADS), LDS_BYTES, stream, a);
#else
#ifndef MK_REPMASK
#define MK_REPMASK 0
#endif
    for (int r = 0; r < ((MK_REPMASK & 1) ? 2 : 1); ++r) launch_phase<0>(grid, stream, a);
    for (int r = 0; r < ((MK_REPMASK & 2) ? 2 : 1); ++r) launch_phase<1>(grid, stream, a);
    for (int r = 0; r < ((MK_REPMASK & 4) ? 2 : 1); ++r) launch_phase<2>(grid, stream, a);
    for (int r = 0; r < ((MK_REPMASK & 8) ? 2 : 1); ++r) launch_phase<3>(grid, stream, a);
    for (int r = 0; r < ((MK_REPMASK & 16) ? 2 : 1); ++r) launch_phase<4>(grid, stream, a);
    for (int r = 0; r < ((MK_REPMASK & 32) ? 2 : 1); ++r) launch_phase<5>(grid, stream, a);
    launch_phase<6>(grid, stream, a);
    for (int r = 0; r < ((MK_REPMASK & 128) ? 2 : 1); ++r) launch_phase<7>(grid, stream, a);
    for (int r = 0; r < ((MK_REPMASK & 256) ? 2 : 1); ++r) launch_phase<8>(grid, stream, a);
    launch_phase<9>(grid, stream, a);
    if (MK_REPMASK & 512) { launch_phase<5>(grid, stream, a); launch_phase<9>(grid, stream, a); }
#endif
}
```

```cpp
#include <hip/hip_runtime.h>
#include <cstdint>
#include <cstdio>

#ifndef MK_LEAK
#define MK_LEAK -1
#endif
#ifndef MK_N_LAUNCHES
#define MK_N_LAUNCHES 1
#endif

#define LAS __attribute__((address_space(3)))
#define GAS __attribute__((address_space(1)))
typedef unsigned short bf16_t;
typedef short bf16x8 __attribute__((ext_vector_type(8)));
typedef float f32x4 __attribute__((ext_vector_type(4)));
typedef float f32x2 __attribute__((ext_vector_type(2)));
typedef unsigned u32x4 __attribute__((ext_vector_type(4)));
typedef unsigned u32x2 __attribute__((ext_vector_type(2)));
typedef GAS unsigned gu32;

constexpr int BATCH = 8, SEQ = 2048, DM = 1024, NTOK = BATCH * SEQ;
constexpr int NH = 8, HD = 64, NIH = 4, TOPK = 256, CHUNK = 64;
constexpr int LRUW = 512;
constexpr int NEXP = 32, NGRP = 4, EPG = 8, DFF = 256, NCLS = NGRP * 28;
constexpr int DIN_PAD = 4096;
constexpr float EPS = 1e-6f;
constexpr int C_Q = 0, C_K = 512, C_V = 576, C_QI = 640, C_KI = 896, C_LX = 960, C_LG = 1472, C_WI = 1984, C_PAD = 1988, C_GA = 2048, C_GB = 3072, C_END = 4096;

constexpr size_t MiB = 1u << 20;
constexpr size_t WS_CTL = 0, CTL_ZERO_BYTES = 1 * MiB;
constexpr size_t WS_MOD = 1 * MiB;
constexpr size_t WS_META = 1 * MiB + 512 * 1024;
constexpr size_t WS_WIN = 2 * MiB, WS_WPA = 10 * MiB, WS_WPB = 11 * MiB, WS_WOUT = 12 * MiB, WS_W13 = 14 * MiB, WS_W2 = 46 * MiB;
constexpr size_t WS_WRH = 62 * MiB, WS_WRL = 62 * MiB + 256 * 1024;
constexpr size_t WS_H = 64 * MiB;
constexpr size_t WS_AO = 64 * MiB, WS_LO = 80 * MiB;
constexpr size_t WS_Q = 96 * MiB, WS_QI = 112 * MiB, WS_K = 120 * MiB, WS_KI = 122 * MiB, WS_VT = 124 * MiB, WS_WI = 126 * MiB, WS_VR = 224 * MiB;
constexpr size_t WS_LX = 128 * MiB, WS_LG = 144 * MiB, WS_MG = 128 * MiB;
constexpr size_t WS_GA = 160 * MiB, WS_GB = 192 * MiB;
constexpr size_t WS_A1 = 64 * MiB;
constexpr size_t WS_H2T = 160 * MiB;
constexpr size_t WS_ACT2 = 192 * MiB;
constexpr size_t WS_H8 = 224 * MiB;
constexpr size_t WS_WIN8 = 6 * MiB;
constexpr size_t WS_EINFO = 64 * MiB;
constexpr size_t WS_CLIST = 72 * MiB;
constexpr int LIST_CAP = 16384;
constexpr size_t WS_ROWSQ = 240 * MiB;
constexpr size_t WS_END = 256 * MiB;
constexpr int CW_BAR = 4096, CW_CNTE = 8192, CW_CNTC = 8192 + 32 * 32, CNT_STRIDE = 32, CW_ROWSQ = 16384;

constexpr int NWAVES = 8, NTHREADS = 512;
constexpr int LDS_BYTES = 151552, RING_BYTES = 131072, MISC_OFF = LDS_BYTES - 512, GF_OFF = RING_BYTES, TBL_OFF = RING_BYTES + 16384;

typedef float f32x2_cv __attribute__((ext_vector_type(2)));
typedef __bf16 bf16x2_cv __attribute__((ext_vector_type(2)));
__device__ __forceinline__ unsigned pk2(float lo, float hi) { const f32x2_cv v = {lo, hi}; return __builtin_bit_cast(unsigned, __builtin_convertvector(v, bf16x2_cv)); }
__device__ __forceinline__ unsigned f2bf(float f) { return pk2(f, 0.f) & 0xffffu; }
__device__ __forceinline__ unsigned cvt_pk_bf16(float lo, float hi) { return pk2(lo, hi); }

#define LDS_BARRIER() do { asm volatile("s_waitcnt lgkmcnt(0)" ::: "memory"); __builtin_amdgcn_s_barrier(); asm volatile("" ::: "memory"); } while (0)
__device__ __forceinline__ float relu_f(float x) { float r; asm("v_max_f32 %0, 0, %1" : "=v"(r) : "v"(x)); return r; }
__device__ __forceinline__ float max3f(float a, float b, float c) { float r; asm("v_max3_f32 %0, %1, %2, %3" : "=v"(r) : "v"(a), "v"(b), "v"(c)); return r; }
typedef int v8i32 __attribute__((ext_vector_type(8)));
__device__ __forceinline__ unsigned pk4_fp8(float a, float b, float c, float d) { int w = 0; w = __builtin_amdgcn_cvt_pk_fp8_f32(a, b, w, false); w = __builtin_amdgcn_cvt_pk_fp8_f32(c, d, w, true); return (unsigned)w; }
__device__ __forceinline__ float bf2f(unsigned short b) { return __builtin_bit_cast(float, (unsigned)b << 16); }
__device__ __forceinline__ float bflo(unsigned w) { return __builtin_bit_cast(float, w << 16); }
__device__ __forceinline__ float bfhi(unsigned w) { return __builtin_bit_cast(float, w & 0xffff0000u); }
__device__ __forceinline__ float wave_sum(float v) {
#pragma unroll
    for (int o = 1; o < 64; o <<= 1) v += __shfl_xor(v, o);
    return v;
}
__device__ __forceinline__ float wave_max(float v) {
#pragma unroll
    for (int o = 1; o < 64; o <<= 1) v = fmaxf(v, __shfl_xor(v, o));
    return v;
}
__device__ __forceinline__ int wave_isum(int v) {
#pragma unroll
    for (int o = 1; o < 64; o <<= 1) v += __shfl_xor(v, o);
    return v;
}
__device__ __forceinline__ float sigmoidf_(float x) { return __builtin_amdgcn_rcpf(1.f + __expf(-x)); }
__host__ __device__ __forceinline__ int perm32(int rho) { const int n = rho >> 4, i = rho & 15; return 8 * (i >> 2) + 4 * n + (i & 3); }
__device__ __forceinline__ int vt_pos(int o) { return 8 * ((o >> 2) & 1) + 4 * (o >> 3) + (o & 3); }

#define XB_TMO      128
#define XB_XCNT(j)  (256  + 64 * (j))
#define XB_XSUB(j)  (1280 + 64 * (j))
#define XB_XGEN(j)  (2304 + 64 * (j))
#define XB_TOP      3328
#define XB_TOPGEN   3392
#define XCD_BAR_WORDS 3456
#define XB_SPIN_CAP (1u << 18)
__device__ __forceinline__ unsigned xb_ld(unsigned* p)              { return __hip_atomic_load(p, __ATOMIC_RELAXED, __HIP_MEMORY_SCOPE_AGENT); }
__device__ __forceinline__ unsigned xb_add(unsigned* p, unsigned v) { return __hip_atomic_fetch_add(p, v, __ATOMIC_RELAXED, __HIP_MEMORY_SCOPE_AGENT); }
__device__ __forceinline__ unsigned xb_xcc_id() { return (unsigned)__builtin_amdgcn_s_getreg((3 << 11) | 20) & 0xFu; }
#define XB_SPIN(cond, bar) do { unsigned _sp = 0; while (cond) { __builtin_amdgcn_s_sleep(1); \
    if ((++_sp & 255u) == 0u) { if (xb_ld(&(bar)[XB_TMO])) break; if (_sp > XB_SPIN_CAP) { atomicAdd(&(bar)[XB_TMO], 1u); break; } } } } while (0)
struct XcdBarrier { unsigned* bar; unsigned x; volatile LAS unsigned* st; };
__device__ __forceinline__ XcdBarrier xcd_barrier_post(unsigned* bar, volatile LAS unsigned* st) {
    XcdBarrier b; b.bar = bar; b.x = xb_xcc_id(); b.st = st;
    if (threadIdx.x == 0) (void)xb_add(&bar[XB_XCNT(b.x)], 1u);
    return b;
}
__device__ __forceinline__ void xcd_barrier_complete(unsigned* bar, unsigned x, unsigned& nloc, unsigned& nx) {
    const unsigned G = gridDim.x * gridDim.y * gridDim.z;
    unsigned sum, cnt, mine, sp = 0u;
    for (;;) {
        sum = 0u; cnt = 0u; mine = 0u;
#pragma unroll
        for (unsigned j = 0; j < 16; ++j) { const unsigned c = xb_ld(&bar[XB_XCNT(j)]); sum += c; cnt += (c > 0u) ? 1u : 0u; mine = (j == x) ? c : mine; }
        if (sum == G) break;
        __builtin_amdgcn_s_sleep(1);
        if ((++sp & 255u) == 0u) { if (xb_ld(&bar[XB_TMO])) break; if (sp > XB_SPIN_CAP) { atomicAdd(&bar[XB_TMO], 1u); break; } }
    }
    nloc = mine > 0u ? mine : 1u; nx = cnt > 0u ? cnt : 1u;
}
__device__ __forceinline__ void xcd_barrier(const XcdBarrier& b) {
    asm volatile("s_waitcnt vmcnt(0)" ::: "memory");
    __syncthreads();
    if (threadIdx.x == 0) {
        unsigned* bar = b.bar;
        __builtin_amdgcn_s_waitcnt(0);
        unsigned nloc = b.st[0], nx = b.st[1];
        if (nloc == 0u) { xcd_barrier_complete(bar, b.x, nloc, nx); b.st[0] = nloc; b.st[1] = nx; }
        const unsigned old = xb_add(&bar[XB_XSUB(b.x)], 1u);
        const unsigned gen = old / nloc;
        if (old + 1u == (gen + 1u) * nloc) {
            __builtin_amdgcn_fence(__ATOMIC_RELEASE, "agent");
            asm volatile("s_waitcnt vmcnt(0)" ::: "memory");
            const unsigned og = xb_add(&bar[XB_TOP], 1u);
            const unsigned tg = og / nx;
            if (og + 1u == (tg + 1u) * nx) xb_add(&bar[XB_TOPGEN], 1u);
            else XB_SPIN(xb_ld(&bar[XB_TOPGEN]) == tg, bar);
            __builtin_amdgcn_fence(__ATOMIC_ACQUIRE, "agent");
            xb_add(&bar[XB_XGEN(b.x)], 1u);
            asm volatile("s_waitcnt vmcnt(0)" ::: "memory");
        } else {
            XB_SPIN(xb_ld(&bar[XB_XGEN(b.x)]) == gen, bar);
            __builtin_amdgcn_fence(__ATOMIC_ACQUIRE, "agent");
            asm volatile("s_waitcnt vmcnt(0)" ::: "memory");
        }
    }
    __syncthreads();
}

struct Args { const void* in[26]; float* out; unsigned char* ws; int ph_lo, ph_hi; };
struct Frame {
    LAS unsigned char* lds;
    int tid, lane, wave, G, bid;
    const Args* ap;
    float* out; unsigned char* ws;
};
#define WSP(T, off) ((T*)(F.ws + (off)))

__device__ __forceinline__ void tr_item(const float* __restrict__ src, int ld, int k0, int c0, int nvalid, bf16_t* dst, int ldd, LAS float* scr, int lane) {
    const int c4 = (lane & 7) * 4, rr = lane >> 3;
    if (nvalid == 32 && ((c0 | ld) & 3) == 0) {
        f32x4 v[8];
#pragma unroll
        for (int i = 0; i < 8; ++i) v[i] = *(const f32x4*)(src + (size_t)(k0 + 8 * i + rr) * ld + c0 + c4);
#pragma unroll
        for (int i = 0; i < 8; ++i) { LAS float* p = scr + (8 * i + rr) * 33 + c4; p[0] = v[i].x; p[1] = v[i].y; p[2] = v[i].z; p[3] = v[i].w; }
    } else {
#pragma unroll 8
        for (int i = 0; i < 32; ++i) { const int kk = 2 * i + (lane >> 5), cc = lane & 31;
            scr[kk * 33 + cc] = (cc < nvalid) ? src[(size_t)(k0 + kk) * ld + c0 + cc] : 0.f; }
    }
    asm volatile("s_waitcnt lgkmcnt(0)" ::: "memory");
    const int c = lane & 7;
#pragma unroll
    for (int j = 0; j < 4; ++j) { const int n = (lane >> 3) + 8 * j; const LAS float* s = scr + (8 * c) * 33 + n;
        u32x4 o; o.x = cvt_pk_bf16(s[0 * 33], s[1 * 33]); o.y = cvt_pk_bf16(s[2 * 33], s[3 * 33]); o.z = cvt_pk_bf16(s[4 * 33], s[5 * 33]); o.w = cvt_pk_bf16(s[6 * 33], s[7 * 33]);
        *(u32x4*)(dst + (size_t)n * ldd + k0 + 8 * c) = o; }
    asm volatile("s_waitcnt lgkmcnt(0)" ::: "memory");
}
constexpr float W8_SCALE = 32.f;
__device__ __forceinline__ void tr_item8(const float* __restrict__ src, int ld, int k0, int c0, int nvalid, unsigned char* dst, int ldd, LAS float* scr, int lane) {
    const int c4 = (lane & 7) * 4, rr = lane >> 3;
    if (nvalid == 32 && ((c0 | ld) & 3) == 0) {
        f32x4 v[8];
#pragma unroll
        for (int i = 0; i < 8; ++i) v[i] = *(const f32x4*)(src + (size_t)(k0 + 8 * i + rr) * ld + c0 + c4);
#pragma unroll
        for (int i = 0; i < 8; ++i) { LAS float* p = scr + (8 * i + rr) * 33 + c4; p[0] = v[i].x; p[1] = v[i].y; p[2] = v[i].z; p[3] = v[i].w; }
    } else {
#pragma unroll 8
        for (int i = 0; i < 32; ++i) { const int kk = 2 * i + (lane >> 5), cc = lane & 31;
            scr[kk * 33 + cc] = (cc < nvalid) ? src[(size_t)(k0 + kk) * ld + c0 + cc] : 0.f; }
    }
    asm volatile("s_waitcnt lgkmcnt(0)" ::: "memory");
    const int c = lane & 7;
#pragma unroll
    for (int j = 0; j < 4; ++j) { const int n = (lane >> 3) + 8 * j; const LAS float* s = scr + (8 * c) * 33 + n;
        u32x2 o; o.x = pk4_fp8(s[0 * 33] * W8_SCALE, s[1 * 33] * W8_SCALE, s[2 * 33] * W8_SCALE, s[3 * 33] * W8_SCALE); o.y = pk4_fp8(s[4 * 33] * W8_SCALE, s[5 * 33] * W8_SCALE, s[6 * 33] * W8_SCALE, s[7 * 33] * W8_SCALE);
        *(u32x2*)(dst + (size_t)n * ldd + k0 + 8 * c) = o; }
    asm volatile("s_waitcnt lgkmcnt(0)" ::: "memory");
}
__device__ __forceinline__ void p0_phase(Frame& F) {
    LAS float* cond = (LAS float*)(F.lds + 8 * 8448);
    LAS float* part = (LAS float*)(F.lds + 8 * 8448 + 32768);
    for (int i = F.tid; i < BATCH * DM; i += NTHREADS) { const float v = ((const float*)F.ap->in[1])[i]; cond[i] = v * __builtin_amdgcn_rcpf(1.f + __expf(-v)); }
    __syncthreads();
#pragma unroll 1
    for (int item = F.bid; item < 384; item += F.G) {
        const int col = item * 16 + (F.lane & 15), kq = F.lane >> 4, kb = 128 * F.wave + kq;
        const float* wp = ((const float*)F.ap->in[2]) + (size_t)kb * 6144 + col;
        float wv[32];
#pragma unroll
        for (int i = 0; i < 32; ++i) wv[i] = wp[(size_t)(4 * i) * 6144];
        float acc[8];
#pragma unroll
        for (int b = 0; b < 8; ++b) acc[b] = 0.f;
#pragma unroll
        for (int i = 0; i < 32; ++i) {
#pragma unroll
            for (int b = 0; b < 8; ++b) acc[b] += cond[b * DM + kb + 4 * i] * wv[i]; }
#pragma unroll
        for (int b = 0; b < 8; ++b) { float v = acc[b]; v += __shfl_xor(v, 16); v += __shfl_xor(v, 32); acc[b] = v; }
        if (kq == 0) {
#pragma unroll
            for (int b = 0; b < 8; ++b) part[(F.wave * 8 + b) * 16 + (F.lane & 15)] = acc[b]; }
        __syncthreads();
        if (F.tid < 128) { const int b = F.tid >> 4, c = F.tid & 15; float s = ((const float*)F.ap->in[3])[item * 16 + c];
#pragma unroll
            for (int w = 0; w < 8; ++w) s += part[(w * 8 + b) * 16 + c];
            WSP(float, WS_MOD)[b * 6144 + item * 16 + c] = s; }
        __syncthreads();
    }
    LAS float* scr = (LAS float*)(F.lds + F.wave * 8448);
    const int gw = F.bid * NWAVES + F.wave, NGW = F.G * NWAVES;
    constexpr int I_WIN = 16 * 128, I_WP = 8 * 32, I_WO = 16 * 32, I_W13 = 32 * 256, I_W2 = 32 * 128;
    constexpr int NITEMS = I_WIN + 2 * I_WP + I_WO + I_W13 + I_W2;
    for (int it = gw; it < NITEMS; it += NGW) {
        int r = it;
        if (r < I_WIN) { const int kb = r / 128, nb = r % 128, n0 = 32 * nb; int c0, nv;
            if (n0 < C_LX) { c0 = n0; nv = 32; } else if (n0 < C_WI) { c0 = n0 + 4; nv = 32; } else if (n0 == C_WI) { c0 = 960; nv = 4; } else if (n0 < C_GA) { c0 = 0; nv = 0; } else { c0 = n0 - 60; nv = 32; }
            if (n0 < C_GA) tr_item(((const float*)F.ap->in[5]), 4036, 64 * kb, c0, nv, WSP(bf16_t, WS_WIN) + (size_t)n0 * 1024, 1024, scr, F.lane);
            else tr_item8(((const float*)F.ap->in[5]), 4036, 64 * kb, c0, nv, WSP(unsigned char, WS_WIN8) + (size_t)(n0 - C_GA) * 1024, 1024, scr, F.lane);
            continue; } r -= I_WIN;
        if (r < I_WP) { const int kb = r / 32, nb = r % 32; tr_item(((const float*)F.ap->in[15]), 1024, 64 * kb, 32 * nb, 32, WSP(bf16_t, WS_WPA) + (size_t)(32 * nb) * 512, 512, scr, F.lane); continue; } r -= I_WP;
        if (r < I_WP) { const int kb = r / 32, nb = r % 32; tr_item(((const float*)F.ap->in[16]), 1024, 64 * kb, 32 * nb, 32, WSP(bf16_t, WS_WPB) + (size_t)(32 * nb) * 512, 512, scr, F.lane); continue; } r -= I_WP;
        if (r < I_WO) { const int kb = r / 32, nb = r % 32; tr_item(((const float*)F.ap->in[17]), 1024, 64 * kb, 32 * nb, 32, WSP(bf16_t, WS_WOUT) + (size_t)(32 * nb) * 1024, 1024, scr, F.lane); continue; } r -= I_WO;
        if (r < I_W13) { const int e = r / 256, r2 = r % 256, kb = r2 / 16, nb = r2 % 16, n0 = 32 * nb, j = n0 >> 8, half = (n0 >> 7) & 1, cc0 = n0 & 127;
            const float* src = (half ? ((const float*)F.ap->in[24]) : ((const float*)F.ap->in[23])) + (size_t)e * 1024 * 256;
            tr_item8(src, 256, 64 * kb, 128 * j + cc0, 32, WSP(unsigned char, WS_W13) + ((size_t)e * 512 + n0) * 1024, 1024, scr, F.lane); continue; } r -= I_W13;
        { const int e = r / 128, r2 = r % 128, kb = r2 / 32, nb = r2 % 32;
            tr_item(((const float*)F.ap->in[25]) + (size_t)e * 256 * 1024, 1024, 64 * kb, 32 * nb, 32, WSP(bf16_t, WS_W2) + ((size_t)e * 1024 + 32 * nb) * 256, 256, scr, F.lane); }
    }
    for (int i = F.bid * NTHREADS + F.tid; i < 48 * 1024; i += F.G * NTHREADS) { const int r = i >> 10, k = i & 1023;
        const float v = r < 4 ? ((const float*)F.ap->in[19])[k * 4 + r] : r < 36 ? ((const float*)F.ap->in[21])[k * 32 + (r - 4)] : 0.f;
        const unsigned hi = f2bf(v); const float rem = v - bf2f((unsigned short)hi);
        WSP(bf16_t, WS_WRH)[i] = (bf16_t)hi; WSP(bf16_t, WS_WRL)[i] = (bf16_t)f2bf(rem); }
}

__device__ __forceinline__ void p1a_phase(Frame& F) {
    const int gw = F.bid * NWAVES + F.wave, NGW = F.G * NWAVES;
    const float* mod = WSP(float, WS_MOD);
    bf16_t* H = WSP(bf16_t, WS_H);
    const float* nmw = (const float*)F.ap->in[4];
#pragma unroll 1
    for (int row0 = 4 * gw; row0 < NTOK; row0 += 4 * NGW) {
        const int b = row0 / SEQ;
        f32x4 v[4][4];
#pragma unroll
        for (int r = 0; r < 4; ++r) { const f32x4* xr = (const f32x4*)(((const float*)F.ap->in[0]) + (size_t)(row0 + r) * DM) + F.lane;
#pragma unroll
            for (int j = 0; j < 4; ++j) v[r][j] = xr[64 * j]; }
        f32x4 gg[4], sh[4];
#pragma unroll
        for (int j = 0; j < 4; ++j) { const int col = 4 * F.lane + 256 * j; gg[j] = *(const f32x4*)(nmw + col) * (*(const f32x4*)(mod + b * 6144 + 1024 + col) + 1.f); sh[j] = *(const f32x4*)(mod + b * 6144 + col); }
#pragma unroll
        for (int r = 0; r < 4; ++r) { float s = 0.f;
#pragma unroll
            for (int j = 0; j < 4; ++j) s += (v[r][j].x * v[r][j].x + v[r][j].y * v[r][j].y) + (v[r][j].z * v[r][j].z + v[r][j].w * v[r][j].w);
            const float rinv = rsqrtf(wave_sum(s) * (1.f / DM) + EPS);
            unsigned long long* o8 = (unsigned long long*)(H + (size_t)(row0 + r) * DM) + F.lane;
            unsigned* o4 = (unsigned*)(F.ws + WS_H8 + (size_t)(row0 + r) * DM) + F.lane;
#pragma unroll
            for (int j = 0; j < 4; ++j) { const f32x4 hv = v[r][j] * rinv * gg[j] + sh[j];
                o8[64 * j] = (unsigned long long)cvt_pk_bf16(hv.x, hv.y) | ((unsigned long long)cvt_pk_bf16(hv.z, hv.w) << 32); o4[64 * j] = pk4_fp8(hv.x, hv.y, hv.z, hv.w); } }
    }
}

struct Unit { const bf16_t* A; const bf16_t* B; int pm, pn, aux, flags; const int* gidx; };
template <bool PERM, class Sched, class Epi>
__device__ __forceinline__ void gemm_naive(int lda, int ldb, int K, const Sched& S, const Epi& E) {
    const int tid = threadIdx.x, wid = __builtin_amdgcn_readfirstlane(tid >> 6), lane = tid & 63, wr = wid >> 2, wc = wid & 3, fr = lane & 15, fq = lane >> 4;
    f32x4 acc[2][2][4][2];
    Unit u;
    for (int i = 0; S.next(i, u); ++i) {
        if (!(u.flags & 1)) {
#pragma unroll
            for (int a = 0; a < 2; ++a)
#pragma unroll
                for (int b = 0; b < 2; ++b)
#pragma unroll
                    for (int m = 0; m < 4; ++m)
#pragma unroll
                        for (int n = 0; n < 2; ++n) acc[a][b][m][n] = (f32x4){0.f, 0.f, 0.f, 0.f};
        }
#pragma unroll 1
        for (int k0 = 0; k0 < K; k0 += 32) {
            bf16x8 bfr[2][2];
#pragma unroll
            for (int bj = 0; bj < 2; ++bj)
#pragma unroll
                for (int n = 0; n < 2; ++n) { const int rho = 16 * n + fr, rr = PERM ? perm32(rho) : rho;
                    bfr[bj][n] = *(const bf16x8*)(u.B + (size_t)(128 * bj + 32 * wc + rr) * ldb + k0 + 8 * fq); }
#pragma unroll
            for (int ai = 0; ai < 2; ++ai) {
                bf16x8 af[4];
#pragma unroll
                for (int m = 0; m < 4; ++m) af[m] = *(const bf16x8*)(u.A + (size_t)(128 * ai + 64 * wr + 16 * m + fr) * lda + k0 + 8 * fq);
#pragma unroll
                for (int bj = 0; bj < 2; ++bj)
#pragma unroll
                    for (int m = 0; m < 4; ++m)
#pragma unroll
                        for (int n = 0; n < 2; ++n) acc[ai][bj][m][n] = __builtin_amdgcn_mfma_f32_16x16x32_bf16(bfr[bj][n], af[m], acc[ai][bj][m][n], 0, 0, 0);
            }
        }
        if (!(u.flags & 2)) E(acc, u, wr, wc, fr, fq);
    }
}


namespace pg8 {
constexpr int BK = 64, HALF = 128, HTB = HALF * BK * 2;
__device__ __forceinline__ int lds_byte(int r, int c) { const int st = (r >> 4) * 2 + (c >> 5), rr = r & 15, cc = c & 31, ob = rr * 64 + cc * 2; return st * 1024 + (ob ^ (((ob >> 9) & 1) << 5)); }
__device__ __forceinline__ void stage_rc(int b, int& R, int& C) { const int st = b / 1024, sb = b % 1024, swz = sb ^ (((sb >> 9) & 1) << 5); R = (st >> 1) * 16 + swz / 64; C = (st & 1) * 32 + (swz % 64) / 2; }
template <class Epi, class Sched, bool ALIGN_EPI, bool GATHER = false, bool FP8 = false>
__device__ __forceinline__ void gemm_phase(LAS unsigned char* lds, int lda, int ldb, int K, const Sched& S, const Epi& E) {
    int tid_ = threadIdx.x; asm volatile("" : "+v"(tid_));
    const int tid = tid_, wid = __builtin_amdgcn_readfirstlane(tid >> 6), lane = tid & 63, wr = wid >> 2, wc = wid & 3, fr = lane & 15, fq = lane >> 4;
    const int nt = K / BK;
    unsigned voffA[2], voffB[2];
#pragma unroll
    for (int i = 0; i < 2; ++i) { int R, C; stage_rc(tid * 16 + i * 8192, R, C); const int Rb = Epi::PERM ? ((R & ~31) + perm32(R & 31)) : R;
        voffA[i] = (unsigned)(R * lda + C) * 2u; voffB[i] = (unsigned)(Rb * ldb + C) * 2u; }
    const size_t kstep = (size_t)(BK * 2);
    const size_t hstepA = GATHER ? 0 : (size_t)HALF * lda * 2, hstepB = (size_t)HALF * ldb * 2;
    unsigned gC[2], gN[2], gcol[2];
#pragma unroll
    for (int i_ = 0; i_ < 2; ++i_) { int R_, C_; stage_rc(tid * 16 + i_ * 8192, R_, C_); gcol[i_] = (unsigned)C_ * 2u; }
#define PG8_GOFF(dst, u) do { _Pragma("unroll") for (int h_ = 0; h_ < 2; ++h_) { unsigned pk_ = 0u; _Pragma("unroll") for (int i_ = 0; i_ < 2; ++i_) { int R_, C_; stage_rc(tid * 16 + i_ * 8192, R_, C_); \
        const int row_ = h_ * HALF + R_; const unsigned tok_ = (unsigned)(u).gidx[4 * (row_ < (u).aux ? row_ : 0)]; pk_ |= tok_ << (16 * i_); } dst[h_] = pk_; } } while (0)
    const unsigned ldsw = (unsigned)wid * 1024u;
    const int aoff = FP8 ? lds_byte(wr * 64 + fr, fq * 16) : lds_byte(wr * 64 + fr, fq * 8), boff = FP8 ? lds_byte(wc * 32 + fr, fq * 16) : lds_byte(wc * 32 + fr, fq * 8);
#define PG8_SA(b, h) (((b) * 2 + (h)) * HTB)
#define PG8_SB(b, h) ((4 + (b) * 2 + (h)) * HTB)
#define PG8_STAGE(bufoff, gbase, voff) do { _Pragma("unroll") for (int _i = 0; _i < 2; ++_i) \
        __builtin_amdgcn_global_load_lds((const unsigned*)((const char*)(gbase) + (voff)[_i]), (LAS unsigned*)(lds + (bufoff) + ldsw + _i * 8192), 16, 0, 0); } while (0)
#define PG8_STAGE_A(b, h, gbase, nx) do { if constexpr (GATHER) { const unsigned pk_ = (nx) ? gN[h] : gC[h]; unsigned vo_[2]; vo_[0] = (pk_ & 0xffffu) * (unsigned)(lda * 2) + gcol[0]; vo_[1] = (pk_ >> 16) * (unsigned)(lda * 2) + gcol[1]; PG8_STAGE(PG8_SA(b, h), gbase, vo_); } \
        else PG8_STAGE(PG8_SA(b, h), (gbase) + (h) * hstepA, voffA); } while (0)
#define PG8_LDA8(dst, b, h) do { _Pragma("unroll") for (int m = 0; m < 4; ++m) { const LAS u32x4* p_ = (const LAS u32x4*)(lds + PG8_SA(b, h) + aoff + m * 2048); const u32x4 x_ = p_[0], y_ = p_[1]; \
        dst[m] = __builtin_bit_cast(v8i32, __builtin_shufflevector(x_, y_, 0, 1, 2, 3, 4, 5, 6, 7)); } } while (0)
#define PG8_LDB8(dst, b, h) do { _Pragma("unroll") for (int n = 0; n < 2; ++n) { const LAS u32x4* p_ = (const LAS u32x4*)(lds + PG8_SB(b, h) + boff + n * 2048); const u32x4 x_ = p_[0], y_ = p_[1]; \
        dst[n] = __builtin_bit_cast(v8i32, __builtin_shufflevector(x_, y_, 0, 1, 2, 3, 4, 5, 6, 7)); } } while (0)
#define PG8_MMA8(ai, bj, At, Bt) do { __builtin_amdgcn_s_setprio(1); _Pragma("unroll") for (int m = 0; m < 4; ++m) _Pragma("unroll") for (int n = 0; n < 2; ++n) \
        asm volatile("v_mfma_scale_f32_16x16x128_f8f6f4 %0, %1, %2, %0, %3, %4 op_sel_hi:[0,0,0]" : "+v"(acc[ai][bj][m][n]) : "v"(Bt[n]), "v"(At[m]), "v"(sclW), "v"(sclA));   \
        __builtin_amdgcn_s_setprio(0); } while (0)
#define PG8_LDA(dst, b, h) do { _Pragma("unroll") for (int m = 0; m < 4; ++m) _Pragma("unroll") for (int k = 0; k < 2; ++k) dst[m][k] = *(const LAS bf16x8*)(lds + PG8_SA(b, h) + aoff + m * 2048 + k * 1024); } while (0)
#define PG8_LDB(dst, b, h) do { _Pragma("unroll") for (int n = 0; n < 2; ++n) _Pragma("unroll") for (int k = 0; k < 2; ++k) dst[n][k] = *(const LAS bf16x8*)(lds + PG8_SB(b, h) + boff + n * 2048 + k * 1024); } while (0)
#define PG8_MMA(ai, bj, At, Bt) do { __builtin_amdgcn_s_setprio(1); _Pragma("unroll") for (int m = 0; m < 4; ++m) _Pragma("unroll") for (int n = 0; n < 2; ++n) _Pragma("unroll") for (int k = 0; k < 2; ++k) \
        acc[ai][bj][m][n] = __builtin_amdgcn_mfma_f32_16x16x32_bf16(Bt[n][k], At[m][k], acc[ai][bj][m][n], 0, 0, 0); __builtin_amdgcn_s_setprio(0); } while (0)
#define PG8_WAIT_V(n) asm volatile("s_waitcnt vmcnt(" #n ")" ::: "memory")
#define PG8_WAIT_L(n) asm volatile("s_waitcnt lgkmcnt(" #n ")" ::: "memory")
#define PG8_BAR __builtin_amdgcn_s_barrier()
#define PG8_SCHED __builtin_amdgcn_sched_barrier(0)
#define PG8_ZERO() do { _Pragma("unroll") for (int a = 0; a < 2; ++a) _Pragma("unroll") for (int b = 0; b < 2; ++b) _Pragma("unroll") for (int m = 0; m < 4; ++m) _Pragma("unroll") for (int n = 0; n < 2; ++n) acc[a][b][m][n] = (f32x4){0.f, 0.f, 0.f, 0.f}; } while (0)
    Unit cur, nxt; int ui = 0;
    if (!S.next(0, cur)) return;
    f32x4 acc[2][2][4][2];
    PG8_ZERO();
    bf16x8 At[4][2], B0[2][2], B1[2][2]; v8i32 At8[4], B08[2], B18[2];
    int sclW = 0x7a7a7a7a, sclA = 0x7f7f7f7f; asm volatile("" : "+v"(sclW), "+v"(sclA));
#define PG8_XLDA(b, h) do { if constexpr (FP8) PG8_LDA8(At8, b, h); else PG8_LDA(At, b, h); } while (0)
#define PG8_XLDB0(b, h) do { if constexpr (FP8) PG8_LDB8(B08, b, h); else PG8_LDB(B0, b, h); } while (0)
#define PG8_XLDB1(b, h) do { if constexpr (FP8) PG8_LDB8(B18, b, h); else PG8_LDB(B1, b, h); } while (0)
#define PG8_XMMA0(ai, bj) do { if constexpr (FP8) PG8_MMA8(ai, bj, At8, B08); else PG8_MMA(ai, bj, At, B0); } while (0)
#define PG8_XMMA1(ai, bj) do { if constexpr (FP8) PG8_MMA8(ai, bj, At8, B18); else PG8_MMA(ai, bj, At, B1); } while (0)
    const char* cA = (const char*)cur.A; const char* cB = (const char*)cur.B;
    if constexpr (GATHER) { PG8_GOFF(gC, cur); gN[0] = gC[0]; gN[1] = gC[1]; }
    PG8_STAGE(PG8_SB(0, 0), cB, voffB); PG8_STAGE(PG8_SB(0, 1), cB + hstepB, voffB); PG8_STAGE_A(0, 0, cA, false); PG8_STAGE_A(0, 1, cA, false);
    if (wr == 1) PG8_BAR;
    PG8_WAIT_V(2); PG8_BAR;
    PG8_STAGE(PG8_SB(1, 0), cB + kstep, voffB); PG8_STAGE_A(1, 0, cA + kstep, false); PG8_STAGE(PG8_SB(1, 1), cB + hstepB + kstep, voffB);
    PG8_WAIT_V(6); PG8_BAR;
    int pre_tk[8];
    for (;;) {
        const bool has_next = S.next(ui + 1, nxt);
        if constexpr (Epi::PRE) { if (!(cur.flags & 1)) E.prefetch(pre_tk, cur, wr, wc, fr, fq); }
        const char* nA = has_next ? (const char*)nxt.A : cA; const char* nB = has_next ? (const char*)nxt.B : cB;
        if constexpr (GATHER) { if (has_next) PG8_GOFF(gN, nxt); }
#pragma unroll 1
        for (int t = 0; t < nt; t += 2) {
            const bool last = (t == nt - 2);
            const char* a1 = cA + (size_t)(t + 1) * kstep;
            const char* a2 = last ? nA : cA + (size_t)(t + 2) * kstep; const char* b2 = last ? nB : cB + (size_t)(t + 2) * kstep;
            const char* a3 = a2 + kstep; const char* b3 = b2 + kstep;
            const bool nx = last && has_next;
            PG8_XLDB0(0, 0); PG8_XLDB1(0, 1); PG8_SCHED; PG8_XLDA(0, 0); PG8_STAGE_A(1, 1, a1, false);
            PG8_WAIT_V(8); PG8_WAIT_L(0); PG8_BAR; PG8_XMMA0(0, 0); PG8_XMMA1(0, 1); PG8_BAR; PG8_SCHED;
            PG8_XLDA(0, 1); PG8_STAGE(PG8_SB(0, 0), b2, voffB); PG8_STAGE(PG8_SB(0, 1), b2 + hstepB, voffB); PG8_STAGE_A(0, 0, a2, nx);
            PG8_WAIT_V(8); PG8_WAIT_L(0); PG8_BAR; PG8_XMMA0(1, 0); PG8_XMMA1(1, 1); PG8_BAR; PG8_SCHED;
            PG8_XLDB0(1, 0); PG8_XLDB1(1, 1); PG8_SCHED; PG8_XLDA(1, 0); PG8_STAGE_A(0, 1, a2, nx);
            PG8_WAIT_V(8); PG8_WAIT_L(0); PG8_BAR; PG8_XMMA0(0, 0); PG8_XMMA1(0, 1); PG8_BAR; PG8_SCHED;
            PG8_XLDA(1, 1); PG8_STAGE(PG8_SB(1, 0), b3, voffB); PG8_STAGE(PG8_SB(1, 1), b3 + hstepB, voffB); PG8_STAGE_A(1, 0, a3, nx);
            PG8_WAIT_V(8); PG8_WAIT_L(0); PG8_BAR; PG8_XMMA0(1, 0); PG8_XMMA1(1, 1); PG8_BAR; PG8_SCHED;
        }
        if constexpr (ALIGN_EPI) { if (wr == 0) PG8_BAR; }
        if constexpr (FP8) asm volatile("s_nop 15\n\ts_nop 7" ::: "memory");
        if (!(cur.flags & 2)) { if constexpr (Epi::PRE) E(acc, cur, wr, wc, fr, fq, pre_tk); else E(acc, cur, wr, wc, fr, fq); }
        if (!has_next) break;
        if (!(nxt.flags & 1)) PG8_ZERO();
        cur = nxt; cA = nA; cB = nB; ++ui;
        if constexpr (GATHER) { gC[0] = gN[0]; gC[1] = gN[1]; }
        if constexpr (ALIGN_EPI) { if (wr == 1) PG8_BAR; }
    }
    PG8_WAIT_V(0);
    if constexpr (!ALIGN_EPI) { if (wr == 0) PG8_BAR; }
    PG8_BAR;
#undef PG8_SA
#undef PG8_SB
#undef PG8_STAGE
#undef PG8_XLDA
#undef PG8_XLDB0
#undef PG8_XLDB1
#undef PG8_XMMA0
#undef PG8_XMMA1
#undef PG8_LDA8
#undef PG8_LDB8
#undef PG8_MMA8
#undef PG8_STAGE_A
#undef PG8_GOFF
#undef PG8_LDA
#undef PG8_LDB
#undef PG8_MMA
#undef PG8_WAIT_V
#undef PG8_WAIT_L
#undef PG8_BAR
#undef PG8_SCHED
#undef PG8_ZERO
}
}
#ifndef MK_NAIVE_GEMM
#define MK_NAIVE_GEMM 0
#endif
template <bool GATHER = false, bool FP8 = false, class Sched, class Epi>
__device__ __forceinline__ void run_gemm(LAS unsigned char* lds, int lda, int ldb, int K, const Sched& S, const Epi& E) {
    pg8::gemm_phase<Epi, Sched, true, GATHER, FP8>(lds, lda, ldb, K, S, E);
}

struct SchedProj { const bf16_t* A; const bf16_t* B; int rowu  , pn0  , G, c;
    __device__ __forceinline__ bool next(int i, Unit& u) const { const int L = i * G + c; if (L >= 64 * 8) return false;
        const int gid = L / 64, w = L % 64; u.pm = gid * 8 + (w % 8); u.pn = pn0 + w / 8;
        u.A = A + (size_t)u.pm * 256 * rowu; u.B = B + (size_t)(w / 8) * 256 * rowu; u.aux = 0; u.flags = 0; u.gidx = nullptr; return true; } };
struct EpiProj {
    static constexpr bool PERM = true; static constexpr bool PRE = false;
    unsigned char* ws;
    __device__ __forceinline__ void operator()(const f32x4 (&acc)[2][2][4][2], const Unit& u, int wr, int wc, int fr, int fq) const {
#pragma unroll
        for (int bj = 0; bj < 2; ++bj) {
            const int cg = u.pn * 256 + bj * 128 + wc * 32;
            const int col = cg + 8 * fq;
            bf16_t* dst; int ld, cb; int mode = 0;
            bf16_t* const Vt = (bf16_t*)(ws + WS_VT); float* const WI = (float*)(ws + WS_WI);
            if (cg < C_K) { dst = (bf16_t*)(ws + WS_Q); ld = 512; cb = C_Q; }
            else if (cg < C_V) { dst = (bf16_t*)(ws + WS_K); ld = 64; cb = C_K; }
            else if (cg < C_QI) { dst = (bf16_t*)(ws + WS_VR); ld = 64; cb = C_V; mode = 2; }
            else if (cg < C_KI) { dst = (bf16_t*)(ws + WS_QI); ld = 256; cb = C_QI; }
            else if (cg < C_LX) { dst = (bf16_t*)(ws + WS_KI); ld = 64; cb = C_KI; }
            else if (cg < C_LG) { dst = (bf16_t*)(ws + WS_LX); ld = 512; cb = C_LX; }
            else if (cg < C_WI) { dst = (bf16_t*)(ws + WS_LG); ld = 512; cb = C_LG; }
            else if (cg < C_PAD + 28) { dst = nullptr; ld = 0; cb = C_WI; mode = 3; }
            else if (cg < C_GA) continue;
            else if (cg < C_GB) { dst = (bf16_t*)(ws + WS_GA); ld = 1024; cb = C_GA; mode = 1; }
            else { dst = (bf16_t*)(ws + WS_GB); ld = 1024; cb = C_GB; mode = 1; }
#pragma unroll
            for (int ai = 0; ai < 2; ++ai)
#pragma unroll
                for (int m = 0; m < 4; ++m) {
                    const int row = u.pm * 256 + ai * 128 + wr * 64 + m * 16 + fr;
                    f32x4 v0 = acc[ai][bj][m][0], v1 = acc[ai][bj][m][1];
                    if (mode == 3) { if (fq == 0) *(f32x4*)(WI + (size_t)row * 4) = v0; continue; }
                    if (mode == 1) {
#pragma unroll
                        for (int e = 0; e < 4; ++e) { v0[e] = sigmoidf_(v0[e]); v1[e] = sigmoidf_(v1[e]); } }
                    u32x4 w; w.x = pk2(v0[0], v0[1]); w.y = pk2(v0[2], v0[3]); w.z = pk2(v1[0], v1[1]); w.w = pk2(v1[2], v1[3]);
                    if (mode != 2) *(u32x4*)(dst + (size_t)row * ld + (col - cb)) = w;
                    if (mode == 2) {
                        const int b = row / SEQ, t = row % SEQ, d0 = col - cb; bf16_t* vp = Vt + ((size_t)b * 64 + d0) * SEQ + (t & ~15) + vt_pos(t & 15);
                        vp[0 * SEQ] = (bf16_t)(w.x & 0xffff); vp[1 * SEQ] = (bf16_t)(w.x >> 16); vp[2 * SEQ] = (bf16_t)(w.y & 0xffff); vp[3 * SEQ] = (bf16_t)(w.y >> 16);
                        vp[4 * SEQ] = (bf16_t)(w.z & 0xffff); vp[5 * SEQ] = (bf16_t)(w.z >> 16); vp[6 * SEQ] = (bf16_t)(w.w & 0xffff); vp[7 * SEQ] = (bf16_t)(w.w >> 16); }
                }
        }
    }
};

__device__ __forceinline__ unsigned fbits(float f) { return __builtin_bit_cast(unsigned, f); }
__device__ __forceinline__ float bitsf(unsigned u) { return __builtin_bit_cast(float, u); }
__device__ __forceinline__ unsigned bfi_b32(unsigned m, unsigned a, unsigned b) { return __builtin_amdgcn_bitop3_b32(a, b, m, 0xe4); }
__device__ __forceinline__ float xor32_max(float x) { typedef unsigned u32x2_ __attribute__((ext_vector_type(2))); const unsigned u = __builtin_bit_cast(unsigned, x);
    const u32x2_ r = __builtin_amdgcn_permlane32_swap(u, u, false, false); return fmaxf(__builtin_bit_cast(float, r.x), __builtin_bit_cast(float, r.y)); }
__device__ __forceinline__ float sum8_dpp(float s) {
    s += __builtin_bit_cast(float, __builtin_amdgcn_update_dpp(0, __builtin_bit_cast(int, s), 0xB1, 0xf, 0xf, true));
    s += __builtin_bit_cast(float, __builtin_amdgcn_update_dpp(0, __builtin_bit_cast(int, s), 0x4E, 0xf, 0xf, true));
    s += __builtin_bit_cast(float, __builtin_amdgcn_update_dpp(0, __builtin_bit_cast(int, s), 0x141, 0xf, 0xf, true));
    return s; }
__device__ __forceinline__ unsigned sortkey(float f) { const unsigned u = __builtin_bit_cast(unsigned, f); return (u & 0x80000000u) ? ~u : (u | 0x80000000u); }
typedef float f32x16 __attribute__((ext_vector_type(16)));
constexpr int AL_QI = 0, AL_HIST = 16896, AL_MASK = 49792, AL_EQ = 57984, AL_RK = 66176, AL_QST = 74368, AL_FLAG = 74368 + 512, AL_OST = 75008, AL_KV = AL_HIST  , KT_STRIDE = 144, VT_STRIDE = 80, KT_BYTES = 32 * KT_STRIDE, KV_BUF = KT_BYTES + 64 * VT_STRIDE, AL_END = AL_OST + 8 * 4608;
static_assert(2 * KV_BUF <= 32 * 257 * 4, "K/V ring fits the histogram region");
constexpr int QI_STRIDE = 528, HIST_STRIDE = 257, OST_STRIDE = 144;
static_assert(AL_END <= RING_BYTES, "attention LDS map");
__device__ __forceinline__ int crow(int i, int hi) { return (i & 3) + 8 * (i >> 2) + 4 * hi; }
__device__ __forceinline__ void attn_unit(Frame& F, int b, int c, int half) {
    int tid_ = F.tid, w_ = F.wave; asm volatile("" : "+v"(tid_), "+s"(w_));
    const int tid = tid_, lane = tid & 63, w = w_, r32 = lane & 31, hi = lane >> 5;
    const int t0 = 64 * c + 32 * half, nk = 64 * (c + 1), ntile = nk >> 5, tok0 = b * SEQ + t0;
    LAS unsigned char* L = F.lds;
    LAS unsigned* hist = (LAS unsigned*)(L + AL_HIST); LAS unsigned* maskw = (LAS unsigned*)(L + AL_MASK); LAS unsigned* eqw = (LAS unsigned*)(L + AL_EQ);
    LAS float* rkL = (LAS float*)(L + AL_RK); LAS unsigned* qst = (LAS unsigned*)(L + AL_QST); LAS unsigned* flagw = (LAS unsigned*)(L + AL_FLAG);
    const bf16_t* KI = WSP(bf16_t, WS_KI) + (size_t)b * SEQ * 64;
    const bf16_t* Kb = WSP(bf16_t, WS_K) + (size_t)b * SEQ * 64;
    const bf16_t* Vt = WSP(bf16_t, WS_VT) + (size_t)b * 64 * SEQ;
    const bool do_sel = nk > TOPK;
    __syncthreads();
#if MK_LEAK >= 0
    const unsigned long long tu0_ = __builtin_amdgcn_s_memrealtime();
#endif
    { const bf16_t* QI = WSP(bf16_t, WS_QI) + (size_t)tok0 * 256;
#pragma unroll
      for (int i = 0; i < 2; ++i) { const int idx = tid + 512 * i, row = idx >> 5, ch = idx & 31;
          *(LAS u32x4*)(L + AL_QI + row * QI_STRIDE + ch * 16) = *(const u32x4*)(QI + (size_t)row * 256 + ch * 8); } }
    if (tid == 0) flagw[0] = 0u;
    if (tid < 32) { qst[tid * 4 + 0] = 0u; qst[tid * 4 + 1] = (unsigned)TOPK; qst[tid * 4 + 2] = 0u; qst[tid * 4 + 3] = 0u; }
    __syncthreads();
    f32x16 sc[8];
    if (do_sel) {
        const f32x4 wv = *(const f32x4*)(WSP(float, WS_WI) + (size_t)(tok0 + r32) * 4) * 0.0625f;
        bf16x8 afn[4];
        { int roff = (32 * w + r32) * 64 + 8 * hi; asm volatile("" : "+v"(roff));
#pragma unroll
          for (int ks = 0; ks < 4; ++ks) afn[ks] = *(const bf16x8*)(KI + roff + 16 * ks); }
#pragma unroll
        for (int j = 0; j < 8; ++j) {
            const int kt = w + 8 * j;
#pragma unroll
            for (int i = 0; i < 16; ++i) sc[j][i] = 0.f;
            if (kt < ntile) {
                bf16x8 af[4];
#pragma unroll
                for (int ks = 0; ks < 4; ++ks) af[ks] = afn[ks];
                if (j < 7 && kt + 8 < ntile) { int roff = (32 * (kt + 8) + r32) * 64 + 8 * hi; asm volatile("" : "+v"(roff));
#pragma unroll
                    for (int ks = 0; ks < 4; ++ks) afn[ks] = *(const bf16x8*)(KI + roff + 16 * ks); }
                int qoff = r32 * QI_STRIDE + hi * 16; asm volatile("" : "+v"(qoff));
                bf16x8 qA[4], qB[4];
#define ATT_QLD(Q, H) do { _Pragma("unroll") for (int ks = 0; ks < 4; ++ks) Q[ks] = *(const LAS bf16x8*)(L + AL_QI + qoff + (H) * 128 + ks * 32); } while (0)
#define ATT_HEAD(Q, H) do { f32x16 acc; \
                    _Pragma("unroll") for (int i = 0; i < 16; ++i) acc[i] = 0.f; \
                    _Pragma("unroll") for (int ks = 0; ks < 4; ++ks) acc = __builtin_amdgcn_mfma_f32_32x32x16_bf16(af[ks], Q[ks], acc, 0, 0, 0); \
                    asm volatile("s_nop 15\n\ts_nop 7" : "+v"(acc));                \
                    _Pragma("unroll") for (int i = 0; i < 16; ++i) sc[j][i] += relu_f(acc[i]) * wv[H]; \
                    __builtin_amdgcn_sched_barrier(0); } while (0)
                ATT_QLD(qA, 0); ATT_QLD(qB, 1); __builtin_amdgcn_sched_barrier(0);
                ATT_HEAD(qA, 0); ATT_QLD(qA, 2); __builtin_amdgcn_sched_barrier(0);
                ATT_HEAD(qB, 1); ATT_QLD(qB, 3); __builtin_amdgcn_sched_barrier(0);
                ATT_HEAD(qA, 2);
                ATT_HEAD(qB, 3);
#undef ATT_HEAD
#undef ATT_QLD
#pragma unroll
                for (int i = 0; i < 16; ++i) sc[j][i] = __builtin_bit_cast(float, sortkey(sc[j][i]));
            }
        }
    }
    unsigned Tq = 0u; bool ordered = false;
    if (do_sel) {
        unsigned prefix = 0u;
        for (int i = tid; i < 32 * HIST_STRIDE; i += NTHREADS) hist[i] = 0u;
        __syncthreads();
#pragma unroll 1
        for (int pass = 0; pass < 3; ++pass) {
            const int shift = 24 - 8 * pass;
#pragma unroll
            for (int j = 0; j < 8; ++j) { const int kt = w + 8 * j;
                if (kt < ntile) {
#pragma unroll
                    for (int i = 0; i < 16; ++i) { const unsigned key = fbits(sc[j][i]);
                        const bool m = (pass == 0) || ((key >> (shift + 8)) == (prefix >> (shift + 8)));
                        if (m) __hip_atomic_fetch_add(hist + r32 * HIST_STRIDE + ((key >> shift) & 255u), 1u, __ATOMIC_RELAXED, __HIP_MEMORY_SCOPE_WORKGROUP); } } }
            __syncthreads();
            {
                const int q = tid >> 4, p = tid & 15, b0 = 16 * (15 - p);
                const unsigned need = qst[q * 4 + 1];
                unsigned s = 0u, hv[16];
#pragma unroll
                for (int e = 0; e < 16; ++e) { hv[e] = hist[q * HIST_STRIDE + b0 + e]; s += hv[e]; hist[q * HIST_STRIDE + b0 + e] = 0u; }
                unsigned P = s;
#pragma unroll
                for (int o = 1; o < 16; o <<= 1) { const unsigned t = __shfl_up(P, o, 16); if (p >= o) P += t; }
                const unsigned Pprev = P - s;
                if (P >= need && Pprev < need) { unsigned run = Pprev; bool done = false;
#pragma unroll
                    for (int e = 15; e >= 0; --e) { const unsigned hc = hv[e]; if (done) continue;
                        if (run + hc >= need) { done = true; qst[q * 4 + 0] = qst[q * 4 + 0] | ((unsigned)(b0 + e) << shift); qst[q * 4 + 1] = need - run; qst[q * 4 + 2] = hc; }
                        else run += hc; } }
            }
            __syncthreads();
            prefix = qst[r32 * 4 + 0];
        }
        Tq = prefix;
        const unsigned needq = qst[r32 * 4 + 1], eqc = qst[r32 * 4 + 2];
        if (needq < eqc) flagw[0] = 1u;
        __syncthreads();
        ordered = flagw[0] != 0u;
    }
#pragma unroll
    for (int j = 0; j < 8; ++j) { const int kt = w + 8 * j;
        if (kt < ntile) { unsigned mw = 0xffffffffu, ew = 0u;
            if (do_sel) { mw = 0u;
#pragma unroll
                for (int i = 0; i < 16; ++i) { const unsigned key = fbits(sc[j][i]) >> 8; const int bit = crow(i, hi);
                    const bool gt = key > (Tq >> 8), eq = key == (Tq >> 8);
                    mw |= ((gt || (eq && !ordered)) ? 1u : 0u) << bit; ew |= (eq ? 1u : 0u) << bit; }
                mw |= __shfl_xor(mw, 32); ew |= __shfl_xor(ew, 32); }
            if (hi == 0) { maskw[kt * 32 + r32] = mw; if (ordered) eqw[kt * 32 + r32] = ew; } } }
    __syncthreads();
    if (ordered) {
        const int q = tid >> 4, p = tid & 15; const int need = (int)qst[q * 4 + 1];
        unsigned ww[4]; int c = 0;
#pragma unroll
        for (int k = 0; k < 4; ++k) { const int kt = 4 * p + k; ww[k] = (kt < ntile) ? eqw[kt * 32 + q] : 0u; c += __popc(ww[k]); }
        int P = c;
#pragma unroll
        for (int o = 1; o < 16; o <<= 1) { const int t = __shfl_up(P, o, 16); if (p >= o) P += t; }
        int quota = need - (P - c); quota = quota < 0 ? 0 : (quota > c ? c : quota);
#pragma unroll
        for (int k = 0; k < 4; ++k) { unsigned w2 = ww[k]; if (quota > 0 && w2 != 0u) { const int pc = __popc(w2); unsigned add = w2;
                if (pc > quota) { add = 0u; while (__popc(add) < quota) { const unsigned lsb = w2 & (0u - w2); add |= lsb; w2 ^= lsb; } }
                quota -= __popc(add); maskw[(4 * p + k) * 32 + q] |= add; } }
        __syncthreads();
    }
#if MK_LEAK >= 0
    const unsigned long long tu1_ = __builtin_amdgcn_s_memrealtime();
#endif
    {
        const int h = w; const int tq = t0 + r32;
        bf16x8 qf[4];
        { const bf16_t* Q = WSP(bf16_t, WS_Q) + (size_t)(tok0 + r32) * 512 + h * 64;
          float qv[4][8]; float ss = 0.f;
#pragma unroll
          for (int ks = 0; ks < 4; ++ks) { const bf16x8 v = *(const bf16x8*)(Q + 16 * ks + 8 * hi);
#pragma unroll
              for (int e = 0; e < 8; ++e) { qv[ks][e] = bf2f((unsigned short)v[e]); ss += qv[ks][e] * qv[ks][e]; } }
          ss += __shfl_xor(ss, 32);
          const float rq = rsqrtf(ss * (1.f / 64.f) + EPS) * 0.125f * 1.4426950408889634f;
          const float* qnw = (const float*)F.ap->in[6]; const float* knw = (const float*)F.ap->in[7];
#pragma unroll
          for (int ks = 0; ks < 4; ++ks) { u32x4 pk;
              const f32x4 a0 = *(const f32x4*)(qnw + 16 * ks + 8 * hi), a1 = *(const f32x4*)(qnw + 16 * ks + 8 * hi + 4), b0 = *(const f32x4*)(knw + 16 * ks + 8 * hi), b1 = *(const f32x4*)(knw + 16 * ks + 8 * hi + 4);
              pk.x = pk2(qv[ks][0] * rq * a0.x * b0.x, qv[ks][1] * rq * a0.y * b0.y); pk.y = pk2(qv[ks][2] * rq * a0.z * b0.z, qv[ks][3] * rq * a0.w * b0.w);
              pk.z = pk2(qv[ks][4] * rq * a1.x * b1.x, qv[ks][5] * rq * a1.y * b1.y); pk.w = pk2(qv[ks][6] * rq * a1.z * b1.z, qv[ks][7] * rq * a1.w * b1.w);
              qf[ks] = __builtin_bit_cast(bf16x8, pk); } }
        const float slope2 = exp2f(-(float)(h + 1)) * 1.4426950408889634f;
        float m = 0.f;
        f32x16 o0, o1, lacc;
#pragma unroll
        for (int i = 0; i < 16; ++i) { o0[i] = 0.f; o1[i] = 0.f; lacc[i] = 0.f; }
        const bf16x8 ones8 = {0x3f80, 0x3f80, 0x3f80, 0x3f80, 0x3f80, 0x3f80, 0x3f80, 0x3f80};
        constexpr int K2_STRIDE = 144, K2_BYTES = 64 * K2_STRIDE, KV2_BUF = 2 * K2_BYTES;
        static_assert(2 * KV2_BUF <= AL_MASK, "K/V ring below the mask words");
        const int npair = c + 1;
        const bf16_t* gK = Kb + (size_t)(tid >> 3) * 64 + (tid & 7) * 8;
        const bf16_t* gV = Vt + (size_t)(tid >> 3) * SEQ + (tid & 7) * 8;
        const int lstK = (tid >> 3) * K2_STRIDE + (tid & 7) * 16;
        LAS unsigned char* kvL = L;
#define ATT_STAGE2(BUF, GK, GV) do { u32x4 w_; \
            { float f_[8] = {bflo(GK.x), bfhi(GK.x), bflo(GK.y), bfhi(GK.y), bflo(GK.z), bfhi(GK.z), bflo(GK.w), bfhi(GK.w)}; \
                float ss_ = (f_[0] * f_[0] + f_[1] * f_[1]) + (f_[2] * f_[2] + f_[3] * f_[3]) + (f_[4] * f_[4] + f_[5] * f_[5]) + (f_[6] * f_[6] + f_[7] * f_[7]); \
                ss_ = sum8_dpp(ss_); \
                const float rk_ = __builtin_amdgcn_rsqf(ss_ * (1.f / 64.f) + EPS); \
                w_.x = cvt_pk_bf16(f_[0] * rk_, f_[1] * rk_); w_.y = cvt_pk_bf16(f_[2] * rk_, f_[3] * rk_); w_.z = cvt_pk_bf16(f_[4] * rk_, f_[5] * rk_); w_.w = cvt_pk_bf16(f_[6] * rk_, f_[7] * rk_); } \
            *(LAS u32x4*)(kvL + (BUF) * KV2_BUF + lstK) = w_; *(LAS u32x4*)(kvL + (BUF) * KV2_BUF + K2_BYTES + lstK) = GV; } while (0)
#define ATT_LOADK(KP) (*(const u32x4*)(gK + (size_t)((KP) < npair ? (KP) : npair - 1) * 4096))
#define ATT_LOADV(KP) (*(const u32x4*)(gV + (size_t)((KP) < npair ? (KP) : npair - 1) * 64))
        u32x4 cK = ATT_LOADK(0), cV = ATT_LOADV(0);
        u32x4 nK = ATT_LOADK(1), nV = ATT_LOADV(1);
        ATT_STAGE2(0, cK, cV);
        float ci[16];
#pragma unroll
        for (int i = 0; i < 16; ++i) ci[i] = slope2 * (float)crow(i, hi);
        const float sq = slope2 * (float)tq;
        __syncthreads();
#define ATT_MAX16(S) do { mx = max3f(mx, S[0], S[1]); mx = max3f(mx, S[2], S[3]); mx = max3f(mx, S[4], S[5]); mx = max3f(mx, S[6], S[7]); mx = max3f(mx, S[8], S[9]); mx = max3f(mx, S[10], S[11]); \
            mx = max3f(mx, S[12], S[13]); mx = max3f(mx, S[14], S[15]); } while (0)
#define ATT_PK(P0, P1, S) do { P0.x = cvt_pk_bf16(S[0], S[1]); P0.y = cvt_pk_bf16(S[2], S[3]); P0.z = cvt_pk_bf16(S[4], S[5]); P0.w = cvt_pk_bf16(S[6], S[7]); \
            P1.x = cvt_pk_bf16(S[8], S[9]); P1.y = cvt_pk_bf16(S[10], S[11]); P1.z = cvt_pk_bf16(S[12], S[13]); P1.w = cvt_pk_bf16(S[14], S[15]); } while (0)
#define ATT_TILE2(KP) do { const int kp_ = (KP); \
            const LAS unsigned char* kb = kvL + (kp_ & 1) * KV2_BUF; \
            const unsigned mw0 = maskw[(2 * kp_) * 32 + r32] >> (4 * hi), mw1 = maskw[(2 * kp_ + 1) * 32 + r32] >> (4 * hi); \
            bf16x8 kf0[4], kf1[4];                                                 \
            _Pragma("unroll") for (int ks = 0; ks < 4; ++ks) { kf0[ks] = *(const LAS bf16x8*)(kb + r32 * K2_STRIDE + ks * 32 + hi * 16); kf1[ks] = *(const LAS bf16x8*)(kb + (32 + r32) * K2_STRIDE + ks * 32 + hi * 16); } \
            __builtin_amdgcn_sched_barrier(0); \
            f32x16 S0, S1; \
            if (kp_ < npair - 1) { const float nmt0 = slope2 * (float)(64 * kp_) - m, nmt1 = nmt0 + slope2 * 32.f;        \
                _Pragma("unroll") for (int i = 0; i < 16; ++i) { const int ko = (i & 3) + 8 * (i >> 2); \
                    const unsigned sel0 = (unsigned)__builtin_amdgcn_sbfe((int)mw0, ko, 1), sel1 = (unsigned)__builtin_amdgcn_sbfe((int)mw1, ko, 1); \
                    S0[i] = bitsf(bfi_b32(sel0, fbits(ci[i] + nmt0), 0xff800000u)); S1[i] = bitsf(bfi_b32(sel1, fbits(ci[i] + nmt1), 0xff800000u)); } } \
            else { const float dbase0 = (float)(tq - 64 * kp_ - 4 * hi), dbase1 = dbase0 - 32.f, sqm = sq - m; \
                _Pragma("unroll") for (int i = 0; i < 16; ++i) { const int ko = (i & 3) + 8 * (i >> 2); \
                    const unsigned sel0 = (unsigned)__builtin_amdgcn_sbfe((int)mw0, ko, 1), sel1 = (unsigned)__builtin_amdgcn_sbfe((int)mw1, ko, 1); \
                    S0[i] = bitsf(bfi_b32(sel0, fbits(sqm - slope2 * fabsf(dbase0 - (float)ko)), 0xff800000u)); S1[i] = bitsf(bfi_b32(sel1, fbits(sqm - slope2 * fabsf(dbase1 - (float)ko)), 0xff800000u)); } } \
            _Pragma("unroll") for (int ks = 0; ks < 4; ++ks) { \
                S0 = __builtin_amdgcn_mfma_f32_32x32x16_bf16(kf0[ks], qf[ks], S0, 0, 0, 0); S1 = __builtin_amdgcn_mfma_f32_32x32x16_bf16(kf1[ks], qf[ks], S1, 0, 0, 0); } \
            asm volatile("s_nop 15\n\ts_nop 7" : "+v"(S0), "+v"(S1));             \
            bf16x8 vf[2][4]; \
            _Pragma("unroll") for (int db = 0; db < 2; ++db) _Pragma("unroll") for (int j4 = 0; j4 < 4; ++j4) vf[db][j4] = *(const LAS bf16x8*)(kb + K2_BYTES + (32 * db + r32) * K2_STRIDE + j4 * 32 + hi * 16); \
            float mx = max3f(S0[0], S0[0], S1[0]); \
            ATT_MAX16(S0); ATT_MAX16(S1); \
            mx = fmaxf(mx, __shfl_xor(mx, 32)); \
            if (__any(mx > 8.f)) {                                             \
                const float dl = fmaxf(mx, 0.f), alpha = __builtin_amdgcn_exp2f(-dl); m += dl; \
                _Pragma("unroll") for (int i = 0; i < 16; ++i) { S0[i] -= dl; S1[i] -= dl; o0[i] *= alpha; o1[i] *= alpha; lacc[i] *= alpha; } } \
            _Pragma("unroll") for (int i = 0; i < 16; ++i) { S0[i] = __builtin_amdgcn_exp2f(S0[i]); S1[i] = __builtin_amdgcn_exp2f(S1[i]); } \
            u32x4 p00, p01, p10, p11; ATT_PK(p00, p01, S0); ATT_PK(p10, p11, S1); \
            const bf16x8 pf00 = __builtin_bit_cast(bf16x8, p00), pf01 = __builtin_bit_cast(bf16x8, p01), pf10 = __builtin_bit_cast(bf16x8, p10), pf11 = __builtin_bit_cast(bf16x8, p11); \
            o0 = __builtin_amdgcn_mfma_f32_32x32x16_bf16(vf[0][0], pf00, o0, 0, 0, 0); o1 = __builtin_amdgcn_mfma_f32_32x32x16_bf16(vf[1][0], pf00, o1, 0, 0, 0); lacc = __builtin_amdgcn_mfma_f32_32x32x16_bf16(ones8, pf00, lacc, 0, 0, 0); \
            o0 = __builtin_amdgcn_mfma_f32_32x32x16_bf16(vf[0][1], pf01, o0, 0, 0, 0); o1 = __builtin_amdgcn_mfma_f32_32x32x16_bf16(vf[1][1], pf01, o1, 0, 0, 0); lacc = __builtin_amdgcn_mfma_f32_32x32x16_bf16(ones8, pf01, lacc, 0, 0, 0); \
            o0 = __builtin_amdgcn_mfma_f32_32x32x16_bf16(vf[0][2], pf10, o0, 0, 0, 0); o1 = __builtin_amdgcn_mfma_f32_32x32x16_bf16(vf[1][2], pf10, o1, 0, 0, 0); lacc = __builtin_amdgcn_mfma_f32_32x32x16_bf16(ones8, pf10, lacc, 0, 0, 0); \
            o0 = __builtin_amdgcn_mfma_f32_32x32x16_bf16(vf[0][3], pf11, o0, 0, 0, 0); o1 = __builtin_amdgcn_mfma_f32_32x32x16_bf16(vf[1][3], pf11, o1, 0, 0, 0); lacc = __builtin_amdgcn_mfma_f32_32x32x16_bf16(ones8, pf11, lacc, 0, 0, 0); \
            } while (0)
#pragma unroll 1
        for (int kp = 0; kp < npair; ++kp) {
            const u32x4 fK = ATT_LOADK(kp + 2), fV = ATT_LOADV(kp + 2);
            ATT_TILE2(kp);
            if (kp + 1 < npair) ATT_STAGE2((kp + 1) & 1, nK, nV);
            LDS_BARRIER();
            nK = fK; nV = fV;
        }
#undef ATT_TILE2
#undef ATT_PK
#undef ATT_MAX16
#undef ATT_LOADK
#undef ATT_LOADV
#undef ATT_STAGE2
        const float inv = __builtin_amdgcn_rcpf(lacc[0]);
        LAS unsigned char* stg = L + AL_OST + w * 4608;
#pragma unroll
        for (int g = 0; g < 4; ++g) {
            *(LAS u32x2*)(stg + r32 * OST_STRIDE + (8 * g + 4 * hi) * 2) = (u32x2){pk2(o0[4 * g] * inv, o0[4 * g + 1] * inv), pk2(o0[4 * g + 2] * inv, o0[4 * g + 3] * inv)};
            *(LAS u32x2*)(stg + r32 * OST_STRIDE + (32 + 8 * g + 4 * hi) * 2) = (u32x2){pk2(o1[4 * g] * inv, o1[4 * g + 1] * inv), pk2(o1[4 * g + 2] * inv, o1[4 * g + 3] * inv)}; }
        asm volatile("s_waitcnt lgkmcnt(0)" ::: "memory");
        bf16_t* AO = WSP(bf16_t, WS_AO) + (size_t)tok0 * 512 + h * 64;
#pragma unroll
        for (int it = 0; it < 4; ++it) { const int row = it * 8 + (lane >> 3), ch = lane & 7;
            *(u32x4*)(AO + (size_t)row * 512 + ch * 8) = *(const LAS u32x4*)(stg + row * OST_STRIDE + ch * 16); }
    }
#if MK_LEAK >= 0
    __syncthreads();
    if (tid == 0) { volatile LAS unsigned* MS = (volatile LAS unsigned*)(F.lds + MISC_OFF); const unsigned long long tu2_ = __builtin_amdgcn_s_memrealtime(); MS[16] += (unsigned)(tu1_ - tu0_); MS[17] += (unsigned)(tu2_ - tu1_); }
#endif
}
__device__ __forceinline__ void attn_phase(Frame& F, int clo, int chi) {
#pragma unroll 1
    for (int p2 = 2 * F.bid; p2 < 512; p2 += ((p2 & 1) ? 2 * F.G - 1 : 1)) { const int p = p2 >> 1, b = p >> 5, jj = p & 31, c1 = jj >> 1, half = jj & 1;
        const int cc = (p2 & 1) ? c1 : 31 - c1; if (cc >= clo && cc < chi) attn_unit(F, b, cc, half); }
}

constexpr int LR_CW = 0, LR_SEG = 2048, LR_AB = 4096;
static_assert(LR_AB + 8 * 16 * 64 * 16 <= MISC_OFF, "LRU LDS map");
__device__ __forceinline__ void lru_item_mfma(Frame& F, int item) {
    int tid_ = F.tid, w_ = F.wave; asm volatile("" : "+v"(tid_), "+s"(w_));
    const int tid = tid_, lane = tid & 63, w = w_, c16 = lane & 15, kg = lane >> 4;
    const int b = item >> 5, n = (item >> 2) & 7, q = item & 3;
    LAS float* cwL = (LAS float*)(F.lds + LR_CW);
    LAS float* segL = (LAS float*)(F.lds + LR_SEG);
    LAS u32x4* abL = (LAS u32x4*)(F.lds + LR_AB) + (size_t)w * 16 * 64 + lane;
    const float* conv_w = (const float*)F.ap->in[8]; const float* conv_b = (const float*)F.ap->in[9];
    const float* w_rec = (const float*)F.ap->in[10] + (size_t)n * 4096; const float* w_ing = (const float*)F.ap->in[12] + (size_t)n * 4096;
    __syncthreads();
    if (tid < 256) cwL[tid] = conv_w[(tid >> 6) * 512 + 64 * n + (tid & 63)]; else if (tid < 320) cwL[tid] = conv_b[64 * n + (tid - 256)];
    bf16x8 Bw[3][2];
#pragma unroll
    for (int ks = 0; ks < 2; ++ks) { u32x4 pr, pi, pd;
        float vr[8], vi[8], vd[8];
#pragma unroll
        for (int j = 0; j < 8; ++j) { const int d = 32 * ks + 8 * kg + j; vr[j] = w_rec[d * 64 + 16 * q + c16]; vi[j] = w_ing[d * 64 + 16 * q + c16]; vd[j] = (d == 16 * q + c16) ? 1.f : 0.f; }
        pr.x = pk2(vr[0], vr[1]); pr.y = pk2(vr[2], vr[3]); pr.z = pk2(vr[4], vr[5]); pr.w = pk2(vr[6], vr[7]);
        pi.x = pk2(vi[0], vi[1]); pi.y = pk2(vi[2], vi[3]); pi.z = pk2(vi[4], vi[5]); pi.w = pk2(vi[6], vi[7]);
        pd.x = pk2(vd[0], vd[1]); pd.y = pk2(vd[2], vd[3]); pd.z = pk2(vd[4], vd[5]); pd.w = pk2(vd[6], vd[7]);
        Bw[0][ks] = __builtin_bit_cast(bf16x8, pr); Bw[1][ks] = __builtin_bit_cast(bf16x8, pi); Bw[2][ks] = __builtin_bit_cast(bf16x8, pd); }
    const int chg = 64 * n + 16 * q + c16;
    const float spl8 = -8.f * log1pf(__expf(-((const float*)F.ap->in[14])[chg])), brc = ((const float*)F.ap->in[11])[chg], bin = ((const float*)F.ap->in[13])[chg];
    const bf16_t* LX = WSP(bf16_t, WS_LX) + (size_t)b * SEQ * 512 + 64 * n + 8 * kg;
    const bf16_t* LG = WSP(bf16_t, WS_LG) + (size_t)b * SEQ * 512 + 64 * n + 16 * q + c16;
    bf16_t* LO = WSP(bf16_t, WS_LO) + (size_t)b * SEQ * 512 + 64 * n + 16 * q + c16;
    __syncthreads();
    u32x4 raw[2][4], rawN[2][4];
#define LRU_LOAD(R, RB) do { const int tb_ = 256 * w + 16 * (RB) + c16 - 3; \
        _Pragma("unroll") for (int ks = 0; ks < 2; ++ks) _Pragma("unroll") for (int tap = 0; tap < 4; ++tap) { const int ts_ = tb_ + tap; \
            R[ks][tap] = *(const u32x4*)(LX + (size_t)(ts_ < 0 ? 0 : ts_) * 512 + 32 * ks); } } while (0)
    LRU_LOAD(raw, 0);
    float Arun = 1.f, Brun = 0.f;
#pragma unroll 1
    for (int rb = 0; rb < 16; ++rb) {
        if (rb < 15) LRU_LOAD(rawN, rb + 1);
        const int tb = 256 * w + 16 * rb + c16 - 3;
        if (w == 0 && rb == 0) {
#pragma unroll
            for (int ks = 0; ks < 2; ++ks)
#pragma unroll
                for (int tap = 0; tap < 4; ++tap) if (tb + tap < 0) raw[ks][tap] = (u32x4){0u, 0u, 0u, 0u}; }
        bf16x8 afr[2];
#pragma unroll
        for (int ks = 0; ks < 2; ++ks) { const int d0 = 32 * ks + 8 * kg; float xc[8];
            { const f32x4 c0 = *(const LAS f32x4*)(cwL + 256 + d0), c1 = *(const LAS f32x4*)(cwL + 256 + d0 + 4);
              xc[0] = c0.x; xc[1] = c0.y; xc[2] = c0.z; xc[3] = c0.w; xc[4] = c1.x; xc[5] = c1.y; xc[6] = c1.z; xc[7] = c1.w; }
#pragma unroll
            for (int tap = 0; tap < 4; ++tap) { const u32x4 v = raw[ks][tap];
                const f32x4 c0 = *(const LAS f32x4*)(cwL + tap * 64 + d0), c1 = *(const LAS f32x4*)(cwL + tap * 64 + d0 + 4);
                xc[0] += bflo(v.x) * c0.x; xc[1] += bfhi(v.x) * c0.y; xc[2] += bflo(v.y) * c0.z; xc[3] += bfhi(v.y) * c0.w;
                xc[4] += bflo(v.z) * c1.x; xc[5] += bfhi(v.z) * c1.y; xc[6] += bflo(v.w) * c1.z; xc[7] += bfhi(v.w) * c1.w; }
            u32x4 pa; pa.x = cvt_pk_bf16(xc[0], xc[1]); pa.y = cvt_pk_bf16(xc[2], xc[3]); pa.z = cvt_pk_bf16(xc[4], xc[5]); pa.w = cvt_pk_bf16(xc[6], xc[7]);
            afr[ks] = __builtin_bit_cast(bf16x8, pa); }
        f32x4 rp = (f32x4){0.f, 0.f, 0.f, 0.f}, ip = rp, xv = rp;
#pragma unroll
        for (int ks = 0; ks < 2; ++ks) { rp = __builtin_amdgcn_mfma_f32_16x16x32_bf16(afr[ks], Bw[0][ks], rp, 0, 0, 0); ip = __builtin_amdgcn_mfma_f32_16x16x32_bf16(afr[ks], Bw[1][ks], ip, 0, 0, 0);
            xv = __builtin_amdgcn_mfma_f32_16x16x32_bf16(afr[ks], Bw[2][ks], xv, 0, 0, 0); }
        float av[4], bv[4]; u32x4 pk;
#pragma unroll
        for (int r = 0; r < 4; ++r) { const float rg = __builtin_amdgcn_rcpf(1.f + __expf(-(rp[r] + brc))), ig = __builtin_amdgcn_rcpf(1.f + __expf(-(ip[r] + bin)));
            const float la = spl8 * rg;
            const float em1 = -la * (1.f + la * (0.5f + la * (0.16666667f + la * (0.041666668f + la * 0.0083333338f))));
            const float em2 = em1 * (2.f - em1);
            const unsigned w2 = cvt_pk_bf16(em1, __builtin_amdgcn_sqrtf(em2) * (ig * xv[r]));
            pk[r] = w2; av[r] = 1.f - bflo(w2); bv[r] = bfhi(w2); }
        abL[rb * 64] = pk;
        float Ag = av[0], Bg = bv[0];
#pragma unroll
        for (int r = 1; r < 4; ++r) { Bg = av[r] * Bg + bv[r]; Ag = Ag * av[r]; }
        const float A0 = __shfl(Ag, c16), B0 = __shfl(Bg, c16), A1 = __shfl(Ag, c16 + 16), B1 = __shfl(Bg, c16 + 16), A2 = __shfl(Ag, c16 + 32), B2 = __shfl(Bg, c16 + 32), A3 = __shfl(Ag, c16 + 48), B3 = __shfl(Bg, c16 + 48);
        const float P2a = A0 * A1, P2b = A1 * B0 + B1, P3a = P2a * A2, P3b = A2 * P2b + B2, Ta = P3a * A3, Tb = A3 * P3b + B3;
        Brun = Ta * Brun + Tb; Arun = Arun * Ta;
#pragma unroll
        for (int ks = 0; ks < 2; ++ks)
#pragma unroll
            for (int tap = 0; tap < 4; ++tap) raw[ks][tap] = rawN[ks][tap];
    }
#undef LRU_LOAD
    if (kg == 0) { segL[(w * 16 + c16) * 2] = Arun; segL[(w * 16 + c16) * 2 + 1] = Brun; }
    __syncthreads();
    float hc = 0.f;
    for (int ww = 0; ww < w; ++ww) hc = segL[(ww * 16 + c16) * 2] * hc + segL[(ww * 16 + c16) * 2 + 1];
#pragma unroll 2
    for (int rb = 0; rb < 16; ++rb) {
        const int t0 = 256 * w + 16 * rb;
        const u32x4 pk = abL[rb * 64];
        float gv[4];
#pragma unroll
        for (int r = 0; r < 4; ++r) gv[r] = bf2f(LG[(size_t)(t0 + 4 * kg + r) * 512]);
        float av[4], bv[4];
#pragma unroll
        for (int r = 0; r < 4; ++r) { av[r] = 1.f - bflo(pk[r]); bv[r] = bfhi(pk[r]); }
        float Ag = av[0], Bg = bv[0];
#pragma unroll
        for (int r = 1; r < 4; ++r) { Bg = av[r] * Bg + bv[r]; Ag = Ag * av[r]; }
        const float A0 = __shfl(Ag, c16), B0 = __shfl(Bg, c16), A1 = __shfl(Ag, c16 + 16), B1 = __shfl(Bg, c16 + 16), A2 = __shfl(Ag, c16 + 32), B2 = __shfl(Bg, c16 + 32), A3 = __shfl(Ag, c16 + 48), B3 = __shfl(Bg, c16 + 48);
        const float P2a = A0 * A1, P2b = A1 * B0 + B1, P3a = P2a * A2, P3b = A2 * P2b + B2, Ta = P3a * A3, Tb = A3 * P3b + B3;
        const float Pa = kg == 0 ? 1.f : kg == 1 ? A0 : kg == 2 ? P2a : P3a, Pb = kg == 0 ? 0.f : kg == 1 ? B0 : kg == 2 ? P2b : P3b;
        float h = Pa * hc + Pb;
#pragma unroll
        for (int r = 0; r < 4; ++r) { h = av[r] * h + bv[r]; const float g = gv[r]; const float u = 0.7978845608028654f * (g + 0.044715f * g * g * g);
            const float ge = g * __builtin_amdgcn_rcpf(1.f + __expf(-2.f * u));
            LO[(size_t)(t0 + 4 * kg + r) * 512] = (bf16_t)f2bf(h * ge); }
        hc = Ta * hc + Tb;
    }
}
__device__ __forceinline__ void lru_phase(Frame& F) {
#pragma unroll 1
    for (int it = F.bid; it < 256; it += F.G) lru_item_mfma(F, it);
}
struct SchedMerge { const bf16_t *AO, *LO, *WPA, *WPB; int G, c;
    __device__ __forceinline__ bool next(int i, Unit& u) const { const int L = (i >> 1) * G + c; if (L >= 64 * 4) return false; const int sub = i & 1;
        u.pm = L % 64; u.pn = L / 64; u.aux = sub; u.flags = 0; u.gidx = nullptr;
        u.A = (sub ? LO : AO) + (size_t)u.pm * 256 * 512; u.B = (sub ? WPB : WPA) + (size_t)u.pn * 256 * 512; return true; } };
struct EpiMerge {   static constexpr bool PERM = true; static constexpr bool PRE = false;
    bf16_t* MG; const bf16_t *GA, *GB;
    __device__ __forceinline__ void operator()(const f32x4 (&acc)[2][2][4][2], const Unit& u, int wr, int wc, int fr, int fq) const {
        const bf16_t* G = u.aux ? GB : GA;
        const size_t base = (size_t)(u.pm * 256 + wr * 64 + fr) * 1024 + u.pn * 256 + wc * 32 + 8 * fq;
#pragma unroll
        for (int ai = 0; ai < 2; ++ai) {
            u32x4 g[4][2], p[4][2];
#pragma unroll
            for (int m = 0; m < 4; ++m)
#pragma unroll
                for (int bj = 0; bj < 2; ++bj) g[m][bj] = *(const u32x4*)(G + base + (size_t)(ai * 128 + m * 16) * 1024 + bj * 128);
            if (u.aux) {
#pragma unroll
                for (int m = 0; m < 4; ++m)
#pragma unroll
                    for (int bj = 0; bj < 2; ++bj) p[m][bj] = *(const u32x4*)(MG + base + (size_t)(ai * 128 + m * 16) * 1024 + bj * 128);
            } else {
#pragma unroll
                for (int m = 0; m < 4; ++m)
#pragma unroll
                    for (int bj = 0; bj < 2; ++bj) p[m][bj] = (u32x4){0u, 0u, 0u, 0u};
            }
#pragma unroll
            for (int m = 0; m < 4; ++m)
#pragma unroll
                for (int bj = 0; bj < 2; ++bj) {
                    const u32x4 gg = g[m][bj], pp = p[m][bj];
                    f32x4 v0 = acc[ai][bj][m][0], v1 = acc[ai][bj][m][1];
                    v0[0] = v0[0] * bflo(gg.x) + bflo(pp.x); v0[1] = v0[1] * bfhi(gg.x) + bfhi(pp.x); v0[2] = v0[2] * bflo(gg.y) + bflo(pp.y); v0[3] = v0[3] * bfhi(gg.y) + bfhi(pp.y);
                    v1[0] = v1[0] * bflo(gg.z) + bflo(pp.z); v1[1] = v1[1] * bfhi(gg.z) + bfhi(pp.z); v1[2] = v1[2] * bflo(gg.w) + bflo(pp.w); v1[3] = v1[3] * bfhi(gg.w) + bfhi(pp.w);
                    u32x4 w; w.x = pk2(v0[0], v0[1]); w.y = pk2(v0[2], v0[3]); w.z = pk2(v1[0], v1[1]); w.w = pk2(v1[2], v1[3]);
                    *(u32x4*)(MG + base + (size_t)(ai * 128 + m * 16) * 1024 + bj * 128) = w; }
        }
    }
};
struct SchedOut { const bf16_t *A, *B; int G, c;
    __device__ __forceinline__ bool next(int i, Unit& u) const { const int L = i * G + c; if (L >= 64 * 4) return false;
        u.pm = L % 64; u.pn = L / 64; u.aux = 0; u.flags = 0; u.gidx = nullptr; u.A = A + (size_t)u.pm * 256 * 1024; u.B = B + (size_t)u.pn * 256 * 1024; return true; } };
struct EpiOut {   static constexpr bool PERM = false; static constexpr bool PRE = false;
    const float* x; const float* mod; float* out; float* rowsq;
    __device__ __forceinline__ void operator()(const f32x4 (&acc)[2][2][4][2], const Unit& u, int wr, int wc, int fr, int fq) const {
        const int b = (u.pm * 256) / SEQ;
        f32x4 gm[2][2];
#pragma unroll
        for (int bj = 0; bj < 2; ++bj)
#pragma unroll
            for (int n = 0; n < 2; ++n) gm[bj][n] = *(const f32x4*)(mod + b * 6144 + 2048 + u.pn * 256 + bj * 128 + wc * 32 + 16 * n + 4 * fq);
        const size_t base = (size_t)(u.pm * 256 + wr * 64 + fr) * 1024 + u.pn * 256 + wc * 32 + 4 * fq;
#pragma unroll
        for (int ai = 0; ai < 2; ++ai) {
            f32x4 xv[4][2][2];
#pragma unroll
            for (int m = 0; m < 4; ++m)
#pragma unroll
                for (int bj = 0; bj < 2; ++bj)
#pragma unroll
                    for (int n = 0; n < 2; ++n) xv[m][bj][n] = *(const f32x4*)(x + base + (size_t)(ai * 128 + m * 16) * 1024 + bj * 128 + 16 * n);
#pragma unroll
            for (int m = 0; m < 4; ++m) { const int row = u.pm * 256 + ai * 128 + wr * 64 + m * 16 + fr; float ss = 0.f;
#pragma unroll
                for (int bj = 0; bj < 2; ++bj)
#pragma unroll
                    for (int n = 0; n < 2; ++n) { const f32x4 v = xv[m][bj][n] + gm[bj][n] * acc[ai][bj][m][n];
                        *(f32x4*)(out + base + (size_t)(ai * 128 + m * 16) * 1024 + bj * 128 + 16 * n) = v; ss += (v.x * v.x + v.y * v.y) + (v.z * v.z + v.w * v.w); }
                ss += __shfl_xor(ss, 16); ss += __shfl_xor(ss, 32);
                if (fq == 0) rowsq[(size_t)row * 16 + u.pn * 4 + wc] = ss; }
        }
    }
};

struct TokMeta { int ea, eb; float ca, cb; int re_a, re_b, cls, rc; };
__device__ __forceinline__ int pair_index(int lo, int hi) { return lo * (15 - lo) / 2 + (hi - lo - 1); }

constexpr int RL_GS = 0, RL_LG = 8192, RL_W = 8192 + 16384, RW_STRIDE = 1040;
static_assert(RL_W + 2 * 48 * RW_STRIDE + 2048 <= RING_BYTES, "routing LDS map");
__device__ __forceinline__ void route_phase(Frame& F) {
    int tid_ = F.tid, w_ = F.wave; asm volatile("" : "+v"(tid_), "+s"(w_));
    const int tid = tid_, lane = tid & 63, w = w_, r16 = lane & 15, r8 = lane & 7, kg = lane >> 4;
    LAS float* gsL = (LAS float*)(F.lds + RL_GS);
    LAS float* lgL = (LAS float*)(F.lds + RL_LG + (w & 3) * 3072);
    const bool act = w < 4;
    LAS unsigned char* wL = F.lds + RL_W;
    LAS unsigned* hbin = (LAS unsigned*)(F.lds + RL_W + 2 * 48 * RW_STRIDE);
    const float* nw = (const float*)F.ap->in[18];
    const float* rowsq = WSP(float, WS_ROWSQ);
#pragma unroll 1
    for (int blk = F.bid; blk < NTOK / 64; blk += F.G) {
        const int tokb = blk * 64, b = tokb / SEQ; const float* mod = WSP(float, WS_MOD) + b * 6144;
        __syncthreads();
        float gsv[2][3];
#pragma unroll
        for (int i = 0; i < 2; ++i) { gsv[i][0] = nw[tid + 512 * i]; gsv[i][1] = mod[4096 + tid + 512 * i]; gsv[i][2] = mod[3072 + tid + 512 * i]; }
        const int tok = tokb + 16 * (w & 3) + r16;
        const float* xr = F.out + (size_t)tok * DM + 8 * kg;
        f32x4 rsq[4];
        { const f32x4* rp = (const f32x4*)(rowsq + (size_t)tok * 16); rsq[0] = rp[0]; rsq[1] = rp[1]; rsq[2] = rp[2]; rsq[3] = rp[3]; }
        f32x4 xA[8][2], xB[8][2];
#define RT_LOAD(X, QD) do { const float* xq_ = xr + 256 * (QD); _Pragma("unroll") for (int i_ = 0; i_ < 8; ++i_) { X[i_][0] = *(const f32x4*)(xq_ + 32 * i_); X[i_][1] = *(const f32x4*)(xq_ + 32 * i_ + 4); } } while (0)
        if (act) { RT_LOAD(xA, 0); RT_LOAD(xB, 1); }
        const unsigned wvo = (unsigned)(((tid >> 6) * 1024 + 8 * (tid & 63)) * 2);
        const int wlo = (tid >> 6) * RW_STRIDE + (tid & 63) * 16;
#define RT_WLOAD(KH) do { const unsigned char* wb_ = F.ws + WS_WRH + 1024 * (KH); _Pragma("unroll") for (int i_ = 0; i_ < 12; ++i_) \
            wreg[i_] = *(const u32x4*)(wb_ + (size_t)((i_ / 6) * (int)(WS_WRL - WS_WRH) + (i_ % 6) * 8 * 2048) + wvo); } while (0)
#define RT_WSTORE() do { _Pragma("unroll") for (int i_ = 0; i_ < 12; ++i_) *(LAS u32x4*)(wL + wlo + ((i_ / 6) * 48 + (i_ % 6) * 8) * RW_STRIDE) = wreg[i_]; } while (0)
#pragma unroll
        for (int i = 0; i < 2; ++i) { gsL[tid + 512 * i] = gsv[i][0] * (1.f + gsv[i][1]); gsL[1024 + tid + 512 * i] = gsv[i][2]; }
        if (tid < 144) hbin[tid] = 0u;
        const float ssq = (((rsq[0].x + rsq[0].y) + (rsq[0].z + rsq[0].w)) + ((rsq[1].x + rsq[1].y) + (rsq[1].z + rsq[1].w))) + (((rsq[2].x + rsq[2].y) + (rsq[2].z + rsq[2].w)) + ((rsq[3].x + rsq[3].y) + (rsq[3].z + rsq[3].w)));
        const float rinv = rsqrtf(ssq * (1.f / DM) + EPS);
        f32x4 acc[3];
#pragma unroll
        for (int nb = 0; nb < 3; ++nb) acc[nb] = (f32x4){0.f, 0.f, 0.f, 0.f};
        unsigned char* h2row = WSP(unsigned char, WS_H2T) + (size_t)tok * DM + 8 * kg;
#define RT_COMP(X, QD) do { _Pragma("unroll") for (int i_ = 0; i_ < 8; ++i_) { const int kq_ = 256 * (QD) + 32 * i_, k0 = kq_ + 8 * kg, kl_ = 256 * ((QD) & 1) + 32 * i_ + 8 * kg; \
                const f32x4 a = X[i_][0], c = X[i_][1]; \
                const f32x4 g0 = *(const LAS f32x4*)(gsL + k0), g1 = *(const LAS f32x4*)(gsL + k0 + 4), s0 = *(const LAS f32x4*)(gsL + 1024 + k0), s1 = *(const LAS f32x4*)(gsL + 1024 + k0 + 4); \
                float hv[8]; hv[0] = a.x * rinv * g0.x + s0.x; hv[1] = a.y * rinv * g0.y + s0.y; hv[2] = a.z * rinv * g0.z + s0.z; hv[3] = a.w * rinv * g0.w + s0.w; \
                hv[4] = c.x * rinv * g1.x + s1.x; hv[5] = c.y * rinv * g1.y + s1.y; hv[6] = c.z * rinv * g1.z + s1.z; hv[7] = c.w * rinv * g1.w + s1.w; \
                u32x4 ph, pl; ph.x = pk2(hv[0], hv[1]); ph.y = pk2(hv[2], hv[3]); ph.z = pk2(hv[4], hv[5]); ph.w = pk2(hv[6], hv[7]); \
                pl.x = pk2(hv[0] - bflo(ph.x), hv[1] - bfhi(ph.x)); pl.y = pk2(hv[2] - bflo(ph.y), hv[3] - bfhi(ph.y)); pl.z = pk2(hv[4] - bflo(ph.z), hv[5] - bfhi(ph.z)); pl.w = pk2(hv[6] - bflo(ph.w), hv[7] - bfhi(ph.w)); \
                *(u32x2*)(h2row + kq_) = (u32x2){pk4_fp8(hv[0], hv[1], hv[2], hv[3]), pk4_fp8(hv[4], hv[5], hv[6], hv[7])};     \
                const bf16x8 ah = __builtin_bit_cast(bf16x8, ph), al = __builtin_bit_cast(bf16x8, pl); \
                _Pragma("unroll") for (int nb = 0; nb < 3; ++nb) { const LAS unsigned char* wp = wL + (16 * nb + r16) * RW_STRIDE + kl_ * 2; \
                    const bf16x8 bh = *(const LAS bf16x8*)wp, bl = *(const LAS bf16x8*)(wp + 48 * RW_STRIDE); \
                    acc[nb] = __builtin_amdgcn_mfma_f32_16x16x32_bf16(ah, bh, acc[nb], 0, 0, 0); acc[nb] = __builtin_amdgcn_mfma_f32_16x16x32_bf16(ah, bl, acc[nb], 0, 0, 0); \
                    acc[nb] = __builtin_amdgcn_mfma_f32_16x16x32_bf16(al, bh, acc[nb], 0, 0, 0); } \
                __builtin_amdgcn_sched_barrier(0); } } while (0)
#pragma unroll 1
        for (int kh = 0; kh < 2; ++kh) {
            __syncthreads();
            { u32x4 wreg[12]; RT_WLOAD(kh); RT_WSTORE(); }
            __syncthreads();
            if (act) {
                RT_COMP(xA, 2 * kh);
                if (kh == 0) RT_LOAD(xA, 2);
                RT_COMP(xB, 2 * kh + 1);
                if (kh == 0) RT_LOAD(xB, 3);
            }
        }
#undef RT_COMP
#undef RT_WSTORE
#undef RT_WLOAD
#undef RT_LOAD
        if (act) {
#pragma unroll
            for (int nb = 0; nb < 3; ++nb)
#pragma unroll
                for (int r = 0; r < 4; ++r) lgL[(4 * kg + r) * 48 + 16 * nb + r16] = acc[nb][r]; }
        asm volatile("s_waitcnt lgkmcnt(0)" ::: "memory");
        TokMeta mt; mt.ea = 0; mt.eb = 0; mt.ca = 0.f; mt.cb = 0.f; mt.re_a = 0; mt.re_b = 0; mt.cls = 0; mt.rc = 0;
        if (act && lane < 16) {
            const LAS float* lg = lgL + lane * 48; const float* bg = (const float*)F.ap->in[20]; const float* be = (const float*)F.ap->in[22];
            float gl[4];
#pragma unroll
            for (int i = 0; i < 4; ++i) gl[i] = lg[i] + bg[i];
            int g = 0; float gmx = gl[0];
#pragma unroll
            for (int i = 1; i < 4; ++i) if (gl[i] > gmx) { gmx = gl[i]; g = i; }
            float gs = 0.f;
#pragma unroll
            for (int i = 0; i < 4; ++i) gs += __expf(gl[i] - gmx);
            const float gw = 1.f / gs;
            float el[8];
#pragma unroll
            for (int i = 0; i < 8; ++i) el[i] = lg[4 + g * 8 + i] + be[g * 8 + i];
            int i1 = 0; float v1 = el[0];
#pragma unroll
            for (int i = 1; i < 8; ++i) if (el[i] > v1) { v1 = el[i]; i1 = i; }
            int i2 = -1; float v2 = -INFINITY;
#pragma unroll
            for (int i = 0; i < 8; ++i) if (i != i1 && (i2 < 0 || el[i] > v2)) { v2 = el[i]; i2 = i; }
            const float e2 = __expf(v2 - v1); const float w1v = gw / (1.f + e2), w2v = gw * e2 / (1.f + e2);
            const int lo = i1 < i2 ? i1 : i2, hi = i1 < i2 ? i2 : i1;
            mt.ea = g * 8 + lo; mt.eb = g * 8 + hi; mt.ca = (i1 < i2) ? w1v : w2v; mt.cb = (i1 < i2) ? w2v : w1v;
            mt.cls = g * 28 + pair_index(lo, hi);
            mt.re_a = (int)__hip_atomic_fetch_add(hbin + mt.ea, 1u, __ATOMIC_RELAXED, __HIP_MEMORY_SCOPE_WORKGROUP); mt.re_b = (int)__hip_atomic_fetch_add(hbin + mt.eb, 1u, __ATOMIC_RELAXED, __HIP_MEMORY_SCOPE_WORKGROUP);
            mt.rc = (int)__hip_atomic_fetch_add(hbin + 32 + mt.cls, 1u, __ATOMIC_RELAXED, __HIP_MEMORY_SCOPE_WORKGROUP);
        }
        __syncthreads();
        if (tid < 144) { const unsigned cnt = hbin[tid]; unsigned base = 0u;
            if (cnt) base = atomicAdd((unsigned*)(F.ws + WS_CTL) + CW_CNTE + tid * CNT_STRIDE, cnt);
            hbin[160 + tid] = base; }
        __syncthreads();
        if (act && lane < 16) { mt.re_a += (int)hbin[160 + mt.ea]; mt.re_b += (int)hbin[160 + mt.eb]; mt.rc += (int)hbin[160 + 32 + mt.cls];
            const int tk = tokb + 16 * w + lane;
            typedef int i32x4 __attribute__((ext_vector_type(4)));
            WSP(i32x4, WS_EINFO)[(size_t)mt.ea * LIST_CAP + mt.re_a] = (i32x4){tk, (int)fbits(mt.ca), mt.cls, mt.rc};
            WSP(i32x4, WS_EINFO)[(size_t)mt.eb * LIST_CAP + mt.re_b] = (i32x4){tk, (int)fbits(mt.cb), mt.cls | (1 << 16), mt.rc};
            WSP(int, WS_CLIST)[(size_t)mt.cls * LIST_CAP + mt.rc] = tk; }
    }
}
struct MoeTables { LAS int* ebase; LAS int* cbase; LAS int* cnt; LAS unsigned short* trows; LAS unsigned short* tcls; LAS unsigned short* order; };
__device__ __forceinline__ MoeTables tables_view(Frame& F, int lds_off) {
    MoeTables T; T.ebase = (LAS int*)(F.lds + lds_off); T.cbase = T.ebase + 40; T.cnt = T.ebase + 160; T.trows = (LAS unsigned short*)(F.lds + lds_off + 1280); T.tcls = T.trows + 256; T.order = T.trows + 512; return T; }
__device__ __forceinline__ MoeTables build_tables(Frame& F, int lds_off) {
    MoeTables T = tables_view(F, lds_off);
    const unsigned* ctl = (const unsigned*)(F.ws + WS_CTL);
    __syncthreads();
    if (F.tid < 144) T.cnt[F.tid] = (int)__hip_atomic_load(ctl + CW_CNTE + F.tid * CNT_STRIDE, __ATOMIC_RELAXED, __HIP_MEMORY_SCOPE_AGENT);
    __syncthreads();
    { int t_ = F.tid; asm volatile("" : "+v"(t_));
      const int l = t_ & 63;
#define BT_UP(P, O) __builtin_amdgcn_ds_bpermute(((l - (O)) & 63) * 4, (P))
      if (t_ < 64) { const int v = (l < NEXP) ? ((T.cnt[l] + 255) >> 8) : 0; int p = v;
#pragma unroll
          for (int o = 1; o < 64; o <<= 1) { const int t = BT_UP(p, o); if (l >= o) p += t; }
          if (l < NEXP) T.ebase[l] = p - v; if (l == NEXP - 1) T.ebase[NEXP] = p; }
      else if (t_ < 128) { const int v0 = (T.cnt[32 + l] + 255) >> 8, v1 = (l + 64 < NCLS) ? ((T.cnt[32 + 64 + l] + 255) >> 8) : 0; int p0 = v0, p1 = v1;
#pragma unroll
          for (int o = 1; o < 64; o <<= 1) { const int t0 = BT_UP(p0, o), t1 = BT_UP(p1, o); if (l >= o) { p0 += t0; p1 += t1; } }
          const int tot0 = __builtin_amdgcn_ds_bpermute(63 * 4, p0);
          T.cbase[l] = p0 - v0; if (l + 64 < NCLS) T.cbase[64 + l] = tot0 + p1 - v1; if (l + 64 == NCLS - 1) T.cbase[NCLS] = tot0 + p1; }
#undef BT_UP
    }
    __syncthreads();
    if (F.tid < NCLS) { const int n = T.cnt[32 + F.tid], b0 = T.cbase[F.tid], nt = T.cbase[F.tid + 1] - b0;
        for (int t = 0; t < nt; ++t) { const int idx = b0 + t; if (idx < 256) { const int rws = n - 256 * t; T.trows[idx] = (unsigned short)(rws > 256 ? 256 : rws); T.tcls[idx] = (unsigned short)F.tid; } } }
    __syncthreads();
    { const int NT = T.cbase[NCLS] < 256 ? T.cbase[NCLS] : 256;
      if (F.tid < NT) { const int mine = T.trows[F.tid]; int rk = 0;
          for (int j = 0; j < NT; ++j) { const int o = T.trows[j]; rk += (o > mine || (o == mine && j < F.tid)) ? 1 : 0; }
          T.order[rk] = (unsigned short)F.tid; } }
    __syncthreads();
    return T;
}
typedef int i32x4 __attribute__((ext_vector_type(4)));
struct SchedMoe1 { const bf16_t *H2, *W13; const LAS int* ebase; const LAS int* cnte; const int* einfo; int G, c;
    __device__ __forceinline__ bool next(int i, Unit& u) const { const int L = i * G + c, ntile = ebase[NEXP]; if (L >= ntile * 2) return false;
        const int rt = L >> 1, j = L & 1; int e = 0;
        for (int q = 1; q < NEXP; ++q) e = (ebase[q] <= rt) ? q : e;
        const int tl = rt - ebase[e];
        u.pm = e * 64 + tl; u.pn = j; u.flags = 0; u.aux = cnte[e] - 256 * tl; u.gidx = einfo + ((size_t)e * LIST_CAP + 256 * tl) * 4;
        u.A = H2; u.B = W13 + ((size_t)e * 512 + 256 * j) * 512; return true; } };
struct EpiMoe1 {   static constexpr bool PERM = true; static constexpr bool PRE = false;
    unsigned char* wsb; const i32x4* einfo; const LAS int* cbase;
    __device__ __forceinline__ void operator()(const f32x4 (&acc)[2][2][4][2], const Unit& u, int wr, int wc, int fr, int fq) const {
        const int e = u.pm >> 6, tl = u.pm & 63;
        i32x4 infs[8];
#pragma unroll
        for (int ai = 0; ai < 2; ++ai)
#pragma unroll
            for (int m = 0; m < 4; ++m) { const int r = ai * 128 + wr * 64 + m * 16 + fr; infs[ai * 4 + m] = einfo[(size_t)e * LIST_CAP + 256 * tl + (r < u.aux ? r : 0)]; }
        unsigned dst[8]; float cs[8];
#pragma unroll
        for (int ai = 0; ai < 2; ++ai)
#pragma unroll
            for (int m = 0; m < 4; ++m) { const int r = ai * 128 + wr * 64 + m * 16 + fr; const i32x4 inf = infs[ai * 4 + m]; cs[ai * 4 + m] = bitsf((unsigned)inf.y); const int cls = inf.z & 0xffff, half = inf.z >> 16;
                const size_t d = ((size_t)cbase[cls] * 256 + inf.w) * 512 + 256 * half + 128 * u.pn + 32 * wc + 8 * fq;
                dst[ai * 4 + m] = (r < u.aux) ? (unsigned)(WS_ACT2 + d * 2) : (unsigned)(WS_META + 16 * (fq + 4 * wc)); }
#pragma unroll
        for (int ai = 0; ai < 2; ++ai)
#pragma unroll
            for (int m = 0; m < 4; ++m) {
                float o[8];
#pragma unroll
                for (int n = 0; n < 2; ++n)
#pragma unroll
                    for (int ee = 0; ee < 4; ++ee) { const float a = acc[ai][0][m][n][ee], g = acc[ai][1][m][n][ee]; o[4 * n + ee] = a * sigmoidf_(a) * g * cs[ai * 4 + m]; }
                u32x4 w; w.x = cvt_pk_bf16(o[0], o[1]); w.y = cvt_pk_bf16(o[2], o[3]); w.z = cvt_pk_bf16(o[4], o[5]); w.w = cvt_pk_bf16(o[6], o[7]);
                *(u32x4*)(wsb + dst[ai * 4 + m]) = w; }
    }
};
struct SchedMoe2 { const bf16_t *act2, *W2; const LAS int* cbase; const LAS int* cntc; const LAS unsigned short* order; const LAS unsigned short* tcls; int G, c;
    __device__ __forceinline__ bool next(int i, Unit& u) const { const int L = (i >> 1) * G + c, ntile = cbase[NCLS]; if (L >= ntile * 4) return false;
        const int sub = i & 1, rk = L >> 2, pn = L & 3;
        const int rt = (ntile <= 256) ? (int)order[rk] : rk;
        int cl = 0;
        if (ntile <= 256) cl = (int)tcls[rt]; else { for (int q = 1; q < NCLS; ++q) cl = (cbase[q] <= rt) ? q : cl; }
        const int g = cl / 28; int p = cl % 28, lo = 0; while (p >= 7 - lo) { p -= 7 - lo; ++lo; } const int hi = lo + 1 + p;
        const int e = g * 8 + (sub ? hi : lo), tl = rt - cbase[cl];
        u.pm = cl * 64 + tl; u.pn = pn; u.flags = sub ? 1 : 2; u.aux = cntc[cl] - 256 * tl; u.gidx = nullptr;
        u.A = act2 + (size_t)rt * 256 * 512 + 256 * sub; u.B = W2 + ((size_t)e * 1024 + 256 * pn) * 256; return true; } };
struct EpiMoe2 {   static constexpr bool PERM = false; static constexpr bool PRE = true;
    float* out; const LAS unsigned char* gfL; const int* clist; float* trash;
    __device__ __forceinline__ void prefetch(int (&tk)[8], const Unit& u, int wr, int wc, int fr, int fq) const {
        const int cl = u.pm >> 6, tl = u.pm & 63;
#pragma unroll
        for (int ai = 0; ai < 2; ++ai)
#pragma unroll
            for (int m = 0; m < 4; ++m) { const int r = ai * 128 + wr * 64 + m * 16 + fr; tk[ai * 4 + m] = (r < u.aux) ? clist[(size_t)cl * LIST_CAP + 256 * tl + r] : -1; }
    }
    __device__ __forceinline__ void operator()(const f32x4 (&acc)[2][2][4][2], const Unit& u, int wr, int wc, int fr, int fq, const int (&tk)[8]) const {
        const int colb = u.pn * 256 + wc * 32 + 4 * fq;
#pragma unroll
        for (int ai = 0; ai < 2; ++ai) {
            f32x4 v[4][2][2];
#pragma unroll
            for (int m = 0; m < 4; ++m) { const int tok = tk[ai * 4 + m]; const float* p = (tok < 0) ? trash + 4 * fq : out + (size_t)tok * 1024 + colb;
#pragma unroll
                for (int bj = 0; bj < 2; ++bj)
#pragma unroll
                    for (int n = 0; n < 2; ++n) v[m][bj][n] = *(const f32x4*)(p + bj * 128 + n * 16); }
#pragma unroll
            for (int m = 0; m < 4; ++m) { const int tok = tk[ai * 4 + m]; const int b = (tok < 0 ? 0 : tok) / SEQ; float* p = (tok < 0) ? trash + 4 * fq : out + (size_t)tok * 1024 + colb;
#pragma unroll
                for (int bj = 0; bj < 2; ++bj)
#pragma unroll
                    for (int n = 0; n < 2; ++n) { const u32x2 gw = *(const LAS u32x2*)(gfL + (b * 1024 + colb + bj * 128 + n * 16) * 2); const f32x4 gf = {bflo(gw.x), bfhi(gw.x), bflo(gw.y), bfhi(gw.y)};
                        *(f32x4*)(p + bj * 128 + n * 16) = v[m][bj][n] + gf * acc[ai][bj][m][n]; } }
        }
    }
};

constexpr int NPHASE = 9;
template <int LO, int HI> __global__ void __launch_bounds__(NTHREADS, 2) mk_fwd(Args args) {
    extern __shared__ __attribute__((aligned(16))) unsigned char lds[];
    Frame F;
    F.lds = (LAS unsigned char*)lds; F.tid = threadIdx.x; F.lane = F.tid & 63; F.wave = __builtin_amdgcn_readfirstlane(F.tid >> 6); F.G = gridDim.x; F.bid = blockIdx.x;
    F.ap = &args;
    F.out = args.out; F.ws = args.ws;
    volatile LAS unsigned* MISC = (volatile LAS unsigned*)((LAS unsigned char*)lds + MISC_OFF);
    if (F.tid < 32) MISC[F.tid] = 0u;
    __syncthreads();
    unsigned* ctl = (unsigned*)(F.ws + WS_CTL);
    XcdBarrier bar; bar.bar = ctl + CW_BAR; bar.x = 0; bar.st = nullptr;
    if (MK_N_LAUNCHES == 1) bar = xcd_barrier_post(ctl + CW_BAR, MISC + 8);
#define IN(k) (LO <= (k) && (k) < HI)
#define SEAM(k) do { if constexpr (IN(k) && IN((k) + 1)) xcd_barrier(bar); } while (0)
#ifndef MK_LEAK
#define MK_LEAK -1
#endif
    unsigned long long ts_[12];
#define STAMP(k) do { if (MK_LEAK >= 0) ts_[k] = __builtin_amdgcn_s_memrealtime(); } while (0)
    STAMP(0);
    if constexpr (IN(0)) { p0_phase(F); } SEAM(0); STAMP(1);
    if constexpr (IN(1)) { p1a_phase(F); } SEAM(1); STAMP(2);
    if constexpr (IN(2)) { EpiProj E{F.ws};
        { SchedProj S{WSP(bf16_t, WS_H), WSP(bf16_t, WS_WIN), 1024, 0, F.G, F.bid}; run_gemm(F.lds, 1024, 1024, 1024, S, E); }
        { SchedProj S{WSP(bf16_t, WS_H8), WSP(bf16_t, WS_WIN8), 512, 8, F.G, F.bid}; run_gemm<false, true>(F.lds, 512, 512, 512, S, E); } }
    SEAM(2);
    unsigned long long tlru_ = 0;
    if constexpr (IN(3)) { lru_phase(F); __syncthreads(); if (MK_LEAK >= 0) tlru_ = __builtin_amdgcn_s_memrealtime(); attn_phase(F, 0, 32); } SEAM(3); STAMP(4);
    if constexpr (IN(4)) { SchedMerge S{WSP(bf16_t, WS_AO), WSP(bf16_t, WS_LO), WSP(bf16_t, WS_WPA), WSP(bf16_t, WS_WPB), F.G, F.bid};
        EpiMerge E{WSP(bf16_t, WS_MG), WSP(bf16_t, WS_GA), WSP(bf16_t, WS_GB)};
        run_gemm(F.lds, 512, 512, 512, S, E); } SEAM(4); STAMP(5);
    if constexpr (IN(5)) { SchedOut S{WSP(bf16_t, WS_MG), WSP(bf16_t, WS_WOUT), F.G, F.bid}; EpiOut E{((const float*)F.ap->in[0]), WSP(float, WS_MOD), F.out, WSP(float, WS_ROWSQ)};
        run_gemm(F.lds, 1024, 1024, 1024, S, E); } SEAM(5); STAMP(6);
    if constexpr (IN(6)) { route_phase(F); } SEAM(6); STAMP(7);
    if constexpr (IN(7)) { const MoeTables T = build_tables(F, TBL_OFF);
        SchedMoe1 S{WSP(bf16_t, WS_H2T), WSP(bf16_t, WS_W13), T.ebase, T.cnt, WSP(int, WS_EINFO), F.G, F.bid}; EpiMoe1 E{F.ws, WSP(i32x4, WS_EINFO), T.cbase};
        run_gemm<true, true>(F.lds, 512, 512, 512, S, E); } SEAM(7); STAMP(8);
    if constexpr (IN(8)) { const MoeTables T = (MK_N_LAUNCHES == 1 && IN(7)) ? tables_view(F, TBL_OFF) : build_tables(F, TBL_OFF);
        SchedMoe2 S{WSP(bf16_t, WS_ACT2), WSP(bf16_t, WS_W2), T.cbase, T.cnt + 32, T.order, T.tcls, F.G, F.bid}; EpiMoe2 E{F.out, F.lds + GF_OFF, WSP(int, WS_CLIST), WSP(float, WS_META)};
        for (int i = F.tid; i < 4096; i += NTHREADS) { const int b = i >> 9, c2 = (i & 511) * 2; const float* gp = WSP(float, WS_MOD) + b * 6144 + 5120 + c2; *(LAS unsigned*)(F.lds + GF_OFF + (b * 1024 + c2) * 2) = pk2(gp[0], gp[1]); }
        __syncthreads();
        run_gemm(F.lds, 512, 256, 256, S, E); }
    STAMP(9);
    if (MK_LEAK >= 0 && F.bid == 0 && F.tid == 0) { asm volatile("s_waitcnt vmcnt(0)" ::: "memory");
        unsigned long long d = 0;
        if (MK_LEAK < 10) d = ts_[MK_LEAK + 1] - ts_[MK_LEAK]; else if (MK_LEAK == 10) d = tlru_ - ts_[3]; else if (MK_LEAK == 11) d = MISC[16]; else if (MK_LEAK == 12) d = MISC[17]; else if (MK_LEAK == 13) d = MISC[18]; else if (MK_LEAK == 14) d = MISC[19]; else if (MK_LEAK == 15) d = MISC[20];
        F.out[0] = (float)d * 0.01f; }
#undef IN
#undef SEAM
}

template <int P> static void launch_phase(int grid, hipStream_t stream, Args a) {
    (void)hipFuncSetAttribute((const void*)mk_fwd<P, P + 1>, hipFuncAttributeMaxDynamicSharedMemorySize, LDS_BYTES);
    a.ph_lo = P; a.ph_hi = P + 1; hipLaunchKernelGGL((mk_fwd<P, P + 1>), dim3(grid), dim3(NTHREADS), LDS_BYTES, stream, a);
}
extern "C" void kernel_launch(void* const* d_in, const int* in_sizes, int n_in, void* d_out, int out_size, void* d_ws, size_t ws_size, hipStream_t stream) {
    static int grid = 0;
    if (grid == 0) {
        if (n_in != 26 || out_size != NTOK * DM || ws_size < WS_END) { fprintf(stderr, "kernel_launch: unexpected shapes (n_in %d out %d ws %zu)\n", n_in, out_size, ws_size); grid = -1; return; }
        int dev = 0, cus = 0, per_cu = 0;
        (void)hipGetDevice(&dev); (void)hipDeviceGetAttribute(&cus, hipDeviceAttributeMultiprocessorCount, dev);
#if MK_N_LAUNCHES == 1
        (void)hipFuncSetAttribute((const void*)mk_fwd<0, NPHASE>, hipFuncAttributeMaxDynamicSharedMemorySize, LDS_BYTES);
        (void)hipOccupancyMaxActiveBlocksPerMultiprocessor(&per_cu, (const void*)mk_fwd<0, NPHASE>, NTHREADS, LDS_BYTES);
#else
        (void)hipOccupancyMaxActiveBlocksPerMultiprocessor(&per_cu, (const void*)mk_fwd<2, 3>, NTHREADS, LDS_BYTES);
#endif
        (void)hipGetLastError();
        if (per_cu < 1) { fprintf(stderr, "kernel_launch: occupancy query says %d blocks per CU\n", per_cu); }
        grid = cus;
    }
    if (grid < 0) return;
    (void)hipMemsetAsync((char*)d_ws + WS_CTL, 0, CTL_ZERO_BYTES, stream);
    Args a{};
    for (int i = 0; i < 26; ++i) a.in[i] = d_in[i];
    a.out = (float*)d_out; a.ws = (unsigned char*)d_ws;
#if MK_N_LAUNCHES == 1
    a.ph_lo = 0; a.ph_hi = NPHASE; hipLaunchKernelGGL((mk_fwd<0, NPHASE>), dim3(grid), dim3(NTHREADS), LDS_BYTES, stream, a);
#else
#ifndef MK_REPMASK
#define MK_REPMASK 0
#endif
    for (int r = 0; r < ((MK_REPMASK & 1) ? 2 : 1); ++r) launch_phase<0>(grid, stream, a);
    for (int r = 0; r < ((MK_REPMASK & 2) ? 2 : 1); ++r) launch_phase<1>(grid, stream, a);
    for (int r = 0; r < ((MK_REPMASK & 4) ? 2 : 1); ++r) launch_phase<2>(grid, stream, a);
    for (int r = 0; r < ((MK_REPMASK & 8) ? 2 : 1); ++r) launch_phase<3>(grid, stream, a);
    for (int r = 0; r < ((MK_REPMASK & 16) ? 2 : 1); ++r) launch_phase<4>(grid, stream, a);
    for (int r = 0; r < ((MK_REPMASK & 32) ? 2 : 1); ++r) launch_phase<5>(grid, stream, a);
    launch_phase<6>(grid, stream, a);
    for (int r = 0; r < ((MK_REPMASK & 128) ? 2 : 1); ++r) launch_phase<7>(grid, stream, a);
    for (int r = 0; r < ((MK_REPMASK & 256) ? 2 : 1); ++r) launch_phase<8>(grid, stream, a);
    launch_phase<9>(grid, stream, a);
    if (MK_REPMASK & 512) { launch_phase<5>(grid, stream, a); launch_phase<9>(grid, stream, a); }
#endif
}
```

```cpp
#include <hip/hip_runtime.h>
#include <cstdint>
#include <cstdio>

#ifndef MK_LEAK
#define MK_LEAK -1
#endif
#ifndef MK_N_LAUNCHES
#define MK_N_LAUNCHES 1
#endif

#define LAS __attribute__((address_space(3)))
#define GAS __attribute__((address_space(1)))
typedef unsigned short bf16_t;
typedef short bf16x8 __attribute__((ext_vector_type(8)));
typedef float f32x4 __attribute__((ext_vector_type(4)));
typedef float f32x2 __attribute__((ext_vector_type(2)));
typedef unsigned u32x4 __attribute__((ext_vector_type(4)));
typedef unsigned u32x2 __attribute__((ext_vector_type(2)));
typedef GAS unsigned gu32;

constexpr int BATCH = 8, SEQ = 2048, DM = 1024, NTOK = BATCH * SEQ;
constexpr int NH = 8, HD = 64, NIH = 4, TOPK = 256, CHUNK = 64;
constexpr int LRUW = 512;
constexpr int NEXP = 32, NGRP = 4, EPG = 8, DFF = 256, NCLS = NGRP * 28;
constexpr int DIN_PAD = 4096;
constexpr float EPS = 1e-6f;
constexpr int C_Q = 0, C_K = 512, C_V = 576, C_QI = 640, C_KI = 896, C_LX = 960, C_LG = 1472, C_WI = 1984, C_PAD = 1988, C_GA = 2048, C_GB = 3072, C_END = 4096;

constexpr size_t MiB = 1u << 20;
constexpr size_t WS_CTL = 0, CTL_ZERO_BYTES = 1 * MiB;
constexpr size_t WS_MOD = 1 * MiB;
constexpr size_t WS_META = 1 * MiB + 512 * 1024;
constexpr size_t WS_WIN = 2 * MiB, WS_WPA = 10 * MiB, WS_WPB = 11 * MiB, WS_WOUT = 12 * MiB, WS_W13 = 14 * MiB, WS_W2 = 46 * MiB;
constexpr size_t WS_WRH = 62 * MiB, WS_WRL = 62 * MiB + 256 * 1024;
constexpr size_t WS_H = 64 * MiB;
constexpr size_t WS_AO = 64 * MiB, WS_LO = 80 * MiB;
constexpr size_t WS_Q = 96 * MiB, WS_QI = 112 * MiB, WS_K = 120 * MiB, WS_KI = 122 * MiB, WS_VT = 124 * MiB, WS_WI = 126 * MiB, WS_VR = 224 * MiB;
constexpr size_t WS_LX = 128 * MiB, WS_LG = 144 * MiB, WS_MG = 128 * MiB;
constexpr size_t WS_GA = 160 * MiB, WS_GB = 192 * MiB;
constexpr size_t WS_A1 = 64 * MiB;
constexpr size_t WS_H2T = 160 * MiB;
constexpr size_t WS_ACT2 = 192 * MiB;
constexpr size_t WS_H8 = 224 * MiB;
constexpr size_t WS_WIN8 = 6 * MiB;
constexpr size_t WS_EINFO = 64 * MiB;
constexpr size_t WS_CLIST = 72 * MiB;
constexpr int LIST_CAP = 16384;
constexpr size_t WS_ROWSQ = 240 * MiB;
constexpr size_t WS_END = 256 * MiB;
constexpr int CW_BAR = 4096, CW_CNTE = 8192, CW_CNTC = 8192 + 32 * 32, CNT_STRIDE = 32, CW_ROWSQ = 16384;

constexpr int NWAVES = 8, NTHREADS = 512;
constexpr int LDS_BYTES = 151552, RING_BYTES = 131072, MISC_OFF = LDS_BYTES - 512, GF_OFF = RING_BYTES, TBL_OFF = RING_BYTES + 16384;

typedef float f32x2_cv __attribute__((ext_vector_type(2)));
typedef __bf16 bf16x2_cv __attribute__((ext_vector_type(2)));
__device__ __forceinline__ unsigned pk2(float lo, float hi) { const f32x2_cv v = {lo, hi}; return __builtin_bit_cast(unsigned, __builtin_convertvector(v, bf16x2_cv)); }
__device__ __forceinline__ unsigned f2bf(float f) { return pk2(f, 0.f) & 0xffffu; }
__device__ __forceinline__ unsigned cvt_pk_bf16(float lo, float hi) { return pk2(lo, hi); }

#define LDS_BARRIER() do { asm volatile("s_waitcnt lgkmcnt(0)" ::: "memory"); __builtin_amdgcn_s_barrier(); asm volatile("" ::: "memory"); } while (0)
__device__ __forceinline__ float relu_f(float x) { float r; asm("v_max_f32 %0, 0, %1" : "=v"(r) : "v"(x)); return r; }
__device__ __forceinline__ float max3f(float a, float b, float c) { float r; asm("v_max3_f32 %0, %1, %2, %3" : "=v"(r) : "v"(a), "v"(b), "v"(c)); return r; }
typedef int v8i32 __attribute__((ext_vector_type(8)));
__device__ __forceinline__ unsigned pk4_fp8(float a, float b, float c, float d) { int w = 0; w = __builtin_amdgcn_cvt_pk_fp8_f32(a, b, w, false); w = __builtin_amdgcn_cvt_pk_fp8_f32(c, d, w, true); return (unsigned)w; }
__device__ __forceinline__ float bf2f(unsigned short b) { return __builtin_bit_cast(float, (unsigned)b << 16); }
__device__ __forceinline__ float bflo(unsigned w) { return __builtin_bit_cast(float, w << 16); }
__device__ __forceinline__ float bfhi(unsigned w) { return __builtin_bit_cast(float, w & 0xffff0000u); }
__device__ __forceinline__ float wave_sum(float v) {
#pragma unroll
    for (int o = 1; o < 64; o <<= 1) v += __shfl_xor(v, o);
    return v;
}
__device__ __forceinline__ float wave_max(float v) {
#pragma unroll
    for (int o = 1; o < 64; o <<= 1) v = fmaxf(v, __shfl_xor(v, o));
    return v;
}
__device__ __forceinline__ int wave_isum(int v) {
#pragma unroll
    for (int o = 1; o < 64; o <<= 1) v += __shfl_xor(v, o);
    return v;
}
__device__ __forceinline__ float sigmoidf_(float x) { return __builtin_amdgcn_rcpf(1.f + __expf(-x)); }
__host__ __device__ __forceinline__ int perm32(int rho) { const int n = rho >> 4, i = rho & 15; return 8 * (i >> 2) + 4 * n + (i & 3); }
__device__ __forceinline__ int vt_pos(int o) { return 8 * ((o >> 2) & 1) + 4 * (o >> 3) + (o & 3); }

#define XB_TMO      128
#define XB_XCNT(j)  (256  + 64 * (j))
#define XB_XSUB(j)  (1280 + 64 * (j))
#define XB_XGEN(j)  (2304 + 64 * (j))
#define XB_TOP      3328
#define XB_TOPGEN   3392
#define XCD_BAR_WORDS 3456
#define XB_SPIN_CAP (1u << 18)
__device__ __forceinline__ unsigned xb_ld(unsigned* p)              { return __hip_atomic_load(p, __ATOMIC_RELAXED, __HIP_MEMORY_SCOPE_AGENT); }
__device__ __forceinline__ unsigned xb_add(unsigned* p, unsigned v) { return __hip_atomic_fetch_add(p, v, __ATOMIC_RELAXED, __HIP_MEMORY_SCOPE_AGENT); }
__device__ __forceinline__ unsigned xb_xcc_id() { return (unsigned)__builtin_amdgcn_s_getreg((3 << 11) | 20) & 0xFu; }
#define XB_SPIN(cond, bar) do { unsigned _sp = 0; while (cond) { __builtin_amdgcn_s_sleep(1); \
    if ((++_sp & 255u) == 0u) { if (xb_ld(&(bar)[XB_TMO])) break; if (_sp > XB_SPIN_CAP) { atomicAdd(&(bar)[XB_TMO], 1u); break; } } } } while (0)
struct XcdBarrier { unsigned* bar; unsigned x; volatile LAS unsigned* st; };
__device__ __forceinline__ XcdBarrier xcd_barrier_post(unsigned* bar, volatile LAS unsigned* st) {
    XcdBarrier b; b.bar = bar; b.x = xb_xcc_id(); b.st = st;
    if (threadIdx.x == 0) (void)xb_add(&bar[XB_XCNT(b.x)], 1u);
    return b;
}
__device__ __forceinline__ void xcd_barrier_complete(unsigned* bar, unsigned x, unsigned& nloc, unsigned& nx) {
    const unsigned G = gridDim.x * gridDim.y * gridDim.z;
    unsigned sum, cnt, mine, sp = 0u;
    for (;;) {
        sum = 0u; cnt = 0u; mine = 0u;
#pragma unroll
        for (unsigned j = 0; j < 16; ++j) { const unsigned c = xb_ld(&bar[XB_XCNT(j)]); sum += c; cnt += (c > 0u) ? 1u : 0u; mine = (j == x) ? c : mine; }
        if (sum == G) break;
        __builtin_amdgcn_s_sleep(1);
        if ((++sp & 255u) == 0u) { if (xb_ld(&bar[XB_TMO])) break; if (sp > XB_SPIN_CAP) { atomicAdd(&bar[XB_TMO], 1u); break; } }
    }
    nloc = mine > 0u ? mine : 1u; nx = cnt > 0u ? cnt : 1u;
}
__device__ __forceinline__ void xcd_barrier(const XcdBarrier& b) {
    asm volatile("s_waitcnt vmcnt(0)" ::: "memory");
    __syncthreads();
    if (threadIdx.x == 0) {
        unsigned* bar = b.bar;
        __builtin_amdgcn_s_waitcnt(0);
        unsigned nloc = b.st[0], nx = b.st[1];
        if (nloc == 0u) { xcd_barrier_complete(bar, b.x, nloc, nx); b.st[0] = nloc; b.st[1] = nx; }
        const unsigned old = xb_add(&bar[XB_XSUB(b.x)], 1u);
        const unsigned gen = old / nloc;
        if (old + 1u == (gen + 1u) * nloc) {
            __builtin_amdgcn_fence(__ATOMIC_RELEASE, "agent");
            asm volatile("s_waitcnt vmcnt(0)" ::: "memory");
            const unsigned og = xb_add(&bar[XB_TOP], 1u);
            const unsigned tg = og / nx;
            if (og + 1u == (tg + 1u) * nx) xb_add(&bar[XB_TOPGEN], 1u);
            else XB_SPIN(xb_ld(&bar[XB_TOPGEN]) == tg, bar);
            __builtin_amdgcn_fence(__ATOMIC_ACQUIRE, "agent");
            xb_add(&bar[XB_XGEN(b.x)], 1u);
            asm volatile("s_waitcnt vmcnt(0)" ::: "memory");
        } else {
            XB_SPIN(xb_ld(&bar[XB_XGEN(b.x)]) == gen, bar);
            __builtin_amdgcn_fence(__ATOMIC_ACQUIRE, "agent");
            asm volatile("s_waitcnt vmcnt(0)" ::: "memory");
        }
    }
    __syncthreads();
}

struct Args { const void* in[26]; float* out; unsigned char* ws; int ph_lo, ph_hi; };
struct Frame {
    LAS unsigned char* lds;
    int tid, lane, wave, G, bid;
    const Args* ap;
    float* out; unsigned char* ws;
};
#define WSP(T, off) ((T*)(F.ws + (off)))

__device__ __forceinline__ void tr_item(const float* __restrict__ src, int ld, int k0, int c0, int nvalid, bf16_t* dst, int ldd, LAS float* scr, int lane) {
    const int c4 = (lane & 7) * 4, rr = lane >> 3;
    if (nvalid == 32 && ((c0 | ld) & 3) == 0) {
        f32x4 v[8];
#pragma unroll
        for (int i = 0; i < 8; ++i) v[i] = *(const f32x4*)(src + (size_t)(k0 + 8 * i + rr) * ld + c0 + c4);
#pragma unroll
        for (int i = 0; i < 8; ++i) { LAS float* p = scr + (8 * i + rr) * 33 + c4; p[0] = v[i].x; p[1] = v[i].y; p[2] = v[i].z; p[3] = v[i].w; }
    } else {
#pragma unroll 8
        for (int i = 0; i < 32; ++i) { const int kk = 2 * i + (lane >> 5), cc = lane & 31;
            scr[kk * 33 + cc] = (cc < nvalid) ? src[(size_t)(k0 + kk) * ld + c0 + cc] : 0.f; }
    }
    asm volatile("s_waitcnt lgkmcnt(0)" ::: "memory");
    const int c = lane & 7;
#pragma unroll
    for (int j = 0; j < 4; ++j) { const int n = (lane >> 3) + 8 * j; const LAS float* s = scr + (8 * c) * 33 + n;
        u32x4 o; o.x = cvt_pk_bf16(s[0 * 33], s[1 * 33]); o.y = cvt_pk_bf16(s[2 * 33], s[3 * 33]); o.z = cvt_pk_bf16(s[4 * 33], s[5 * 33]); o.w = cvt_pk_bf16(s[6 * 33], s[7 * 33]);
        *(u32x4*)(dst + (size_t)n * ldd + k0 + 8 * c) = o; }
    asm volatile("s_waitcnt lgkmcnt(0)" ::: "memory");
}
constexpr float W8_SCALE = 32.f;
__device__ __forceinline__ void tr_item8(const float* __restrict__ src, int ld, int k0, int c0, int nvalid, unsigned char* dst, int ldd, LAS float* scr, int lane) {
    const int c4 = (lane & 7) * 4, rr = lane >> 3;
    if (nvalid == 32 && ((c0 | ld) & 3) == 0) {
        f32x4 v[8];
#pragma unroll
        for (int i = 0; i < 8; ++i) v[i] = *(const f32x4*)(src + (size_t)(k0 + 8 * i + rr) * ld + c0 + c4);
#pragma unroll
        for (int i = 0; i < 8; ++i) { LAS float* p = scr + (8 * i + rr) * 33 + c4; p[0] = v[i].x; p[1] = v[i].y; p[2] = v[i].z; p[3] = v[i].w; }
    } else {
#pragma unroll 8
        for (int i = 0; i < 32; ++i) { const int kk = 2 * i + (lane >> 5), cc = lane & 31;
            scr[kk * 33 + cc] = (cc < nvalid) ? src[(size_t)(k0 + kk) * ld + c0 + cc] : 0.f; }
    }
    asm volatile("s_waitcnt lgkmcnt(0)" ::: "memory");
    const int c = lane & 7;
#pragma unroll
    for (int j = 0; j < 4; ++j) { const int n = (lane >> 3) + 8 * j; const LAS float* s = scr + (8 * c) * 33 + n;
        u32x2 o; o.x = pk4_fp8(s[0 * 33] * W8_SCALE, s[1 * 33] * W8_SCALE, s[2 * 33] * W8_SCALE, s[3 * 33] * W8_SCALE); o.y = pk4_fp8(s[4 * 33] * W8_SCALE, s[5 * 33] * W8_SCALE, s[6 * 33] * W8_SCALE, s[7 * 33] * W8_SCALE);
        *(u32x2*)(dst + (size_t)n * ldd + k0 + 8 * c) = o; }
    asm volatile("s_waitcnt lgkmcnt(0)" ::: "memory");
}
__device__ __forceinline__ void p0_phase(Frame& F) {
    LAS float* cond = (LAS float*)(F.lds + 8 * 8448);
    LAS float* part = (LAS float*)(F.lds + 8 * 8448 + 32768);
    for (int i = F.tid; i < BATCH * DM; i += NTHREADS) { const float v = ((const float*)F.ap->in[1])[i]; cond[i] = v * __builtin_amdgcn_rcpf(1.f + __expf(-v)); }
    __syncthreads();
#pragma unroll 1
    for (int item = F.bid; item < 384; item += F.G) {
        const int col = item * 16 + (F.lane & 15), kq = F.lane >> 4, kb = 128 * F.wave + kq;
        const float* wp = ((const float*)F.ap->in[2]) + (size_t)kb * 6144 + col;
        float wv[32];
#pragma unroll
        for (int i = 0; i < 32; ++i) wv[i] = wp[(size_t)(4 * i) * 6144];
        float acc[8];
#pragma unroll
        for (int b = 0; b < 8; ++b) acc[b] = 0.f;
#pragma unroll
        for (int i = 0; i < 32; ++i) {
#pragma unroll
            for (int b = 0; b < 8; ++b) acc[b] += cond[b * DM + kb + 4 * i] * wv[i]; }
#pragma unroll
        for (int b = 0; b < 8; ++b) { float v = acc[b]; v += __shfl_xor(v, 16); v += __shfl_xor(v, 32); acc[b] = v; }
        if (kq == 0) {
#pragma unroll
            for (int b = 0; b < 8; ++b) part[(F.wave * 8 + b) * 16 + (F.lane & 15)] = acc[b]; }
        __syncthreads();
        if (F.tid < 128) { const int b = F.tid >> 4, c = F.tid & 15; float s = ((const float*)F.ap->in[3])[item * 16 + c];
#pragma unroll
            for (int w = 0; w < 8; ++w) s += part[(w * 8 + b) * 16 + c];
            WSP(float, WS_MOD)[b * 6144 + item * 16 + c] = s; }
        __syncthreads();
    }
    LAS float* scr = (LAS float*)(F.lds + F.wave * 8448);
    const int gw = F.bid * NWAVES + F.wave, NGW = F.G * NWAVES;
    constexpr int I_WIN = 16 * 128, I_WP = 8 * 32, I_WO = 16 * 32, I_W13 = 32 * 256, I_W2 = 32 * 128;
    constexpr int NITEMS = I_WIN + 2 * I_WP + I_WO + I_W13 + I_W2;
    for (int it = gw; it < NITEMS; it += NGW) {
        int r = it;
        if (r < I_WIN) { const int kb = r / 128, nb = r % 128, n0 = 32 * nb; int c0, nv;
            if (n0 < C_LX) { c0 = n0; nv = 32; } else if (n0 < C_WI) { c0 = n0 + 4; nv = 32; } else if (n0 == C_WI) { c0 = 960; nv = 4; } else if (n0 < C_GA) { c0 = 0; nv = 0; } else { c0 = n0 - 60; nv = 32; }
            if (n0 < C_GA) tr_item(((const float*)F.ap->in[5]), 4036, 64 * kb, c0, nv, WSP(bf16_t, WS_WIN) + (size_t)n0 * 1024, 1024, scr, F.lane);
            else tr_item8(((const float*)F.ap->in[5]), 4036, 64 * kb, c0, nv, WSP(unsigned char, WS_WIN8) + (size_t)(n0 - C_GA) * 1024, 1024, scr, F.lane);
            continue; } r -= I_WIN;
        if (r < I_WP) { const int kb = r / 32, nb = r % 32; tr_item(((const float*)F.ap->in[15]), 1024, 64 * kb, 32 * nb, 32, WSP(bf16_t, WS_WPA) + (size_t)(32 * nb) * 512, 512, scr, F.lane); continue; } r -= I_WP;
        if (r < I_WP) { const int kb = r / 32, nb = r % 32; tr_item(((const float*)F.ap->in[16]), 1024, 64 * kb, 32 * nb, 32, WSP(bf16_t, WS_WPB) + (size_t)(32 * nb) * 512, 512, scr, F.lane); continue; } r -= I_WP;
        if (r < I_WO) { const int kb = r / 32, nb = r % 32; tr_item(((const float*)F.ap->in[17]), 1024, 64 * kb, 32 * nb, 32, WSP(bf16_t, WS_WOUT) + (size_t)(32 * nb) * 1024, 1024, scr, F.lane); continue; } r -= I_WO;
        if (r < I_W13) { const int e = r / 256, r2 = r % 256, kb = r2 / 16, nb = r2 % 16, n0 = 32 * nb, j = n0 >> 8, half = (n0 >> 7) & 1, cc0 = n0 & 127;
            const float* src = (half ? ((const float*)F.ap->in[24]) : ((const float*)F.ap->in[23])) + (size_t)e * 1024 * 256;
            tr_item8(src, 256, 64 * kb, 128 * j + cc0, 32, WSP(unsigned char, WS_W13) + ((size_t)e * 512 + n0) * 1024, 1024, scr, F.lane); continue; } r -= I_W13;
        { const int e = r / 128, r2 = r % 128, kb = r2 / 32, nb = r2 % 32;
            tr_item(((const float*)F.ap->in[25]) + (size_t)e * 256 * 1024, 1024, 64 * kb, 32 * nb, 32, WSP(bf16_t, WS_W2) + ((size_t)e * 1024 + 32 * nb) * 256, 256, scr, F.lane); }
    }
    for (int i = F.bid * NTHREADS + F.tid; i < 48 * 1024; i += F.G * NTHREADS) { const int r = i >> 10, k = i & 1023;
        const float v = r < 4 ? ((const float*)F.ap->in[19])[k * 4 + r] : r < 36 ? ((const float*)F.ap->in[21])[k * 32 + (r - 4)] : 0.f;
        const unsigned hi = f2bf(v); const float rem = v - bf2f((unsigned short)hi);
        WSP(bf16_t, WS_WRH)[i] = (bf16_t)hi; WSP(bf16_t, WS_WRL)[i] = (bf16_t)f2bf(rem); }
}

__device__ __forceinline__ void p1a_phase(Frame& F) {
    const int gw = F.bid * NWAVES + F.wave, NGW = F.G * NWAVES;
    const float* mod = WSP(float, WS_MOD);
    bf16_t* H = WSP(bf16_t, WS_H);
    const float* nmw = (const float*)F.ap->in[4];
#pragma unroll 1
    for (int row0 = 4 * gw; row0 < NTOK; row0 += 4 * NGW) {
        const int b = row0 / SEQ;
        f32x4 v[4][4];
#pragma unroll
        for (int r = 0; r < 4; ++r) { const f32x4* xr = (const f32x4*)(((const float*)F.ap->in[0]) + (size_t)(row0 + r) * DM) + F.lane;
#pragma unroll
            for (int j = 0; j < 4; ++j) v[r][j] = xr[64 * j]; }
        f32x4 gg[4], sh[4];
#pragma unroll
        for (int j = 0; j < 4; ++j) { const int col = 4 * F.lane + 256 * j; gg[j] = *(const f32x4*)(nmw + col) * (*(const f32x4*)(mod + b * 6144 + 1024 + col) + 1.f); sh[j] = *(const f32x4*)(mod + b * 6144 + col); }
#pragma unroll
        for (int r = 0; r < 4; ++r) { float s = 0.f;
#pragma unroll
            for (int j = 0; j < 4; ++j) s += (v[r][j].x * v[r][j].x + v[r][j].y * v[r][j].y) + (v[r][j].z * v[r][j].z + v[r][j].w * v[r][j].w);
            const float rinv = rsqrtf(wave_sum(s) * (1.f / DM) + EPS);
            unsigned long long* o8 = (unsigned long long*)(H + (size_t)(row0 + r) * DM) + F.lane;
            unsigned* o4 = (unsigned*)(F.ws + WS_H8 + (size_t)(row0 + r) * DM) + F.lane;
#pragma unroll
            for (int j = 0; j < 4; ++j) { const f32x4 hv = v[r][j] * rinv * gg[j] + sh[j];
                o8[64 * j] = (unsigned long long)cvt_pk_bf16(hv.x, hv.y) | ((unsigned long long)cvt_pk_bf16(hv.z, hv.w) << 32); o4[64 * j] = pk4_fp8(hv.x, hv.y, hv.z, hv.w); } }
    }
}

struct Unit { const bf16_t* A; const bf16_t* B; int pm, pn, aux, flags; const int* gidx; };
template <bool PERM, class Sched, class Epi>
__device__ __forceinline__ void gemm_naive(int lda, int ldb, int K, const Sched& S, const Epi& E) {
    const int tid = threadIdx.x, wid = __builtin_amdgcn_readfirstlane(tid >> 6), lane = tid & 63, wr = wid >> 2, wc = wid & 3, fr = lane & 15, fq = lane >> 4;
    f32x4 acc[2][2][4][2];
    Unit u;
    for (int i = 0; S.next(i, u); ++i) {
        if (!(u.flags & 1)) {
#pragma unroll
            for (int a = 0; a < 2; ++a)
#pragma unroll
                for (int b = 0; b < 2; ++b)
#pragma unroll
                    for (int m = 0; m < 4; ++m)
#pragma unroll
                        for (int n = 0; n < 2; ++n) acc[a][b][m][n] = (f32x4){0.f, 0.f, 0.f, 0.f};
        }
#pragma unroll 1
        for (int k0 = 0; k0 < K; k0 += 32) {
            bf16x8 bfr[2][2];
#pragma unroll
            for (int bj = 0; bj < 2; ++bj)
#pragma unroll
                for (int n = 0; n < 2; ++n) { const int rho = 16 * n + fr, rr = PERM ? perm32(rho) : rho;
                    bfr[bj][n] = *(const bf16x8*)(u.B + (size_t)(128 * bj + 32 * wc + rr) * ldb + k0 + 8 * fq); }
#pragma unroll
            for (int ai = 0; ai < 2; ++ai) {
                bf16x8 af[4];
#pragma unroll
                for (int m = 0; m < 4; ++m) af[m] = *(const bf16x8*)(u.A + (size_t)(128 * ai + 64 * wr + 16 * m + fr) * lda + k0 + 8 * fq);
#pragma unroll
                for (int bj = 0; bj < 2; ++bj)
#pragma unroll
                    for (int m = 0; m < 4; ++m)
#pragma unroll
                        for (int n = 0; n < 2; ++n) acc[ai][bj][m][n] = __builtin_amdgcn_mfma_f32_16x16x32_bf16(bfr[bj][n], af[m], acc[ai][bj][m][n], 0, 0, 0);
            }
        }
        if (!(u.flags & 2)) E(acc, u, wr, wc, fr, fq);
    }
}


namespace pg8 {
constexpr int BK = 64, HALF = 128, HTB = HALF * BK * 2;
__device__ __forceinline__ int lds_byte(int r, int c) { const int st = (r >> 4) * 2 + (c >> 5), rr = r & 15, cc = c & 31, ob = rr * 64 + cc * 2; return st * 1024 + (ob ^ (((ob >> 9) & 1) << 5)); }
__device__ __forceinline__ void stage_rc(int b, int& R, int& C) { const int st = b / 1024, sb = b % 1024, swz = sb ^ (((sb >> 9) & 1) << 5); R = (st >> 1) * 16 + swz / 64; C = (st & 1) * 32 + (swz % 64) / 2; }
template <class Epi, class Sched, bool ALIGN_EPI, bool GATHER = false, bool FP8 = false>
__device__ __forceinline__ void gemm_phase(LAS unsigned char* lds, int lda, int ldb, int K, const Sched& S, const Epi& E) {
    int tid_ = threadIdx.x; asm volatile("" : "+v"(tid_));
    const int tid = tid_, wid = __builtin_amdgcn_readfirstlane(tid >> 6), lane = tid & 63, wr = wid >> 2, wc = wid & 3, fr = lane & 15, fq = lane >> 4;
    const int nt = K / BK;
    unsigned voffA[2], voffB[2];
#pragma unroll
    for (int i = 0; i < 2; ++i) { int R, C; stage_rc(tid * 16 + i * 8192, R, C); const int Rb = Epi::PERM ? ((R & ~31) + perm32(R & 31)) : R;
        voffA[i] = (unsigned)(R * lda + C) * 2u; voffB[i] = (unsigned)(Rb * ldb + C) * 2u; }
    const size_t kstep = (size_t)(BK * 2);
    const size_t hstepA = GATHER ? 0 : (size_t)HALF * lda * 2, hstepB = (size_t)HALF * ldb * 2;
    unsigned gC[2], gN[2], gcol[2];
#pragma unroll
    for (int i_ = 0; i_ < 2; ++i_) { int R_, C_; stage_rc(tid * 16 + i_ * 8192, R_, C_); gcol[i_] = (unsigned)C_ * 2u; }
#define PG8_GOFF(dst, u) do { _Pragma("unroll") for (int h_ = 0; h_ < 2; ++h_) { unsigned pk_ = 0u; _Pragma("unroll") for (int i_ = 0; i_ < 2; ++i_) { int R_, C_; stage_rc(tid * 16 + i_ * 8192, R_, C_); \
        const int row_ = h_ * HALF + R_; const unsigned tok_ = (unsigned)(u).gidx[4 * (row_ < (u).aux ? row_ : 0)]; pk_ |= tok_ << (16 * i_); } dst[h_] = pk_; } } while (0)
    const unsigned ldsw = (unsigned)wid * 1024u;
    const int aoff = FP8 ? lds_byte(wr * 64 + fr, fq * 16) : lds_byte(wr * 64 + fr, fq * 8), boff = FP8 ? lds_byte(wc * 32 + fr, fq * 16) : lds_byte(wc * 32 + fr, fq * 8);
#define PG8_SA(b, h) (((b) * 2 + (h)) * HTB)
#define PG8_SB(b, h) ((4 + (b) * 2 + (h)) * HTB)
#define PG8_STAGE(bufoff, gbase, voff) do { _Pragma("unroll") for (int _i = 0; _i < 2; ++_i) \
        __builtin_amdgcn_global_load_lds((const unsigned*)((const char*)(gbase) + (voff)[_i]), (LAS unsigned*)(lds + (bufoff) + ldsw + _i * 8192), 16, 0, 0); } while (0)
#define PG8_STAGE_A(b, h, gbase, nx) do { if constexpr (GATHER) { const unsigned pk_ = (nx) ? gN[h] : gC[h]; unsigned vo_[2]; vo_[0] = (pk_ & 0xffffu) * (unsigned)(lda * 2) + gcol[0]; vo_[1] = (pk_ >> 16) * (unsigned)(lda * 2) + gcol[1]; PG8_STAGE(PG8_SA(b, h), gbase, vo_); } \
        else PG8_STAGE(PG8_SA(b, h), (gbase) + (h) * hstepA, voffA); } while (0)
#define PG8_LDA8(dst, b, h) do { _Pragma("unroll") for (int m = 0; m < 4; ++m) { const LAS u32x4* p_ = (const LAS u32x4*)(lds + PG8_SA(b, h) + aoff + m * 2048); const u32x4 x_ = p_[0], y_ = p_[1]; \
        dst[m] = __builtin_bit_cast(v8i32, __builtin_shufflevector(x_, y_, 0, 1, 2, 3, 4, 5, 6, 7)); } } while (0)
#define PG8_LDB8(dst, b, h) do { _Pragma("unroll") for (int n = 0; n < 2; ++n) { const LAS u32x4* p_ = (const LAS u32x4*)(lds + PG8_SB(b, h) + boff + n * 2048); const u32x4 x_ = p_[0], y_ = p_[1]; \
        dst[n] = __builtin_bit_cast(v8i32, __builtin_shufflevector(x_, y_, 0, 1, 2, 3, 4, 5, 6, 7)); } } while (0)
#define PG8_MMA8(ai, bj, At, Bt) do { __builtin_amdgcn_s_setprio(1); _Pragma("unroll") for (int m = 0; m < 4; ++m) _Pragma("unroll") for (int n = 0; n < 2; ++n) \
        asm volatile("v_mfma_scale_f32_16x16x128_f8f6f4 %0, %1, %2, %0, %3, %4 op_sel_hi:[0,0,0]" : "+v"(acc[ai][bj][m][n]) : "v"(Bt[n]), "v"(At[m]), "v"(sclW), "v"(sclA));   \
        __builtin_amdgcn_s_setprio(0); } while (0)
#define PG8_LDA(dst, b, h) do { _Pragma("unroll") for (int m = 0; m < 4; ++m) _Pragma("unroll") for (int k = 0; k < 2; ++k) dst[m][k] = *(const LAS bf16x8*)(lds + PG8_SA(b, h) + aoff + m * 2048 + k * 1024); } while (0)
#define PG8_LDB(dst, b, h) do { _Pragma("unroll") for (int n = 0; n < 2; ++n) _Pragma("unroll") for (int k = 0; k < 2; ++k) dst[n][k] = *(const LAS bf16x8*)(lds + PG8_SB(b, h) + boff + n * 2048 + k * 1024); } while (0)
#define PG8_MMA(ai, bj, At, Bt) do { __builtin_amdgcn_s_setprio(1); _Pragma("unroll") for (int m = 0; m < 4; ++m) _Pragma("unroll") for (int n = 0; n < 2; ++n) _Pragma("unroll") for (int k = 0; k < 2; ++k) \
        acc[ai][bj][m][n] = __builtin_amdgcn_mfma_f32_16x16x32_bf16(Bt[n][k], At[m][k], acc[ai][bj][m][n], 0, 0, 0); __builtin_amdgcn_s_setprio(0); } while (0)
#define PG8_WAIT_V(n) asm volatile("s_waitcnt vmcnt(" #n ")" ::: "memory")
#define PG8_WAIT_L(n) asm volatile("s_waitcnt lgkmcnt(" #n ")" ::: "memory")
#define PG8_BAR __builtin_amdgcn_s_barrier()
#define PG8_SCHED __builtin_amdgcn_sched_barrier(0)
#define PG8_ZERO() do { _Pragma("unroll") for (int a = 0; a < 2; ++a) _Pragma("unroll") for (int b = 0; b < 2; ++b) _Pragma("unroll") for (int m = 0; m < 4; ++m) _Pragma("unroll") for (int n = 0; n < 2; ++n) acc[a][b][m][n] = (f32x4){0.f, 0.f, 0.f, 0.f}; } while (0)
    Unit cur, nxt; int ui = 0;
    if (!S.next(0, cur)) return;
    f32x4 acc[2][2][4][2];
    PG8_ZERO();
    bf16x8 At[4][2], B0[2][2], B1[2][2]; v8i32 At8[4], B08[2], B18[2];
    int sclW = 0x7a7a7a7a, sclA = 0x7f7f7f7f; asm volatile("" : "+v"(sclW), "+v"(sclA));
#define PG8_XLDA(b, h) do { if constexpr (FP8) PG8_LDA8(At8, b, h); else PG8_LDA(At, b, h); } while (0)
#define PG8_XLDB0(b, h) do { if constexpr (FP8) PG8_LDB8(B08, b, h); else PG8_LDB(B0, b, h); } while (0)
#define PG8_XLDB1(b, h) do { if constexpr (FP8) PG8_LDB8(B18, b, h); else PG8_LDB(B1, b, h); } while (0)
#define PG8_XMMA0(ai, bj) do { if constexpr (FP8) PG8_MMA8(ai, bj, At8, B08); else PG8_MMA(ai, bj, At, B0); } while (0)
#define PG8_XMMA1(ai, bj) do { if constexpr (FP8) PG8_MMA8(ai, bj, At8, B18); else PG8_MMA(ai, bj, At, B1); } while (0)
    const char* cA = (const char*)cur.A; const char* cB = (const char*)cur.B;
    if constexpr (GATHER) { PG8_GOFF(gC, cur); gN[0] = gC[0]; gN[1] = gC[1]; }
    PG8_STAGE(PG8_SB(0, 0), cB, voffB); PG8_STAGE(PG8_SB(0, 1), cB + hstepB, voffB); PG8_STAGE_A(0, 0, cA, false); PG8_STAGE_A(0, 1, cA, false);
    if (wr == 1) PG8_BAR;
    PG8_WAIT_V(2); PG8_BAR;
    PG8_STAGE(PG8_SB(1, 0), cB + kstep, voffB); PG8_STAGE_A(1, 0, cA + kstep, false); PG8_STAGE(PG8_SB(1, 1), cB + hstepB + kstep, voffB);
    PG8_WAIT_V(6); PG8_BAR;
    int pre_tk[8];
    for (;;) {
        const bool has_next = S.next(ui + 1, nxt);
        if constexpr (Epi::PRE) { if (!(cur.flags & 1)) E.prefetch(pre_tk, cur, wr, wc, fr, fq); }
        const char* nA = has_next ? (const char*)nxt.A : cA; const char* nB = has_next ? (const char*)nxt.B : cB;
        if constexpr (GATHER) { if (has_next) PG8_GOFF(gN, nxt); }
#pragma unroll 1
        for (int t = 0; t < nt; t += 2) {
            const bool last = (t == nt - 2);
            const char* a1 = cA + (size_t)(t + 1) * kstep;
            const char* a2 = last ? nA : cA + (size_t)(t + 2) * kstep; const char* b2 = last ? nB : cB + (size_t)(t + 2) * kstep;
            const char* a3 = a2 + kstep; const char* b3 = b2 + kstep;
            const bool nx = last && has_next;
            PG8_XLDB0(0, 0); PG8_XLDB1(0, 1); PG8_SCHED; PG8_XLDA(0, 0); PG8_STAGE_A(1, 1, a1, false);
            PG8_WAIT_V(8); PG8_WAIT_L(0); PG8_BAR; PG8_XMMA0(0, 0); PG8_XMMA1(0, 1); PG8_BAR; PG8_SCHED;
            PG8_XLDA(0, 1); PG8_STAGE(PG8_SB(0, 0), b2, voffB); PG8_STAGE(PG8_SB(0, 1), b2 + hstepB, voffB); PG8_STAGE_A(0, 0, a2, nx);
            PG8_WAIT_V(8); PG8_WAIT_L(0); PG8_BAR; PG8_XMMA0(1, 0); PG8_XMMA1(1, 1); PG8_BAR; PG8_SCHED;
            PG8_XLDB0(1, 0); PG8_XLDB1(1, 1); PG8_SCHED; PG8_XLDA(1, 0); PG8_STAGE_A(0, 1, a2, nx);
            PG8_WAIT_V(8); PG8_WAIT_L(0); PG8_BAR; PG8_XMMA0(0, 0); PG8_XMMA1(0, 1); PG8_BAR; PG8_SCHED;
            PG8_XLDA(1, 1); PG8_STAGE(PG8_SB(1, 0), b3, voffB); PG8_STAGE(PG8_SB(1, 1), b3 + hstepB, voffB); PG8_STAGE_A(1, 0, a3, nx);
            PG8_WAIT_V(8); PG8_WAIT_L(0); PG8_BAR; PG8_XMMA0(1, 0); PG8_XMMA1(1, 1); PG8_BAR; PG8_SCHED;
        }
        if constexpr (ALIGN_EPI) { if (wr == 0) PG8_BAR; }
        if constexpr (FP8) asm volatile("s_nop 15\n\ts_nop 7" ::: "memory");
        if (!(cur.flags & 2)) { if constexpr (Epi::PRE) E(acc, cur, wr, wc, fr, fq, pre_tk); else E(acc, cur, wr, wc, fr, fq); }
        if (!has_next) break;
        if (!(nxt.flags & 1)) PG8_ZERO();
        cur = nxt; cA = nA; cB = nB; ++ui;
        if constexpr (GATHER) { gC[0] = gN[0]; gC[1] = gN[1]; }
        if constexpr (ALIGN_EPI) { if (wr == 1) PG8_BAR; }
    }
    PG8_WAIT_V(0);
    if constexpr (!ALIGN_EPI) { if (wr == 0) PG8_BAR; }
    PG8_BAR;
#undef PG8_SA
#undef PG8_SB
#undef PG8_STAGE
#undef PG8_XLDA
#undef PG8_XLDB0
#undef PG8_XLDB1
#undef PG8_XMMA0
#undef PG8_XMMA1
#undef PG8_LDA8
#undef PG8_LDB8
#undef PG8_MMA8
#undef PG8_STAGE_A
#undef PG8_GOFF
#undef PG8_LDA
#undef PG8_LDB
#undef PG8_MMA
#undef PG8_WAIT_V
#undef PG8_WAIT_L
#undef PG8_BAR
#undef PG8_SCHED
#undef PG8_ZERO
}
}
#ifndef MK_NAIVE_GEMM
#define MK_NAIVE_GEMM 0
#endif
template <bool GATHER = false, bool FP8 = false, class Sched, class Epi>
__device__ __forceinline__ void run_gemm(LAS unsigned char* lds, int lda, int ldb, int K, const Sched& S, const Epi& E) {
    pg8::gemm_phase<Epi, Sched, true, GATHER, FP8>(lds, lda, ldb, K, S, E);
}

struct SchedProj { const bf16_t* A; const bf16_t* B; int rowu  , pn0  , G, c;
    __device__ __forceinline__ bool next(int i, Unit& u) const { const int L = i * G + c; if (L >= 64 * 8) return false;
        const int gid = L / 64, w = L % 64; u.pm = gid * 8 + (w % 8); u.pn = pn0 + w / 8;
        u.A = A + (size_t)u.pm * 256 * rowu; u.B = B + (size_t)(w / 8) * 256 * rowu; u.aux = 0; u.flags = 0; u.gidx = nullptr; return true; } };
struct EpiProj {
    static constexpr bool PERM = true; static constexpr bool PRE = false;
    unsigned char* ws;
    __device__ __forceinline__ void operator()(const f32x4 (&acc)[2][2][4][2], const Unit& u, int wr, int wc, int fr, int fq) const {
#pragma unroll
        for (int bj = 0; bj < 2; ++bj) {
            const int cg = u.pn * 256 + bj * 128 + wc * 32;
            const int col = cg + 8 * fq;
            bf16_t* dst; int ld, cb; int mode = 0;
            bf16_t* const Vt = (bf16_t*)(ws + WS_VT); float* const WI = (float*)(ws + WS_WI);
            if (cg < C_K) { dst = (bf16_t*)(ws + WS_Q); ld = 512; cb = C_Q; }
            else if (cg < C_V) { dst = (bf16_t*)(ws + WS_K); ld = 64; cb = C_K; }
            else if (cg < C_QI) { dst = (bf16_t*)(ws + WS_VR); ld = 64; cb = C_V; mode = 2; }
            else if (cg < C_KI) { dst = (bf16_t*)(ws + WS_QI); ld = 256; cb = C_QI; }
            else if (cg < C_LX) { dst = (bf16_t*)(ws + WS_KI); ld = 64; cb = C_KI; }
            else if (cg < C_LG) { dst = (bf16_t*)(ws + WS_LX); ld = 512; cb = C_LX; }
            else if (cg < C_WI) { dst = (bf16_t*)(ws + WS_LG); ld = 512; cb = C_LG; }
            else if (cg < C_PAD + 28) { dst = nullptr; ld = 0; cb = C_WI; mode = 3; }
            else if (cg < C_GA) continue;
            else if (cg < C_GB) { dst = (bf16_t*)(ws + WS_GA); ld = 1024; cb = C_GA; mode = 1; }
            else { dst = (bf16_t*)(ws + WS_GB); ld = 1024; cb = C_GB; mode = 1; }
#pragma unroll
            for (int ai = 0; ai < 2; ++ai)
#pragma unroll
                for (int m = 0; m < 4; ++m) {
                    const int row = u.pm * 256 + ai * 128 + wr * 64 + m * 16 + fr;
                    f32x4 v0 = acc[ai][bj][m][0], v1 = acc[ai][bj][m][1];
                    if (mode == 3) { if (fq == 0) *(f32x4*)(WI + (size_t)row * 4) = v0; continue; }
                    if (mode == 1) {
#pragma unroll
                        for (int e = 0; e < 4; ++e) { v0[e] = sigmoidf_(v0[e]); v1[e] = sigmoidf_(v1[e]); } }
                    u32x4 w; w.x = pk2(v0[0], v0[1]); w.y = pk2(v0[2], v0[3]); w.z = pk2(v1[0], v1[1]); w.w = pk2(v1[2], v1[3]);
                    if (mode != 2) *(u32x4*)(dst + (size_t)row * ld + (col - cb)) = w;
                    if (mode == 2) {
                        const int b = row / SEQ, t = row % SEQ, d0 = col - cb; bf16_t* vp = Vt + ((size_t)b * 64 + d0) * SEQ + (t & ~15) + vt_pos(t & 15);
                        vp[0 * SEQ] = (bf16_t)(w.x & 0xffff); vp[1 * SEQ] = (bf16_t)(w.x >> 16); vp[2 * SEQ] = (bf16_t)(w.y & 0xffff); vp[3 * SEQ] = (bf16_t)(w.y >> 16);
                        vp[4 * SEQ] = (bf16_t)(w.z & 0xffff); vp[5 * SEQ] = (bf16_t)(w.z >> 16); vp[6 * SEQ] = (bf16_t)(w.w & 0xffff); vp[7 * SEQ] = (bf16_t)(w.w >> 16); }
                }
        }
    }
};

__device__ __forceinline__ unsigned fbits(float f) { return __builtin_bit_cast(unsigned, f); }
__device__ __forceinline__ float bitsf(unsigned u) { return __builtin_bit_cast(float, u); }
__device__ __forceinline__ unsigned bfi_b32(unsigned m, unsigned a, unsigned b) { return __builtin_amdgcn_bitop3_b32(a, b, m, 0xe4); }
__device__ __forceinline__ float xor32_max(float x) { typedef unsigned u32x2_ __attribute__((ext_vector_type(2))); const unsigned u = __builtin_bit_cast(unsigned, x);
    const u32x2_ r = __builtin_amdgcn_permlane32_swap(u, u, false, false); return fmaxf(__builtin_bit_cast(float, r.x), __builtin_bit_cast(float, r.y)); }
__device__ __forceinline__ float sum8_dpp(float s) {
    s += __builtin_bit_cast(float, __builtin_amdgcn_update_dpp(0, __builtin_bit_cast(int, s), 0xB1, 0xf, 0xf, true));
    s += __builtin_bit_cast(float, __builtin_amdgcn_update_dpp(0, __builtin_bit_cast(int, s), 0x4E, 0xf, 0xf, true));
    s += __builtin_bit_cast(float, __builtin_amdgcn_update_dpp(0, __builtin_bit_cast(int, s), 0x141, 0xf, 0xf, true));
    return s; }
__device__ __forceinline__ unsigned sortkey(float f) { const unsigned u = __builtin_bit_cast(unsigned, f); return (u & 0x80000000u) ? ~u : (u | 0x80000000u); }
typedef float f32x16 __attribute__((ext_vector_type(16)));
constexpr int AL_QI = 0, AL_HIST = 16896, AL_MASK = 49792, AL_EQ = 57984, AL_RK = 66176, AL_QST = 74368, AL_FLAG = 74368 + 512, AL_OST = 75008, AL_KV = AL_HIST  , KT_STRIDE = 144, VT_STRIDE = 80, KT_BYTES = 32 * KT_STRIDE, KV_BUF = KT_BYTES + 64 * VT_STRIDE, AL_END = AL_OST + 8 * 4608;
static_assert(2 * KV_BUF <= 32 * 257 * 4, "K/V ring fits the histogram region");
constexpr int QI_STRIDE = 528, HIST_STRIDE = 257, OST_STRIDE = 144;
static_assert(AL_END <= RING_BYTES, "attention LDS map");
__device__ __forceinline__ int crow(int i, int hi) { return (i & 3) + 8 * (i >> 2) + 4 * hi; }
__device__ __forceinline__ void attn_unit(Frame& F, int b, int c, int half) {
    int tid_ = F.tid, w_ = F.wave; asm volatile("" : "+v"(tid_), "+s"(w_));
    const int tid = tid_, lane = tid & 63, w = w_, r32 = lane & 31, hi = lane >> 5;
    const int t0 = 64 * c + 32 * half, nk = 64 * (c + 1), ntile = nk >> 5, tok0 = b * SEQ + t0;
    LAS unsigned char* L = F.lds;
    LAS unsigned* hist = (LAS unsigned*)(L + AL_HIST); LAS unsigned* maskw = (LAS unsigned*)(L + AL_MASK); LAS unsigned* eqw = (LAS unsigned*)(L + AL_EQ);
    LAS float* rkL = (LAS float*)(L + AL_RK); LAS unsigned* qst = (LAS unsigned*)(L + AL_QST); LAS unsigned* flagw = (LAS unsigned*)(L + AL_FLAG);
    const bf16_t* KI = WSP(bf16_t, WS_KI) + (size_t)b * SEQ * 64;
    const bf16_t* Kb = WSP(bf16_t, WS_K) + (size_t)b * SEQ * 64;
    const bf16_t* Vt = WSP(bf16_t, WS_VT) + (size_t)b * 64 * SEQ;
    const bool do_sel = nk > TOPK;
    __syncthreads();
#if MK_LEAK >= 0
    const unsigned long long tu0_ = __builtin_amdgcn_s_memrealtime();
#endif
    { const bf16_t* QI = WSP(bf16_t, WS_QI) + (size_t)tok0 * 256;
#pragma unroll
      for (int i = 0; i < 2; ++i) { const int idx = tid + 512 * i, row = idx >> 5, ch = idx & 31;
          *(LAS u32x4*)(L + AL_QI + row * QI_STRIDE + ch * 16) = *(const u32x4*)(QI + (size_t)row * 256 + ch * 8); } }
    if (tid == 0) flagw[0] = 0u;
    if (tid < 32) { qst[tid * 4 + 0] = 0u; qst[tid * 4 + 1] = (unsigned)TOPK; qst[tid * 4 + 2] = 0u; qst[tid * 4 + 3] = 0u; }
    __syncthreads();
    f32x16 sc[8];
    if (do_sel) {
        const f32x4 wv = *(const f32x4*)(WSP(float, WS_WI) + (size_t)(tok0 + r32) * 4) * 0.0625f;
        bf16x8 afn[4];
        { int roff = (32 * w + r32) * 64 + 8 * hi; asm volatile("" : "+v"(roff));
#pragma unroll
          for (int ks = 0; ks < 4; ++ks) afn[ks] = *(const bf16x8*)(KI + roff + 16 * ks); }
#pragma unroll
        for (int j = 0; j < 8; ++j) {
            const int kt = w + 8 * j;
#pragma unroll
            for (int i = 0; i < 16; ++i) sc[j][i] = 0.f;
            if (kt < ntile) {
                bf16x8 af[4];
#pragma unroll
                for (int ks = 0; ks < 4; ++ks) af[ks] = afn[ks];
                if (j < 7 && kt + 8 < ntile) { int roff = (32 * (kt + 8) + r32) * 64 + 8 * hi; asm volatile("" : "+v"(roff));
#pragma unroll
                    for (int ks = 0; ks < 4; ++ks) afn[ks] = *(const bf16x8*)(KI + roff + 16 * ks); }
                int qoff = r32 * QI_STRIDE + hi * 16; asm volatile("" : "+v"(qoff));
                bf16x8 qA[4], qB[4];
#define ATT_QLD(Q, H) do { _Pragma("unroll") for (int ks = 0; ks < 4; ++ks) Q[ks] = *(const LAS bf16x8*)(L + AL_QI + qoff + (H) * 128 + ks * 32); } while (0)
#define ATT_HEAD(Q, H) do { f32x16 acc; \
                    _Pragma("unroll") for (int i = 0; i < 16; ++i) acc[i] = 0.f; \
                    _Pragma("unroll") for (int ks = 0; ks < 4; ++ks) acc = __builtin_amdgcn_mfma_f32_32x32x16_bf16(af[ks], Q[ks], acc, 0, 0, 0); \
                    asm volatile("s_nop 15\n\ts_nop 7" : "+v"(acc));                \
                    _Pragma("unroll") for (int i = 0; i < 16; ++i) sc[j][i] += relu_f(acc[i]) * wv[H]; \
                    __builtin_amdgcn_sched_barrier(0); } while (0)
                ATT_QLD(qA, 0); ATT_QLD(qB, 1); __builtin_amdgcn_sched_barrier(0);
                ATT_HEAD(qA, 0); ATT_QLD(qA, 2); __builtin_amdgcn_sched_barrier(0);
                ATT_HEAD(qB, 1); ATT_QLD(qB, 3); __builtin_amdgcn_sched_barrier(0);
                ATT_HEAD(qA, 2);
                ATT_HEAD(qB, 3);
#undef ATT_HEAD
#undef ATT_QLD
#pragma unroll
                for (int i = 0; i < 16; ++i) sc[j][i] = __builtin_bit_cast(float, sortkey(sc[j][i]));
            }
        }
    }
    unsigned Tq = 0u; bool ordered = false;
    if (do_sel) {
        unsigned prefix = 0u;
        for (int i = tid; i < 32 * HIST_STRIDE; i += NTHREADS) hist[i] = 0u;
        __syncthreads();
#pragma unroll 1
        for (int pass = 0; pass < 2; ++pass) {
            const int shift = 24 - 8 * pass;
#pragma unroll
            for (int j = 0; j < 8; ++j) { const int kt = w + 8 * j;
                if (kt < ntile) {
#pragma unroll
                    for (int i = 0; i < 16; ++i) { const unsigned key = fbits(sc[j][i]);
                        const bool m = (pass == 0) || ((key >> (shift + 8)) == (prefix >> (shift + 8)));
                        if (m) __hip_atomic_fetch_add(hist + r32 * HIST_STRIDE + ((key >> shift) & 255u), 1u, __ATOMIC_RELAXED, __HIP_MEMORY_SCOPE_WORKGROUP); } } }
            __syncthreads();
            {
                const int q = tid >> 4, p = tid & 15, b0 = 16 * (15 - p);
                const unsigned need = qst[q * 4 + 1];
                unsigned s = 0u, hv[16];
#pragma unroll
                for (int e = 0; e < 16; ++e) { hv[e] = hist[q * HIST_STRIDE + b0 + e]; s += hv[e]; hist[q * HIST_STRIDE + b0 + e] = 0u; }
                unsigned P = s;
#pragma unroll
                for (int o = 1; o < 16; o <<= 1) { const unsigned t = __shfl_up(P, o, 16); if (p >= o) P += t; }
                const unsigned Pprev = P - s;
                if (P >= need && Pprev < need) { unsigned run = Pprev; bool done = false;
#pragma unroll
                    for (int e = 15; e >= 0; --e) { const unsigned hc = hv[e]; if (done) continue;
                        if (run + hc >= need) { done = true; qst[q * 4 + 0] = qst[q * 4 + 0] | ((unsigned)(b0 + e) << shift); qst[q * 4 + 1] = need - run; qst[q * 4 + 2] = hc; }
                        else run += hc; } }
            }
            __syncthreads();
            prefix = qst[r32 * 4 + 0];
        }
        Tq = prefix;
        const unsigned needq = qst[r32 * 4 + 1], eqc = qst[r32 * 4 + 2];
        if (needq < eqc) flagw[0] = 1u;
        __syncthreads();
        ordered = flagw[0] != 0u;
    }
#pragma unroll
    for (int j = 0; j < 8; ++j) { const int kt = w + 8 * j;
        if (kt < ntile) { unsigned mw = 0xffffffffu, ew = 0u;
            if (do_sel) { mw = 0u;
#pragma unroll
                for (int i = 0; i < 16; ++i) { const unsigned key = fbits(sc[j][i]) >> 16; const int bit = crow(i, hi);
                    const bool gt = key > (Tq >> 16), eq = key == (Tq >> 16);
                    mw |= ((gt || (eq && !ordered)) ? 1u : 0u) << bit; ew |= (eq ? 1u : 0u) << bit; }
                mw |= __shfl_xor(mw, 32); ew |= __shfl_xor(ew, 32); }
            if (hi == 0) { maskw[kt * 32 + r32] = mw; if (ordered) eqw[kt * 32 + r32] = ew; } } }
    __syncthreads();
    if (ordered) {
        const int q = tid >> 4, p = tid & 15; const int need = (int)qst[q * 4 + 1];
        unsigned ww[4]; int c = 0;
#pragma unroll
        for (int k = 0; k < 4; ++k) { const int kt = 4 * p + k; ww[k] = (kt < ntile) ? eqw[kt * 32 + q] : 0u; c += __popc(ww[k]); }
        int P = c;
#pragma unroll
        for (int o = 1; o < 16; o <<= 1) { const int t = __shfl_up(P, o, 16); if (p >= o) P += t; }
        int quota = need - (P - c); quota = quota < 0 ? 0 : (quota > c ? c : quota);
#pragma unroll
        for (int k = 0; k < 4; ++k) { unsigned w2 = ww[k]; if (quota > 0 && w2 != 0u) { const int pc = __popc(w2); unsigned add = w2;
                if (pc > quota) { add = 0u; while (__popc(add) < quota) { const unsigned lsb = w2 & (0u - w2); add |= lsb; w2 ^= lsb; } }
                quota -= __popc(add); maskw[(4 * p + k) * 32 + q] |= add; } }
        __syncthreads();
    }
#if MK_LEAK >= 0
    const unsigned long long tu1_ = __builtin_amdgcn_s_memrealtime();
#endif
    {
        const int h = w; const int tq = t0 + r32;
        bf16x8 qf[4];
        { const bf16_t* Q = WSP(bf16_t, WS_Q) + (size_t)(tok0 + r32) * 512 + h * 64;
          float qv[4][8]; float ss = 0.f;
#pragma unroll
          for (int ks = 0; ks < 4; ++ks) { const bf16x8 v = *(const bf16x8*)(Q + 16 * ks + 8 * hi);
#pragma unroll
              for (int e = 0; e < 8; ++e) { qv[ks][e] = bf2f((unsigned short)v[e]); ss += qv[ks][e] * qv[ks][e]; } }
          ss += __shfl_xor(ss, 32);
          const float rq = rsqrtf(ss * (1.f / 64.f) + EPS) * 0.125f * 1.4426950408889634f;
          const float* qnw = (const float*)F.ap->in[6]; const float* knw = (const float*)F.ap->in[7];
#pragma unroll
          for (int ks = 0; ks < 4; ++ks) { u32x4 pk;
              const f32x4 a0 = *(const f32x4*)(qnw + 16 * ks + 8 * hi), a1 = *(const f32x4*)(qnw + 16 * ks + 8 * hi + 4), b0 = *(const f32x4*)(knw + 16 * ks + 8 * hi), b1 = *(const f32x4*)(knw + 16 * ks + 8 * hi + 4);
              pk.x = pk2(qv[ks][0] * rq * a0.x * b0.x, qv[ks][1] * rq * a0.y * b0.y); pk.y = pk2(qv[ks][2] * rq * a0.z * b0.z, qv[ks][3] * rq * a0.w * b0.w);
              pk.z = pk2(qv[ks][4] * rq * a1.x * b1.x, qv[ks][5] * rq * a1.y * b1.y); pk.w = pk2(qv[ks][6] * rq * a1.z * b1.z, qv[ks][7] * rq * a1.w * b1.w);
              qf[ks] = __builtin_bit_cast(bf16x8, pk); } }
        const float slope2 = exp2f(-(float)(h + 1)) * 1.4426950408889634f;
        float m = 0.f;
        f32x16 o0, o1, lacc;
#pragma unroll
        for (int i = 0; i < 16; ++i) { o0[i] = 0.f; o1[i] = 0.f; lacc[i] = 0.f; }
        const bf16x8 ones8 = {0x3f80, 0x3f80, 0x3f80, 0x3f80, 0x3f80, 0x3f80, 0x3f80, 0x3f80};
        constexpr int K2_STRIDE = 144, K2_BYTES = 64 * K2_STRIDE, KV2_BUF = 2 * K2_BYTES;
        static_assert(2 * KV2_BUF <= AL_MASK, "K/V ring below the mask words");
        const int npair = c + 1;
        const bf16_t* gK = Kb + (size_t)(tid >> 3) * 64 + (tid & 7) * 8;
        const bf16_t* gV = Vt + (size_t)(tid >> 3) * SEQ + (tid & 7) * 8;
        const int lstK = (tid >> 3) * K2_STRIDE + (tid & 7) * 16;
        LAS unsigned char* kvL = L;
#define ATT_STAGE2(BUF, GK, GV) do { u32x4 w_; \
            { float f_[8] = {bflo(GK.x), bfhi(GK.x), bflo(GK.y), bfhi(GK.y), bflo(GK.z), bfhi(GK.z), bflo(GK.w), bfhi(GK.w)}; \
                float ss_ = (f_[0] * f_[0] + f_[1] * f_[1]) + (f_[2] * f_[2] + f_[3] * f_[3]) + (f_[4] * f_[4] + f_[5] * f_[5]) + (f_[6] * f_[6] + f_[7] * f_[7]); \
                ss_ = sum8_dpp(ss_); \
                const float rk_ = __builtin_amdgcn_rsqf(ss_ * (1.f / 64.f) + EPS); \
                w_.x = cvt_pk_bf16(f_[0] * rk_, f_[1] * rk_); w_.y = cvt_pk_bf16(f_[2] * rk_, f_[3] * rk_); w_.z = cvt_pk_bf16(f_[4] * rk_, f_[5] * rk_); w_.w = cvt_pk_bf16(f_[6] * rk_, f_[7] * rk_); } \
            *(LAS u32x4*)(kvL + (BUF) * KV2_BUF + lstK) = w_; *(LAS u32x4*)(kvL + (BUF) * KV2_BUF + K2_BYTES + lstK) = GV; } while (0)
#define ATT_LOADK(KP) (*(const u32x4*)(gK + (size_t)((KP) < npair ? (KP) : npair - 1) * 4096))
#define ATT_LOADV(KP) (*(const u32x4*)(gV + (size_t)((KP) < npair ? (KP) : npair - 1) * 64))
        u32x4 cK = ATT_LOADK(0), cV = ATT_LOADV(0);
        u32x4 nK = ATT_LOADK(1), nV = ATT_LOADV(1);
        ATT_STAGE2(0, cK, cV);
        float ci[16];
#pragma unroll
        for (int i = 0; i < 16; ++i) ci[i] = slope2 * (float)crow(i, hi);
        const float sq = slope2 * (float)tq;
        __syncthreads();
#define ATT_MAX16(S) do { mx = max3f(mx, S[0], S[1]); mx = max3f(mx, S[2], S[3]); mx = max3f(mx, S[4], S[5]); mx = max3f(mx, S[6], S[7]); mx = max3f(mx, S[8], S[9]); mx = max3f(mx, S[10], S[11]); \
            mx = max3f(mx, S[12], S[13]); mx = max3f(mx, S[14], S[15]); } while (0)
#define ATT_PK(P0, P1, S) do { P0.x = cvt_pk_bf16(S[0], S[1]); P0.y = cvt_pk_bf16(S[2], S[3]); P0.z = cvt_pk_bf16(S[4], S[5]); P0.w = cvt_pk_bf16(S[6], S[7]); \
            P1.x = cvt_pk_bf16(S[8], S[9]); P1.y = cvt_pk_bf16(S[10], S[11]); P1.z = cvt_pk_bf16(S[12], S[13]); P1.w = cvt_pk_bf16(S[14], S[15]); } while (0)
#define ATT_TILE2(KP) do { const int kp_ = (KP); \
            const LAS unsigned char* kb = kvL + (kp_ & 1) * KV2_BUF; \
            const unsigned mw0 = maskw[(2 * kp_) * 32 + r32] >> (4 * hi), mw1 = maskw[(2 * kp_ + 1) * 32 + r32] >> (4 * hi); \
            bf16x8 kf0[4], kf1[4];                                                 \
            _Pragma("unroll") for (int ks = 0; ks < 4; ++ks) { kf0[ks] = *(const LAS bf16x8*)(kb + r32 * K2_STRIDE + ks * 32 + hi * 16); kf1[ks] = *(const LAS bf16x8*)(kb + (32 + r32) * K2_STRIDE + ks * 32 + hi * 16); } \
            __builtin_amdgcn_sched_barrier(0); \
            f32x16 S0, S1; \
            if (kp_ < npair - 1) { const float nmt0 = slope2 * (float)(64 * kp_) - m, nmt1 = nmt0 + slope2 * 32.f;        \
                _Pragma("unroll") for (int i = 0; i < 16; ++i) { const int ko = (i & 3) + 8 * (i >> 2); \
                    const unsigned sel0 = (unsigned)__builtin_amdgcn_sbfe((int)mw0, ko, 1), sel1 = (unsigned)__builtin_amdgcn_sbfe((int)mw1, ko, 1); \
                    S0[i] = bitsf(bfi_b32(sel0, fbits(ci[i] + nmt0), 0xff800000u)); S1[i] = bitsf(bfi_b32(sel1, fbits(ci[i] + nmt1), 0xff800000u)); } } \
            else { const float dbase0 = (float)(tq - 64 * kp_ - 4 * hi), dbase1 = dbase0 - 32.f, sqm = sq - m; \
                _Pragma("unroll") for (int i = 0; i < 16; ++i) { const int ko = (i & 3) + 8 * (i >> 2); \
                    const unsigned sel0 = (unsigned)__builtin_amdgcn_sbfe((int)mw0, ko, 1), sel1 = (unsigned)__builtin_amdgcn_sbfe((int)mw1, ko, 1); \
                    S0[i] = bitsf(bfi_b32(sel0, fbits(sqm - slope2 * fabsf(dbase0 - (float)ko)), 0xff800000u)); S1[i] = bitsf(bfi_b32(sel1, fbits(sqm - slope2 * fabsf(dbase1 - (float)ko)), 0xff800000u)); } } \
            _Pragma("unroll") for (int ks = 0; ks < 4; ++ks) { \
                S0 = __builtin_amdgcn_mfma_f32_32x32x16_bf16(kf0[ks], qf[ks], S0, 0, 0, 0); S1 = __builtin_amdgcn_mfma_f32_32x32x16_bf16(kf1[ks], qf[ks], S1, 0, 0, 0); } \
            asm volatile("s_nop 15\n\ts_nop 7" : "+v"(S0), "+v"(S1));             \
            bf16x8 vf[2][4]; \
            _Pragma("unroll") for (int db = 0; db < 2; ++db) _Pragma("unroll") for (int j4 = 0; j4 < 4; ++j4) vf[db][j4] = *(const LAS bf16x8*)(kb + K2_BYTES + (32 * db + r32) * K2_STRIDE + j4 * 32 + hi * 16); \
            float mx = max3f(S0[0], S0[0], S1[0]); \
            ATT_MAX16(S0); ATT_MAX16(S1); \
            mx = fmaxf(mx, __shfl_xor(mx, 32)); \
            if (__any(mx > 8.f)) {                                             \
                const float dl = fmaxf(mx, 0.f), alpha = __builtin_amdgcn_exp2f(-dl); m += dl; \
                _Pragma("unroll") for (int i = 0; i < 16; ++i) { S0[i] -= dl; S1[i] -= dl; o0[i] *= alpha; o1[i] *= alpha; lacc[i] *= alpha; } } \
            _Pragma("unroll") for (int i = 0; i < 16; ++i) { S0[i] = __builtin_amdgcn_exp2f(S0[i]); S1[i] = __builtin_amdgcn_exp2f(S1[i]); } \
            u32x4 p00, p01, p10, p11; ATT_PK(p00, p01, S0); ATT_PK(p10, p11, S1); \
            const bf16x8 pf00 = __builtin_bit_cast(bf16x8, p00), pf01 = __builtin_bit_cast(bf16x8, p01), pf10 = __builtin_bit_cast(bf16x8, p10), pf11 = __builtin_bit_cast(bf16x8, p11); \
            o0 = __builtin_amdgcn_mfma_f32_32x32x16_bf16(vf[0][0], pf00, o0, 0, 0, 0); o1 = __builtin_amdgcn_mfma_f32_32x32x16_bf16(vf[1][0], pf00, o1, 0, 0, 0); lacc = __builtin_amdgcn_mfma_f32_32x32x16_bf16(ones8, pf00, lacc, 0, 0, 0); \
            o0 = __builtin_amdgcn_mfma_f32_32x32x16_bf16(vf[0][1], pf01, o0, 0, 0, 0); o1 = __builtin_amdgcn_mfma_f32_32x32x16_bf16(vf[1][1], pf01, o1, 0, 0, 0); lacc = __builtin_amdgcn_mfma_f32_32x32x16_bf16(ones8, pf01, lacc, 0, 0, 0); \
            o0 = __builtin_amdgcn_mfma_f32_32x32x16_bf16(vf[0][2], pf10, o0, 0, 0, 0); o1 = __builtin_amdgcn_mfma_f32_32x32x16_bf16(vf[1][2], pf10, o1, 0, 0, 0); lacc = __builtin_amdgcn_mfma_f32_32x32x16_bf16(ones8, pf10, lacc, 0, 0, 0); \
            o0 = __builtin_amdgcn_mfma_f32_32x32x16_bf16(vf[0][3], pf11, o0, 0, 0, 0); o1 = __builtin_amdgcn_mfma_f32_32x32x16_bf16(vf[1][3], pf11, o1, 0, 0, 0); lacc = __builtin_amdgcn_mfma_f32_32x32x16_bf16(ones8, pf11, lacc, 0, 0, 0); \
            } while (0)
#pragma unroll 1
        for (int kp = 0; kp < npair; ++kp) {
            const u32x4 fK = ATT_LOADK(kp + 2), fV = ATT_LOADV(kp + 2);
            ATT_TILE2(kp);
            if (kp + 1 < npair) ATT_STAGE2((kp + 1) & 1, nK, nV);
            LDS_BARRIER();
            nK = fK; nV = fV;
        }
#undef ATT_TILE2
#undef ATT_PK
#undef ATT_MAX16
#undef ATT_LOADK
#undef ATT_LOADV
#undef ATT_STAGE2
        const float inv = __builtin_amdgcn_rcpf(lacc[0]);
        LAS unsigned char* stg = L + AL_OST + w * 4608;
#pragma unroll
        for (int g = 0; g < 4; ++g) {
            *(LAS u32x2*)(stg + r32 * OST_STRIDE + (8 * g + 4 * hi) * 2) = (u32x2){pk2(o0[4 * g] * inv, o0[4 * g + 1] * inv), pk2(o0[4 * g + 2] * inv, o0[4 * g + 3] * inv)};
            *(LAS u32x2*)(stg + r32 * OST_STRIDE + (32 + 8 * g + 4 * hi) * 2) = (u32x2){pk2(o1[4 * g] * inv, o1[4 * g + 1] * inv), pk2(o1[4 * g + 2] * inv, o1[4 * g + 3] * inv)}; }
        asm volatile("s_waitcnt lgkmcnt(0)" ::: "memory");
        bf16_t* AO = WSP(bf16_t, WS_AO) + (size_t)tok0 * 512 + h * 64;
#pragma unroll
        for (int it = 0; it < 4; ++it) { const int row = it * 8 + (lane >> 3), ch = lane & 7;
            *(u32x4*)(AO + (size_t)row * 512 + ch * 8) = *(const LAS u32x4*)(stg + row * OST_STRIDE + ch * 16); }
    }
#if MK_LEAK >= 0
    __syncthreads();
    if (tid == 0) { volatile LAS unsigned* MS = (volatile LAS unsigned*)(F.lds + MISC_OFF); const unsigned long long tu2_ = __builtin_amdgcn_s_memrealtime(); MS[16] += (unsigned)(tu1_ - tu0_); MS[17] += (unsigned)(tu2_ - tu1_); }
#endif
}
__device__ __forceinline__ void attn_phase(Frame& F, int clo, int chi) {
#pragma unroll 1
    for (int p2 = 2 * F.bid; p2 < 512; p2 += ((p2 & 1) ? 2 * F.G - 1 : 1)) { const int p = p2 >> 1, b = p >> 5, jj = p & 31, c1 = jj >> 1, half = jj & 1;
        const int cc = (p2 & 1) ? c1 : 31 - c1; if (cc >= clo && cc < chi) attn_unit(F, b, cc, half); }
}

constexpr int LR_CW = 0, LR_SEG = 2048, LR_AB = 4096;
static_assert(LR_AB + 8 * 16 * 64 * 16 <= MISC_OFF, "LRU LDS map");
__device__ __forceinline__ void lru_item_mfma(Frame& F, int item) {
    int tid_ = F.tid, w_ = F.wave; asm volatile("" : "+v"(tid_), "+s"(w_));
    const int tid = tid_, lane = tid & 63, w = w_, c16 = lane & 15, kg = lane >> 4;
    const int b = item >> 5, n = (item >> 2) & 7, q = item & 3;
    LAS float* cwL = (LAS float*)(F.lds + LR_CW);
    LAS float* segL = (LAS float*)(F.lds + LR_SEG);
    LAS u32x4* abL = (LAS u32x4*)(F.lds + LR_AB) + (size_t)w * 16 * 64 + lane;
    const float* conv_w = (const float*)F.ap->in[8]; const float* conv_b = (const float*)F.ap->in[9];
    const float* w_rec = (const float*)F.ap->in[10] + (size_t)n * 4096; const float* w_ing = (const float*)F.ap->in[12] + (size_t)n * 4096;
    __syncthreads();
    if (tid < 256) cwL[tid] = conv_w[(tid >> 6) * 512 + 64 * n + (tid & 63)]; else if (tid < 320) cwL[tid] = conv_b[64 * n + (tid - 256)];
    bf16x8 Bw[3][2];
#pragma unroll
    for (int ks = 0; ks < 2; ++ks) { u32x4 pr, pi, pd;
        float vr[8], vi[8], vd[8];
#pragma unroll
        for (int j = 0; j < 8; ++j) { const int d = 32 * ks + 8 * kg + j; vr[j] = w_rec[d * 64 + 16 * q + c16]; vi[j] = w_ing[d * 64 + 16 * q + c16]; vd[j] = (d == 16 * q + c16) ? 1.f : 0.f; }
        pr.x = pk2(vr[0], vr[1]); pr.y = pk2(vr[2], vr[3]); pr.z = pk2(vr[4], vr[5]); pr.w = pk2(vr[6], vr[7]);
        pi.x = pk2(vi[0], vi[1]); pi.y = pk2(vi[2], vi[3]); pi.z = pk2(vi[4], vi[5]); pi.w = pk2(vi[6], vi[7]);
        pd.x = pk2(vd[0], vd[1]); pd.y = pk2(vd[2], vd[3]); pd.z = pk2(vd[4], vd[5]); pd.w = pk2(vd[6], vd[7]);
        Bw[0][ks] = __builtin_bit_cast(bf16x8, pr); Bw[1][ks] = __builtin_bit_cast(bf16x8, pi); Bw[2][ks] = __builtin_bit_cast(bf16x8, pd); }
    const int chg = 64 * n + 16 * q + c16;
    const float spl8 = -8.f * log1pf(__expf(-((const float*)F.ap->in[14])[chg])), brc = ((const float*)F.ap->in[11])[chg], bin = ((const float*)F.ap->in[13])[chg];
    const bf16_t* LX = WSP(bf16_t, WS_LX) + (size_t)b * SEQ * 512 + 64 * n + 8 * kg;
    const bf16_t* LG = WSP(bf16_t, WS_LG) + (size_t)b * SEQ * 512 + 64 * n + 16 * q + c16;
    bf16_t* LO = WSP(bf16_t, WS_LO) + (size_t)b * SEQ * 512 + 64 * n + 16 * q + c16;
    __syncthreads();
    u32x4 raw[2][4], rawN[2][4];
#define LRU_LOAD(R, RB) do { const int tb_ = 256 * w + 16 * (RB) + c16 - 3; \
        _Pragma("unroll") for (int ks = 0; ks < 2; ++ks) _Pragma("unroll") for (int tap = 0; tap < 4; ++tap) { const int ts_ = tb_ + tap; \
            R[ks][tap] = *(const u32x4*)(LX + (size_t)(ts_ < 0 ? 0 : ts_) * 512 + 32 * ks); } } while (0)
    LRU_LOAD(raw, 0);
    float Arun = 1.f, Brun = 0.f;
#pragma unroll 1
    for (int rb = 0; rb < 16; ++rb) {
        if (rb < 15) LRU_LOAD(rawN, rb + 1);
        const int tb = 256 * w + 16 * rb + c16 - 3;
        if (w == 0 && rb == 0) {
#pragma unroll
            for (int ks = 0; ks < 2; ++ks)
#pragma unroll
                for (int tap = 0; tap < 4; ++tap) if (tb + tap < 0) raw[ks][tap] = (u32x4){0u, 0u, 0u, 0u}; }
        bf16x8 afr[2];
#pragma unroll
        for (int ks = 0; ks < 2; ++ks) { const int d0 = 32 * ks + 8 * kg; float xc[8];
            { const f32x4 c0 = *(const LAS f32x4*)(cwL + 256 + d0), c1 = *(const LAS f32x4*)(cwL + 256 + d0 + 4);
              xc[0] = c0.x; xc[1] = c0.y; xc[2] = c0.z; xc[3] = c0.w; xc[4] = c1.x; xc[5] = c1.y; xc[6] = c1.z; xc[7] = c1.w; }
#pragma unroll
            for (int tap = 0; tap < 4; ++tap) { const u32x4 v = raw[ks][tap];
                const f32x4 c0 = *(const LAS f32x4*)(cwL + tap * 64 + d0), c1 = *(const LAS f32x4*)(cwL + tap * 64 + d0 + 4);
                xc[0] += bflo(v.x) * c0.x; xc[1] += bfhi(v.x) * c0.y; xc[2] += bflo(v.y) * c0.z; xc[3] += bfhi(v.y) * c0.w;
                xc[4] += bflo(v.z) * c1.x; xc[5] += bfhi(v.z) * c1.y; xc[6] += bflo(v.w) * c1.z; xc[7] += bfhi(v.w) * c1.w; }
            u32x4 pa; pa.x = cvt_pk_bf16(xc[0], xc[1]); pa.y = cvt_pk_bf16(xc[2], xc[3]); pa.z = cvt_pk_bf16(xc[4], xc[5]); pa.w = cvt_pk_bf16(xc[6], xc[7]);
            afr[ks] = __builtin_bit_cast(bf16x8, pa); }
        f32x4 rp = (f32x4){0.f, 0.f, 0.f, 0.f}, ip = rp, xv = rp;
#pragma unroll
        for (int ks = 0; ks < 2; ++ks) { rp = __builtin_amdgcn_mfma_f32_16x16x32_bf16(afr[ks], Bw[0][ks], rp, 0, 0, 0); ip = __builtin_amdgcn_mfma_f32_16x16x32_bf16(afr[ks], Bw[1][ks], ip, 0, 0, 0);
            xv = __builtin_amdgcn_mfma_f32_16x16x32_bf16(afr[ks], Bw[2][ks], xv, 0, 0, 0); }
        float av[4], bv[4]; u32x4 pk;
#pragma unroll
        for (int r = 0; r < 4; ++r) { const float rg = __builtin_amdgcn_rcpf(1.f + __expf(-(rp[r] + brc))), ig = __builtin_amdgcn_rcpf(1.f + __expf(-(ip[r] + bin)));
            const float la = spl8 * rg;
            const float em1 = -la * (1.f + la * (0.5f + la * (0.16666667f + la * (0.041666668f + la * 0.0083333338f))));
            const float em2 = em1 * (2.f - em1);
            const unsigned w2 = cvt_pk_bf16(em1, __builtin_amdgcn_sqrtf(em2) * (ig * xv[r]));
            pk[r] = w2; av[r] = 1.f - bflo(w2); bv[r] = bfhi(w2); }
        abL[rb * 64] = pk;
        float Ag = av[0], Bg = bv[0];
#pragma unroll
        for (int r = 1; r < 4; ++r) { Bg = av[r] * Bg + bv[r]; Ag = Ag * av[r]; }
        const float A0 = __shfl(Ag, c16), B0 = __shfl(Bg, c16), A1 = __shfl(Ag, c16 + 16), B1 = __shfl(Bg, c16 + 16), A2 = __shfl(Ag, c16 + 32), B2 = __shfl(Bg, c16 + 32), A3 = __shfl(Ag, c16 + 48), B3 = __shfl(Bg, c16 + 48);
        const float P2a = A0 * A1, P2b = A1 * B0 + B1, P3a = P2a * A2, P3b = A2 * P2b + B2, Ta = P3a * A3, Tb = A3 * P3b + B3;
        Brun = Ta * Brun + Tb; Arun = Arun * Ta;
#pragma unroll
        for (int ks = 0; ks < 2; ++ks)
#pragma unroll
            for (int tap = 0; tap < 4; ++tap) raw[ks][tap] = rawN[ks][tap];
    }
#undef LRU_LOAD
    if (kg == 0) { segL[(w * 16 + c16) * 2] = Arun; segL[(w * 16 + c16) * 2 + 1] = Brun; }
    __syncthreads();
    float hc = 0.f;
    for (int ww = 0; ww < w; ++ww) hc = segL[(ww * 16 + c16) * 2] * hc + segL[(ww * 16 + c16) * 2 + 1];
#pragma unroll 2
    for (int rb = 0; rb < 16; ++rb) {
        const int t0 = 256 * w + 16 * rb;
        const u32x4 pk = abL[rb * 64];
        float gv[4];
#pragma unroll
        for (int r = 0; r < 4; ++r) gv[r] = bf2f(LG[(size_t)(t0 + 4 * kg + r) * 512]);
        float av[4], bv[4];
#pragma unroll
        for (int r = 0; r < 4; ++r) { av[r] = 1.f - bflo(pk[r]); bv[r] = bfhi(pk[r]); }
        float Ag = av[0], Bg = bv[0];
#pragma unroll
        for (int r = 1; r < 4; ++r) { Bg = av[r] * Bg + bv[r]; Ag = Ag * av[r]; }
        const float A0 = __shfl(Ag, c16), B0 = __shfl(Bg, c16), A1 = __shfl(Ag, c16 + 16), B1 = __shfl(Bg, c16 + 16), A2 = __shfl(Ag, c16 + 32), B2 = __shfl(Bg, c16 + 32), A3 = __shfl(Ag, c16 + 48), B3 = __shfl(Bg, c16 + 48);
        const float P2a = A0 * A1, P2b = A1 * B0 + B1, P3a = P2a * A2, P3b = A2 * P2b + B2, Ta = P3a * A3, Tb = A3 * P3b + B3;
        const float Pa = kg == 0 ? 1.f : kg == 1 ? A0 : kg == 2 ? P2a : P3a, Pb = kg == 0 ? 0.f : kg == 1 ? B0 : kg == 2 ? P2b : P3b;
        float h = Pa * hc + Pb;
#pragma unroll
        for (int r = 0; r < 4; ++r) { h = av[r] * h + bv[r]; const float g = gv[r]; const float u = 0.7978845608028654f * (g + 0.044715f * g * g * g);
            const float ge = g * __builtin_amdgcn_rcpf(1.f + __expf(-2.f * u));
            LO[(size_t)(t0 + 4 * kg + r) * 512] = (bf16_t)f2bf(h * ge); }
        hc = Ta * hc + Tb;
    }
}
__device__ __forceinline__ void lru_phase(Frame& F) {
#pragma unroll 1
    for (int it = F.bid; it < 256; it += F.G) lru_item_mfma(F, it);
}
struct SchedMerge { const bf16_t *AO, *LO, *WPA, *WPB; int G, c;
    __device__ __forceinline__ bool next(int i, Unit& u) const { const int L = (i >> 1) * G + c; if (L >= 64 * 4) return false; const int sub = i & 1;
        u.pm = L % 64; u.pn = L / 64; u.aux = sub; u.flags = 0; u.gidx = nullptr;
        u.A = (sub ? LO : AO) + (size_t)u.pm * 256 * 512; u.B = (sub ? WPB : WPA) + (size_t)u.pn * 256 * 512; return true; } };
struct EpiMerge {   static constexpr bool PERM = true; static constexpr bool PRE = false;
    bf16_t* MG; const bf16_t *GA, *GB;
    __device__ __forceinline__ void operator()(const f32x4 (&acc)[2][2][4][2], const Unit& u, int wr, int wc, int fr, int fq) const {
        const bf16_t* G = u.aux ? GB : GA;
        const size_t base = (size_t)(u.pm * 256 + wr * 64 + fr) * 1024 + u.pn * 256 + wc * 32 + 8 * fq;
#pragma unroll
        for (int ai = 0; ai < 2; ++ai) {
            u32x4 g[4][2], p[4][2];
#pragma unroll
            for (int m = 0; m < 4; ++m)
#pragma unroll
                for (int bj = 0; bj < 2; ++bj) g[m][bj] = *(const u32x4*)(G + base + (size_t)(ai * 128 + m * 16) * 1024 + bj * 128);
            if (u.aux) {
#pragma unroll
                for (int m = 0; m < 4; ++m)
#pragma unroll
                    for (int bj = 0; bj < 2; ++bj) p[m][bj] = *(const u32x4*)(MG + base + (size_t)(ai * 128 + m * 16) * 1024 + bj * 128);
            } else {
#pragma unroll
                for (int m = 0; m < 4; ++m)
#pragma unroll
                    for (int bj = 0; bj < 2; ++bj) p[m][bj] = (u32x4){0u, 0u, 0u, 0u};
            }
#pragma unroll
            for (int m = 0; m < 4; ++m)
#pragma unroll
                for (int bj = 0; bj < 2; ++bj) {
                    const u32x4 gg = g[m][bj], pp = p[m][bj];
                    f32x4 v0 = acc[ai][bj][m][0], v1 = acc[ai][bj][m][1];
                    v0[0] = v0[0] * bflo(gg.x) + bflo(pp.x); v0[1] = v0[1] * bfhi(gg.x) + bfhi(pp.x); v0[2] = v0[2] * bflo(gg.y) + bflo(pp.y); v0[3] = v0[3] * bfhi(gg.y) + bfhi(pp.y);
                    v1[0] = v1[0] * bflo(gg.z) + bflo(pp.z); v1[1] = v1[1] * bfhi(gg.z) + bfhi(pp.z); v1[2] = v1[2] * bflo(gg.w) + bflo(pp.w); v1[3] = v1[3] * bfhi(gg.w) + bfhi(pp.w);
                    u32x4 w; w.x = pk2(v0[0], v0[1]); w.y = pk2(v0[2], v0[3]); w.z = pk2(v1[0], v1[1]); w.w = pk2(v1[2], v1[3]);
                    *(u32x4*)(MG + base + (size_t)(ai * 128 + m * 16) * 1024 + bj * 128) = w; }
        }
    }
};
struct SchedOut { const bf16_t *A, *B; int G, c;
    __device__ __forceinline__ bool next(int i, Unit& u) const { const int L = i * G + c; if (L >= 64 * 4) return false;
        u.pm = L % 64; u.pn = L / 64; u.aux = 0; u.flags = 0; u.gidx = nullptr; u.A = A + (size_t)u.pm * 256 * 1024; u.B = B + (size_t)u.pn * 256 * 1024; return true; } };
struct EpiOut {   static constexpr bool PERM = false; static constexpr bool PRE = false;
    const float* x; const float* mod; float* out; float* rowsq;
    __device__ __forceinline__ void operator()(const f32x4 (&acc)[2][2][4][2], const Unit& u, int wr, int wc, int fr, int fq) const {
        const int b = (u.pm * 256) / SEQ;
        f32x4 gm[2][2];
#pragma unroll
        for (int bj = 0; bj < 2; ++bj)
#pragma unroll
            for (int n = 0; n < 2; ++n) gm[bj][n] = *(const f32x4*)(mod + b * 6144 + 2048 + u.pn * 256 + bj * 128 + wc * 32 + 16 * n + 4 * fq);
        const size_t base = (size_t)(u.pm * 256 + wr * 64 + fr) * 1024 + u.pn * 256 + wc * 32 + 4 * fq;
#pragma unroll
        for (int ai = 0; ai < 2; ++ai) {
            f32x4 xv[4][2][2];
#pragma unroll
            for (int m = 0; m < 4; ++m)
#pragma unroll
                for (int bj = 0; bj < 2; ++bj)
#pragma unroll
                    for (int n = 0; n < 2; ++n) xv[m][bj][n] = *(const f32x4*)(x + base + (size_t)(ai * 128 + m * 16) * 1024 + bj * 128 + 16 * n);
#pragma unroll
            for (int m = 0; m < 4; ++m) { const int row = u.pm * 256 + ai * 128 + wr * 64 + m * 16 + fr; float ss = 0.f;
#pragma unroll
                for (int bj = 0; bj < 2; ++bj)
#pragma unroll
                    for (int n = 0; n < 2; ++n) { const f32x4 v = xv[m][bj][n] + gm[bj][n] * acc[ai][bj][m][n];
                        *(f32x4*)(out + base + (size_t)(ai * 128 + m * 16) * 1024 + bj * 128 + 16 * n) = v; ss += (v.x * v.x + v.y * v.y) + (v.z * v.z + v.w * v.w); }
                ss += __shfl_xor(ss, 16); ss += __shfl_xor(ss, 32);
                if (fq == 0) rowsq[(size_t)row * 16 + u.pn * 4 + wc] = ss; }
        }
    }
};

struct TokMeta { int ea, eb; float ca, cb; int re_a, re_b, cls, rc; };
__device__ __forceinline__ int pair_index(int lo, int hi) { return lo * (15 - lo) / 2 + (hi - lo - 1); }

constexpr int RL_GS = 0, RL_LG = 8192, RL_W = 8192 + 16384, RW_STRIDE = 1040;
static_assert(RL_W + 2 * 48 * RW_STRIDE + 2048 <= RING_BYTES, "routing LDS map");
__device__ __forceinline__ void route_phase(Frame& F) {
    int tid_ = F.tid, w_ = F.wave; asm volatile("" : "+v"(tid_), "+s"(w_));
    const int tid = tid_, lane = tid & 63, w = w_, r16 = lane & 15, r8 = lane & 7, kg = lane >> 4;
    LAS float* gsL = (LAS float*)(F.lds + RL_GS);
    LAS float* lgL = (LAS float*)(F.lds + RL_LG + (w & 3) * 3072);
    const bool act = w < 4;
    LAS unsigned char* wL = F.lds + RL_W;
    LAS unsigned* hbin = (LAS unsigned*)(F.lds + RL_W + 2 * 48 * RW_STRIDE);
    const float* nw = (const float*)F.ap->in[18];
    const float* rowsq = WSP(float, WS_ROWSQ);
#pragma unroll 1
    for (int blk = F.bid; blk < NTOK / 64; blk += F.G) {
        const int tokb = blk * 64, b = tokb / SEQ; const float* mod = WSP(float, WS_MOD) + b * 6144;
        __syncthreads();
        float gsv[2][3];
#pragma unroll
        for (int i = 0; i < 2; ++i) { gsv[i][0] = nw[tid + 512 * i]; gsv[i][1] = mod[4096 + tid + 512 * i]; gsv[i][2] = mod[3072 + tid + 512 * i]; }
        const int tok = tokb + 16 * (w & 3) + r16;
        const float* xr = F.out + (size_t)tok * DM + 8 * kg;
        f32x4 rsq[4];
        { const f32x4* rp = (const f32x4*)(rowsq + (size_t)tok * 16); rsq[0] = rp[0]; rsq[1] = rp[1]; rsq[2] = rp[2]; rsq[3] = rp[3]; }
        f32x4 xA[8][2], xB[8][2];
#define RT_LOAD(X, QD) do { const float* xq_ = xr + 256 * (QD); _Pragma("unroll") for (int i_ = 0; i_ < 8; ++i_) { X[i_][0] = *(const f32x4*)(xq_ + 32 * i_); X[i_][1] = *(const f32x4*)(xq_ + 32 * i_ + 4); } } while (0)
        if (act) { RT_LOAD(xA, 0); RT_LOAD(xB, 1); }
        const unsigned wvo = (unsigned)(((tid >> 6) * 1024 + 8 * (tid & 63)) * 2);
        const int wlo = (tid >> 6) * RW_STRIDE + (tid & 63) * 16;
#define RT_WLOAD(KH) do { const unsigned char* wb_ = F.ws + WS_WRH + 1024 * (KH); _Pragma("unroll") for (int i_ = 0; i_ < 12; ++i_) \
            wreg[i_] = *(const u32x4*)(wb_ + (size_t)((i_ / 6) * (int)(WS_WRL - WS_WRH) + (i_ % 6) * 8 * 2048) + wvo); } while (0)
#define RT_WSTORE() do { _Pragma("unroll") for (int i_ = 0; i_ < 12; ++i_) *(LAS u32x4*)(wL + wlo + ((i_ / 6) * 48 + (i_ % 6) * 8) * RW_STRIDE) = wreg[i_]; } while (0)
#pragma unroll
        for (int i = 0; i < 2; ++i) { gsL[tid + 512 * i] = gsv[i][0] * (1.f + gsv[i][1]); gsL[1024 + tid + 512 * i] = gsv[i][2]; }
        if (tid < 144) hbin[tid] = 0u;
        const float ssq = (((rsq[0].x + rsq[0].y) + (rsq[0].z + rsq[0].w)) + ((rsq[1].x + rsq[1].y) + (rsq[1].z + rsq[1].w))) + (((rsq[2].x + rsq[2].y) + (rsq[2].z + rsq[2].w)) + ((rsq[3].x + rsq[3].y) + (rsq[3].z + rsq[3].w)));
        const float rinv = rsqrtf(ssq * (1.f / DM) + EPS);
        f32x4 acc[3];
#pragma unroll
        for (int nb = 0; nb < 3; ++nb) acc[nb] = (f32x4){0.f, 0.f, 0.f, 0.f};
        unsigned char* h2row = WSP(unsigned char, WS_H2T) + (size_t)tok * DM + 8 * kg;
#define RT_COMP(X, QD) do { _Pragma("unroll") for (int i_ = 0; i_ < 8; ++i_) { const int kq_ = 256 * (QD) + 32 * i_, k0 = kq_ + 8 * kg, kl_ = 256 * ((QD) & 1) + 32 * i_ + 8 * kg; \
                const f32x4 a = X[i_][0], c = X[i_][1]; \
                const f32x4 g0 = *(const LAS f32x4*)(gsL + k0), g1 = *(const LAS f32x4*)(gsL + k0 + 4), s0 = *(const LAS f32x4*)(gsL + 1024 + k0), s1 = *(const LAS f32x4*)(gsL + 1024 + k0 + 4); \
                float hv[8]; hv[0] = a.x * rinv * g0.x + s0.x; hv[1] = a.y * rinv * g0.y + s0.y; hv[2] = a.z * rinv * g0.z + s0.z; hv[3] = a.w * rinv * g0.w + s0.w; \
                hv[4] = c.x * rinv * g1.x + s1.x; hv[5] = c.y * rinv * g1.y + s1.y; hv[6] = c.z * rinv * g1.z + s1.z; hv[7] = c.w * rinv * g1.w + s1.w; \
                u32x4 ph, pl; ph.x = pk2(hv[0], hv[1]); ph.y = pk2(hv[2], hv[3]); ph.z = pk2(hv[4], hv[5]); ph.w = pk2(hv[6], hv[7]); \
                pl.x = pk2(hv[0] - bflo(ph.x), hv[1] - bfhi(ph.x)); pl.y = pk2(hv[2] - bflo(ph.y), hv[3] - bfhi(ph.y)); pl.z = pk2(hv[4] - bflo(ph.z), hv[5] - bfhi(ph.z)); pl.w = pk2(hv[6] - bflo(ph.w), hv[7] - bfhi(ph.w)); \
                *(u32x2*)(h2row + kq_) = (u32x2){pk4_fp8(hv[0], hv[1], hv[2], hv[3]), pk4_fp8(hv[4], hv[5], hv[6], hv[7])};     \
                const bf16x8 ah = __builtin_bit_cast(bf16x8, ph), al = __builtin_bit_cast(bf16x8, pl); \
                _Pragma("unroll") for (int nb = 0; nb < 3; ++nb) { const LAS unsigned char* wp = wL + (16 * nb + r16) * RW_STRIDE + kl_ * 2; \
                    const bf16x8 bh = *(const LAS bf16x8*)wp, bl = *(const LAS bf16x8*)(wp + 48 * RW_STRIDE); \
                    acc[nb] = __builtin_amdgcn_mfma_f32_16x16x32_bf16(ah, bh, acc[nb], 0, 0, 0); acc[nb] = __builtin_amdgcn_mfma_f32_16x16x32_bf16(ah, bl, acc[nb], 0, 0, 0); \
                    acc[nb] = __builtin_amdgcn_mfma_f32_16x16x32_bf16(al, bh, acc[nb], 0, 0, 0); } \
                __builtin_amdgcn_sched_barrier(0); } } while (0)
#pragma unroll 1
        for (int kh = 0; kh < 2; ++kh) {
            __syncthreads();
            { u32x4 wreg[12]; RT_WLOAD(kh); RT_WSTORE(); }
            __syncthreads();
            if (act) {
                RT_COMP(xA, 2 * kh);
                if (kh == 0) RT_LOAD(xA, 2);
                RT_COMP(xB, 2 * kh + 1);
                if (kh == 0) RT_LOAD(xB, 3);
            }
        }
#undef RT_COMP
#undef RT_WSTORE
#undef RT_WLOAD
#undef RT_LOAD
        if (act) {
#pragma unroll
            for (int nb = 0; nb < 3; ++nb)
#pragma unroll
                for (int r = 0; r < 4; ++r) lgL[(4 * kg + r) * 48 + 16 * nb + r16] = acc[nb][r]; }
        asm volatile("s_waitcnt lgkmcnt(0)" ::: "memory");
        TokMeta mt; mt.ea = 0; mt.eb = 0; mt.ca = 0.f; mt.cb = 0.f; mt.re_a = 0; mt.re_b = 0; mt.cls = 0; mt.rc = 0;
        if (act && lane < 16) {
            const LAS float* lg = lgL + lane * 48; const float* bg = (const float*)F.ap->in[20]; const float* be = (const float*)F.ap->in[22];
            float gl[4];
#pragma unroll
            for (int i = 0; i < 4; ++i) gl[i] = lg[i] + bg[i];
            int g = 0; float gmx = gl[0];
#pragma unroll
            for (int i = 1; i < 4; ++i) if (gl[i] > gmx) { gmx = gl[i]; g = i; }
            float gs = 0.f;
#pragma unroll
            for (int i = 0; i < 4; ++i) gs += __expf(gl[i] - gmx);
            const float gw = 1.f / gs;
            float el[8];
#pragma unroll
            for (int i = 0; i < 8; ++i) el[i] = lg[4 + g * 8 + i] + be[g * 8 + i];
            int i1 = 0; float v1 = el[0];
#pragma unroll
            for (int i = 1; i < 8; ++i) if (el[i] > v1) { v1 = el[i]; i1 = i; }
            int i2 = -1; float v2 = -INFINITY;
#pragma unroll
            for (int i = 0; i < 8; ++i) if (i != i1 && (i2 < 0 || el[i] > v2)) { v2 = el[i]; i2 = i; }
            const float e2 = __expf(v2 - v1); const float w1v = gw / (1.f + e2), w2v = gw * e2 / (1.f + e2);
            const int lo = i1 < i2 ? i1 : i2, hi = i1 < i2 ? i2 : i1;
            mt.ea = g * 8 + lo; mt.eb = g * 8 + hi; mt.ca = (i1 < i2) ? w1v : w2v; mt.cb = (i1 < i2) ? w2v : w1v;
            mt.cls = g * 28 + pair_index(lo, hi);
            mt.re_a = (int)__hip_atomic_fetch_add(hbin + mt.ea, 1u, __ATOMIC_RELAXED, __HIP_MEMORY_SCOPE_WORKGROUP); mt.re_b = (int)__hip_atomic_fetch_add(hbin + mt.eb, 1u, __ATOMIC_RELAXED, __HIP_MEMORY_SCOPE_WORKGROUP);
            mt.rc = (int)__hip_atomic_fetch_add(hbin + 32 + mt.cls, 1u, __ATOMIC_RELAXED, __HIP_MEMORY_SCOPE_WORKGROUP);
        }
        __syncthreads();
        if (tid < 144) { const unsigned cnt = hbin[tid]; unsigned base = 0u;
            if (cnt) base = atomicAdd((unsigned*)(F.ws + WS_CTL) + CW_CNTE + tid * CNT_STRIDE, cnt);
            hbin[160 + tid] = base; }
        __syncthreads();
        if (act && lane < 16) { mt.re_a += (int)hbin[160 + mt.ea]; mt.re_b += (int)hbin[160 + mt.eb]; mt.rc += (int)hbin[160 + 32 + mt.cls];
            const int tk = tokb + 16 * w + lane;
            typedef int i32x4 __attribute__((ext_vector_type(4)));
            WSP(i32x4, WS_EINFO)[(size_t)mt.ea * LIST_CAP + mt.re_a] = (i32x4){tk, (int)fbits(mt.ca), mt.cls, mt.rc};
            WSP(i32x4, WS_EINFO)[(size_t)mt.eb * LIST_CAP + mt.re_b] = (i32x4){tk, (int)fbits(mt.cb), mt.cls | (1 << 16), mt.rc};
            WSP(int, WS_CLIST)[(size_t)mt.cls * LIST_CAP + mt.rc] = tk; }
    }
}
struct MoeTables { LAS int* ebase; LAS int* cbase; LAS int* cnt; LAS unsigned short* trows; LAS unsigned short* tcls; LAS unsigned short* order; };
__device__ __forceinline__ MoeTables tables_view(Frame& F, int lds_off) {
    MoeTables T; T.ebase = (LAS int*)(F.lds + lds_off); T.cbase = T.ebase + 40; T.cnt = T.ebase + 160; T.trows = (LAS unsigned short*)(F.lds + lds_off + 1280); T.tcls = T.trows + 256; T.order = T.trows + 512; return T; }
__device__ __forceinline__ MoeTables build_tables(Frame& F, int lds_off) {
    MoeTables T = tables_view(F, lds_off);
    const unsigned* ctl = (const unsigned*)(F.ws + WS_CTL);
    __syncthreads();
    if (F.tid < 144) T.cnt[F.tid] = (int)__hip_atomic_load(ctl + CW_CNTE + F.tid * CNT_STRIDE, __ATOMIC_RELAXED, __HIP_MEMORY_SCOPE_AGENT);
    __syncthreads();
    { int t_ = F.tid; asm volatile("" : "+v"(t_));
      const int l = t_ & 63;
#define BT_UP(P, O) __builtin_amdgcn_ds_bpermute(((l - (O)) & 63) * 4, (P))
      if (t_ < 64) { const int v = (l < NEXP) ? ((T.cnt[l] + 255) >> 8) : 0; int p = v;
#pragma unroll
          for (int o = 1; o < 64; o <<= 1) { const int t = BT_UP(p, o); if (l >= o) p += t; }
          if (l < NEXP) T.ebase[l] = p - v; if (l == NEXP - 1) T.ebase[NEXP] = p; }
      else if (t_ < 128) { const int v0 = (T.cnt[32 + l] + 255) >> 8, v1 = (l + 64 < NCLS) ? ((T.cnt[32 + 64 + l] + 255) >> 8) : 0; int p0 = v0, p1 = v1;
#pragma unroll
          for (int o = 1; o < 64; o <<= 1) { const int t0 = BT_UP(p0, o), t1 = BT_UP(p1, o); if (l >= o) { p0 += t0; p1 += t1; } }
          const int tot0 = __builtin_amdgcn_ds_bpermute(63 * 4, p0);
          T.cbase[l] = p0 - v0; if (l + 64 < NCLS) T.cbase[64 + l] = tot0 + p1 - v1; if (l + 64 == NCLS - 1) T.cbase[NCLS] = tot0 + p1; }
#undef BT_UP
    }
    __syncthreads();
    if (F.tid < NCLS) { const int n = T.cnt[32 + F.tid], b0 = T.cbase[F.tid], nt = T.cbase[F.tid + 1] - b0;
        for (int t = 0; t < nt; ++t) { const int idx = b0 + t; if (idx < 256) { const int rws = n - 256 * t; T.trows[idx] = (unsigned short)(rws > 256 ? 256 : rws); T.tcls[idx] = (unsigned short)F.tid; } } }
    __syncthreads();
    { const int NT = T.cbase[NCLS] < 256 ? T.cbase[NCLS] : 256;
      if (F.tid < NT) { const int mine = T.trows[F.tid]; int rk = 0;
          for (int j = 0; j < NT; ++j) { const int o = T.trows[j]; rk += (o > mine || (o == mine && j < F.tid)) ? 1 : 0; }
          T.order[rk] = (unsigned short)F.tid; } }
    __syncthreads();
    return T;
}
typedef int i32x4 __attribute__((ext_vector_type(4)));
struct SchedMoe1 { const bf16_t *H2, *W13; const LAS int* ebase; const LAS int* cnte; const int* einfo; int G, c;
    __device__ __forceinline__ bool next(int i, Unit& u) const { const int L = i * G + c, ntile = ebase[NEXP]; if (L >= ntile * 2) return false;
        const int rt = L >> 1, j = L & 1; int e = 0;
        for (int q = 1; q < NEXP; ++q) e = (ebase[q] <= rt) ? q : e;
        const int tl = rt - ebase[e];
        u.pm = e * 64 + tl; u.pn = j; u.flags = 0; u.aux = cnte[e] - 256 * tl; u.gidx = einfo + ((size_t)e * LIST_CAP + 256 * tl) * 4;
        u.A = H2; u.B = W13 + ((size_t)e * 512 + 256 * j) * 512; return true; } };
struct EpiMoe1 {   static constexpr bool PERM = true; static constexpr bool PRE = false;
    unsigned char* wsb; const i32x4* einfo; const LAS int* cbase;
    __device__ __forceinline__ void operator()(const f32x4 (&acc)[2][2][4][2], const Unit& u, int wr, int wc, int fr, int fq) const {
        const int e = u.pm >> 6, tl = u.pm & 63;
        i32x4 infs[8];
#pragma unroll
        for (int ai = 0; ai < 2; ++ai)
#pragma unroll
            for (int m = 0; m < 4; ++m) { const int r = ai * 128 + wr * 64 + m * 16 + fr; infs[ai * 4 + m] = einfo[(size_t)e * LIST_CAP + 256 * tl + (r < u.aux ? r : 0)]; }
        unsigned dst[8]; float cs[8];
#pragma unroll
        for (int ai = 0; ai < 2; ++ai)
#pragma unroll
            for (int m = 0; m < 4; ++m) { const int r = ai * 128 + wr * 64 + m * 16 + fr; const i32x4 inf = infs[ai * 4 + m]; cs[ai * 4 + m] = bitsf((unsigned)inf.y); const int cls = inf.z & 0xffff, half = inf.z >> 16;
                const size_t d = ((size_t)cbase[cls] * 256 + inf.w) * 512 + 256 * half + 128 * u.pn + 32 * wc + 8 * fq;
                dst[ai * 4 + m] = (r < u.aux) ? (unsigned)(WS_ACT2 + d * 2) : (unsigned)(WS_META + 16 * (fq + 4 * wc)); }
#pragma unroll
        for (int ai = 0; ai < 2; ++ai)
#pragma unroll
            for (int m = 0; m < 4; ++m) {
                float o[8];
#pragma unroll
                for (int n = 0; n < 2; ++n)
#pragma unroll
                    for (int ee = 0; ee < 4; ++ee) { const float a = acc[ai][0][m][n][ee], g = acc[ai][1][m][n][ee]; o[4 * n + ee] = a * sigmoidf_(a) * g * cs[ai * 4 + m]; }
                u32x4 w; w.x = cvt_pk_bf16(o[0], o[1]); w.y = cvt_pk_bf16(o[2], o[3]); w.z = cvt_pk_bf16(o[4], o[5]); w.w = cvt_pk_bf16(o[6], o[7]);
                *(u32x4*)(wsb + dst[ai * 4 + m]) = w; }
    }
};
struct SchedMoe2 { const bf16_t *act2, *W2; const LAS int* cbase; const LAS int* cntc; const LAS unsigned short* order; const LAS unsigned short* tcls; int G, c;
    __device__ __forceinline__ bool next(int i, Unit& u) const { const int L = (i >> 1) * G + c, ntile = cbase[NCLS]; if (L >= ntile * 4) return false;
        const int sub = i & 1, rk = L >> 2, pn = L & 3;
        const int rt = (ntile <= 256) ? (int)order[rk] : rk;
        int cl = 0;
        if (ntile <= 256) cl = (int)tcls[rt]; else { for (int q = 1; q < NCLS; ++q) cl = (cbase[q] <= rt) ? q : cl; }
        const int g = cl / 28; int p = cl % 28, lo = 0; while (p >= 7 - lo) { p -= 7 - lo; ++lo; } const int hi = lo + 1 + p;
        const int e = g * 8 + (sub ? hi : lo), tl = rt - cbase[cl];
        u.pm = cl * 64 + tl; u.pn = pn; u.flags = sub ? 1 : 2; u.aux = cntc[cl] - 256 * tl; u.gidx = nullptr;
        u.A = act2 + (size_t)rt * 256 * 512 + 256 * sub; u.B = W2 + ((size_t)e * 1024 + 256 * pn) * 256; return true; } };
struct EpiMoe2 {   static constexpr bool PERM = false; static constexpr bool PRE = true;
    float* out; const LAS unsigned char* gfL; const int* clist; float* trash;
    __device__ __forceinline__ void prefetch(int (&tk)[8], const Unit& u, int wr, int wc, int fr, int fq) const {
        const int cl = u.pm >> 6, tl = u.pm & 63;
#pragma unroll
        for (int ai = 0; ai < 2; ++ai)
#pragma unroll
            for (int m = 0; m < 4; ++m) { const int r = ai * 128 + wr * 64 + m * 16 + fr; tk[ai * 4 + m] = (r < u.aux) ? clist[(size_t)cl * LIST_CAP + 256 * tl + r] : -1; }
    }
    __device__ __forceinline__ void operator()(const f32x4 (&acc)[2][2][4][2], const Unit& u, int wr, int wc, int fr, int fq, const int (&tk)[8]) const {
        const int colb = u.pn * 256 + wc * 32 + 4 * fq;
#pragma unroll
        for (int ai = 0; ai < 2; ++ai) {
            f32x4 v[4][2][2];
#pragma unroll
            for (int m = 0; m < 4; ++m) { const int tok = tk[ai * 4 + m]; const float* p = (tok < 0) ? trash + 4 * fq : out + (size_t)tok * 1024 + colb;
#pragma unroll
                for (int bj = 0; bj < 2; ++bj)
#pragma unroll
                    for (int n = 0; n < 2; ++n) v[m][bj][n] = *(const f32x4*)(p + bj * 128 + n * 16); }
#pragma unroll
            for (int m = 0; m < 4; ++m) { const int tok = tk[ai * 4 + m]; const int b = (tok < 0 ? 0 : tok) / SEQ; float* p = (tok < 0) ? trash + 4 * fq : out + (size_t)tok * 1024 + colb;
#pragma unroll
                for (int bj = 0; bj < 2; ++bj)
#pragma unroll
                    for (int n = 0; n < 2; ++n) { const u32x2 gw = *(const LAS u32x2*)(gfL + (b * 1024 + colb + bj * 128 + n * 16) * 2); const f32x4 gf = {bflo(gw.x), bfhi(gw.x), bflo(gw.y), bfhi(gw.y)};
                        *(f32x4*)(p + bj * 128 + n * 16) = v[m][bj][n] + gf * acc[ai][bj][m][n]; } }
        }
    }
};

constexpr int NPHASE = 9;
template <int LO, int HI> __global__ void __launch_bounds__(NTHREADS, 2) mk_fwd(Args args) {
    extern __shared__ __attribute__((aligned(16))) unsigned char lds[];
    Frame F;
    F.lds = (LAS unsigned char*)lds; F.tid = threadIdx.x; F.lane = F.tid & 63; F.wave = __builtin_amdgcn_readfirstlane(F.tid >> 6); F.G = gridDim.x; F.bid = blockIdx.x;
    F.ap = &args;
    F.out = args.out; F.ws = args.ws;
    volatile LAS unsigned* MISC = (volatile LAS unsigned*)((LAS unsigned char*)lds + MISC_OFF);
    if (F.tid < 32) MISC[F.tid] = 0u;
    __syncthreads();
    unsigned* ctl = (unsigned*)(F.ws + WS_CTL);
    XcdBarrier bar; bar.bar = ctl + CW_BAR; bar.x = 0; bar.st = nullptr;
    if (MK_N_LAUNCHES == 1) bar = xcd_barrier_post(ctl + CW_BAR, MISC + 8);
#define IN(k) (LO <= (k) && (k) < HI)
#define SEAM(k) do { if constexpr (IN(k) && IN((k) + 1)) xcd_barrier(bar); } while (0)
#ifndef MK_LEAK
#define MK_LEAK -1
#endif
    unsigned long long ts_[12];
#define STAMP(k) do { if (MK_LEAK >= 0) ts_[k] = __builtin_amdgcn_s_memrealtime(); } while (0)
    STAMP(0);
    if constexpr (IN(0)) { p0_phase(F); } SEAM(0); STAMP(1);
    if constexpr (IN(1)) { p1a_phase(F); } SEAM(1); STAMP(2);
    if constexpr (IN(2)) { EpiProj E{F.ws};
        { SchedProj S{WSP(bf16_t, WS_H), WSP(bf16_t, WS_WIN), 1024, 0, F.G, F.bid}; run_gemm(F.lds, 1024, 1024, 1024, S, E); }
        { SchedProj S{WSP(bf16_t, WS_H8), WSP(bf16_t, WS_WIN8), 512, 8, F.G, F.bid}; run_gemm<false, true>(F.lds, 512, 512, 512, S, E); } }
    SEAM(2);
    unsigned long long tlru_ = 0;
    if constexpr (IN(3)) { lru_phase(F); __syncthreads(); if (MK_LEAK >= 0) tlru_ = __builtin_amdgcn_s_memrealtime(); attn_phase(F, 0, 32); } SEAM(3); STAMP(4);
    if constexpr (IN(4)) { SchedMerge S{WSP(bf16_t, WS_AO), WSP(bf16_t, WS_LO), WSP(bf16_t, WS_WPA), WSP(bf16_t, WS_WPB), F.G, F.bid};
        EpiMerge E{WSP(bf16_t, WS_MG), WSP(bf16_t, WS_GA), WSP(bf16_t, WS_GB)};
        run_gemm(F.lds, 512, 512, 512, S, E); } SEAM(4); STAMP(5);
    if constexpr (IN(5)) { SchedOut S{WSP(bf16_t, WS_MG), WSP(bf16_t, WS_WOUT), F.G, F.bid}; EpiOut E{((const float*)F.ap->in[0]), WSP(float, WS_MOD), F.out, WSP(float, WS_ROWSQ)};
        run_gemm(F.lds, 1024, 1024, 1024, S, E); } SEAM(5); STAMP(6);
    if constexpr (IN(6)) { route_phase(F); } SEAM(6); STAMP(7);
    if constexpr (IN(7)) { const MoeTables T = build_tables(F, TBL_OFF);
        SchedMoe1 S{WSP(bf16_t, WS_H2T), WSP(bf16_t, WS_W13), T.ebase, T.cnt, WSP(int, WS_EINFO), F.G, F.bid}; EpiMoe1 E{F.ws, WSP(i32x4, WS_EINFO), T.cbase};
        run_gemm<true, true>(F.lds, 512, 512, 512, S, E); } SEAM(7); STAMP(8);
    if constexpr (IN(8)) { const MoeTables T = (MK_N_LAUNCHES == 1 && IN(7)) ? tables_view(F, TBL_OFF) : build_tables(F, TBL_OFF);
        SchedMoe2 S{WSP(bf16_t, WS_ACT2), WSP(bf16_t, WS_W2), T.cbase, T.cnt + 32, T.order, T.tcls, F.G, F.bid}; EpiMoe2 E{F.out, F.lds + GF_OFF, WSP(int, WS_CLIST), WSP(float, WS_META)};
        for (int i = F.tid; i < 4096; i += NTHREADS) { const int b = i >> 9, c2 = (i & 511) * 2; const float* gp = WSP(float, WS_MOD) + b * 6144 + 5120 + c2; *(LAS unsigned*)(F.lds + GF_OFF + (b * 1024 + c2) * 2) = pk2(gp[0], gp[1]); }
        __syncthreads();
        run_gemm(F.lds, 512, 256, 256, S, E); }
    STAMP(9);
    if (MK_LEAK >= 0 && F.bid == 0 && F.tid == 0) { asm volatile("s_waitcnt vmcnt(0)" ::: "memory");
        unsigned long long d = 0;
        if (MK_LEAK < 10) d = ts_[MK_LEAK + 1] - ts_[MK_LEAK]; else if (MK_LEAK == 10) d = tlru_ - ts_[3]; else if (MK_LEAK == 11) d = MISC[16]; else if (MK_LEAK == 12) d = MISC[17]; else if (MK_LEAK == 13) d = MISC[18]; else if (MK_LEAK == 14) d = MISC[19]; else if (MK_LEAK == 15) d = MISC[20];
        F.out[0] = (float)d * 0.01f; }
#undef IN
#undef SEAM
}

template <int P> static void launch_phase(int grid, hipStream_t stream, Args a) {
    (void)hipFuncSetAttribute((const void*)mk_fwd<P, P + 1>, hipFuncAttributeMaxDynamicSharedMemorySize, LDS_BYTES);
    a.ph_lo = P; a.ph_hi = P + 1; hipLaunchKernelGGL((mk_fwd<P, P + 1>), dim3(grid), dim3(NTHREADS), LDS_BYTES, stream, a);
}
extern "C" void kernel_launch(void* const* d_in, const int* in_sizes, int n_in, void* d_out, int out_size, void* d_ws, size_t ws_size, hipStream_t stream) {
    static int grid = 0;
    if (grid == 0) {
        if (n_in != 26 || out_size != NTOK * DM || ws_size < WS_END) { fprintf(stderr, "kernel_launch: unexpected shapes (n_in %d out %d ws %zu)\n", n_in, out_size, ws_size); grid = -1; return; }
        int dev = 0, cus = 0, per_cu = 0;
        (void)hipGetDevice(&dev); (void)hipDeviceGetAttribute(&cus, hipDeviceAttributeMultiprocessorCount, dev);
#if MK_N_LAUNCHES == 1
        (void)hipFuncSetAttribute((const void*)mk_fwd<0, NPHASE>, hipFuncAttributeMaxDynamicSharedMemorySize, LDS_BYTES);
        (void)hipOccupancyMaxActiveBlocksPerMultiprocessor(&per_cu, (const void*)mk_fwd<0, NPHASE>, NTHREADS, LDS_BYTES);
#else
        (void)hipOccupancyMaxActiveBlocksPerMultiprocessor(&per_cu, (const void*)mk_fwd<2, 3>, NTHREADS, LDS_BYTES);
#endif
        (void)hipGetLastError();
        if (per_cu < 1) { fprintf(stderr, "kernel_launch: occupancy query says %d blocks per CU\n", per_cu); }
        grid = cus;
    }
    if (grid < 0) return;
    (void)hipMemsetAsync((char*)d_ws + WS_CTL, 0, CTL_ZERO_BYTES, stream);
    Args a{};
    for (int i = 0; i < 26; ++i) a.in[i] = d_in[i];
    a.out = (float*)d_out; a.ws = (unsigned char*)d_ws;
#if MK_N_LAUNCHES == 1
    a.ph_lo = 0; a.ph_hi = NPHASE; hipLaunchKernelGGL((mk_fwd<0, NPHASE>), dim3(grid), dim3(NTHREADS), LDS_BYTES, stream, a);
#else
#ifndef MK_REPMASK
#define MK_REPMASK 0
#endif
    for (int r = 0; r < ((MK_REPMASK & 1) ? 2 : 1); ++r) launch_phase<0>(grid, stream, a);
    for (int r = 0; r < ((MK_REPMASK & 2) ? 2 : 1); ++r) launch_phase<1>(grid, stream, a);
    for (int r = 0; r < ((MK_REPMASK & 4) ? 2 : 1); ++r) launch_phase<2>(grid, stream, a);
    for (int r = 0; r < ((MK_REPMASK & 8) ? 2 : 1); ++r) launch_phase<3>(grid, stream, a);
    for (int r = 0; r < ((MK_REPMASK & 16) ? 2 : 1); ++r) launch_phase<4>(grid, stream, a);
    for (int r = 0; r < ((MK_REPMASK & 32) ? 2 : 1); ++r) launch_phase<5>(grid, stream, a);
    launch_phase<6>(grid, stream, a);
    for (int r = 0; r < ((MK_REPMASK & 128) ? 2 : 1); ++r) launch_phase<7>(grid, stream, a);
    for (int r = 0; r < ((MK_REPMASK & 256) ? 2 : 1); ++r) launch_phase<8>(grid, stream, a);
    launch_phase<9>(grid, stream, a);
    if (MK_REPMASK & 512) { launch_phase<5>(grid, stream, a); launch_phase<9>(grid, stream, a); }
#endif
}
```

```cpp
#include <hip/hip_runtime.h>
#include <cstdint>
#include <cstdio>

#ifndef MK_LEAK
#define MK_LEAK -1
#endif
#ifndef MK_N_LAUNCHES
#define MK_N_LAUNCHES 1
#endif

#define LAS __attribute__((address_space(3)))
#define GAS __attribute__((address_space(1)))
typedef unsigned short bf16_t;
typedef short bf16x8 __attribute__((ext_vector_type(8)));
typedef float f32x4 __attribute__((ext_vector_type(4)));
typedef float f32x2 __attribute__((ext_vector_type(2)));
typedef unsigned u32x4 __attribute__((ext_vector_type(4)));
typedef unsigned u32x2 __attribute__((ext_vector_type(2)));
typedef GAS unsigned gu32;

constexpr int BATCH = 8, SEQ = 2048, DM = 1024, NTOK = BATCH * SEQ;
constexpr int NH = 8, HD = 64, NIH = 4, TOPK = 256, CHUNK = 64;
constexpr int LRUW = 512;
constexpr int NEXP = 32, NGRP = 4, EPG = 8, DFF = 256, NCLS = NGRP * 28;
constexpr int DIN_PAD = 4096;
constexpr float EPS = 1e-6f;
constexpr int C_Q = 0, C_K = 512, C_V = 576, C_QI = 640, C_KI = 896, C_LX = 960, C_LG = 1472, C_WI = 1984, C_PAD = 1988, C_GA = 2048, C_GB = 3072, C_END = 4096;

constexpr size_t MiB = 1u << 20;
constexpr size_t WS_CTL = 0, CTL_ZERO_BYTES = 1 * MiB;
constexpr size_t WS_MOD = 1 * MiB;
constexpr size_t WS_META = 1 * MiB + 512 * 1024;
constexpr size_t WS_WIN = 2 * MiB, WS_WPA = 10 * MiB, WS_WPB = 11 * MiB, WS_WOUT = 12 * MiB, WS_W13 = 14 * MiB, WS_W2 = 46 * MiB;
constexpr size_t WS_WRH = 62 * MiB, WS_WRL = 62 * MiB + 256 * 1024;
constexpr size_t WS_H = 64 * MiB;
constexpr size_t WS_AO = 64 * MiB, WS_LO = 80 * MiB;
constexpr size_t WS_Q = 96 * MiB, WS_QI = 112 * MiB, WS_K = 120 * MiB, WS_KI = 122 * MiB, WS_VT = 124 * MiB, WS_WI = 126 * MiB, WS_VR = 224 * MiB;
constexpr size_t WS_LX = 128 * MiB, WS_LG = 144 * MiB, WS_MG = 128 * MiB;
constexpr size_t WS_GA = 160 * MiB, WS_GB = 192 * MiB;
constexpr size_t WS_X1B = 96 * MiB;
constexpr size_t WS_A1 = 64 * MiB;
constexpr size_t WS_H2T = 160 * MiB;
constexpr size_t WS_ACT2 = 192 * MiB;
constexpr size_t WS_H8 = 224 * MiB;
constexpr size_t WS_WIN8 = 6 * MiB;
constexpr size_t WS_EINFO = 64 * MiB;
constexpr size_t WS_CLIST = 72 * MiB;
constexpr int LIST_CAP = 16384;
constexpr size_t WS_ROWSQ = 240 * MiB;
constexpr size_t WS_END = 256 * MiB;
constexpr int CW_BAR = 4096, CW_CNTE = 8192, CW_CNTC = 8192 + 32 * 32, CNT_STRIDE = 32, CW_ROWSQ = 16384;

constexpr int NWAVES = 8, NTHREADS = 512;
constexpr int LDS_BYTES = 151552, RING_BYTES = 131072, MISC_OFF = LDS_BYTES - 512, GF_OFF = RING_BYTES, TBL_OFF = RING_BYTES + 16384;

typedef float f32x2_cv __attribute__((ext_vector_type(2)));
typedef __bf16 bf16x2_cv __attribute__((ext_vector_type(2)));
__device__ __forceinline__ unsigned pk2(float lo, float hi) { const f32x2_cv v = {lo, hi}; return __builtin_bit_cast(unsigned, __builtin_convertvector(v, bf16x2_cv)); }
__device__ __forceinline__ unsigned f2bf(float f) { return pk2(f, 0.f) & 0xffffu; }
__device__ __forceinline__ unsigned cvt_pk_bf16(float lo, float hi) { return pk2(lo, hi); }

#define LDS_BARRIER() do { asm volatile("s_waitcnt lgkmcnt(0)" ::: "memory"); __builtin_amdgcn_s_barrier(); asm volatile("" ::: "memory"); } while (0)
__device__ __forceinline__ float relu_f(float x) { float r; asm("v_max_f32 %0, 0, %1" : "=v"(r) : "v"(x)); return r; }
__device__ __forceinline__ float max3f(float a, float b, float c) { float r; asm("v_max3_f32 %0, %1, %2, %3" : "=v"(r) : "v"(a), "v"(b), "v"(c)); return r; }
typedef int v8i32 __attribute__((ext_vector_type(8)));
__device__ __forceinline__ unsigned pk4_fp8(float a, float b, float c, float d) { int w = 0; w = __builtin_amdgcn_cvt_pk_fp8_f32(a, b, w, false); w = __builtin_amdgcn_cvt_pk_fp8_f32(c, d, w, true); return (unsigned)w; }
__device__ __forceinline__ float bf2f(unsigned short b) { return __builtin_bit_cast(float, (unsigned)b << 16); }
__device__ __forceinline__ float bflo(unsigned w) { return __builtin_bit_cast(float, w << 16); }
__device__ __forceinline__ float bfhi(unsigned w) { return __builtin_bit_cast(float, w & 0xffff0000u); }
__device__ __forceinline__ float wave_sum(float v) {
#pragma unroll
    for (int o = 1; o < 64; o <<= 1) v += __shfl_xor(v, o);
    return v;
}
__device__ __forceinline__ float wave_max(float v) {
#pragma unroll
    for (int o = 1; o < 64; o <<= 1) v = fmaxf(v, __shfl_xor(v, o));
    return v;
}
__device__ __forceinline__ int wave_isum(int v) {
#pragma unroll
    for (int o = 1; o < 64; o <<= 1) v += __shfl_xor(v, o);
    return v;
}
__device__ __forceinline__ float sigmoidf_(float x) { return __builtin_amdgcn_rcpf(1.f + __expf(-x)); }
__host__ __device__ __forceinline__ int perm32(int rho) { const int n = rho >> 4, i = rho & 15; return 8 * (i >> 2) + 4 * n + (i & 3); }
__device__ __forceinline__ int vt_pos(int o) { return 8 * ((o >> 2) & 1) + 4 * (o >> 3) + (o & 3); }

#define XB_TMO      128
#define XB_XCNT(j)  (256  + 64 * (j))
#define XB_XSUB(j)  (1280 + 64 * (j))
#define XB_XGEN(j)  (2304 + 64 * (j))
#define XB_TOP      3328
#define XB_TOPGEN   3392
#define XCD_BAR_WORDS 3456
#define XB_SPIN_CAP (1u << 18)
__device__ __forceinline__ unsigned xb_ld(unsigned* p)              { return __hip_atomic_load(p, __ATOMIC_RELAXED, __HIP_MEMORY_SCOPE_AGENT); }
__device__ __forceinline__ unsigned xb_add(unsigned* p, unsigned v) { return __hip_atomic_fetch_add(p, v, __ATOMIC_RELAXED, __HIP_MEMORY_SCOPE_AGENT); }
__device__ __forceinline__ unsigned xb_xcc_id() { return (unsigned)__builtin_amdgcn_s_getreg((3 << 11) | 20) & 0xFu; }
#define XB_SPIN(cond, bar) do { unsigned _sp = 0; while (cond) { __builtin_amdgcn_s_sleep(1); \
    if ((++_sp & 255u) == 0u) { if (xb_ld(&(bar)[XB_TMO])) break; if (_sp > XB_SPIN_CAP) { atomicAdd(&(bar)[XB_TMO], 1u); break; } } } } while (0)
struct XcdBarrier { unsigned* bar; unsigned x; volatile LAS unsigned* st; };
__device__ __forceinline__ XcdBarrier xcd_barrier_post(unsigned* bar, volatile LAS unsigned* st) {
    XcdBarrier b; b.bar = bar; b.x = xb_xcc_id(); b.st = st;
    if (threadIdx.x == 0) (void)xb_add(&bar[XB_XCNT(b.x)], 1u);
    return b;
}
__device__ __forceinline__ void xcd_barrier_complete(unsigned* bar, unsigned x, unsigned& nloc, unsigned& nx) {
    const unsigned G = gridDim.x * gridDim.y * gridDim.z;
    unsigned sum, cnt, mine, sp = 0u;
    for (;;) {
        sum = 0u; cnt = 0u; mine = 0u;
#pragma unroll
        for (unsigned j = 0; j < 16; ++j) { const unsigned c = xb_ld(&bar[XB_XCNT(j)]); sum += c; cnt += (c > 0u) ? 1u : 0u; mine = (j == x) ? c : mine; }
        if (sum == G) break;
        __builtin_amdgcn_s_sleep(1);
        if ((++sp & 255u) == 0u) { if (xb_ld(&bar[XB_TMO])) break; if (sp > XB_SPIN_CAP) { atomicAdd(&bar[XB_TMO], 1u); break; } }
    }
    nloc = mine > 0u ? mine : 1u; nx = cnt > 0u ? cnt : 1u;
}
__device__ __forceinline__ void xcd_barrier(const XcdBarrier& b) {
    asm volatile("s_waitcnt vmcnt(0)" ::: "memory");
    __syncthreads();
    if (threadIdx.x == 0) {
        unsigned* bar = b.bar;
        __builtin_amdgcn_s_waitcnt(0);
        unsigned nloc = b.st[0], nx = b.st[1];
        if (nloc == 0u) { xcd_barrier_complete(bar, b.x, nloc, nx); b.st[0] = nloc; b.st[1] = nx; }
        const unsigned old = xb_add(&bar[XB_XSUB(b.x)], 1u);
        const unsigned gen = old / nloc;
        if (old + 1u == (gen + 1u) * nloc) {
            __builtin_amdgcn_fence(__ATOMIC_RELEASE, "agent");
            asm volatile("s_waitcnt vmcnt(0)" ::: "memory");
            const unsigned og = xb_add(&bar[XB_TOP], 1u);
            const unsigned tg = og / nx;
            if (og + 1u == (tg + 1u) * nx) xb_add(&bar[XB_TOPGEN], 1u);
            else XB_SPIN(xb_ld(&bar[XB_TOPGEN]) == tg, bar);
            __builtin_amdgcn_fence(__ATOMIC_ACQUIRE, "agent");
            xb_add(&bar[XB_XGEN(b.x)], 1u);
            asm volatile("s_waitcnt vmcnt(0)" ::: "memory");
        } else {
            XB_SPIN(xb_ld(&bar[XB_XGEN(b.x)]) == gen, bar);
            __builtin_amdgcn_fence(__ATOMIC_ACQUIRE, "agent");
            asm volatile("s_waitcnt vmcnt(0)" ::: "memory");
        }
    }
    __syncthreads();
}

struct Args { const void* in[26]; float* out; unsigned char* ws; int ph_lo, ph_hi; };
struct Frame {
    LAS unsigned char* lds;
    int tid, lane, wave, G, bid;
    const Args* ap;
    float* out; unsigned char* ws;
};
#define WSP(T, off) ((T*)(F.ws + (off)))

__device__ __forceinline__ void tr_item(const float* __restrict__ src, int ld, int k0, int c0, int nvalid, bf16_t* dst, int ldd, LAS float* scr, int lane) {
    const int c4 = (lane & 7) * 4, rr = lane >> 3;
    if (nvalid == 32 && ((c0 | ld) & 3) == 0) {
        f32x4 v[8];
#pragma unroll
        for (int i = 0; i < 8; ++i) v[i] = *(const f32x4*)(src + (size_t)(k0 + 8 * i + rr) * ld + c0 + c4);
#pragma unroll
        for (int i = 0; i < 8; ++i) { LAS float* p = scr + (8 * i + rr) * 33 + c4; p[0] = v[i].x; p[1] = v[i].y; p[2] = v[i].z; p[3] = v[i].w; }
    } else {
#pragma unroll 8
        for (int i = 0; i < 32; ++i) { const int kk = 2 * i + (lane >> 5), cc = lane & 31;
            scr[kk * 33 + cc] = (cc < nvalid) ? src[(size_t)(k0 + kk) * ld + c0 + cc] : 0.f; }
    }
    asm volatile("s_waitcnt lgkmcnt(0)" ::: "memory");
    const int c = lane & 7;
#pragma unroll
    for (int j = 0; j < 4; ++j) { const int n = (lane >> 3) + 8 * j; const LAS float* s = scr + (8 * c) * 33 + n;
        u32x4 o; o.x = cvt_pk_bf16(s[0 * 33], s[1 * 33]); o.y = cvt_pk_bf16(s[2 * 33], s[3 * 33]); o.z = cvt_pk_bf16(s[4 * 33], s[5 * 33]); o.w = cvt_pk_bf16(s[6 * 33], s[7 * 33]);
        *(u32x4*)(dst + (size_t)n * ldd + k0 + 8 * c) = o; }
    asm volatile("s_waitcnt lgkmcnt(0)" ::: "memory");
}
constexpr float ACT8_SCALE = 8.f;
#define A8(x) __builtin_amdgcn_fmed3f((x) * ACT8_SCALE, -440.f, 440.f)
constexpr float W8_SCALE = 32.f;
__device__ __forceinline__ void tr_item8(const float* __restrict__ src, int ld, int k0, int c0, int nvalid, unsigned char* dst, int ldd, LAS float* scr, int lane) {
    const int c4 = (lane & 7) * 4, rr = lane >> 3;
    if (nvalid == 32 && ((c0 | ld) & 3) == 0) {
        f32x4 v[8];
#pragma unroll
        for (int i = 0; i < 8; ++i) v[i] = *(const f32x4*)(src + (size_t)(k0 + 8 * i + rr) * ld + c0 + c4);
#pragma unroll
        for (int i = 0; i < 8; ++i) { LAS float* p = scr + (8 * i + rr) * 33 + c4; p[0] = v[i].x; p[1] = v[i].y; p[2] = v[i].z; p[3] = v[i].w; }
    } else {
#pragma unroll 8
        for (int i = 0; i < 32; ++i) { const int kk = 2 * i + (lane >> 5), cc = lane & 31;
            scr[kk * 33 + cc] = (cc < nvalid) ? src[(size_t)(k0 + kk) * ld + c0 + cc] : 0.f; }
    }
    asm volatile("s_waitcnt lgkmcnt(0)" ::: "memory");
    const int c = lane & 7;
#pragma unroll
    for (int j = 0; j < 4; ++j) { const int n = (lane >> 3) + 8 * j; const LAS float* s = scr + (8 * c) * 33 + n;
        u32x2 o; o.x = pk4_fp8(s[0 * 33] * W8_SCALE, s[1 * 33] * W8_SCALE, s[2 * 33] * W8_SCALE, s[3 * 33] * W8_SCALE); o.y = pk4_fp8(s[4 * 33] * W8_SCALE, s[5 * 33] * W8_SCALE, s[6 * 33] * W8_SCALE, s[7 * 33] * W8_SCALE);
        *(u32x2*)(dst + (size_t)n * ldd + k0 + 8 * c) = o; }
    asm volatile("s_waitcnt lgkmcnt(0)" ::: "memory");
}
__device__ __forceinline__ void p0_phase(Frame& F) {
    LAS float* cond = (LAS float*)(F.lds + 8 * 8448);
    LAS float* part = (LAS float*)(F.lds + 8 * 8448 + 32768);
    for (int i = F.tid; i < BATCH * DM; i += NTHREADS) { const float v = ((const float*)F.ap->in[1])[i]; cond[i] = v * __builtin_amdgcn_rcpf(1.f + __expf(-v)); }
    __syncthreads();
#pragma unroll 1
    for (int item = F.bid; item < 384; item += F.G) {
        const int col = item * 16 + (F.lane & 15), kq = F.lane >> 4, kb = 128 * F.wave + kq;
        const float* wp = ((const float*)F.ap->in[2]) + (size_t)kb * 6144 + col;
        float wv[32];
#pragma unroll
        for (int i = 0; i < 32; ++i) wv[i] = wp[(size_t)(4 * i) * 6144];
        float acc[8];
#pragma unroll
        for (int b = 0; b < 8; ++b) acc[b] = 0.f;
#pragma unroll
        for (int i = 0; i < 32; ++i) {
#pragma unroll
            for (int b = 0; b < 8; ++b) acc[b] += cond[b * DM + kb + 4 * i] * wv[i]; }
#pragma unroll
        for (int b = 0; b < 8; ++b) { float v = acc[b]; v += __shfl_xor(v, 16); v += __shfl_xor(v, 32); acc[b] = v; }
        if (kq == 0) {
#pragma unroll
            for (int b = 0; b < 8; ++b) part[(F.wave * 8 + b) * 16 + (F.lane & 15)] = acc[b]; }
        __syncthreads();
        if (F.tid < 128) { const int b = F.tid >> 4, c = F.tid & 15; float s = ((const float*)F.ap->in[3])[item * 16 + c];
#pragma unroll
            for (int w = 0; w < 8; ++w) s += part[(w * 8 + b) * 16 + c];
            WSP(float, WS_MOD)[b * 6144 + item * 16 + c] = s; }
        __syncthreads();
    }
    LAS float* scr = (LAS float*)(F.lds + F.wave * 8448);
    const int gw = F.bid * NWAVES + F.wave, NGW = F.G * NWAVES;
    constexpr int I_WIN = 16 * 128, I_WP = 8 * 32, I_WO = 16 * 32, I_W13 = 32 * 256, I_W2 = 32 * 128;
    constexpr int NITEMS = I_WIN;
    for (int it = gw; it < NITEMS; it += NGW) {
        int r = it;
        if (r < I_WIN) { const int kb = r / 128, nb = r % 128, n0 = 32 * nb; int c0, nv;
            if (n0 < C_LX) { c0 = n0; nv = 32; } else if (n0 < C_WI) { c0 = n0 + 4; nv = 32; } else if (n0 == C_WI) { c0 = 960; nv = 4; } else if (n0 < C_GA) { c0 = 0; nv = 0; } else { c0 = n0 - 60; nv = 32; }
            if (n0 < C_GA) tr_item(((const float*)F.ap->in[5]), 4036, 64 * kb, c0, nv, WSP(bf16_t, WS_WIN) + (size_t)n0 * 1024, 1024, scr, F.lane);
            else tr_item8(((const float*)F.ap->in[5]), 4036, 64 * kb, c0, nv, WSP(unsigned char, WS_WIN8) + (size_t)(n0 - C_GA) * 1024, 1024, scr, F.lane);
            }
    }
    for (int i = F.bid * NTHREADS + F.tid; i < 48 * 1024; i += F.G * NTHREADS) { const int r = i >> 10, k = i & 1023;
        const float v = r < 4 ? ((const float*)F.ap->in[19])[k * 4 + r] : r < 36 ? ((const float*)F.ap->in[21])[k * 32 + (r - 4)] : 0.f;
        const unsigned hi = f2bf(v); const float rem = v - bf2f((unsigned short)hi);
        WSP(bf16_t, WS_WRH)[i] = (bf16_t)hi; WSP(bf16_t, WS_WRL)[i] = (bf16_t)f2bf(rem); }
}

__device__ __forceinline__ void conv_experts(Frame& F) {
    int lane_ = F.lane, wv_ = F.wave; asm volatile("" : "+v"(lane_), "+s"(wv_));
    LAS float* scr = (LAS float*)(F.lds + wv_ * 8448);
    const int gw = F.bid * NWAVES + wv_, NGW = F.G * NWAVES;
    constexpr int I_WP = 8 * 32, I_WO = 16 * 32, I_W13 = 32 * 256, I_W2 = 32 * 128;
    __syncthreads();
#pragma unroll 1
    for (int it = gw; it < 2 * I_WP + I_WO + I_W13 + I_W2; it += NGW) {
        int r = it;
        if (r < I_WP) { const int kb = r / 32, nb = r % 32; tr_item8(((const float*)F.ap->in[15]), 1024, 64 * kb, 32 * nb, 32, WSP(unsigned char, WS_WPA) + (size_t)(32 * nb) * 512, 512, scr, lane_); continue; } r -= I_WP;
        if (r < I_WP) { const int kb = r / 32, nb = r % 32; tr_item8(((const float*)F.ap->in[16]), 1024, 64 * kb, 32 * nb, 32, WSP(unsigned char, WS_WPB) + (size_t)(32 * nb) * 512, 512, scr, lane_); continue; } r -= I_WP;
        if (r < I_WO) { const int kb = r / 32, nb = r % 32; tr_item8(((const float*)F.ap->in[17]), 1024, 64 * kb, 32 * nb, 32, WSP(unsigned char, WS_WOUT) + (size_t)(32 * nb) * 1024, 1024, scr, lane_); continue; } r -= I_WO;
        if (r < I_W13) { const int e = r / 256, r2 = r % 256, kb = r2 / 16, nb = r2 % 16, n0 = 32 * nb, j = n0 >> 8, half = (n0 >> 7) & 1, cc0 = n0 & 127;
            const float* src = (half ? ((const float*)F.ap->in[24]) : ((const float*)F.ap->in[23])) + (size_t)e * 1024 * 256;
            tr_item8(src, 256, 64 * kb, 128 * j + cc0, 32, WSP(unsigned char, WS_W13) + ((size_t)e * 512 + n0) * 1024, 1024, scr, lane_); continue; } r -= I_W13;
        { const int e = r / 128, r2 = r % 128, kb = r2 / 32, nb = r2 % 32;
            tr_item8(((const float*)F.ap->in[25]) + (size_t)e * 256 * 1024, 1024, 64 * kb, 32 * nb, 32, WSP(unsigned char, WS_W2) + ((size_t)e * 1024 + 32 * nb) * 256, 256, scr, lane_); }
    }
    __syncthreads();
}

__device__ __forceinline__ void p1a_phase(Frame& F) {
    const int gw = F.bid * NWAVES + F.wave, NGW = F.G * NWAVES;
    const float* mod = WSP(float, WS_MOD);
    bf16_t* H = WSP(bf16_t, WS_H);
    const float* nmw = (const float*)F.ap->in[4];
#pragma unroll 1
    for (int row0 = 4 * gw; row0 < NTOK; row0 += 4 * NGW) {
        const int b = row0 / SEQ;
        f32x4 v[4][4];
#pragma unroll
        for (int r = 0; r < 4; ++r) { const f32x4* xr = (const f32x4*)(((const float*)F.ap->in[0]) + (size_t)(row0 + r) * DM) + F.lane;
#pragma unroll
            for (int j = 0; j < 4; ++j) v[r][j] = xr[64 * j]; }
        f32x4 gg[4], sh[4];
#pragma unroll
        for (int j = 0; j < 4; ++j) { const int col = 4 * F.lane + 256 * j; gg[j] = *(const f32x4*)(nmw + col) * (*(const f32x4*)(mod + b * 6144 + 1024 + col) + 1.f); sh[j] = *(const f32x4*)(mod + b * 6144 + col); }
#pragma unroll
        for (int r = 0; r < 4; ++r) { float s = 0.f;
#pragma unroll
            for (int j = 0; j < 4; ++j) s += (v[r][j].x * v[r][j].x + v[r][j].y * v[r][j].y) + (v[r][j].z * v[r][j].z + v[r][j].w * v[r][j].w);
            const float rinv = rsqrtf(wave_sum(s) * (1.f / DM) + EPS);
            unsigned long long* o8 = (unsigned long long*)(H + (size_t)(row0 + r) * DM) + F.lane;
            unsigned* o4 = (unsigned*)(F.ws + WS_H8 + (size_t)(row0 + r) * DM) + F.lane;
#pragma unroll
            for (int j = 0; j < 4; ++j) { const f32x4 hv = v[r][j] * rinv * gg[j] + sh[j];
                o8[64 * j] = (unsigned long long)cvt_pk_bf16(hv.x, hv.y) | ((unsigned long long)cvt_pk_bf16(hv.z, hv.w) << 32); o4[64 * j] = pk4_fp8(hv.x, hv.y, hv.z, hv.w); } }
    }
}

struct Unit { const bf16_t* A; const bf16_t* B; int pm, pn, aux, flags; const int* gidx; };
template <bool PERM, class Sched, class Epi>
__device__ __forceinline__ void gemm_naive(int lda, int ldb, int K, const Sched& S, const Epi& E) {
    const int tid = threadIdx.x, wid = __builtin_amdgcn_readfirstlane(tid >> 6), lane = tid & 63, wr = wid >> 2, wc = wid & 3, fr = lane & 15, fq = lane >> 4;
    f32x4 acc[2][2][4][2];
    Unit u;
    for (int i = 0; S.next(i, u); ++i) {
        if (!(u.flags & 1)) {
#pragma unroll
            for (int a = 0; a < 2; ++a)
#pragma unroll
                for (int b = 0; b < 2; ++b)
#pragma unroll
                    for (int m = 0; m < 4; ++m)
#pragma unroll
                        for (int n = 0; n < 2; ++n) acc[a][b][m][n] = (f32x4){0.f, 0.f, 0.f, 0.f};
        }
#pragma unroll 1
        for (int k0 = 0; k0 < K; k0 += 32) {
            bf16x8 bfr[2][2];
#pragma unroll
            for (int bj = 0; bj < 2; ++bj)
#pragma unroll
                for (int n = 0; n < 2; ++n) { const int rho = 16 * n + fr, rr = PERM ? perm32(rho) : rho;
                    bfr[bj][n] = *(const bf16x8*)(u.B + (size_t)(128 * bj + 32 * wc + rr) * ldb + k0 + 8 * fq); }
#pragma unroll
            for (int ai = 0; ai < 2; ++ai) {
                bf16x8 af[4];
#pragma unroll
                for (int m = 0; m < 4; ++m) af[m] = *(const bf16x8*)(u.A + (size_t)(128 * ai + 64 * wr + 16 * m + fr) * lda + k0 + 8 * fq);
#pragma unroll
                for (int bj = 0; bj < 2; ++bj)
#pragma unroll
                    for (int m = 0; m < 4; ++m)
#pragma unroll
                        for (int n = 0; n < 2; ++n) acc[ai][bj][m][n] = __builtin_amdgcn_mfma_f32_16x16x32_bf16(bfr[bj][n], af[m], acc[ai][bj][m][n], 0, 0, 0);
            }
        }
        if (!(u.flags & 2)) E(acc, u, wr, wc, fr, fq);
    }
}


namespace pg8 {
constexpr int BK = 64, HALF = 128, HTB = HALF * BK * 2;
__device__ __forceinline__ int lds_byte(int r, int c) { const int st = (r >> 4) * 2 + (c >> 5), rr = r & 15, cc = c & 31, ob = rr * 64 + cc * 2; return st * 1024 + (ob ^ (((ob >> 9) & 1) << 5)); }
__device__ __forceinline__ void stage_rc(int b, int& R, int& C) { const int st = b / 1024, sb = b % 1024, swz = sb ^ (((sb >> 9) & 1) << 5); R = (st >> 1) * 16 + swz / 64; C = (st & 1) * 32 + (swz % 64) / 2; }
template <class Epi, class Sched, bool ALIGN_EPI, bool GATHER = false, bool FP8 = false>
__device__ __forceinline__ void gemm_phase(LAS unsigned char* lds, int lda, int ldb, int K, const Sched& S, const Epi& E, int scl_a = 0x7f7f7f7f) {
    int tid_ = threadIdx.x; asm volatile("" : "+v"(tid_));
    const int tid = tid_, wid = __builtin_amdgcn_readfirstlane(tid >> 6), lane = tid & 63, wr = wid >> 2, wc = wid & 3, fr = lane & 15, fq = lane >> 4;
    const int nt = K / BK;
    unsigned voffA[2], voffB[2];
#pragma unroll
    for (int i = 0; i < 2; ++i) { int R, C; stage_rc(tid * 16 + i * 8192, R, C); const int Rb = Epi::PERM ? ((R & ~31) + perm32(R & 31)) : R;
        voffA[i] = (unsigned)(R * lda + C) * 2u; voffB[i] = (unsigned)(Rb * ldb + C) * 2u; }
    const size_t kstep = (size_t)(BK * 2);
    const size_t hstepA = GATHER ? 0 : (size_t)HALF * lda * 2, hstepB = (size_t)HALF * ldb * 2;
    unsigned gC[2], gN[2], gcol[2];
#pragma unroll
    for (int i_ = 0; i_ < 2; ++i_) { int R_, C_; stage_rc(tid * 16 + i_ * 8192, R_, C_); gcol[i_] = (unsigned)C_ * 2u; }
#define PG8_GOFF(dst, u) do { _Pragma("unroll") for (int h_ = 0; h_ < 2; ++h_) { unsigned pk_ = 0u; _Pragma("unroll") for (int i_ = 0; i_ < 2; ++i_) { int R_, C_; stage_rc(tid * 16 + i_ * 8192, R_, C_); \
        const int row_ = h_ * HALF + R_; const unsigned tok_ = (unsigned)(u).gidx[4 * (row_ < (u).aux ? row_ : 0)]; pk_ |= tok_ << (16 * i_); } dst[h_] = pk_; } } while (0)
    const unsigned ldsw = (unsigned)wid * 1024u;
    const int aoff = FP8 ? lds_byte(wr * 64 + fr, fq * 16) : lds_byte(wr * 64 + fr, fq * 8), boff = FP8 ? lds_byte(wc * 32 + fr, fq * 16) : lds_byte(wc * 32 + fr, fq * 8);
#define PG8_SA(b, h) (((b) * 2 + (h)) * HTB)
#define PG8_SB(b, h) ((4 + (b) * 2 + (h)) * HTB)
#define PG8_STAGE(bufoff, gbase, voff) do { _Pragma("unroll") for (int _i = 0; _i < 2; ++_i) \
        __builtin_amdgcn_global_load_lds((const unsigned*)((const char*)(gbase) + (voff)[_i]), (LAS unsigned*)(lds + (bufoff) + ldsw + _i * 8192), 16, 0, 0); } while (0)
#define PG8_STAGE_A(b, h, gbase, nx) do { if constexpr (GATHER) { const unsigned pk_ = (nx) ? gN[h] : gC[h]; unsigned vo_[2]; vo_[0] = (pk_ & 0xffffu) * (unsigned)(lda * 2) + gcol[0]; vo_[1] = (pk_ >> 16) * (unsigned)(lda * 2) + gcol[1]; PG8_STAGE(PG8_SA(b, h), gbase, vo_); } \
        else PG8_STAGE(PG8_SA(b, h), (gbase) + (h) * hstepA, voffA); } while (0)
#define PG8_LDA8(dst, b, h) do { _Pragma("unroll") for (int m = 0; m < 4; ++m) { const LAS u32x4* p_ = (const LAS u32x4*)(lds + PG8_SA(b, h) + aoff + m * 2048); const u32x4 x_ = p_[0], y_ = p_[1]; \
        dst[m] = __builtin_bit_cast(v8i32, __builtin_shufflevector(x_, y_, 0, 1, 2, 3, 4, 5, 6, 7)); } } while (0)
#define PG8_LDB8(dst, b, h) do { _Pragma("unroll") for (int n = 0; n < 2; ++n) { const LAS u32x4* p_ = (const LAS u32x4*)(lds + PG8_SB(b, h) + boff + n * 2048); const u32x4 x_ = p_[0], y_ = p_[1]; \
        dst[n] = __builtin_bit_cast(v8i32, __builtin_shufflevector(x_, y_, 0, 1, 2, 3, 4, 5, 6, 7)); } } while (0)
#define PG8_MMA8(ai, bj, At, Bt) do { __builtin_amdgcn_s_setprio(1); _Pragma("unroll") for (int m = 0; m < 4; ++m) _Pragma("unroll") for (int n = 0; n < 2; ++n) \
        asm volatile("v_mfma_scale_f32_16x16x128_f8f6f4 %0, %1, %2, %0, %3, %4 op_sel_hi:[0,0,0]" : "+v"(acc[ai][bj][m][n]) : "v"(Bt[n]), "v"(At[m]), "v"(sclW), "v"(sclA));   \
        __builtin_amdgcn_s_setprio(0); } while (0)
#define PG8_LDA(dst, b, h) do { _Pragma("unroll") for (int m = 0; m < 4; ++m) _Pragma("unroll") for (int k = 0; k < 2; ++k) dst[m][k] = *(const LAS bf16x8*)(lds + PG8_SA(b, h) + aoff + m * 2048 + k * 1024); } while (0)
#define PG8_LDB(dst, b, h) do { _Pragma("unroll") for (int n = 0; n < 2; ++n) _Pragma("unroll") for (int k = 0; k < 2; ++k) dst[n][k] = *(const LAS bf16x8*)(lds + PG8_SB(b, h) + boff + n * 2048 + k * 1024); } while (0)
#define PG8_MMA(ai, bj, At, Bt) do { __builtin_amdgcn_s_setprio(1); _Pragma("unroll") for (int m = 0; m < 4; ++m) _Pragma("unroll") for (int n = 0; n < 2; ++n) _Pragma("unroll") for (int k = 0; k < 2; ++k) \
        acc[ai][bj][m][n] = __builtin_amdgcn_mfma_f32_16x16x32_bf16(Bt[n][k], At[m][k], acc[ai][bj][m][n], 0, 0, 0); __builtin_amdgcn_s_setprio(0); } while (0)
#define PG8_WAIT_V(n) asm volatile("s_waitcnt vmcnt(" #n ")" ::: "memory")
#define PG8_WAIT_L(n) asm volatile("s_waitcnt lgkmcnt(" #n ")" ::: "memory")
#define PG8_BAR __builtin_amdgcn_s_barrier()
#define PG8_SCHED __builtin_amdgcn_sched_barrier(0)
#define PG8_ZERO() do { _Pragma("unroll") for (int a = 0; a < 2; ++a) _Pragma("unroll") for (int b = 0; b < 2; ++b) _Pragma("unroll") for (int m = 0; m < 4; ++m) _Pragma("unroll") for (int n = 0; n < 2; ++n) acc[a][b][m][n] = (f32x4){0.f, 0.f, 0.f, 0.f}; } while (0)
    Unit cur, nxt; int ui = 0;
    if (!S.next(0, cur)) return;
    f32x4 acc[2][2][4][2];
    PG8_ZERO();
    bf16x8 At[4][2], B0[2][2], B1[2][2]; v8i32 At8[4], B08[2], B18[2];
    int sclW = 0x7a7a7a7a, sclA = scl_a; asm volatile("" : "+v"(sclW), "+v"(sclA));
#define PG8_XLDA(b, h) do { if constexpr (FP8) PG8_LDA8(At8, b, h); else PG8_LDA(At, b, h); } while (0)
#define PG8_XLDB0(b, h) do { if constexpr (FP8) PG8_LDB8(B08, b, h); else PG8_LDB(B0, b, h); } while (0)
#define PG8_XLDB1(b, h) do { if constexpr (FP8) PG8_LDB8(B18, b, h); else PG8_LDB(B1, b, h); } while (0)
#define PG8_XMMA0(ai, bj) do { if constexpr (FP8) PG8_MMA8(ai, bj, At8, B08); else PG8_MMA(ai, bj, At, B0); } while (0)
#define PG8_XMMA1(ai, bj) do { if constexpr (FP8) PG8_MMA8(ai, bj, At8, B18); else PG8_MMA(ai, bj, At, B1); } while (0)
    const char* cA = (const char*)cur.A; const char* cB = (const char*)cur.B;
    if constexpr (GATHER) { PG8_GOFF(gC, cur); gN[0] = gC[0]; gN[1] = gC[1]; }
    PG8_STAGE(PG8_SB(0, 0), cB, voffB); PG8_STAGE(PG8_SB(0, 1), cB + hstepB, voffB); PG8_STAGE_A(0, 0, cA, false); PG8_STAGE_A(0, 1, cA, false);
    if (wr == 1) PG8_BAR;
    PG8_WAIT_V(2); PG8_BAR;
    PG8_STAGE(PG8_SB(1, 0), cB + kstep, voffB); PG8_STAGE_A(1, 0, cA + kstep, false); PG8_STAGE(PG8_SB(1, 1), cB + hstepB + kstep, voffB);
    PG8_WAIT_V(6); PG8_BAR;
    int pre_tk[8];
#define PG8_KLOOP() _Pragma("unroll 1") \
        for (int t = 0; t < nt; t += 2) { \
            const bool last = (t == nt - 2); \
            const char* a1 = cA + (size_t)(t + 1) * kstep; \
            const char* a2 = last ? nA : cA + (size_t)(t + 2) * kstep; const char* b2 = last ? nB : cB + (size_t)(t + 2) * kstep; \
            const char* a3 = a2 + kstep; const char* b3 = b2 + kstep; \
            const bool nx = last && has_next; \
            PG8_XLDB0(0, 0); PG8_XLDB1(0, 1); PG8_SCHED; PG8_XLDA(0, 0); PG8_STAGE_A(1, 1, a1, false); \
            PG8_WAIT_V(8); PG8_WAIT_L(0); PG8_BAR; PG8_XMMA0(0, 0); PG8_XMMA1(0, 1); PG8_BAR; PG8_SCHED; \
            PG8_XLDA(0, 1); PG8_STAGE(PG8_SB(0, 0), b2, voffB); PG8_STAGE(PG8_SB(0, 1), b2 + hstepB, voffB); PG8_STAGE_A(0, 0, a2, nx); \
            PG8_WAIT_V(8); PG8_WAIT_L(0); PG8_BAR; PG8_XMMA0(1, 0); PG8_XMMA1(1, 1); PG8_BAR; PG8_SCHED; \
            PG8_XLDB0(1, 0); PG8_XLDB1(1, 1); PG8_SCHED; PG8_XLDA(1, 0); PG8_STAGE_A(0, 1, a2, nx); \
            PG8_WAIT_V(8); PG8_WAIT_L(0); PG8_BAR; PG8_XMMA0(0, 0); PG8_XMMA1(0, 1); PG8_BAR; PG8_SCHED; \
            PG8_XLDA(1, 1); PG8_STAGE(PG8_SB(1, 0), b3, voffB); PG8_STAGE(PG8_SB(1, 1), b3 + hstepB, voffB); PG8_STAGE_A(1, 0, a3, nx); \
            PG8_WAIT_V(8); PG8_WAIT_L(0); PG8_BAR; PG8_XMMA0(1, 0); PG8_XMMA1(1, 1); PG8_BAR; PG8_SCHED; \
        }
    for (;;) {
        bool has_next = S.next(ui + 1, nxt);
        if constexpr (Epi::PRE) { if (!(cur.flags & 1)) E.prefetch(pre_tk, cur, wr, wc, fr, fq); }
        const char* nA = has_next ? (const char*)nxt.A : cA; const char* nB = has_next ? (const char*)nxt.B : cB;
        if constexpr (GATHER) { if (has_next) PG8_GOFF(gN, nxt); }
        PG8_KLOOP();
        if constexpr (ALIGN_EPI) { if (wr == 0) PG8_BAR; }
        if constexpr (FP8) asm volatile("s_nop 15\n\ts_nop 7" ::: "memory");
        if constexpr (Epi::MID) {
            E.mid(acc, cur, wr, wc, fr, fq);
            cur = nxt; cA = nA; cB = nB; ++ui;
            if constexpr (ALIGN_EPI) { if (wr == 1) PG8_BAR; }
            has_next = S.next(ui + 1, nxt);
            nA = has_next ? (const char*)nxt.A : cA; nB = has_next ? (const char*)nxt.B : cB;
            PG8_KLOOP();
            if constexpr (ALIGN_EPI) { if (wr == 0) PG8_BAR; }
            if constexpr (FP8) asm volatile("s_nop 15\n\ts_nop 7" ::: "memory");
            E(acc, cur, wr, wc, fr, fq);
        } else {
            if (!(cur.flags & 2)) { if constexpr (Epi::PRE) E(acc, cur, wr, wc, fr, fq, pre_tk); else E(acc, cur, wr, wc, fr, fq); }
        }
        if (!has_next) break;
        if constexpr (Epi::MID) PG8_ZERO(); else { if (!(nxt.flags & 1)) PG8_ZERO(); }
        cur = nxt; cA = nA; cB = nB; ++ui;
        if constexpr (GATHER) { gC[0] = gN[0]; gC[1] = gN[1]; }
        if constexpr (ALIGN_EPI) { if (wr == 1) PG8_BAR; }
    }
#undef PG8_KLOOP
    PG8_WAIT_V(0);
    if constexpr (!ALIGN_EPI) { if (wr == 0) PG8_BAR; }
    PG8_BAR;
#undef PG8_SA
#undef PG8_SB
#undef PG8_STAGE
#undef PG8_XLDA
#undef PG8_XLDB0
#undef PG8_XLDB1
#undef PG8_XMMA0
#undef PG8_XMMA1
#undef PG8_LDA8
#undef PG8_LDB8
#undef PG8_MMA8
#undef PG8_STAGE_A
#undef PG8_GOFF
#undef PG8_LDA
#undef PG8_LDB
#undef PG8_MMA
#undef PG8_WAIT_V
#undef PG8_WAIT_L
#undef PG8_BAR
#undef PG8_SCHED
#undef PG8_ZERO
}
}
#ifndef MK_NAIVE_GEMM
#define MK_NAIVE_GEMM 0
#endif
template <bool GATHER = false, bool FP8 = false, class Sched, class Epi>
__device__ __forceinline__ void run_gemm(LAS unsigned char* lds, int lda, int ldb, int K, const Sched& S, const Epi& E, int scl_a = 0x7f7f7f7f) {
    pg8::gemm_phase<Epi, Sched, true, GATHER, FP8>(lds, lda, ldb, K, S, E, scl_a);
}

struct SchedProj { const bf16_t* A; const bf16_t* B; int rowu  , pn0  , G, c;
    __device__ __forceinline__ bool next(int i, Unit& u) const { const int L = i * G + c; if (L >= 64 * 8) return false;
        const int gid = L / 64, w = L % 64; u.pm = gid * 8 + (w % 8); u.pn = pn0 + w / 8;
        u.A = A + (size_t)u.pm * 256 * rowu; u.B = B + (size_t)(w / 8) * 256 * rowu; u.aux = 0; u.flags = 0; u.gidx = nullptr; return true; } };
struct EpiProj {
    static constexpr bool PERM = true; static constexpr bool PRE = false; static constexpr bool MID = false;
    unsigned char* ws;
    __device__ __forceinline__ void operator()(const f32x4 (&acc)[2][2][4][2], const Unit& u, int wr, int wc, int fr, int fq) const {
#pragma unroll
        for (int bj = 0; bj < 2; ++bj) {
            const int cg = u.pn * 256 + bj * 128 + wc * 32;
            const int col = cg + 8 * fq;
            bf16_t* dst; int ld, cb; int mode = 0;
            bf16_t* const Vt = (bf16_t*)(ws + WS_VT); float* const WI = (float*)(ws + WS_WI);
            if (cg < C_K) { dst = (bf16_t*)(ws + WS_Q); ld = 512; cb = C_Q; }
            else if (cg < C_V) { dst = (bf16_t*)(ws + WS_K); ld = 64; cb = C_K; }
            else if (cg < C_QI) { dst = (bf16_t*)(ws + WS_VR); ld = 64; cb = C_V; mode = 2; }
            else if (cg < C_KI) { dst = (bf16_t*)(ws + WS_QI); ld = 256; cb = C_QI; }
            else if (cg < C_LX) { dst = (bf16_t*)(ws + WS_KI); ld = 64; cb = C_KI; }
            else if (cg < C_LG) { dst = (bf16_t*)(ws + WS_LX); ld = 512; cb = C_LX; mode = 4; }
            else if (cg < C_WI) { dst = (bf16_t*)(ws + WS_LG); ld = 512; cb = C_LG; }
            else if (cg < C_PAD + 28) { dst = nullptr; ld = 0; cb = C_WI; mode = 3; }
            else if (cg < C_GA) continue;
            else if (cg < C_GB) { dst = (bf16_t*)(ws + WS_GA); ld = 1024; cb = C_GA; mode = 1; }
            else { dst = (bf16_t*)(ws + WS_GB); ld = 1024; cb = C_GB; mode = 1; }
#pragma unroll
            for (int ai = 0; ai < 2; ++ai)
#pragma unroll
                for (int m = 0; m < 4; ++m) {
                    const int row = u.pm * 256 + ai * 128 + wr * 64 + m * 16 + fr;
                    f32x4 v0 = acc[ai][bj][m][0], v1 = acc[ai][bj][m][1];
                    if (mode == 3) { if (fq == 0) *(f32x4*)(WI + (size_t)row * 4) = v0; continue; }
                    if (mode == 1) {
#pragma unroll
                        for (int e = 0; e < 4; ++e) { v0[e] = sigmoidf_(v0[e]) * 255.f; v1[e] = sigmoidf_(v1[e]) * 255.f; }
                        unsigned q0 = 0u, q1 = 0u;
                        q0 = __builtin_amdgcn_cvt_pk_u8_f32(v0[0], 0, q0); q0 = __builtin_amdgcn_cvt_pk_u8_f32(v0[1], 1, q0); q0 = __builtin_amdgcn_cvt_pk_u8_f32(v0[2], 2, q0); q0 = __builtin_amdgcn_cvt_pk_u8_f32(v0[3], 3, q0);
                        q1 = __builtin_amdgcn_cvt_pk_u8_f32(v1[0], 0, q1); q1 = __builtin_amdgcn_cvt_pk_u8_f32(v1[1], 1, q1); q1 = __builtin_amdgcn_cvt_pk_u8_f32(v1[2], 2, q1); q1 = __builtin_amdgcn_cvt_pk_u8_f32(v1[3], 3, q1);
                        *(u32x2*)((unsigned char*)dst + (size_t)row * 1024 + (col - cb)) = (u32x2){q0, q1}; continue; }
                    u32x4 w; w.x = pk2(v0[0], v0[1]); w.y = pk2(v0[2], v0[3]); w.z = pk2(v1[0], v1[1]); w.w = pk2(v1[2], v1[3]);
                    if (mode == 4) { const int bb = row / SEQ, tt = row % SEQ, c8 = (col - cb) >> 3; *(u32x4*)(dst + (((size_t)bb * 64 + c8) * SEQ + tt) * 8) = w; }
                    else if (mode != 2) *(u32x4*)(dst + (size_t)row * ld + (col - cb)) = w;
                    if (mode == 2) {
                        const int b = row / SEQ, t = row % SEQ, d0 = col - cb; bf16_t* vp = Vt + ((size_t)b * 64 + d0) * SEQ + (t & ~15) + vt_pos(t & 15);
                        vp[0 * SEQ] = (bf16_t)(w.x & 0xffff); vp[1 * SEQ] = (bf16_t)(w.x >> 16); vp[2 * SEQ] = (bf16_t)(w.y & 0xffff); vp[3 * SEQ] = (bf16_t)(w.y >> 16);
                        vp[4 * SEQ] = (bf16_t)(w.z & 0xffff); vp[5 * SEQ] = (bf16_t)(w.z >> 16); vp[6 * SEQ] = (bf16_t)(w.w & 0xffff); vp[7 * SEQ] = (bf16_t)(w.w >> 16); }
                }
        }
    }
};

__device__ __forceinline__ unsigned fbits(float f) { return __builtin_bit_cast(unsigned, f); }
__device__ __forceinline__ float bitsf(unsigned u) { return __builtin_bit_cast(float, u); }
__device__ __forceinline__ unsigned bfi_b32(unsigned m, unsigned a, unsigned b) { return __builtin_amdgcn_bitop3_b32(a, b, m, 0xe4); }
__device__ __forceinline__ float xor32_max(float x) { typedef unsigned u32x2_ __attribute__((ext_vector_type(2))); const unsigned u = __builtin_bit_cast(unsigned, x);
    const u32x2_ r = __builtin_amdgcn_permlane32_swap(u, u, false, false); return fmaxf(__builtin_bit_cast(float, r.x), __builtin_bit_cast(float, r.y)); }
__device__ __forceinline__ float sum8_dpp(float s) {
    s += __builtin_bit_cast(float, __builtin_amdgcn_update_dpp(0, __builtin_bit_cast(int, s), 0xB1, 0xf, 0xf, true));
    s += __builtin_bit_cast(float, __builtin_amdgcn_update_dpp(0, __builtin_bit_cast(int, s), 0x4E, 0xf, 0xf, true));
    s += __builtin_bit_cast(float, __builtin_amdgcn_update_dpp(0, __builtin_bit_cast(int, s), 0x141, 0xf, 0xf, true));
    return s; }
__device__ __forceinline__ unsigned sortkey(float f) { const unsigned u = __builtin_bit_cast(unsigned, f); return (u & 0x80000000u) ? ~u : (u | 0x80000000u); }
typedef float f32x16 __attribute__((ext_vector_type(16)));
constexpr int AL_QI = 0, AL_HIST = 16896, AL_MASK = 49792, AL_EQ = 57984, AL_RK = 66176, AL_QST = 74368, AL_FLAG = 74368 + 512, AL_OST = 75008, AL_KV = AL_HIST  , KT_STRIDE = 144, VT_STRIDE = 80, KT_BYTES = 32 * KT_STRIDE, KV_BUF = KT_BYTES + 64 * VT_STRIDE, AL_END = AL_OST + 8 * 4608;
static_assert(2 * KV_BUF <= 32 * 257 * 4, "K/V ring fits the histogram region");
constexpr int QI_STRIDE = 528, HIST_STRIDE = 257, OST_STRIDE = 144;
static_assert(AL_END <= RING_BYTES, "attention LDS map");
__device__ __forceinline__ int crow(int i, int hi) { return (i & 3) + 8 * (i >> 2) + 4 * hi; }
__device__ __forceinline__ void attn_unit(Frame& F, int b, int c, int half) {
    int tid_ = F.tid, w_ = F.wave; asm volatile("" : "+v"(tid_), "+s"(w_));
    const int tid = tid_, lane = tid & 63, w = w_, r32 = lane & 31, hi = lane >> 5;
    const int t0 = 64 * c + 32 * half, nk = 64 * (c + 1), ntile = nk >> 5, tok0 = b * SEQ + t0;
    LAS unsigned char* L = F.lds;
    LAS unsigned* hist = (LAS unsigned*)(L + AL_HIST); LAS unsigned* maskw = (LAS unsigned*)(L + AL_MASK); LAS unsigned* eqw = (LAS unsigned*)(L + AL_EQ);
    LAS float* rkL = (LAS float*)(L + AL_RK); LAS unsigned* qst = (LAS unsigned*)(L + AL_QST); LAS unsigned* flagw = (LAS unsigned*)(L + AL_FLAG);
    const bf16_t* KI = WSP(bf16_t, WS_KI) + (size_t)b * SEQ * 64;
    const bf16_t* Kb = WSP(bf16_t, WS_K) + (size_t)b * SEQ * 64;
    const bf16_t* Vt = WSP(bf16_t, WS_VT) + (size_t)b * 64 * SEQ;
    const bool do_sel = nk > TOPK;
    __syncthreads();
#if MK_LEAK >= 0
    const unsigned long long tu0_ = __builtin_amdgcn_s_memrealtime();
#endif
    { const bf16_t* QI = WSP(bf16_t, WS_QI) + (size_t)tok0 * 256;
#pragma unroll
      for (int i = 0; i < 2; ++i) { const int idx = tid + 512 * i, row = idx >> 5, ch = idx & 31;
          *(LAS u32x4*)(L + AL_QI + row * QI_STRIDE + ch * 16) = *(const u32x4*)(QI + (size_t)row * 256 + ch * 8); } }
    if (tid == 0) flagw[0] = 0u;
    if (tid < 32) { qst[tid * 4 + 0] = 0u; qst[tid * 4 + 1] = (unsigned)TOPK; qst[tid * 4 + 2] = 0u; qst[tid * 4 + 3] = 0u; }
    __syncthreads();
    f32x16 sc[8];
    if (do_sel) {
        const f32x4 wv = *(const f32x4*)(WSP(float, WS_WI) + (size_t)(tok0 + r32) * 4) * 0.0625f;
        bf16x8 afn[4];
        { int roff = (32 * w + r32) * 64 + 8 * hi; asm volatile("" : "+v"(roff));
#pragma unroll
          for (int ks = 0; ks < 4; ++ks) afn[ks] = *(const bf16x8*)(KI + roff + 16 * ks); }
#pragma unroll
        for (int j = 0; j < 8; ++j) {
            const int kt = w + 8 * j;
#pragma unroll
            for (int i = 0; i < 16; ++i) sc[j][i] = 0.f;
            if (kt < ntile) {
                bf16x8 af[4];
#pragma unroll
                for (int ks = 0; ks < 4; ++ks) af[ks] = afn[ks];
                if (j < 7 && kt + 8 < ntile) { int roff = (32 * (kt + 8) + r32) * 64 + 8 * hi; asm volatile("" : "+v"(roff));
#pragma unroll
                    for (int ks = 0; ks < 4; ++ks) afn[ks] = *(const bf16x8*)(KI + roff + 16 * ks); }
                int qoff = r32 * QI_STRIDE + hi * 16; asm volatile("" : "+v"(qoff));
                bf16x8 qA[4], qB[4];
#define ATT_QLD(Q, H) do { _Pragma("unroll") for (int ks = 0; ks < 4; ++ks) Q[ks] = *(const LAS bf16x8*)(L + AL_QI + qoff + (H) * 128 + ks * 32); } while (0)
#define ATT_HEAD(Q, H) do { f32x16 acc; \
                    _Pragma("unroll") for (int i = 0; i < 16; ++i) acc[i] = 0.f; \
                    _Pragma("unroll") for (int ks = 0; ks < 4; ++ks) acc = __builtin_amdgcn_mfma_f32_32x32x16_bf16(af[ks], Q[ks], acc, 0, 0, 0); \
                    asm volatile("s_nop 15\n\ts_nop 7" : "+v"(acc));                \
                    _Pragma("unroll") for (int i = 0; i < 16; ++i) sc[j][i] += relu_f(acc[i]) * wv[H]; \
                    __builtin_amdgcn_sched_barrier(0); } while (0)
                ATT_QLD(qA, 0); ATT_QLD(qB, 1); __builtin_amdgcn_sched_barrier(0);
                ATT_HEAD(qA, 0); ATT_QLD(qA, 2); __builtin_amdgcn_sched_barrier(0);
                ATT_HEAD(qB, 1); ATT_QLD(qB, 3); __builtin_amdgcn_sched_barrier(0);
                ATT_HEAD(qA, 2);
                ATT_HEAD(qB, 3);
#undef ATT_HEAD
#undef ATT_QLD
#pragma unroll
                for (int i = 0; i < 16; ++i) sc[j][i] = __builtin_bit_cast(float, sortkey(sc[j][i]));
            }
        }
    }
    unsigned Tq = 0u; bool ordered = false;
    if (do_sel) {
        unsigned prefix = 0u;
        for (int i = tid; i < 32 * HIST_STRIDE; i += NTHREADS) hist[i] = 0u;
        __syncthreads();
#pragma unroll 1
        for (int pass = 0; pass < 2; ++pass) {
            const int shift = 24 - 8 * pass;
#pragma unroll
            for (int j = 0; j < 8; ++j) { const int kt = w + 8 * j;
                if (kt < ntile) {
#pragma unroll
                    for (int i = 0; i < 16; ++i) { const unsigned key = fbits(sc[j][i]);
                        const bool m = (pass == 0) || ((key >> (shift + 8)) == (prefix >> (shift + 8)));
                        if (m) __hip_atomic_fetch_add(hist + r32 * HIST_STRIDE + ((key >> shift) & 255u), 1u, __ATOMIC_RELAXED, __HIP_MEMORY_SCOPE_WORKGROUP); } } }
            __syncthreads();
            {
                const int q = tid >> 4, p = tid & 15, b0 = 16 * (15 - p);
                const unsigned need = qst[q * 4 + 1];
                unsigned s = 0u, hv[16];
#pragma unroll
                for (int e = 0; e < 16; ++e) { hv[e] = hist[q * HIST_STRIDE + b0 + e]; s += hv[e]; hist[q * HIST_STRIDE + b0 + e] = 0u; }
                unsigned P = s;
#pragma unroll
                for (int o = 1; o < 16; o <<= 1) { const unsigned t = __shfl_up(P, o, 16); if (p >= o) P += t; }
                const unsigned Pprev = P - s;
                if (P >= need && Pprev < need) { unsigned run = Pprev; bool done = false;
#pragma unroll
                    for (int e = 15; e >= 0; --e) { const unsigned hc = hv[e]; if (done) continue;
                        if (run + hc >= need) { done = true; qst[q * 4 + 0] = qst[q * 4 + 0] | ((unsigned)(b0 + e) << shift); qst[q * 4 + 1] = need - run; qst[q * 4 + 2] = hc; }
                        else run += hc; } }
            }
            __syncthreads();
            prefix = qst[r32 * 4 + 0];
        }
        Tq = prefix;
        const unsigned needq = qst[r32 * 4 + 1], eqc = qst[r32 * 4 + 2];
        if (needq < eqc) flagw[0] = 1u;
        __syncthreads();
        ordered = flagw[0] != 0u;
    }
#pragma unroll
    for (int j = 0; j < 8; ++j) { const int kt = w + 8 * j;
        if (kt < ntile) { unsigned mw = 0xffffffffu, ew = 0u;
            if (do_sel) { mw = 0u;
#pragma unroll
                for (int i = 0; i < 16; ++i) { const unsigned key = fbits(sc[j][i]) >> 16; const int bit = crow(i, hi);
                    const bool gt = key > (Tq >> 16), eq = key == (Tq >> 16);
                    mw |= ((gt || (eq && !ordered)) ? 1u : 0u) << bit; ew |= (eq ? 1u : 0u) << bit; }
                mw |= __shfl_xor(mw, 32); ew |= __shfl_xor(ew, 32); }
            if (hi == 0) { maskw[kt * 32 + r32] = mw; if (ordered) eqw[kt * 32 + r32] = ew; } } }
    __syncthreads();
    if (ordered) {
        const int q = tid >> 4, p = tid & 15; const int need = (int)qst[q * 4 + 1];
        unsigned ww[4]; int c = 0;
#pragma unroll
        for (int k = 0; k < 4; ++k) { const int kt = 4 * p + k; ww[k] = (kt < ntile) ? eqw[kt * 32 + q] : 0u; c += __popc(ww[k]); }
        int P = c;
#pragma unroll
        for (int o = 1; o < 16; o <<= 1) { const int t = __shfl_up(P, o, 16); if (p >= o) P += t; }
        int quota = need - (P - c); quota = quota < 0 ? 0 : (quota > c ? c : quota);
#pragma unroll
        for (int k = 0; k < 4; ++k) { unsigned w2 = ww[k]; if (quota > 0 && w2 != 0u) { const int pc = __popc(w2); unsigned add = w2;
                if (pc > quota) { add = 0u; while (__popc(add) < quota) { const unsigned lsb = w2 & (0u - w2); add |= lsb; w2 ^= lsb; } }
                quota -= __popc(add); maskw[(4 * p + k) * 32 + q] |= add; } }
        __syncthreads();
    }
#if MK_LEAK >= 0
    const unsigned long long tu1_ = __builtin_amdgcn_s_memrealtime();
#endif
    {
        const int h = w; const int tq = t0 + r32;
        bf16x8 qf[4];
        { const bf16_t* Q = WSP(bf16_t, WS_Q) + (size_t)(tok0 + r32) * 512 + h * 64;
          float qv[4][8]; float ss = 0.f;
#pragma unroll
          for (int ks = 0; ks < 4; ++ks) { const bf16x8 v = *(const bf16x8*)(Q + 16 * ks + 8 * hi);
#pragma unroll
              for (int e = 0; e < 8; ++e) { qv[ks][e] = bf2f((unsigned short)v[e]); ss += qv[ks][e] * qv[ks][e]; } }
          ss += __shfl_xor(ss, 32);
          const float rq = rsqrtf(ss * (1.f / 64.f) + EPS) * 0.125f * 1.4426950408889634f;
          const float* qnw = (const float*)F.ap->in[6]; const float* knw = (const float*)F.ap->in[7];
#pragma unroll
          for (int ks = 0; ks < 4; ++ks) { u32x4 pk;
              const f32x4 a0 = *(const f32x4*)(qnw + 16 * ks + 8 * hi), a1 = *(const f32x4*)(qnw + 16 * ks + 8 * hi + 4), b0 = *(const f32x4*)(knw + 16 * ks + 8 * hi), b1 = *(const f32x4*)(knw + 16 * ks + 8 * hi + 4);
              pk.x = pk2(qv[ks][0] * rq * a0.x * b0.x, qv[ks][1] * rq * a0.y * b0.y); pk.y = pk2(qv[ks][2] * rq * a0.z * b0.z, qv[ks][3] * rq * a0.w * b0.w);
              pk.z = pk2(qv[ks][4] * rq * a1.x * b1.x, qv[ks][5] * rq * a1.y * b1.y); pk.w = pk2(qv[ks][6] * rq * a1.z * b1.z, qv[ks][7] * rq * a1.w * b1.w);
              qf[ks] = __builtin_bit_cast(bf16x8, pk); } }
        const float slope2 = exp2f(-(float)(h + 1)) * 1.4426950408889634f;
        float m = 0.f;
        f32x16 o0, o1; f32x2_cv lsum = {0.f, 0.f};
#pragma unroll
        for (int i = 0; i < 16; ++i) { o0[i] = 0.f; o1[i] = 0.f; }
        constexpr int K2_STRIDE = 144, K2_BYTES = 64 * K2_STRIDE, KV2_BUF = 2 * K2_BYTES;
        static_assert(2 * KV2_BUF <= AL_MASK, "K/V ring below the mask words");
        const int npair = c + 1;
        const bf16_t* gK = Kb + (size_t)(tid >> 3) * 64 + (tid & 7) * 8;
        const bf16_t* gV = Vt + (size_t)(tid >> 3) * SEQ + (tid & 7) * 8;
        const int lstK = (tid >> 3) * K2_STRIDE + (tid & 7) * 16;
        LAS unsigned char* kvL = L;
#define ATT_STAGE2(BUF, GK, GV) do { u32x4 w_; \
            { float f_[8] = {bflo(GK.x), bfhi(GK.x), bflo(GK.y), bfhi(GK.y), bflo(GK.z), bfhi(GK.z), bflo(GK.w), bfhi(GK.w)}; \
                float ss_ = (f_[0] * f_[0] + f_[1] * f_[1]) + (f_[2] * f_[2] + f_[3] * f_[3]) + (f_[4] * f_[4] + f_[5] * f_[5]) + (f_[6] * f_[6] + f_[7] * f_[7]); \
                ss_ = sum8_dpp(ss_); \
                const float rk_ = __builtin_amdgcn_rsqf(ss_ * (1.f / 64.f) + EPS); \
                w_.x = cvt_pk_bf16(f_[0] * rk_, f_[1] * rk_); w_.y = cvt_pk_bf16(f_[2] * rk_, f_[3] * rk_); w_.z = cvt_pk_bf16(f_[4] * rk_, f_[5] * rk_); w_.w = cvt_pk_bf16(f_[6] * rk_, f_[7] * rk_); } \
            *(LAS u32x4*)(kvL + (BUF) * KV2_BUF + lstK) = w_; *(LAS u32x4*)(kvL + (BUF) * KV2_BUF + K2_BYTES + lstK) = GV; } while (0)
#define ATT_LOADK(KP) (*(const u32x4*)(gK + (size_t)((KP) < npair ? (KP) : npair - 1) * 4096))
#define ATT_LOADV(KP) (*(const u32x4*)(gV + (size_t)((KP) < npair ? (KP) : npair - 1) * 64))
        u32x4 cK = ATT_LOADK(0), cV = ATT_LOADV(0);
        u32x4 nK = ATT_LOADK(1), nV = ATT_LOADV(1);
        ATT_STAGE2(0, cK, cV);
        float ci[16];
#pragma unroll
        for (int i = 0; i < 16; ++i) ci[i] = slope2 * (float)crow(i, hi);
        const float sq = slope2 * (float)tq;
        __syncthreads();
#define ATT_MAX16(S) do { mx = max3f(mx, S[0], S[1]); mx = max3f(mx, S[2], S[3]); mx = max3f(mx, S[4], S[5]); mx = max3f(mx, S[6], S[7]); mx = max3f(mx, S[8], S[9]); mx = max3f(mx, S[10], S[11]); \
            mx = max3f(mx, S[12], S[13]); mx = max3f(mx, S[14], S[15]); } while (0)
#define ATT_PK(P0, P1, S) do { P0.x = cvt_pk_bf16(S[0], S[1]); P0.y = cvt_pk_bf16(S[2], S[3]); P0.z = cvt_pk_bf16(S[4], S[5]); P0.w = cvt_pk_bf16(S[6], S[7]); \
            P1.x = cvt_pk_bf16(S[8], S[9]); P1.y = cvt_pk_bf16(S[10], S[11]); P1.z = cvt_pk_bf16(S[12], S[13]); P1.w = cvt_pk_bf16(S[14], S[15]); } while (0)
#define ATT_TILE2(KP) do { const int kp_ = (KP); \
            const LAS unsigned char* kb = kvL + (kp_ & 1) * KV2_BUF; \
            const unsigned mw0 = maskw[(2 * kp_) * 32 + r32] >> (4 * hi), mw1 = maskw[(2 * kp_ + 1) * 32 + r32] >> (4 * hi); \
            bf16x8 kf0[4], kf1[4];                                                 \
            _Pragma("unroll") for (int ks = 0; ks < 4; ++ks) { kf0[ks] = *(const LAS bf16x8*)(kb + r32 * K2_STRIDE + ks * 32 + hi * 16); kf1[ks] = *(const LAS bf16x8*)(kb + (32 + r32) * K2_STRIDE + ks * 32 + hi * 16); } \
            __builtin_amdgcn_sched_barrier(0); \
            f32x16 S0, S1; \
            if (kp_ < npair - 1) { const float nmt0 = slope2 * (float)(64 * kp_) - m, nmt1 = nmt0 + slope2 * 32.f;        \
                _Pragma("unroll") for (int i = 0; i < 16; ++i) { const int ko = (i & 3) + 8 * (i >> 2); \
                    const unsigned sel0 = (unsigned)__builtin_amdgcn_sbfe((int)mw0, ko, 1), sel1 = (unsigned)__builtin_amdgcn_sbfe((int)mw1, ko, 1); \
                    S0[i] = bitsf(bfi_b32(sel0, fbits(ci[i] + nmt0), 0xff800000u)); S1[i] = bitsf(bfi_b32(sel1, fbits(ci[i] + nmt1), 0xff800000u)); } } \
            else { const float dbase0 = (float)(tq - 64 * kp_ - 4 * hi), dbase1 = dbase0 - 32.f, sqm = sq - m; \
                _Pragma("unroll") for (int i = 0; i < 16; ++i) { const int ko = (i & 3) + 8 * (i >> 2); \
                    const unsigned sel0 = (unsigned)__builtin_amdgcn_sbfe((int)mw0, ko, 1), sel1 = (unsigned)__builtin_amdgcn_sbfe((int)mw1, ko, 1); \
                    S0[i] = bitsf(bfi_b32(sel0, fbits(sqm - slope2 * fabsf(dbase0 - (float)ko)), 0xff800000u)); S1[i] = bitsf(bfi_b32(sel1, fbits(sqm - slope2 * fabsf(dbase1 - (float)ko)), 0xff800000u)); } } \
            _Pragma("unroll") for (int ks = 0; ks < 4; ++ks) { \
                S0 = __builtin_amdgcn_mfma_f32_32x32x16_bf16(kf0[ks], qf[ks], S0, 0, 0, 0); S1 = __builtin_amdgcn_mfma_f32_32x32x16_bf16(kf1[ks], qf[ks], S1, 0, 0, 0); } \
            asm volatile("s_nop 15\n\ts_nop 7" : "+v"(S0), "+v"(S1));             \
            bf16x8 vf[2][4]; \
            _Pragma("unroll") for (int db = 0; db < 2; ++db) _Pragma("unroll") for (int j4 = 0; j4 < 4; ++j4) vf[db][j4] = *(const LAS bf16x8*)(kb + K2_BYTES + (32 * db + r32) * K2_STRIDE + j4 * 32 + hi * 16); \
            float mx = max3f(S0[0], S0[0], S1[0]); \
            ATT_MAX16(S0); ATT_MAX16(S1); \
            mx = fmaxf(mx, __shfl_xor(mx, 32)); \
            if (__any(mx > 8.f)) {                                             \
                const float dl = fmaxf(mx, 0.f), alpha = __builtin_amdgcn_exp2f(-dl); m += dl; \
                _Pragma("unroll") for (int i = 0; i < 16; ++i) { S0[i] -= dl; S1[i] -= dl; o0[i] *= alpha; o1[i] *= alpha; } lsum *= alpha; } \
            _Pragma("unroll") for (int i = 0; i < 16; ++i) { S0[i] = __builtin_amdgcn_exp2f(S0[i]); S1[i] = __builtin_amdgcn_exp2f(S1[i]); } \
            _Pragma("unroll") for (int i = 0; i < 16; i += 2) { lsum += (f32x2_cv){S0[i], S0[i + 1]}; lsum += (f32x2_cv){S1[i], S1[i + 1]}; } \
            u32x4 p00, p01, p10, p11; ATT_PK(p00, p01, S0); ATT_PK(p10, p11, S1); \
            const bf16x8 pf00 = __builtin_bit_cast(bf16x8, p00), pf01 = __builtin_bit_cast(bf16x8, p01), pf10 = __builtin_bit_cast(bf16x8, p10), pf11 = __builtin_bit_cast(bf16x8, p11); \
            o0 = __builtin_amdgcn_mfma_f32_32x32x16_bf16(vf[0][0], pf00, o0, 0, 0, 0); o1 = __builtin_amdgcn_mfma_f32_32x32x16_bf16(vf[1][0], pf00, o1, 0, 0, 0); \
            o0 = __builtin_amdgcn_mfma_f32_32x32x16_bf16(vf[0][1], pf01, o0, 0, 0, 0); o1 = __builtin_amdgcn_mfma_f32_32x32x16_bf16(vf[1][1], pf01, o1, 0, 0, 0); \
            o0 = __builtin_amdgcn_mfma_f32_32x32x16_bf16(vf[0][2], pf10, o0, 0, 0, 0); o1 = __builtin_amdgcn_mfma_f32_32x32x16_bf16(vf[1][2], pf10, o1, 0, 0, 0); \
            o0 = __builtin_amdgcn_mfma_f32_32x32x16_bf16(vf[0][3], pf11, o0, 0, 0, 0); o1 = __builtin_amdgcn_mfma_f32_32x32x16_bf16(vf[1][3], pf11, o1, 0, 0, 0); \
            } while (0)
#pragma unroll 1
        for (int kp = 0; kp < npair; ++kp) {
            const u32x4 fK = ATT_LOADK(kp + 2), fV = ATT_LOADV(kp + 2);
            ATT_TILE2(kp);
            if (kp + 1 < npair) ATT_STAGE2((kp + 1) & 1, nK, nV);
            LDS_BARRIER();
            nK = fK; nV = fV;
        }
#undef ATT_TILE2
#undef ATT_PK
#undef ATT_MAX16
#undef ATT_LOADK
#undef ATT_LOADV
#undef ATT_STAGE2
        float lrow = lsum[0] + lsum[1]; lrow += __shfl_xor(lrow, 32);
        const float inv = __builtin_amdgcn_rcpf(lrow);
        LAS unsigned char* stg = L + AL_OST + w * 4608;
#pragma unroll
        for (int g = 0; g < 4; ++g) {
            *(LAS u32x2*)(stg + r32 * OST_STRIDE + (8 * g + 4 * hi) * 2) = (u32x2){pk2(o0[4 * g] * inv, o0[4 * g + 1] * inv), pk2(o0[4 * g + 2] * inv, o0[4 * g + 3] * inv)};
            *(LAS u32x2*)(stg + r32 * OST_STRIDE + (32 + 8 * g + 4 * hi) * 2) = (u32x2){pk2(o1[4 * g] * inv, o1[4 * g + 1] * inv), pk2(o1[4 * g + 2] * inv, o1[4 * g + 3] * inv)}; }
        asm volatile("s_waitcnt lgkmcnt(0)" ::: "memory");
        unsigned char* AO = WSP(unsigned char, WS_AO) + (size_t)tok0 * 512 + h * 64;
#define O8(x) __builtin_amdgcn_fmed3f((x) * 16.f, -440.f, 440.f)
#pragma unroll
        for (int it = 0; it < 4; ++it) { const int row = it * 8 + (lane >> 3), ch = lane & 7; const u32x4 v = *(const LAS u32x4*)(stg + row * OST_STRIDE + ch * 16);
            *(u32x2*)(AO + (size_t)row * 512 + ch * 8) = (u32x2){pk4_fp8(O8(bflo(v.x)), O8(bfhi(v.x)), O8(bflo(v.y)), O8(bfhi(v.y))), pk4_fp8(O8(bflo(v.z)), O8(bfhi(v.z)), O8(bflo(v.w)), O8(bfhi(v.w)))}; }
#undef O8
    }
#if MK_LEAK >= 0
    __syncthreads();
    if (tid == 0) { volatile LAS unsigned* MS = (volatile LAS unsigned*)(F.lds + MISC_OFF); const unsigned long long tu2_ = __builtin_amdgcn_s_memrealtime(); MS[16] += (unsigned)(tu1_ - tu0_); MS[17] += (unsigned)(tu2_ - tu1_); }
#endif
}
__device__ __forceinline__ void attn_phase(Frame& F, int clo, int chi) {
#pragma unroll 1
    for (int p2 = 2 * F.bid; p2 < 512; p2 += ((p2 & 1) ? 2 * F.G - 1 : 1)) { const int p = p2 >> 1, x_ = p & 7, m_ = p >> 3, b = (x_ & ~3) + (m_ & 3), jj = (x_ & 3) * 8 + (m_ >> 2), c1 = jj >> 1, half = jj & 1;
        const int cc = (p2 & 1) ? c1 : 31 - c1; if (cc >= clo && cc < chi) attn_unit(F, b, cc, half); }
}

constexpr int LR_CW = 0, LR_SEG = 2048, LR_AB = 4096;
static_assert(LR_AB + 8 * 16 * 64 * 16 <= MISC_OFF, "LRU LDS map");
__device__ __forceinline__ void lru_item_mfma(Frame& F, int item) {
    int tid_ = F.tid, w_ = F.wave; asm volatile("" : "+v"(tid_), "+s"(w_));
    const int tid = tid_, lane = tid & 63, w = w_, c16 = lane & 15, kg = lane >> 4;
    const int b = item >> 5, n = (item >> 2) & 7, q = item & 3;
    LAS float* cwL = (LAS float*)(F.lds + LR_CW);
    LAS float* segL = (LAS float*)(F.lds + LR_SEG);
    LAS u32x4* abL = (LAS u32x4*)(F.lds + LR_AB) + (size_t)w * 16 * 64 + lane;
    const float* conv_w = (const float*)F.ap->in[8]; const float* conv_b = (const float*)F.ap->in[9];
    const float* w_rec = (const float*)F.ap->in[10] + (size_t)n * 4096; const float* w_ing = (const float*)F.ap->in[12] + (size_t)n * 4096;
    __syncthreads();
    if (tid < 256) cwL[tid] = conv_w[(tid >> 6) * 512 + 64 * n + (tid & 63)]; else if (tid < 320) cwL[tid] = conv_b[64 * n + (tid - 256)];
    __syncthreads();
    bf16x8 Bw[4][3][2];
    float pbr = 0.f, pbi = 0.f;
#pragma unroll
    for (int ks = 0; ks < 2; ++ks) { float vr[8], vi[8];
#pragma unroll
        for (int j = 0; j < 8; ++j) { const int d = 32 * ks + 8 * kg + j; vr[j] = w_rec[d * 64 + 16 * q + c16]; vi[j] = w_ing[d * 64 + 16 * q + c16]; }
        { const f32x4 b0 = *(const LAS f32x4*)(cwL + 256 + 32 * ks + 8 * kg), b1 = *(const LAS f32x4*)(cwL + 256 + 32 * ks + 8 * kg + 4);
          pbr += (vr[0] * b0.x + vr[1] * b0.y) + (vr[2] * b0.z + vr[3] * b0.w) + (vr[4] * b1.x + vr[5] * b1.y) + (vr[6] * b1.z + vr[7] * b1.w);
          pbi += (vi[0] * b0.x + vi[1] * b0.y) + (vi[2] * b0.z + vi[3] * b0.w) + (vi[4] * b1.x + vi[5] * b1.y) + (vi[6] * b1.z + vi[7] * b1.w); }
#pragma unroll
        for (int tap = 0; tap < 4; ++tap) { const f32x4 c0 = *(const LAS f32x4*)(cwL + tap * 64 + 32 * ks + 8 * kg), c1 = *(const LAS f32x4*)(cwL + tap * 64 + 32 * ks + 8 * kg + 4);
            const float cw8[8] = {c0.x, c0.y, c0.z, c0.w, c1.x, c1.y, c1.z, c1.w}; float vd[8];
#pragma unroll
            for (int j = 0; j < 8; ++j) vd[j] = (32 * ks + 8 * kg + j == 16 * q + c16) ? cw8[j] : 0.f;
            u32x4 pr, pi, pd;
            pr.x = pk2(vr[0] * cw8[0], vr[1] * cw8[1]); pr.y = pk2(vr[2] * cw8[2], vr[3] * cw8[3]); pr.z = pk2(vr[4] * cw8[4], vr[5] * cw8[5]); pr.w = pk2(vr[6] * cw8[6], vr[7] * cw8[7]);
            pi.x = pk2(vi[0] * cw8[0], vi[1] * cw8[1]); pi.y = pk2(vi[2] * cw8[2], vi[3] * cw8[3]); pi.z = pk2(vi[4] * cw8[4], vi[5] * cw8[5]); pi.w = pk2(vi[6] * cw8[6], vi[7] * cw8[7]);
            pd.x = pk2(vd[0], vd[1]); pd.y = pk2(vd[2], vd[3]); pd.z = pk2(vd[4], vd[5]); pd.w = pk2(vd[6], vd[7]);
            Bw[tap][0][ks] = __builtin_bit_cast(bf16x8, pr); Bw[tap][1][ks] = __builtin_bit_cast(bf16x8, pi); Bw[tap][2][ks] = __builtin_bit_cast(bf16x8, pd); } }
    pbr += __shfl_xor(pbr, 16); pbr += __shfl_xor(pbr, 32); pbi += __shfl_xor(pbi, 16); pbi += __shfl_xor(pbi, 32);
    const float xcb = cwL[256 + 16 * q + c16];
    const int chg = 64 * n + 16 * q + c16;
    const float spl8 = -8.f * log1pf(__expf(-((const float*)F.ap->in[14])[chg])), brc = ((const float*)F.ap->in[11])[chg] + pbr, bin = ((const float*)F.ap->in[13])[chg] + pbi;
    const bf16_t* LX = WSP(bf16_t, WS_LX) + (((size_t)b * 64 + 8 * n + kg) * SEQ) * 8;
    const bf16_t* LG = WSP(bf16_t, WS_LG) + (size_t)b * SEQ * 512 + 64 * n + 16 * q + c16;
    unsigned char* LO = WSP(unsigned char, WS_LO) + (size_t)b * SEQ * 512 + 64 * n + 16 * q + c16;
    __syncthreads();
    u32x4 rawA[2][4], rawB[2][4], rawC[2][4];
#define LRU_LOAD(R, RB) do { const int tb_ = 256 * w + 16 * (RB) + c16 - 3; \
        _Pragma("unroll") for (int ks = 0; ks < 2; ++ks) _Pragma("unroll") for (int tap = 0; tap < 4; ++tap) { const int ts_ = tb_ + tap; \
            R[ks][tap] = *(const u32x4*)(LX + ((size_t)(4 * ks) * SEQ + (ts_ < 0 ? 0 : ts_)) * 8); } } while (0)
    float Arun = 1.f, Brun = 0.f;
#define LRU_BODY(R, RB) do { const int rb_ = (RB); const int tb = 256 * w + 16 * rb_ + c16 - 3; \
        if (w == 0 && rb_ == 0) {                                                      \
            _Pragma("unroll") for (int ks = 0; ks < 2; ++ks) _Pragma("unroll") for (int tap = 0; tap < 4; ++tap) if (tb + tap < 0) R[ks][tap] = (u32x4){0u, 0u, 0u, 0u}; } \
        f32x4 rp = (f32x4){0.f, 0.f, 0.f, 0.f}, ip = rp, xv = rp; \
        _Pragma("unroll") for (int tap = 0; tap < 4; ++tap) _Pragma("unroll") for (int ks = 0; ks < 2; ++ks) { const bf16x8 afr = __builtin_bit_cast(bf16x8, R[ks][tap]); \
                rp = __builtin_amdgcn_mfma_f32_16x16x32_bf16(afr, Bw[tap][0][ks], rp, 0, 0, 0); ip = __builtin_amdgcn_mfma_f32_16x16x32_bf16(afr, Bw[tap][1][ks], ip, 0, 0, 0); \
                xv = __builtin_amdgcn_mfma_f32_16x16x32_bf16(afr, Bw[tap][2][ks], xv, 0, 0, 0); } \
          \
        float av[4], bv[4]; u32x4 pk; \
        _Pragma("unroll") for (int r = 0; r < 4; ++r) { const float rg = __builtin_amdgcn_rcpf(1.f + __expf(-(rp[r] + brc))), ig = __builtin_amdgcn_rcpf(1.f + __expf(-(ip[r] + bin))); \
            const float la = spl8 * rg; \
            const float em1 = -la * (1.f + la * (0.5f + la * (0.16666667f + la * (0.041666668f + la * 0.0083333338f))));            \
            const float em2 = em1 * (2.f - em1);                                                                                       \
            const unsigned w2 = cvt_pk_bf16(em1, __builtin_amdgcn_sqrtf(em2) * (ig * (xv[r] + xcb))); \
            pk[r] = w2; av[r] = 1.f - bflo(w2); bv[r] = bfhi(w2); } \
        abL[rb_ * 64] = pk; \
        float Ag = av[0], Bg = bv[0]; \
        _Pragma("unroll") for (int r = 1; r < 4; ++r) { Bg = av[r] * Bg + bv[r]; Ag = Ag * av[r]; } \
        const float A0 = __shfl(Ag, c16), B0 = __shfl(Bg, c16), A1 = __shfl(Ag, c16 + 16), B1 = __shfl(Bg, c16 + 16), A2 = __shfl(Ag, c16 + 32), B2 = __shfl(Bg, c16 + 32), A3 = __shfl(Ag, c16 + 48), B3 = __shfl(Bg, c16 + 48); \
        const float P2a = A0 * A1, P2b = A1 * B0 + B1, P3a = P2a * A2, P3b = A2 * P2b + B2, Ta = P3a * A3, Tb = A3 * P3b + B3; \
        Brun = Ta * Brun + Tb; Arun = Arun * Ta; } while (0)
    LRU_LOAD(rawA, 0); LRU_LOAD(rawB, 1);
#pragma unroll 1
    for (int rb = 0; rb < 15; rb += 3) {
        LRU_LOAD(rawC, rb + 2); LRU_BODY(rawA, rb);
        LRU_LOAD(rawA, rb + 3); LRU_BODY(rawB, rb + 1);
        if (rb + 4 < 16) LRU_LOAD(rawB, rb + 4);
        LRU_BODY(rawC, rb + 2);
    }
    LRU_BODY(rawA, 15);
#undef LRU_BODY
#undef LRU_LOAD
    if (kg == 0) { segL[(w * 16 + c16) * 2] = Arun; segL[(w * 16 + c16) * 2 + 1] = Brun; }
    __syncthreads();
    float hc = 0.f;
    for (int ww = 0; ww < w; ++ww) hc = segL[(ww * 16 + c16) * 2] * hc + segL[(ww * 16 + c16) * 2 + 1];
#pragma unroll 2
    for (int rb = 0; rb < 16; ++rb) {
        const int t0 = 256 * w + 16 * rb;
        const u32x4 pk = abL[rb * 64];
        float gv[4];
#pragma unroll
        for (int r = 0; r < 4; ++r) gv[r] = bf2f(LG[(size_t)(t0 + 4 * kg + r) * 512]);
        float av[4], bv[4];
#pragma unroll
        for (int r = 0; r < 4; ++r) { av[r] = 1.f - bflo(pk[r]); bv[r] = bfhi(pk[r]); }
        float Ag = av[0], Bg = bv[0];
#pragma unroll
        for (int r = 1; r < 4; ++r) { Bg = av[r] * Bg + bv[r]; Ag = Ag * av[r]; }
        const float A0 = __shfl(Ag, c16), B0 = __shfl(Bg, c16), A1 = __shfl(Ag, c16 + 16), B1 = __shfl(Bg, c16 + 16), A2 = __shfl(Ag, c16 + 32), B2 = __shfl(Bg, c16 + 32), A3 = __shfl(Ag, c16 + 48), B3 = __shfl(Bg, c16 + 48);
        const float P2a = A0 * A1, P2b = A1 * B0 + B1, P3a = P2a * A2, P3b = A2 * P2b + B2, Ta = P3a * A3, Tb = A3 * P3b + B3;
        const float Pa = kg == 0 ? 1.f : kg == 1 ? A0 : kg == 2 ? P2a : P3a, Pb = kg == 0 ? 0.f : kg == 1 ? B0 : kg == 2 ? P2b : P3b;
        float h = Pa * hc + Pb;
#pragma unroll
        for (int r = 0; r < 4; ++r) { h = av[r] * h + bv[r]; const float g = gv[r]; const float u = 0.7978845608028654f * (g + 0.044715f * g * g * g);
            const float ge = g * __builtin_amdgcn_rcpf(1.f + __expf(-2.f * u));
            LO[(size_t)(t0 + 4 * kg + r) * 512] = (unsigned char)(pk4_fp8(__builtin_amdgcn_fmed3f(h * ge * 16.f, -440.f, 440.f), 0.f, 0.f, 0.f) & 0xffu); }
        hc = Ta * hc + Tb;
    }
}
__device__ __forceinline__ void lru_phase(Frame& F) {
#pragma unroll 1
    for (int it = F.bid; it < 256; it += F.G) lru_item_mfma(F, (F.G == 256) ? ((it & 7) * 32 + (it >> 3)) : it);
}
struct SchedMerge { const bf16_t *AO, *LO, *WPA, *WPB; int G, c;
    __device__ __forceinline__ bool next(int i, Unit& u) const { const int L = (i >> 1) * G + c; if (L >= 64 * 4) return false; const int sub = i & 1;
        u.pm = L % 64; u.pn = L / 64; u.aux = sub; u.flags = sub ? 1 : 2; u.gidx = nullptr;
        u.A = (sub ? LO : AO) + (size_t)u.pm * 256 * 256; u.B = (sub ? WPB : WPA) + (size_t)u.pn * 256 * 256; return true; } };
#define UB0(x) ((float)((x) & 255u))
#define UB1(x) ((float)(((x) >> 8) & 255u))
#define UB2(x) ((float)(((x) >> 16) & 255u))
#define UB3(x) ((float)((x) >> 24))
struct EpiMerge {   static constexpr bool PERM = true; static constexpr bool PRE = false; static constexpr bool MID = true;
    bf16_t* MG; const unsigned char *GA, *GB;
#define SCL(x, r) (x) *= (r)
    __device__ __forceinline__ void mid(f32x4 (&acc)[2][2][4][2], const Unit& u, int wr, int wc, int fr, int fq) const {
        int lo_ = (wr * 64 + fr) * 1024 + wc * 32 + 8 * fq; asm volatile("" : "+v"(lo_));
        const unsigned base = (unsigned)(u.pm * 256 * 1024 + u.pn * 256) + (unsigned)lo_;
#pragma unroll
        for (int ai = 0; ai < 2; ++ai)
#pragma unroll
        for (int mh = 0; mh < 2; ++mh) {
            u32x2 a[2][2], b[2][2];
#pragma unroll
            for (int m = 0; m < 2; ++m)
#pragma unroll
                for (int bj = 0; bj < 2; ++bj) { a[m][bj] = *(const u32x2*)(GA + base + (unsigned)((ai * 128 + (2 * mh + m) * 16) * 1024 + bj * 128)); b[m][bj] = *(const u32x2*)(GB + base + (unsigned)((ai * 128 + (2 * mh + m) * 16) * 1024 + bj * 128)); }
#pragma unroll
            for (int m = 0; m < 2; ++m)
#pragma unroll
                for (int bj = 0; bj < 2; ++bj) {
                    const u32x2 qa = a[m][bj], qb = b[m][bj];
                    f32x4& v0 = acc[ai][bj][2 * mh + m][0]; f32x4& v1 = acc[ai][bj][2 * mh + m][1];
                    SCL(v0[0], UB0(qa.x) * __builtin_amdgcn_rcpf(fmaxf(UB0(qb.x), 0.5f))); SCL(v0[1], UB1(qa.x) * __builtin_amdgcn_rcpf(fmaxf(UB1(qb.x), 0.5f)));
                    SCL(v0[2], UB2(qa.x) * __builtin_amdgcn_rcpf(fmaxf(UB2(qb.x), 0.5f))); SCL(v0[3], UB3(qa.x) * __builtin_amdgcn_rcpf(fmaxf(UB3(qb.x), 0.5f)));
                    SCL(v1[0], UB0(qa.y) * __builtin_amdgcn_rcpf(fmaxf(UB0(qb.y), 0.5f))); SCL(v1[1], UB1(qa.y) * __builtin_amdgcn_rcpf(fmaxf(UB1(qb.y), 0.5f)));
                    SCL(v1[2], UB2(qa.y) * __builtin_amdgcn_rcpf(fmaxf(UB2(qb.y), 0.5f))); SCL(v1[3], UB3(qa.y) * __builtin_amdgcn_rcpf(fmaxf(UB3(qb.y), 0.5f))); }
        }
    }
#undef SCL
    __device__ __forceinline__ void operator()(const f32x4 (&acc)[2][2][4][2], const Unit& u, int wr, int wc, int fr, int fq) const {
        constexpr float K8 = 1.f / 255.f;
        int lo_ = (wr * 64 + fr) * 1024 + wc * 32 + 8 * fq; asm volatile("" : "+v"(lo_));
        const unsigned base = (unsigned)(u.pm * 256 * 1024 + u.pn * 256) + (unsigned)lo_;
#pragma unroll
        for (int ai = 0; ai < 2; ++ai) {
            u32x2 b[4][2];
#pragma unroll
            for (int m = 0; m < 4; ++m)
#pragma unroll
                for (int bj = 0; bj < 2; ++bj) b[m][bj] = *(const u32x2*)(GB + base + (unsigned)((ai * 128 + m * 16) * 1024 + bj * 128));
#pragma unroll
            for (int m = 0; m < 4; ++m)
#pragma unroll
                for (int bj = 0; bj < 2; ++bj) {
                    const u32x2 qb = b[m][bj];
                    f32x4 v0 = acc[ai][bj][m][0], v1 = acc[ai][bj][m][1];
                    v0[0] *= fmaxf(UB0(qb.x), 0.5f) * K8; v0[1] *= fmaxf(UB1(qb.x), 0.5f) * K8; v0[2] *= fmaxf(UB2(qb.x), 0.5f) * K8; v0[3] *= fmaxf(UB3(qb.x), 0.5f) * K8;
                    v1[0] *= fmaxf(UB0(qb.y), 0.5f) * K8; v1[1] *= fmaxf(UB1(qb.y), 0.5f) * K8; v1[2] *= fmaxf(UB2(qb.y), 0.5f) * K8; v1[3] *= fmaxf(UB3(qb.y), 0.5f) * K8;
#define M8(x) __builtin_amdgcn_fmed3f((x) * 16.f, -440.f, 440.f)
                    *(u32x2*)((unsigned char*)MG + base + (unsigned)((ai * 128 + m * 16) * 1024 + bj * 128)) = (u32x2){pk4_fp8(M8(v0[0]), M8(v0[1]), M8(v0[2]), M8(v0[3])), pk4_fp8(M8(v1[0]), M8(v1[1]), M8(v1[2]), M8(v1[3]))}; }
#undef M8
        }
    }
};
#undef UB0
#undef UB1
#undef UB2
#undef UB3
struct SchedOut { const bf16_t *A, *B; int G, c;
    __device__ __forceinline__ bool next(int i, Unit& u) const { const int L = i * G + c; if (L >= 64 * 4) return false;
        u.pm = L % 64; u.pn = L / 64; u.aux = 0; u.flags = 0; u.gidx = nullptr; u.A = A + (size_t)u.pm * 256 * 512; u.B = B + (size_t)u.pn * 256 * 512; return true; } };
struct EpiOut {   static constexpr bool PERM = false; static constexpr bool PRE = false; static constexpr bool MID = false;
    const float* x; const float* mod; bf16_t* out; float* rowsq;
    __device__ __forceinline__ void operator()(const f32x4 (&acc)[2][2][4][2], const Unit& u, int wr, int wc, int fr, int fq) const {
        const int b = (u.pm * 256) / SEQ;
        f32x4 gm[2][2];
#pragma unroll
        for (int bj = 0; bj < 2; ++bj)
#pragma unroll
            for (int n = 0; n < 2; ++n) gm[bj][n] = *(const f32x4*)(mod + b * 6144 + 2048 + u.pn * 256 + bj * 128 + wc * 32 + 16 * n + 4 * fq);
        const size_t base = (size_t)(u.pm * 256 + wr * 64 + fr) * 1024 + u.pn * 256 + wc * 32 + 4 * fq;
#pragma unroll
        for (int ai = 0; ai < 2; ++ai) {
            f32x4 xv[4][2][2];
#pragma unroll
            for (int m = 0; m < 4; ++m)
#pragma unroll
                for (int bj = 0; bj < 2; ++bj)
#pragma unroll
                    for (int n = 0; n < 2; ++n) xv[m][bj][n] = *(const f32x4*)(x + base + (size_t)(ai * 128 + m * 16) * 1024 + bj * 128 + 16 * n);
#pragma unroll
            for (int m = 0; m < 4; ++m) { const int row = u.pm * 256 + ai * 128 + wr * 64 + m * 16 + fr; float ss = 0.f;
#pragma unroll
                for (int bj = 0; bj < 2; ++bj)
#pragma unroll
                    for (int n = 0; n < 2; ++n) { const f32x4 v = xv[m][bj][n] + gm[bj][n] * acc[ai][bj][m][n];
                        *(u32x2*)(out + base + (size_t)(ai * 128 + m * 16) * 1024 + bj * 128 + 16 * n) = (u32x2){pk2(v.x, v.y), pk2(v.z, v.w)}; ss += (v.x * v.x + v.y * v.y) + (v.z * v.z + v.w * v.w); }
                ss += __shfl_xor(ss, 16); ss += __shfl_xor(ss, 32);
                if (fq == 0) rowsq[(size_t)row * 16 + u.pn * 4 + wc] = ss; }
        }
    }
};

struct TokMeta { int ea, eb; float ca, cb; int re_a, re_b, cls, rc; };
__device__ __forceinline__ int pair_index(int lo, int hi) { return lo * (15 - lo) / 2 + (hi - lo - 1); }

constexpr int RL_GS = 0, RL_LG = 8192, RL_W = 8192 + 16384, RW_STRIDE = 1040;
static_assert(RL_W + 2 * 48 * RW_STRIDE + 2048 <= RING_BYTES, "routing LDS map");
__device__ __forceinline__ void route_phase(Frame& F) {
    int tid_ = F.tid, w_ = F.wave; asm volatile("" : "+v"(tid_), "+s"(w_));
    const int tid = tid_, lane = tid & 63, w = w_, r16 = lane & 15, r8 = lane & 7, kg = lane >> 4;
    LAS float* gsL = (LAS float*)(F.lds + RL_GS);
    LAS float* lgL = (LAS float*)(F.lds + RL_LG + (w & 3) * 3072);
    const bool act = w < 4;
    LAS unsigned char* wL = F.lds + RL_W;
    LAS unsigned* hbin = (LAS unsigned*)(F.lds + RL_W + 2 * 48 * RW_STRIDE);
    const float* nw = (const float*)F.ap->in[18];
    const float* rowsq = WSP(float, WS_ROWSQ);
#pragma unroll 1
    for (int blk = F.bid; blk < NTOK / 64; blk += F.G) {
        const int tokb = blk * 64, b = tokb / SEQ; const float* mod = WSP(float, WS_MOD) + b * 6144;
        __syncthreads();
        float gsv[2][3];
#pragma unroll
        for (int i = 0; i < 2; ++i) { gsv[i][0] = nw[tid + 512 * i]; gsv[i][1] = mod[4096 + tid + 512 * i]; gsv[i][2] = mod[3072 + tid + 512 * i]; }
        const int tok = tokb + 16 * (w & 3) + r16;
        const bf16_t* xr = WSP(bf16_t, WS_X1B) + (size_t)tok * DM + 8 * kg;
        f32x4 rsq[4];
        { const f32x4* rp = (const f32x4*)(rowsq + (size_t)tok * 16); rsq[0] = rp[0]; rsq[1] = rp[1]; rsq[2] = rp[2]; rsq[3] = rp[3]; }
        u32x4 xA[8], xB[8];
#define RT_LOAD(X, QD) do { const bf16_t* xq_ = xr + 256 * (QD); _Pragma("unroll") for (int i_ = 0; i_ < 8; ++i_) X[i_] = *(const u32x4*)(xq_ + 32 * i_); } while (0)
        if (act) { RT_LOAD(xA, 0); RT_LOAD(xB, 1); }
        const unsigned wvo = (unsigned)(((tid >> 6) * 1024 + 8 * (tid & 63)) * 2);
        const int wlo = (tid >> 6) * RW_STRIDE + (tid & 63) * 16;
#define RT_WLOAD(KH) do { const unsigned char* wb_ = F.ws + WS_WRH + 1024 * (KH); _Pragma("unroll") for (int i_ = 0; i_ < 12; ++i_) \
            wreg[i_] = *(const u32x4*)(wb_ + (size_t)((i_ / 6) * (int)(WS_WRL - WS_WRH) + (i_ % 6) * 8 * 2048) + wvo); } while (0)
#define RT_WSTORE() do { _Pragma("unroll") for (int i_ = 0; i_ < 12; ++i_) *(LAS u32x4*)(wL + wlo + ((i_ / 6) * 48 + (i_ % 6) * 8) * RW_STRIDE) = wreg[i_]; } while (0)
#pragma unroll
        for (int i = 0; i < 2; ++i) { gsL[tid + 512 * i] = gsv[i][0] * (1.f + gsv[i][1]); gsL[1024 + tid + 512 * i] = gsv[i][2]; }
        if (tid < 144) hbin[tid] = 0u;
        const float ssq = (((rsq[0].x + rsq[0].y) + (rsq[0].z + rsq[0].w)) + ((rsq[1].x + rsq[1].y) + (rsq[1].z + rsq[1].w))) + (((rsq[2].x + rsq[2].y) + (rsq[2].z + rsq[2].w)) + ((rsq[3].x + rsq[3].y) + (rsq[3].z + rsq[3].w)));
        const float rinv = rsqrtf(ssq * (1.f / DM) + EPS);
        f32x4 acc[3];
#pragma unroll
        for (int nb = 0; nb < 3; ++nb) acc[nb] = (f32x4){0.f, 0.f, 0.f, 0.f};
        unsigned char* h2row = WSP(unsigned char, WS_H2T) + (size_t)tok * DM + 8 * kg;
#define RT_COMP(X, QD) do { _Pragma("unroll") for (int i_ = 0; i_ < 8; ++i_) { const int kq_ = 256 * (QD) + 32 * i_, k0 = kq_ + 8 * kg, kl_ = 256 * ((QD) & 1) + 32 * i_ + 8 * kg; \
                const u32x4 xw_ = X[i_]; const f32x4 a = {bflo(xw_.x), bfhi(xw_.x), bflo(xw_.y), bfhi(xw_.y)}, c = {bflo(xw_.z), bfhi(xw_.z), bflo(xw_.w), bfhi(xw_.w)}; \
                const f32x4 g0 = *(const LAS f32x4*)(gsL + k0), g1 = *(const LAS f32x4*)(gsL + k0 + 4), s0 = *(const LAS f32x4*)(gsL + 1024 + k0), s1 = *(const LAS f32x4*)(gsL + 1024 + k0 + 4); \
                float hv[8]; hv[0] = a.x * rinv * g0.x + s0.x; hv[1] = a.y * rinv * g0.y + s0.y; hv[2] = a.z * rinv * g0.z + s0.z; hv[3] = a.w * rinv * g0.w + s0.w; \
                hv[4] = c.x * rinv * g1.x + s1.x; hv[5] = c.y * rinv * g1.y + s1.y; hv[6] = c.z * rinv * g1.z + s1.z; hv[7] = c.w * rinv * g1.w + s1.w; \
                u32x4 ph, pl; ph.x = pk2(hv[0], hv[1]); ph.y = pk2(hv[2], hv[3]); ph.z = pk2(hv[4], hv[5]); ph.w = pk2(hv[6], hv[7]); \
                pl.x = pk2(hv[0] - bflo(ph.x), hv[1] - bfhi(ph.x)); pl.y = pk2(hv[2] - bflo(ph.y), hv[3] - bfhi(ph.y)); pl.z = pk2(hv[4] - bflo(ph.z), hv[5] - bfhi(ph.z)); pl.w = pk2(hv[6] - bflo(ph.w), hv[7] - bfhi(ph.w)); \
                *(u32x2*)(h2row + kq_) = (u32x2){pk4_fp8(hv[0], hv[1], hv[2], hv[3]), pk4_fp8(hv[4], hv[5], hv[6], hv[7])};     \
                const bf16x8 ah = __builtin_bit_cast(bf16x8, ph), al = __builtin_bit_cast(bf16x8, pl); \
                _Pragma("unroll") for (int nb = 0; nb < 3; ++nb) { const LAS unsigned char* wp = wL + (16 * nb + r16) * RW_STRIDE + kl_ * 2; \
                    const bf16x8 bh = *(const LAS bf16x8*)wp, bl = *(const LAS bf16x8*)(wp + 48 * RW_STRIDE); \
                    acc[nb] = __builtin_amdgcn_mfma_f32_16x16x32_bf16(ah, bh, acc[nb], 0, 0, 0); acc[nb] = __builtin_amdgcn_mfma_f32_16x16x32_bf16(ah, bl, acc[nb], 0, 0, 0); \
                    acc[nb] = __builtin_amdgcn_mfma_f32_16x16x32_bf16(al, bh, acc[nb], 0, 0, 0); } \
                __builtin_amdgcn_sched_barrier(0); } } while (0)
#pragma unroll 1
        for (int kh = 0; kh < 2; ++kh) {
            __syncthreads();
            { u32x4 wreg[12]; RT_WLOAD(kh); RT_WSTORE(); }
            __syncthreads();
            if (act) {
                RT_COMP(xA, 2 * kh);
                if (kh == 0) RT_LOAD(xA, 2);
                RT_COMP(xB, 2 * kh + 1);
                if (kh == 0) RT_LOAD(xB, 3);
            }
        }
#undef RT_COMP
#undef RT_WSTORE
#undef RT_WLOAD
#undef RT_LOAD
        if (act) {
#pragma unroll
            for (int nb = 0; nb < 3; ++nb)
#pragma unroll
                for (int r = 0; r < 4; ++r) lgL[(4 * kg + r) * 48 + 16 * nb + r16] = acc[nb][r]; }
        asm volatile("s_waitcnt lgkmcnt(0)" ::: "memory");
        TokMeta mt; mt.ea = 0; mt.eb = 0; mt.ca = 0.f; mt.cb = 0.f; mt.re_a = 0; mt.re_b = 0; mt.cls = 0; mt.rc = 0;
        if (act && lane < 16) {
            const LAS float* lg = lgL + lane * 48; const float* bg = (const float*)F.ap->in[20]; const float* be = (const float*)F.ap->in[22];
            float gl[4];
#pragma unroll
            for (int i = 0; i < 4; ++i) gl[i] = lg[i] + bg[i];
            int g = 0; float gmx = gl[0];
#pragma unroll
            for (int i = 1; i < 4; ++i) if (gl[i] > gmx) { gmx = gl[i]; g = i; }
            float gs = 0.f;
#pragma unroll
            for (int i = 0; i < 4; ++i) gs += __expf(gl[i] - gmx);
            const float gw = 1.f / gs;
            float el[8];
#pragma unroll
            for (int i = 0; i < 8; ++i) el[i] = lg[4 + g * 8 + i] + be[g * 8 + i];
            int i1 = 0; float v1 = el[0];
#pragma unroll
            for (int i = 1; i < 8; ++i) if (el[i] > v1) { v1 = el[i]; i1 = i; }
            int i2 = -1; float v2 = -INFINITY;
#pragma unroll
            for (int i = 0; i < 8; ++i) if (i != i1 && (i2 < 0 || el[i] > v2)) { v2 = el[i]; i2 = i; }
            const float e2 = __expf(v2 - v1); const float w1v = gw / (1.f + e2), w2v = gw * e2 / (1.f + e2);
            const int lo = i1 < i2 ? i1 : i2, hi = i1 < i2 ? i2 : i1;
            mt.ea = g * 8 + lo; mt.eb = g * 8 + hi; mt.ca = (i1 < i2) ? w1v : w2v; mt.cb = (i1 < i2) ? w2v : w1v;
            mt.cls = g * 28 + pair_index(lo, hi);
            mt.re_a = (int)__hip_atomic_fetch_add(hbin + mt.ea, 1u, __ATOMIC_RELAXED, __HIP_MEMORY_SCOPE_WORKGROUP); mt.re_b = (int)__hip_atomic_fetch_add(hbin + mt.eb, 1u, __ATOMIC_RELAXED, __HIP_MEMORY_SCOPE_WORKGROUP);
            mt.rc = (int)__hip_atomic_fetch_add(hbin + 32 + mt.cls, 1u, __ATOMIC_RELAXED, __HIP_MEMORY_SCOPE_WORKGROUP);
        }
        __syncthreads();
        if (tid < 144) { const unsigned cnt = hbin[tid]; unsigned base = 0u;
            if (cnt) base = atomicAdd((unsigned*)(F.ws + WS_CTL) + CW_CNTE + tid * CNT_STRIDE, cnt);
            hbin[160 + tid] = base; }
        __syncthreads();
        if (act && lane < 16) { mt.re_a += (int)hbin[160 + mt.ea]; mt.re_b += (int)hbin[160 + mt.eb]; mt.rc += (int)hbin[160 + 32 + mt.cls];
            const int tk = tokb + 16 * w + lane;
            typedef int i32x4 __attribute__((ext_vector_type(4)));
            WSP(i32x4, WS_EINFO)[(size_t)mt.ea * LIST_CAP + mt.re_a] = (i32x4){tk, (int)fbits(mt.ca), mt.cls, mt.rc};
            WSP(i32x4, WS_EINFO)[(size_t)mt.eb * LIST_CAP + mt.re_b] = (i32x4){tk, (int)fbits(mt.cb), mt.cls | (1 << 16), mt.rc};
            WSP(int, WS_CLIST)[(size_t)mt.cls * LIST_CAP + mt.rc] = tk; }
    }
}
struct MoeTables { LAS int* ebase; LAS int* cbase; LAS int* cnt; LAS unsigned short* trows; LAS unsigned short* tcls; LAS unsigned short* order; };
__device__ __forceinline__ MoeTables tables_view(Frame& F, int lds_off) {
    MoeTables T; T.ebase = (LAS int*)(F.lds + lds_off); T.cbase = T.ebase + 40; T.cnt = T.ebase + 160; T.trows = (LAS unsigned short*)(F.lds + lds_off + 1280); T.tcls = T.trows + 256; T.order = T.trows + 512; return T; }
__device__ __forceinline__ MoeTables build_tables(Frame& F, int lds_off) {
    MoeTables T = tables_view(F, lds_off);
    const unsigned* ctl = (const unsigned*)(F.ws + WS_CTL);
    __syncthreads();
    if (F.tid < 144) T.cnt[F.tid] = (int)__hip_atomic_load(ctl + CW_CNTE + F.tid * CNT_STRIDE, __ATOMIC_RELAXED, __HIP_MEMORY_SCOPE_AGENT);
    __syncthreads();
    { int t_ = F.tid; asm volatile("" : "+v"(t_));
      const int l = t_ & 63;
#define BT_UP(P, O) __builtin_amdgcn_ds_bpermute(((l - (O)) & 63) * 4, (P))
      if (t_ < 64) { const int v = (l < NEXP) ? ((T.cnt[l] + 255) >> 8) : 0; int p = v;
#pragma unroll
          for (int o = 1; o < 64; o <<= 1) { const int t = BT_UP(p, o); if (l >= o) p += t; }
          if (l < NEXP) T.ebase[l] = p - v; if (l == NEXP - 1) T.ebase[NEXP] = p; }
      else if (t_ < 128) { const int v0 = (T.cnt[32 + l] + 255) >> 8, v1 = (l + 64 < NCLS) ? ((T.cnt[32 + 64 + l] + 255) >> 8) : 0; int p0 = v0, p1 = v1;
#pragma unroll
          for (int o = 1; o < 64; o <<= 1) { const int t0 = BT_UP(p0, o), t1 = BT_UP(p1, o); if (l >= o) { p0 += t0; p1 += t1; } }
          const int tot0 = __builtin_amdgcn_ds_bpermute(63 * 4, p0);
          T.cbase[l] = p0 - v0; if (l + 64 < NCLS) T.cbase[64 + l] = tot0 + p1 - v1; if (l + 64 == NCLS - 1) T.cbase[NCLS] = tot0 + p1; }
#undef BT_UP
    }
    __syncthreads();
    if (F.tid < NCLS) { const int n = T.cnt[32 + F.tid], b0 = T.cbase[F.tid], nt = T.cbase[F.tid + 1] - b0;
        for (int t = 0; t < nt; ++t) { const int idx = b0 + t; if (idx < 256) { const int rws = n - 256 * t; T.trows[idx] = (unsigned short)(rws > 256 ? 256 : rws); T.tcls[idx] = (unsigned short)F.tid; } } }
    __syncthreads();
    { const int NT = T.cbase[NCLS] < 256 ? T.cbase[NCLS] : 256;
      if (F.tid < NT) { const int mine = T.trows[F.tid]; int rk = 0;
          for (int j = 0; j < NT; ++j) { const int o = T.trows[j]; rk += (o > mine || (o == mine && j < F.tid)) ? 1 : 0; }
          T.order[rk] = (unsigned short)F.tid; } }
    __syncthreads();
    return T;
}
typedef int i32x4 __attribute__((ext_vector_type(4)));
struct SchedMoe1 { const bf16_t *H2, *W13; const LAS int* ebase; const LAS int* cnte; const int* einfo; int G, c;
    __device__ __forceinline__ bool next(int i, Unit& u) const { const int cs = (i == 0 && (G & 7) == 0) ? ((c & 7) * (G >> 3) + (c >> 3)) : c;
        const int L = i * G + cs, ntile = ebase[NEXP]; if (L >= ntile * 2) return false;
        const int rt = L >> 1, j = L & 1; int e = 0;
        for (int q = 1; q < NEXP; ++q) e = (ebase[q] <= rt) ? q : e;
        const int tl = rt - ebase[e];
        u.pm = e * 64 + tl; u.pn = j; u.flags = 0; u.aux = cnte[e] - 256 * tl; u.gidx = einfo + ((size_t)e * LIST_CAP + 256 * tl) * 4;
        u.A = H2; u.B = W13 + ((size_t)e * 512 + 256 * j) * 512; return true; } };
struct EpiMoe1 {   static constexpr bool PERM = true; static constexpr bool PRE = false; static constexpr bool MID = false;
    unsigned char* wsb; const i32x4* einfo; const LAS int* cbase;
    __device__ __forceinline__ void operator()(const f32x4 (&acc)[2][2][4][2], const Unit& u, int wr, int wc, int fr, int fq) const {
        const int e = u.pm >> 6, tl = u.pm & 63;
        i32x4 infs[8];
#pragma unroll
        for (int ai = 0; ai < 2; ++ai)
#pragma unroll
            for (int m = 0; m < 4; ++m) { const int r = ai * 128 + wr * 64 + m * 16 + fr; infs[ai * 4 + m] = einfo[(size_t)e * LIST_CAP + 256 * tl + (r < u.aux ? r : 0)]; }
        unsigned dst[8]; float cs[8];
#pragma unroll
        for (int ai = 0; ai < 2; ++ai)
#pragma unroll
            for (int m = 0; m < 4; ++m) { const int r = ai * 128 + wr * 64 + m * 16 + fr; const i32x4 inf = infs[ai * 4 + m]; cs[ai * 4 + m] = bitsf((unsigned)inf.y); const int cls = inf.z & 0xffff, half = inf.z >> 16;
                const size_t d = ((size_t)cbase[cls] * 256 + inf.w) * 512 + 256 * half + 128 * u.pn + 32 * wc + 8 * fq;
                dst[ai * 4 + m] = (r < u.aux) ? (unsigned)(WS_ACT2 + d) : (unsigned)(WS_META + 16 * (fq + 4 * wc)); }
#pragma unroll
        for (int ai = 0; ai < 2; ++ai)
#pragma unroll
            for (int m = 0; m < 4; ++m) {
                float o[8];
#pragma unroll
                for (int n = 0; n < 2; ++n)
#pragma unroll
                    for (int ee = 0; ee < 4; ++ee) { const float a = acc[ai][0][m][n][ee], g = acc[ai][1][m][n][ee]; o[4 * n + ee] = a * sigmoidf_(a) * g * cs[ai * 4 + m]; }
                *(u32x2*)(wsb + dst[ai * 4 + m]) = (u32x2){pk4_fp8(A8(o[0]), A8(o[1]), A8(o[2]), A8(o[3])), pk4_fp8(A8(o[4]), A8(o[5]), A8(o[6]), A8(o[7]))}; }
    }
};
struct SchedMoe2 { const bf16_t *act2, *W2; const LAS int* cbase; const LAS int* cntc; const LAS unsigned short* order; const LAS unsigned short* tcls; int G, c;
    __device__ __forceinline__ bool next(int i, Unit& u) const { const int cs = ((G & 7) == 0) ? ((c & 7) * (G >> 3) + (c >> 3)) : c;
        const int L = (i >> 1) * G + cs, ntile = cbase[NCLS]; if (L >= ntile * 4) return false;
        const int sub = i & 1, rk = L >> 2, pn = L & 3;
        const int rt = (ntile <= 256) ? (int)order[rk] : rk;
        int cl = 0;
        if (ntile <= 256) cl = (int)tcls[rt]; else { for (int q = 1; q < NCLS; ++q) cl = (cbase[q] <= rt) ? q : cl; }
        const int g = cl / 28; int p = cl % 28, lo = 0; while (p >= 7 - lo) { p -= 7 - lo; ++lo; } const int hi = lo + 1 + p;
        const int e = g * 8 + (sub ? hi : lo), tl = rt - cbase[cl];
        u.pm = cl * 64 + tl; u.pn = pn; u.flags = sub ? 1 : 2; u.aux = cntc[cl] - 256 * tl; u.gidx = nullptr;
        u.A = act2 + (size_t)rt * 256 * 256 + 128 * sub; u.B = W2 + ((size_t)e * 1024 + 256 * pn) * 128; return true; } };
struct EpiMoe2 {   static constexpr bool PERM = false; static constexpr bool PRE = true; static constexpr bool MID = false;
    float* out; const bf16_t* x1b; const LAS unsigned char* gfL; const int* clist; float* trash;
    __device__ __forceinline__ void prefetch(int (&tk)[8], const Unit& u, int wr, int wc, int fr, int fq) const {
        const int cl = u.pm >> 6, tl = u.pm & 63;
#pragma unroll
        for (int ai = 0; ai < 2; ++ai)
#pragma unroll
            for (int m = 0; m < 4; ++m) { const int r = ai * 128 + wr * 64 + m * 16 + fr; tk[ai * 4 + m] = (r < u.aux) ? clist[(size_t)cl * LIST_CAP + 256 * tl + r] : -1; }
    }
    __device__ __forceinline__ void operator()(const f32x4 (&acc)[2][2][4][2], const Unit& u, int wr, int wc, int fr, int fq, const int (&tk)[8]) const {
        const int colb = u.pn * 256 + wc * 32 + 4 * fq;
#define M2_PTR(R) ((tk[R] < 0) ? trash + 4 * fq : out + (size_t)tk[R] * 1024 + colb)
#define M2_XPTR(R) ((tk[R] < 0) ? (const bf16_t*)trash + 4 * fq : x1b + (size_t)tk[R] * 1024 + colb)
#define M2_LOAD(V, R0) do { _Pragma("unroll") for (int rr = 0; rr < 2; ++rr) { const bf16_t* p_ = M2_XPTR((R0) + rr); _Pragma("unroll") for (int bj = 0; bj < 2; ++bj) _Pragma("unroll") for (int n = 0; n < 2; ++n) V[rr][bj][n] = *(const u32x2*)(p_ + bj * 128 + n * 16); } } while (0)
#define M2_STORE(V, R0) do { _Pragma("unroll") for (int rr = 0; rr < 2; ++rr) { const int R_ = (R0) + rr; const int tok_ = tk[R_]; const int b_ = (tok_ < 0 ? 0 : tok_) / SEQ; float* p_ = M2_PTR(R_); \
            _Pragma("unroll") for (int bj = 0; bj < 2; ++bj) _Pragma("unroll") for (int n = 0; n < 2; ++n) { const u32x2 gw = *(const LAS u32x2*)(gfL + (b_ * 1024 + colb + bj * 128 + n * 16) * 2); \
                const f32x4 gf = {bflo(gw.x), bfhi(gw.x), bflo(gw.y), bfhi(gw.y)}; const u32x2 xw_ = V[rr][bj][n]; const f32x4 x1_ = {bflo(xw_.x), bfhi(xw_.x), bflo(xw_.y), bfhi(xw_.y)}; *(f32x4*)(p_ + bj * 128 + n * 16) = x1_ + gf * acc[R_ >> 2][bj][R_ & 3][n]; } } } while (0)
        u32x2 vA[2][2][2], vB[2][2][2];
        M2_LOAD(vA, 0); M2_LOAD(vB, 2);
        M2_STORE(vA, 0); M2_LOAD(vA, 4);
        M2_STORE(vB, 2); M2_LOAD(vB, 6);
        M2_STORE(vA, 4); M2_STORE(vB, 6);
#undef M2_STORE
#undef M2_LOAD
#undef M2_XPTR
#undef M2_PTR
    }
};

constexpr int NPHASE = 9;
template <int LO, int HI> __global__ void __launch_bounds__(NTHREADS, 2) mk_fwd(Args args) {
    extern __shared__ __attribute__((aligned(16))) unsigned char lds[];
    Frame F;
    F.lds = (LAS unsigned char*)lds; F.tid = threadIdx.x; F.lane = F.tid & 63; F.wave = __builtin_amdgcn_readfirstlane(F.tid >> 6); F.G = gridDim.x; F.bid = blockIdx.x;
    F.ap = &args;
    F.out = args.out; F.ws = args.ws;
    volatile LAS unsigned* MISC = (volatile LAS unsigned*)((LAS unsigned char*)lds + MISC_OFF);
    if (F.tid < 32) MISC[F.tid] = 0u;
    __syncthreads();
    unsigned* ctl = (unsigned*)(F.ws + WS_CTL);
    XcdBarrier bar; bar.bar = ctl + CW_BAR; bar.x = 0; bar.st = nullptr;
    if (MK_N_LAUNCHES == 1) bar = xcd_barrier_post(ctl + CW_BAR, MISC + 8);
#define IN(k) (LO <= (k) && (k) < HI)
#define SEAM(k) do { if constexpr (IN(k) && IN((k) + 1)) xcd_barrier(bar); } while (0)
#ifndef MK_LEAK
#define MK_LEAK -1
#endif
    unsigned long long ts_[12];
#define STAMP(k) do { if (MK_LEAK >= 0) ts_[k] = __builtin_amdgcn_s_memrealtime(); } while (0)
    STAMP(0);
    if constexpr (IN(0)) { p0_phase(F); } SEAM(0); STAMP(1);
    if constexpr (IN(1)) { p1a_phase(F); } SEAM(1); STAMP(2);
    if constexpr (IN(2)) { EpiProj E{F.ws};
        const int cpos = (F.bid >> 1) % 3;
#pragma unroll 1
        for (int ps = 0; ps < 3; ++ps) {
            if (ps == cpos) conv_experts(F);
            if (ps < 2) {
                if (((ps ^ F.bid) & 1) == 0) { SchedProj S{WSP(bf16_t, WS_H), WSP(bf16_t, WS_WIN), 1024, 0, F.G, F.bid}; run_gemm(F.lds, 1024, 1024, 1024, S, E); }
                else { SchedProj S{WSP(bf16_t, WS_H8), WSP(bf16_t, WS_WIN8), 512, 8, F.G, F.bid}; run_gemm<false, true>(F.lds, 512, 512, 512, S, E); } } } }
    SEAM(2);
    unsigned long long tlru_ = 0;
    if constexpr (IN(3)) { lru_phase(F); __syncthreads(); if (MK_LEAK >= 0) tlru_ = __builtin_amdgcn_s_memrealtime(); attn_phase(F, 0, 32); } SEAM(3); STAMP(4);
    if constexpr (IN(4)) { SchedMerge S{WSP(bf16_t, WS_AO), WSP(bf16_t, WS_LO), WSP(bf16_t, WS_WPA), WSP(bf16_t, WS_WPB), F.G, F.bid};
        EpiMerge E{WSP(bf16_t, WS_MG), WSP(unsigned char, WS_GA), WSP(unsigned char, WS_GB)};
        run_gemm<false, true>(F.lds, 256, 256, 256, S, E, 0x7b7b7b7b); } SEAM(4); STAMP(5);
    if constexpr (IN(5)) { SchedOut S{WSP(bf16_t, WS_MG), WSP(bf16_t, WS_WOUT), F.G, F.bid}; EpiOut E{((const float*)F.ap->in[0]), WSP(float, WS_MOD), WSP(bf16_t, WS_X1B), WSP(float, WS_ROWSQ)};
        run_gemm<false, true>(F.lds, 512, 512, 512, S, E, 0x7b7b7b7b); } SEAM(5); STAMP(6);
    if constexpr (IN(6)) { route_phase(F); } SEAM(6); STAMP(7);
    if constexpr (IN(7)) { const MoeTables T = build_tables(F, TBL_OFF);
        SchedMoe1 S{WSP(bf16_t, WS_H2T), WSP(bf16_t, WS_W13), T.ebase, T.cnt, WSP(int, WS_EINFO), F.G, F.bid}; EpiMoe1 E{F.ws, WSP(i32x4, WS_EINFO), T.cbase};
        run_gemm<true, true>(F.lds, 512, 512, 512, S, E); } SEAM(7); STAMP(8);
    if constexpr (IN(8)) { const MoeTables T = (MK_N_LAUNCHES == 1 && IN(7)) ? tables_view(F, TBL_OFF) : build_tables(F, TBL_OFF);
        SchedMoe2 S{WSP(bf16_t, WS_ACT2), WSP(bf16_t, WS_W2), T.cbase, T.cnt + 32, T.order, T.tcls, F.G, F.bid}; EpiMoe2 E{F.out, WSP(bf16_t, WS_X1B), F.lds + GF_OFF, WSP(int, WS_CLIST), WSP(float, WS_META)};
        for (int i = F.tid; i < 4096; i += NTHREADS) { const int b = i >> 9, c2 = (i & 511) * 2; const float* gp = WSP(float, WS_MOD) + b * 6144 + 5120 + c2; *(LAS unsigned*)(F.lds + GF_OFF + (b * 1024 + c2) * 2) = pk2(gp[0], gp[1]); }
        __syncthreads();
        run_gemm<false, true>(F.lds, 256, 128, 128, S, E, 0x7c7c7c7c); }
    STAMP(9);
    if (MK_LEAK >= 0 && F.bid == 0 && F.tid == 0) { asm volatile("s_waitcnt vmcnt(0)" ::: "memory");
        unsigned long long d = 0;
        if (MK_LEAK < 10) d = ts_[MK_LEAK + 1] - ts_[MK_LEAK]; else if (MK_LEAK == 10) d = tlru_ - ts_[3]; else if (MK_LEAK == 11) d = MISC[16]; else if (MK_LEAK == 12) d = MISC[17]; else if (MK_LEAK == 13) d = MISC[18]; else if (MK_LEAK == 14) d = MISC[19]; else if (MK_LEAK == 15) d = MISC[20];
        F.out[0] = (float)d * 0.01f; }
#undef IN
#undef SEAM
}

template <int P> static void launch_phase(int grid, hipStream_t stream, Args a) {
    (void)hipFuncSetAttribute((const void*)mk_fwd<P, P + 1>, hipFuncAttributeMaxDynamicSharedMemorySize, LDS_BYTES);
    a.ph_lo = P; a.ph_hi = P + 1; hipLaunchKernelGGL((mk_fwd<P, P + 1>), dim3(grid), dim3(NTHREADS), LDS_BYTES, stream, a);
}
extern "C" void kernel_launch(void* const* d_in, const int* in_sizes, int n_in, void* d_out, int out_size, void* d_ws, size_t ws_size, hipStream_t stream) {
    static int grid = 0;
    if (grid == 0) {
        if (n_in != 26 || out_size != NTOK * DM || ws_size < WS_END) { fprintf(stderr, "kernel_launch: unexpected shapes (n_in %d out %d ws %zu)\n", n_in, out_size, ws_size); grid = -1; return; }
        int dev = 0, cus = 0, per_cu = 0;
        (void)hipGetDevice(&dev); (void)hipDeviceGetAttribute(&cus, hipDeviceAttributeMultiprocessorCount, dev);
#if MK_N_LAUNCHES == 1
        (void)hipFuncSetAttribute((const void*)mk_fwd<0, NPHASE>, hipFuncAttributeMaxDynamicSharedMemorySize, LDS_BYTES);
        (void)hipOccupancyMaxActiveBlocksPerMultiprocessor(&per_cu, (const void*)mk_fwd<0, NPHASE>, NTHREADS, LDS_BYTES);
#else
        (void)hipOccupancyMaxActiveBlocksPerMultiprocessor(&per_cu, (const void*)mk_fwd<2, 3>, NTHREADS, LDS_BYTES);
#endif
        (void)hipGetLastError();
        if (per_cu < 1) { fprintf(stderr, "kernel_launch: occupancy query says %d blocks per CU\n", per_cu); }
        grid = cus;
    }
    if (grid < 0) return;
    (void)hipMemsetAsync((char*)d_ws + WS_CTL, 0, CTL_ZERO_BYTES, stream);
    Args a{};
    for (int i = 0; i < 26; ++i) a.in[i] = d_in[i];
    a.out = (float*)d_out; a.ws = (unsigned char*)d_ws;
#if MK_N_LAUNCHES == 1
    a.ph_lo = 0; a.ph_hi = NPHASE; hipLaunchKernelGGL((mk_fwd<0, NPHASE>), dim3(grid), dim3(NTHREADS), LDS_BYTES, stream, a);
#else
#ifndef MK_REPMASK
#define MK_REPMASK 0
#endif
    for (int r = 0; r < ((MK_REPMASK & 1) ? 2 : 1); ++r) launch_phase<0>(grid, stream, a);
    for (int r = 0; r < ((MK_REPMASK & 2) ? 2 : 1); ++r) launch_phase<1>(grid, stream, a);
    for (int r = 0; r < ((MK_REPMASK & 4) ? 2 : 1); ++r) launch_phase<2>(grid, stream, a);
    for (int r = 0; r < ((MK_REPMASK & 8) ? 2 : 1); ++r) launch_phase<3>(grid, stream, a);
    for (int r = 0; r < ((MK_REPMASK & 16) ? 2 : 1); ++r) launch_phase<4>(grid, stream, a);
    for (int r = 0; r < ((MK_REPMASK & 32) ? 2 : 1); ++r) launch_phase<5>(grid, stream, a);
    launch_phase<6>(grid, stream, a);
    for (int r = 0; r < ((MK_REPMASK & 128) ? 2 : 1); ++r) launch_phase<7>(grid, stream, a);
    for (int r = 0; r < ((MK_REPMASK & 256) ? 2 : 1); ++r) launch_phase<8>(grid, stream, a);
    launch_phase<9>(grid, stream, a);
    if (MK_REPMASK & 512) { launch_phase<5>(grid, stream, a); launch_phase<9>(grid, stream, a); }
#endif
}
```
